# Optimizing an MI355X kernel written in HIP

```python
import math
import jax, jax.numpy as jnp
from jax import lax
import numpy as np

D_MODEL = 1024
BATCH = 8
SEQ = 4096
DEPTH = 1

GRID_W = 64
CTX_LEN = 256
N_HEADS = 8
HEAD_DIM = 64
V_DIM = 2 * HEAD_DIM
ATTN_WIDTH = N_HEADS * V_DIM
QK_WIDTH = N_HEADS * 2 * HEAD_DIM
D_CONV = D_MODEL
CONV_WIDTH = 31
N_EXPERTS = 16
CAPACITY_FACTOR = 2
D_FF_EXPERT = 2816
ROPE_THETA = 10000.0
Q_BLOCK = 128
EPS = 1e-6
N_MOD = 6
PROJ_WIDTH = 2 * D_CONV + 2 * QK_WIDTH + ATTN_WIDTH + 2 * D_MODEL

kernel_name = "hybrid_conv_diffattn_ecmoe_dit_layer"


def rmsnorm(x, g):
    xf = x.astype(jnp.float32)
    y = xf * lax.rsqrt(jnp.mean(xf * xf, axis=-1, keepdims=True) + EPS)
    return (y * g.astype(jnp.float32)).astype(x.dtype)


def layernorm(x, g, b):
    xf = x.astype(jnp.float32)
    mu = jnp.mean(xf, axis=-1, keepdims=True)
    xc = xf - mu
    y = xc * lax.rsqrt(jnp.mean(xc * xc, axis=-1, keepdims=True) + EPS)
    return (y * g.astype(jnp.float32) + b.astype(jnp.float32)).astype(x.dtype)


def modulate(h, shift, scale):
    return h * (1 + scale) + shift


def axial_rope_tables(n_tokens):
    rows = n_tokens // GRID_W
    row = jnp.repeat(jnp.arange(rows), GRID_W)
    col = jnp.tile(jnp.arange(GRID_W), rows)
    n_freq = HEAD_DIM // 4
    inv = ROPE_THETA ** (-jnp.arange(n_freq, dtype=jnp.float32) / n_freq)
    ang_r = row[:, None].astype(jnp.float32) * inv
    ang_c = col[:, None].astype(jnp.float32) * inv
    return jnp.cos(ang_r), jnp.sin(ang_r), jnp.cos(ang_c), jnp.sin(ang_c)


def rope_1d(x, cos, sin):
    x1, x2 = jnp.split(x, 2, axis=-1)
    return jnp.concatenate([x1 * cos - x2 * sin, x1 * sin + x2 * cos], axis=-1)


def apply_axial_rope(x, tables):
    cos_r, sin_r, cos_c, sin_c = [t[:, None, None, :].astype(x.dtype) for t in tables]
    xr, xc = jnp.split(x, 2, axis=-1)
    return jnp.concatenate([rope_1d(xr, cos_r, sin_r), rope_1d(xc, cos_c, sin_c)], axis=-1)


def split_projection(p):
    sizes = [D_CONV, D_CONV, QK_WIDTH, QK_WIDTH, ATTN_WIDTH, D_MODEL, D_MODEL]
    cuts = list(np.cumsum(sizes)[:-1])
    return jnp.split(p, cuts, axis=-1)


def conv_branch(a, b, w_dw, b_dw, ln_g, ln_b, w_o, b_o):
    u = a * jax.nn.sigmoid(b)
    u = lax.conv_general_dilated(
        u, w_dw[:, None, :].astype(u.dtype), window_strides=(1,),
        padding=[(CONV_WIDTH // 2, CONV_WIDTH // 2)],
        dimension_numbers=("NWC", "WIO", "NWC"), feature_group_count=D_CONV) + b_dw
    u = jax.nn.silu(layernorm(u, ln_g, ln_b))
    return u @ w_o + b_o


def diff_weights(q, k, lam):
    logits = jnp.einsum("bqhmd,bkhmd->bhmqk", q, k).astype(jnp.float32) * (HEAD_DIM ** -0.5)
    p = jax.nn.softmax(logits, axis=-1)
    return p[:, :, 0] - lam * p[:, :, 1]


def diff_attention_blocks(q, k, v, lam):
    bsz, t = q.shape[0], q.shape[1]
    n_blk = t // Q_BLOCK
    qb = q.reshape(bsz, n_blk, Q_BLOCK, N_HEADS, 2, HEAD_DIM).swapaxes(0, 1)

    def one_block(q_blk):
        w = diff_weights(q_blk, k, lam)
        return jnp.einsum("bhqk,bkhe->bqhe", w.astype(v.dtype), v)

    out = lax.map(one_block, qb)
    return out.swapaxes(0, 1).reshape(bsz, t, N_HEADS, V_DIM)


def diff_head_out(o, g_subln, lam_init, w_o):
    bsz, t = o.shape[0], o.shape[1]
    o = rmsnorm(o, g_subln) * (1.0 - lam_init)
    return o.reshape(bsz, t, ATTN_WIDTH) @ w_o


def ec_moe(h, w_router, w_g, w_u, w_d):
    bsz, t = h.shape[0], h.shape[1]
    cap = CAPACITY_FACTOR * t // N_EXPERTS
    aff = jax.nn.softmax(jnp.einsum("btd,de->bte", h, w_router).astype(jnp.float32), axis=-1)
    gates, idx = lax.top_k(aff.transpose(0, 2, 1), cap)
    bidx = jnp.arange(bsz)[:, None, None]
    xs = h[bidx, idx]
    hid = jax.nn.silu(jnp.einsum("becd,edf->becf", xs, w_g)) * jnp.einsum("becd,edf->becf", xs, w_u)
    ys = jnp.einsum("becf,efd->becd", hid, w_d) * gates[..., None].astype(h.dtype)
    return jnp.zeros_like(h).at[bidx, idx].add(ys)


def setup_inputs(seed: int = 0) -> dict:
    key = jax.random.key(seed)
    ks = jax.random.split(key, 32)
    f32 = jnp.float32

    def nrm(k, shape, scale):
        return jax.random.normal(k, shape, f32) * scale

    L = DEPTH
    return {
        "x": nrm(ks[0], (BATCH, SEQ, D_MODEL), 1.0),
        "c": nrm(ks[1], (BATCH, D_MODEL), 1.0),
        "ctx": nrm(ks[2], (BATCH, CTX_LEN, D_MODEL), 1.0),
        "c_ctx": nrm(ks[3], (D_MODEL,), 1.0),
        "w_ada": nrm(ks[4], (L, D_MODEL, N_MOD * D_MODEL), 0.5 * D_MODEL ** -0.5),
        "b_ada": nrm(ks[5], (L, N_MOD * D_MODEL), 0.02),
        "g_norm_mix": 1.0 + nrm(ks[6], (L, D_MODEL), 0.02),
        "g_norm_ffn": 1.0 + nrm(ks[7], (L, D_MODEL), 0.02),
        "w_in": nrm(ks[8], (L, D_MODEL, PROJ_WIDTH), D_MODEL ** -0.5),
        "w_dw": nrm(ks[9], (L, CONV_WIDTH, D_CONV), CONV_WIDTH ** -0.5),
        "b_dw": nrm(ks[10], (L, D_CONV), 0.02),
        "ln_g_conv": 1.0 + nrm(ks[11], (L, D_CONV), 0.02),
        "ln_b_conv": nrm(ks[12], (L, D_CONV), 0.02),
        "w_conv_out": nrm(ks[13], (L, D_CONV, D_MODEL), D_CONV ** -0.5),
        "b_conv_out": nrm(ks[14], (L, D_MODEL), 0.02),
        "lambda_q1": nrm(ks[15], (L, HEAD_DIM), 0.1),
        "lambda_k1": nrm(ks[16], (L, HEAD_DIM), 0.1),
        "lambda_q2": nrm(ks[17], (L, HEAD_DIM), 0.1),
        "lambda_k2": nrm(ks[18], (L, HEAD_DIM), 0.1),
        "g_subln": 1.0 + nrm(ks[19], (L, V_DIM), 0.02),
        "w_attn_out": nrm(ks[20], (L, ATTN_WIDTH, D_MODEL), ATTN_WIDTH ** -0.5),
        "w_out": nrm(ks[21], (L, D_MODEL, D_MODEL), D_MODEL ** -0.5),
        "w_router": nrm(ks[22], (L, D_MODEL, N_EXPERTS), D_MODEL ** -0.5),
        "w_expert_gate": nrm(ks[23], (L, N_EXPERTS, D_MODEL, D_FF_EXPERT), D_MODEL ** -0.5),
        "w_expert_up": nrm(ks[24], (L, N_EXPERTS, D_MODEL, D_FF_EXPERT), D_MODEL ** -0.5),
        "w_expert_down": nrm(ks[25], (L, N_EXPERTS, D_FF_EXPERT, D_MODEL), D_FF_EXPERT ** -0.5),
        "g_final": 1.0 + nrm(ks[26], (D_MODEL,), 0.02),
    }


def reference(x, c, ctx, c_ctx, w_ada, b_ada, g_norm_mix, g_norm_ffn, w_in, w_dw, b_dw,
              ln_g_conv, ln_b_conv, w_conv_out, b_conv_out, lambda_q1, lambda_k1, lambda_q2,
              lambda_k2, g_subln, w_attn_out, w_out, w_router, w_expert_gate, w_expert_up,
              w_expert_down, g_final):
    bsz, t = x.shape[0], x.shape[1]
    n_ctx = ctx.shape[1]
    rope = axial_rope_tables(t)

    for l in range(DEPTH):
        last = l == DEPTH - 1
        lam_init = 0.8 - 0.6 * math.exp(-0.3 * l)
        lam = (jnp.exp(jnp.sum(lambda_q1[l].astype(jnp.float32) * lambda_k1[l].astype(jnp.float32)))
               - jnp.exp(jnp.sum(lambda_q2[l].astype(jnp.float32) * lambda_k2[l].astype(jnp.float32)))
               + lam_init)

        mod_lat = (jax.nn.silu(c) @ w_ada[l] + b_ada[l])[:, None, :]
        mod_ctx = jax.nn.silu(c_ctx) @ w_ada[l] + b_ada[l]
        sh_m, sc_m, g_m, sh_f, sc_f, g_f = jnp.split(mod_lat, N_MOD, axis=-1)
        csh_m, csc_m, cg_m, csh_f, csc_f, cg_f = jnp.split(mod_ctx, N_MOD, axis=-1)

        h_lat = modulate(rmsnorm(x, g_norm_mix[l]), sh_m, sc_m)
        h_ctx = modulate(rmsnorm(ctx, g_norm_mix[l]), csh_m, csc_m)
        a_l, b_l, q_l, k_l, v_l, gc_l, ga_l = split_projection(h_lat @ w_in[l])
        a_c, b_c, q_c, k_c, v_c, gc_c, ga_c = split_projection(h_ctx @ w_in[l])

        q_l = apply_axial_rope(q_l.reshape(bsz, t, N_HEADS, 2, HEAD_DIM), rope)
        k_l = apply_axial_rope(k_l.reshape(bsz, t, N_HEADS, 2, HEAD_DIM), rope)
        v_l = v_l.reshape(bsz, t, N_HEADS, V_DIM)
        k_c = k_c.reshape(bsz, n_ctx, N_HEADS, 2, HEAD_DIM)
        v_c = v_c.reshape(bsz, n_ctx, N_HEADS, V_DIM)

        keys = jnp.concatenate([k_l, k_c], axis=1)
        vals = jnp.concatenate([v_l, v_c], axis=1)
        y_attn_l = diff_head_out(diff_attention_blocks(q_l, keys, vals, lam), g_subln[l], lam_init, w_attn_out[l])
        y_conv_l = conv_branch(a_l, b_l, w_dw[l], b_dw[l], ln_g_conv[l], ln_b_conv[l], w_conv_out[l], b_conv_out[l])
        mix_l = (jax.nn.sigmoid(ga_l) * y_attn_l + jax.nn.sigmoid(gc_l) * y_conv_l) @ w_out[l]

        if not last:
            q_c = q_c.reshape(bsz, n_ctx, N_HEADS, 2, HEAD_DIM)
            w_cc = diff_weights(q_c, k_c, lam)
            o_c = jnp.einsum("bhqk,bkhe->bqhe", w_cc.astype(v_c.dtype), v_c)
            y_attn_c = diff_head_out(o_c, g_subln[l], lam_init, w_attn_out[l])
            y_conv_c = conv_branch(a_c, b_c, w_dw[l], b_dw[l], ln_g_conv[l], ln_b_conv[l], w_conv_out[l], b_conv_out[l])
            mix_c = (jax.nn.sigmoid(ga_c) * y_attn_c + jax.nn.sigmoid(gc_c) * y_conv_c) @ w_out[l]
            ctx = ctx + cg_m * mix_c
            hf_c = modulate(rmsnorm(ctx, g_norm_ffn[l]), csh_f, csc_f)
            ctx = ctx + cg_f * ec_moe(hf_c, w_router[l], w_expert_gate[l], w_expert_up[l], w_expert_down[l])

        x = x + g_m * mix_l

        hf_l = modulate(rmsnorm(x, g_norm_ffn[l]), sh_f, sc_f)
        x = x + g_f * ec_moe(hf_l, w_router[l], w_expert_gate[l], w_expert_up[l], w_expert_down[l])

    return rmsnorm(x, g_final)
```

```cpp
#include <hip/hip_runtime.h>
#include <cstdio>
#include <cstdint>

#ifndef MK_N_LAUNCHES
#define MK_N_LAUNCHES 1
#endif

#define LAS __attribute__((address_space(3)))
typedef unsigned short bf16_t;
typedef short bf16x8 __attribute__((ext_vector_type(8)));
typedef short s16x4 __attribute__((ext_vector_type(4)));
typedef float f32x2 __attribute__((ext_vector_type(2)));
typedef float f32x4 __attribute__((ext_vector_type(4)));
typedef float f32x16 __attribute__((ext_vector_type(16)));
typedef unsigned u32x2 __attribute__((ext_vector_type(2)));
typedef unsigned u32x4 __attribute__((ext_vector_type(4)));

constexpr int NB = 8, NT = 4096, DM = 1024, NCX = 256, NHD = 8, NEXP = 16, CAP = 512, DFF = 2816;
constexpr int MLAT = NB * NT, MCTX = NB * NCX, MALL = MLAT + MCTX, KVR = NT + NCX;
constexpr int NPROJ = 7168, NMOD = 6 * DM;
constexpr float EPS = 1e-6f;
constexpr float QSCALE = 0.125f * 1.4426950408889634f;

constexpr size_t MiB = 1u << 20;
constexpr size_t WS_CTL = 0, CTL_ZERO_BYTES = 65536;
constexpr size_t WS_MOD = 65536;
constexpr size_t WS_ROPE = 294912;
constexpr size_t WS_AFF = 1 * MiB;
constexpr size_t WS_SEL = 3 * MiB;
constexpr size_t WS_WIN = 8 * MiB, WS_WCO = 22 * MiB, WS_WAO = 24 * MiB, WS_WO = 26 * MiB;
constexpr size_t WS_H = 28 * MiB;
constexpr size_t WS_ATTO = 28 * MiB;
constexpr size_t WS_U = 96 * MiB;
constexpr size_t WS_MIX = 96 * MiB;
constexpr size_t WS_Q = 160 * MiB;
constexpr size_t WS_K = 224 * MiB;
constexpr size_t WS_V = 292 * MiB;
constexpr size_t WS_GC = 360 * MiB, WS_GA = 424 * MiB;
constexpr size_t WS_CACT = 488 * MiB;
constexpr size_t WS_O1 = 552 * MiB;
constexpr size_t WS_WGU = 8 * MiB;
constexpr size_t WS_XS = 184 * MiB;
constexpr size_t WS_HF = 312 * MiB;
constexpr size_t WS_HID = 312 * MiB;
constexpr size_t WS_WD = 184 * MiB;
constexpr size_t WS_YS = 8 * MiB;
constexpr size_t WS_END = 680 * MiB;

constexpr int RING_BYTES = 131072, LDSCTL_OFF = RING_BYTES, LDS_BYTES = 147456;

#define LDS_WAIT() asm volatile("s_waitcnt lgkmcnt(0)" ::: "memory")
#define VM_WAIT() asm volatile("s_waitcnt vmcnt(0)" ::: "memory")
__device__ __forceinline__ unsigned cvt_pk_bf16(float lo, float hi) { unsigned r; asm volatile("v_cvt_pk_bf16_f32 %0, %1, %2" : "=v"(r) : "v"(lo), "v"(hi)); return r; }
__device__ __forceinline__ float bf_lo(unsigned u) { return __uint_as_float(u << 16); }
__device__ __forceinline__ float bf_hi(unsigned u) { return __uint_as_float(u & 0xffff0000u); }
__device__ __forceinline__ float wave_sum(float v) {
#pragma unroll
    for (int o = 1; o < 64; o <<= 1) v += __shfl_xor(v, o);
    return v;
}
__device__ __forceinline__ float sigmoidf_(float x) { return __builtin_amdgcn_rcpf(1.0f + __expf(-x)); }

#define XB_TMO      128
#define XB_XCNT(j)  (256  + 64 * (j))
#define XB_XSUB(j)  (1280 + 64 * (j))
#define XB_XGEN(j)  (2304 + 64 * (j))
#define XB_TOP      3328
#define XB_TOPGEN   3392
#define XCD_BAR_WORDS 3456
#define XB_SPIN_CAP (1u << 18)
__device__ __forceinline__ unsigned xb_ld(unsigned* p)              { return __hip_atomic_load(p, __ATOMIC_RELAXED, __HIP_MEMORY_SCOPE_AGENT); }
__device__ __forceinline__ unsigned xb_add(unsigned* p, unsigned v) { return __hip_atomic_fetch_add(p, v, __ATOMIC_RELAXED, __HIP_MEMORY_SCOPE_AGENT); }
__device__ __forceinline__ unsigned xb_xcc_id() { return (unsigned)__builtin_amdgcn_s_getreg((3 << 11) | 20) & 0xFu; }
#define XB_SPIN(cond, bar) do { unsigned _sp = 0; while (cond) { __builtin_amdgcn_s_sleep(1); \
    if ((++_sp & 255u) == 0u) { if (xb_ld(&(bar)[XB_TMO])) break; if (_sp > XB_SPIN_CAP) { atomicAdd(&(bar)[XB_TMO], 1u); break; } } } } while (0)
struct XcdBarrier { unsigned* bar; unsigned x; volatile LAS unsigned* st; };
__device__ __forceinline__ XcdBarrier xcd_barrier_post(unsigned* bar, volatile LAS unsigned* st) {
    XcdBarrier b; b.bar = bar; b.x = xb_xcc_id(); b.st = st;
    if (threadIdx.x == 0) (void)xb_add(&bar[XB_XCNT(b.x)], 1u);
    return b;
}
__device__ __forceinline__ void xcd_barrier_complete(unsigned* bar, unsigned x, unsigned& nloc, unsigned& nx) {
    const unsigned G = gridDim.x * gridDim.y * gridDim.z;
    unsigned sum, cnt, mine, sp = 0u;
    for (;;) {
        sum = 0u; cnt = 0u; mine = 0u;
#pragma unroll
        for (unsigned j = 0; j < 16; ++j) { const unsigned c = xb_ld(&bar[XB_XCNT(j)]); sum += c; cnt += (c > 0u) ? 1u : 0u; mine = (j == x) ? c : mine; }
        if (sum == G) break;
        __builtin_amdgcn_s_sleep(1);
        if ((++sp & 255u) == 0u) { if (xb_ld(&bar[XB_TMO])) break; if (sp > XB_SPIN_CAP) { atomicAdd(&bar[XB_TMO], 1u); break; } }
    }
    nloc = mine > 0u ? mine : 1u; nx = cnt > 0u ? cnt : 1u;
}
__device__ __forceinline__ void xcd_barrier(const XcdBarrier& b) {
    asm volatile("s_waitcnt vmcnt(0)" ::: "memory");
    __syncthreads();
    if (threadIdx.x == 0) {
        unsigned* bar = b.bar;
        __builtin_amdgcn_s_waitcnt(0);
        unsigned nloc = b.st[0], nx = b.st[1];
        if (nloc == 0u) { xcd_barrier_complete(bar, b.x, nloc, nx); b.st[0] = nloc; b.st[1] = nx; }
        const unsigned old = xb_add(&bar[XB_XSUB(b.x)], 1u);
        const unsigned gen = old / nloc;
        if (old + 1u == (gen + 1u) * nloc) {
            __builtin_amdgcn_fence(__ATOMIC_RELEASE, "agent");
            asm volatile("s_waitcnt vmcnt(0)" ::: "memory");
            const unsigned og = xb_add(&bar[XB_TOP], 1u);
            const unsigned tg = og / nx;
            if (og + 1u == (tg + 1u) * nx) xb_add(&bar[XB_TOPGEN], 1u);
            else XB_SPIN(xb_ld(&bar[XB_TOPGEN]) == tg, bar);
            __builtin_amdgcn_fence(__ATOMIC_ACQUIRE, "agent");
            xb_add(&bar[XB_XGEN(b.x)], 1u);
            asm volatile("s_waitcnt vmcnt(0)" ::: "memory");
        } else {
            XB_SPIN(xb_ld(&bar[XB_XGEN(b.x)]) == gen, bar);
            __builtin_amdgcn_fence(__ATOMIC_ACQUIRE, "agent");
            asm volatile("s_waitcnt vmcnt(0)" ::: "memory");
        }
    }
    __syncthreads();
}

namespace pg8 {
constexpr int BM = 256, BK = 64, HALF = 128, HTB = HALF * BK * 2, STAGE_BYTES = 8 * HTB, NXCD = 8, WGM = 8;
__host__ __device__ __forceinline__ int lds_byte(int r, int c) { const int st = (r >> 4) * 2 + (c >> 5), rr = r & 15, cc = c & 31, ob = rr * 64 + cc * 2; return st * 1024 + (ob ^ (((ob >> 9) & 1) << 5)); }
__host__ __device__ __forceinline__ void stage_rc(int b, int& R, int& C) { const int st = b / 1024, sb = b % 1024, swz = sb ^ (((sb >> 9) & 1) << 5); R = (st >> 1) * 16 + swz / 64; C = (st & 1) * 32 + (swz % 64) / 2; }
__host__ __device__ __forceinline__ int perm32(int rho) { const int n = rho >> 4, i = rho & 15; return 8 * (i >> 2) + 4 * n + (i & 3); }

struct Unit { int pm, pn, aux; };

__device__ __forceinline__ void tile_of(int L, int nM, int nN, int& pm, int& pn) {
    const int nwg = nM * nN; int wgid = L;
    { const int q = nwg / NXCD, r = nwg % NXCD, xcd = wgid % NXCD, off = wgid / NXCD; wgid = (xcd < r ? xcd * (q + 1) : r * (q + 1) + (xcd - r) * q) + off; }
    const int nig = WGM * nN, gid = wgid / nig, fm = gid * WGM, gsz = (nM - fm) < WGM ? (nM - fm) : WGM;
    pm = fm + ((wgid % nig) % gsz); pn = (wgid % nig) / gsz;
}

template <class Epi, class Sched, bool ALIGN_EPI, bool SP2>
__device__ __forceinline__ void gemm_phase(LAS unsigned char* lds, const int K, const Sched& S, const Epi& E) {
    const int tid = threadIdx.x, wid = __builtin_amdgcn_readfirstlane(tid >> 6), lane = tid & 63, wr = wid >> 2, wc = wid & 3, fr = lane & 15, fq = lane >> 4;
    const int nt = K / BK;
    unsigned voffA[2], voffB[2];
#pragma unroll
    for (int i = 0; i < 2; ++i) { int R, C; stage_rc(tid * 16 + i * 8192, R, C); const int Rb = Epi::PERM ? ((R & ~31) + perm32(R & 31)) : R;
        voffA[i] = (unsigned)(R * K + C) * 2u; voffB[i] = (unsigned)(Rb * K + C) * 2u; }
    const size_t kstep = (size_t)(BK * 2);
    const size_t hstep = (size_t)HALF * K * 2;
    const unsigned ldsw = (unsigned)wid * 1024u;
    const int aoff = lds_byte(wr * 64 + fr, fq * 8), boff = lds_byte(wc * 32 + fr, fq * 8);
#define PG8_SA(b, h) (((b) * 2 + (h)) * HTB)
#define PG8_SB(b, h) ((4 + (b) * 2 + (h)) * HTB)
#define PG8_STAGE(bufoff, gbase, voff) do { _Pragma("unroll") for (int _i = 0; _i < 2; ++_i) \
        __builtin_amdgcn_global_load_lds((const unsigned*)((const char*)(gbase) + (voff)[_i]), (LAS unsigned*)(lds + (bufoff) + ldsw + _i * 8192), 16, 0, 0); } while (0)
#define PG8_LDA(dst, b, h) do { _Pragma("unroll") for (int m = 0; m < 4; ++m) _Pragma("unroll") for (int k = 0; k < 2; ++k) dst[m][k] = *(const LAS bf16x8*)(lds + PG8_SA(b, h) + aoff + m * 2048 + k * 1024); } while (0)
#define PG8_LDB(dst, b, h) do { _Pragma("unroll") for (int n = 0; n < 2; ++n) _Pragma("unroll") for (int k = 0; k < 2; ++k) dst[n][k] = *(const LAS bf16x8*)(lds + PG8_SB(b, h) + boff + n * 2048 + k * 1024); } while (0)
#define PG8_MMA(ai, bj, At, Bt) do { __builtin_amdgcn_s_setprio(1); _Pragma("unroll") for (int m = 0; m < 4; ++m) _Pragma("unroll") for (int n = 0; n < 2; ++n) _Pragma("unroll") for (int k = 0; k < 2; ++k) \
        acc[ai][bj][m][n] = __builtin_amdgcn_mfma_f32_16x16x32_bf16(Bt[n][k], At[m][k], acc[ai][bj][m][n], 0, 0, 0); __builtin_amdgcn_s_setprio(0); } while (0)
#define PG8_WAIT_V(n) asm volatile("s_waitcnt vmcnt(" #n ")" ::: "memory")
#define PG8_WAIT_L(n) asm volatile("s_waitcnt lgkmcnt(" #n ")" ::: "memory")
#define PG8_BAR __builtin_amdgcn_s_barrier()
#define PG8_SCHED __builtin_amdgcn_sched_barrier(0)
    Unit cur, nxt; int ui = 0;
    if (!S.next(0, cur)) return;
    f32x4 acc[2][2][4][2];
#pragma unroll
    for (int a = 0; a < 2; ++a)
#pragma unroll
        for (int b = 0; b < 2; ++b)
#pragma unroll
            for (int m = 0; m < 4; ++m)
#pragma unroll
                for (int n = 0; n < 2; ++n) acc[a][b][m][n] = (f32x4){0.f, 0.f, 0.f, 0.f};
    bf16x8 At[4][2], B0[2][2], B1[2][2];
    const char* cA = S.a_ptr(cur); const char* cB = S.b_ptr(cur);
    if constexpr (SP2) {
        PG8_STAGE(PG8_SB(0, 0), cB, voffB); PG8_STAGE(PG8_SB(0, 1), cB + hstep, voffB); PG8_STAGE(PG8_SA(0, 0), cA, voffA); PG8_STAGE(PG8_SA(0, 1), cA + hstep, voffA);
        if (wr == 1) PG8_BAR;
        PG8_WAIT_V(2); PG8_BAR;
        PG8_STAGE(PG8_SB(1, 0), cB + kstep, voffB); PG8_STAGE(PG8_SA(1, 0), cA + kstep, voffA); PG8_STAGE(PG8_SB(1, 1), cB + hstep + kstep, voffB);
        PG8_WAIT_V(6); PG8_BAR;
    } else {
        PG8_STAGE(PG8_SB(0, 0), cB, voffB); PG8_STAGE(PG8_SA(0, 0), cA, voffA); PG8_STAGE(PG8_SB(0, 1), cB + hstep, voffB); PG8_STAGE(PG8_SA(0, 1), cA + hstep, voffA);
        if (wr == 1) PG8_BAR;
        PG8_WAIT_V(4); PG8_BAR;
        PG8_STAGE(PG8_SB(1, 0), cB + kstep, voffB); PG8_STAGE(PG8_SA(1, 0), cA + kstep, voffA); PG8_STAGE(PG8_SB(1, 1), cB + hstep + kstep, voffB);
        PG8_WAIT_V(6); PG8_BAR;
    }
    for (;;) {
        const bool has_next = S.next(ui + 1, nxt);
        const char* nA = has_next ? S.a_ptr(nxt) : cA; const char* nB = has_next ? S.b_ptr(nxt) : cB;
        for (int t = 0; t < nt; t += 2) {
            const bool last = (t == nt - 2);
            const char* a1 = cA + (size_t)(t + 1) * kstep;
            const char* a2 = last ? nA : cA + (size_t)(t + 2) * kstep; const char* b2 = last ? nB : cB + (size_t)(t + 2) * kstep;
            const char* a3 = a2 + kstep; const char* b3 = b2 + kstep;
            if constexpr (SP2) {
            PG8_LDB(B0, 0, 0); PG8_LDB(B1, 0, 1); PG8_SCHED; PG8_LDA(At, 0, 0); PG8_STAGE(PG8_SA(1, 1), a1 + hstep, voffA);
            PG8_WAIT_V(8); PG8_WAIT_L(0); PG8_BAR; PG8_MMA(0, 0, At, B0); PG8_MMA(0, 1, At, B1); PG8_BAR; PG8_SCHED;
            PG8_LDA(At, 0, 1); PG8_STAGE(PG8_SB(0, 0), b2, voffB); PG8_STAGE(PG8_SB(0, 1), b2 + hstep, voffB); PG8_STAGE(PG8_SA(0, 0), a2, voffA);
            PG8_WAIT_V(8); PG8_WAIT_L(0); PG8_BAR; PG8_MMA(1, 0, At, B0); PG8_MMA(1, 1, At, B1); PG8_BAR; PG8_SCHED;
            PG8_LDB(B0, 1, 0); PG8_LDB(B1, 1, 1); PG8_SCHED; PG8_LDA(At, 1, 0); PG8_STAGE(PG8_SA(0, 1), a2 + hstep, voffA);
            PG8_WAIT_V(8); PG8_WAIT_L(0); PG8_BAR; PG8_MMA(0, 0, At, B0); PG8_MMA(0, 1, At, B1); PG8_BAR; PG8_SCHED;
            PG8_LDA(At, 1, 1); PG8_STAGE(PG8_SB(1, 0), b3, voffB); PG8_STAGE(PG8_SB(1, 1), b3 + hstep, voffB); PG8_STAGE(PG8_SA(1, 0), a3, voffA);
            PG8_WAIT_V(8); PG8_WAIT_L(0); PG8_BAR; PG8_MMA(1, 0, At, B0); PG8_MMA(1, 1, At, B1); PG8_BAR; PG8_SCHED;
            } else {
            PG8_LDB(B0, 0, 0); PG8_SCHED; PG8_LDA(At, 0, 0); PG8_STAGE(PG8_SA(1, 1), a1 + hstep, voffA);
            PG8_WAIT_L(8); PG8_BAR; PG8_WAIT_L(0); PG8_MMA(0, 0, At, B0); PG8_BAR; PG8_SCHED;
            PG8_LDB(B1, 0, 1); PG8_STAGE(PG8_SB(0, 0), b2, voffB);
            PG8_BAR; PG8_WAIT_L(0); PG8_MMA(0, 1, At, B1); PG8_BAR;
            PG8_LDA(At, 0, 1); PG8_STAGE(PG8_SA(0, 0), a2, voffA);
            PG8_BAR; PG8_WAIT_L(0); PG8_MMA(1, 0, At, B0); PG8_BAR; PG8_SCHED;
            PG8_STAGE(PG8_SB(0, 1), b2 + hstep, voffB);
            PG8_WAIT_V(6); PG8_BAR; PG8_MMA(1, 1, At, B1); PG8_BAR;
            PG8_LDB(B0, 1, 0); PG8_SCHED; PG8_LDA(At, 1, 0); PG8_STAGE(PG8_SA(0, 1), a2 + hstep, voffA);
            PG8_WAIT_L(8); PG8_BAR; PG8_WAIT_L(0); PG8_MMA(0, 0, At, B0); PG8_BAR; PG8_SCHED;
            PG8_LDB(B1, 1, 1); PG8_STAGE(PG8_SB(1, 0), b3, voffB);
            PG8_BAR; PG8_WAIT_L(0); PG8_MMA(0, 1, At, B1); PG8_BAR;
            PG8_LDA(At, 1, 1); PG8_STAGE(PG8_SA(1, 0), a3, voffA);
            PG8_BAR; PG8_WAIT_L(0); PG8_MMA(1, 0, At, B0); PG8_BAR; PG8_SCHED;
            PG8_STAGE(PG8_SB(1, 1), b3 + hstep, voffB);
            PG8_WAIT_V(6); PG8_BAR; PG8_MMA(1, 1, At, B1); PG8_BAR;
            }
        }
        if constexpr (ALIGN_EPI) { if (wr == 0) PG8_BAR; }
        E(acc, cur, wr, wc, fr, fq);
        if (!has_next) break;
        if (!S.keep(cur)) {
#pragma unroll
            for (int a = 0; a < 2; ++a)
#pragma unroll
                for (int b = 0; b < 2; ++b)
#pragma unroll
                    for (int m = 0; m < 4; ++m)
#pragma unroll
                        for (int n = 0; n < 2; ++n) acc[a][b][m][n] = (f32x4){0.f, 0.f, 0.f, 0.f};
        }
        cur = nxt; cA = nA; cB = nB; ++ui;
        if constexpr (ALIGN_EPI) { if (wr == 1) PG8_BAR; }
    }
    PG8_WAIT_V(0);
    if constexpr (!ALIGN_EPI) { if (wr == 0) PG8_BAR; }
    PG8_BAR;
#undef PG8_SA
#undef PG8_SB
#undef PG8_STAGE
#undef PG8_LDA
#undef PG8_LDB
#undef PG8_MMA
#undef PG8_WAIT_V
#undef PG8_WAIT_L
#undef PG8_BAR
#undef PG8_SCHED
}
}
using pg8::Unit;

#ifndef PG8_SP2
#define PG8_SP2 true
#endif
#ifndef PG8_ALIGN
#define PG8_ALIGN true
#endif

enum InIdx { I_X = 0, I_C, I_CTX, I_CCTX, I_WADA, I_BADA, I_GMIX, I_GFFN, I_WIN, I_WDW, I_BDW, I_LNG, I_LNB, I_WCO, I_BCO, I_LQ1, I_LK1, I_LQ2, I_LK2, I_GSUB, I_WAO, I_WOUT, I_WR, I_WEG, I_WEU, I_WED, I_GFIN, N_IN };
struct Args { const float* in[N_IN]; float* out; unsigned char* ws; int ph_lo, ph_hi, li, pad; };

__device__ __forceinline__ void ph_adaln(const Args& a, LAS unsigned char* lds, int bid, int G) {
    const int tid = threadIdx.x;
    LAS float* sil = (LAS float*)lds;
    LAS float* red = sil + 9 * 1024;
    const float* c = a.in[I_C]; const float* cc = a.in[I_CCTX]; const float* w = a.in[I_WADA]; const float* bb = a.in[I_BADA];
    float* mod = (float*)(a.ws + WS_MOD);
    for (int i = tid; i < 9 * 1024; i += 512) { const float v = (i < 8192) ? c[i] : cc[i - 8192]; sil[i] = v / (1.0f + expf(-v)); }
    __syncthreads();
    for (int unit = bid; unit < NMOD / 32; unit += G) {
        const int n0 = unit * 32, col = tid & 31, kp = tid >> 5;
        float acc[9];
#pragma unroll
        for (int r = 0; r < 9; ++r) acc[r] = 0.f;
#pragma unroll 8
        for (int kk = 0; kk < 64; ++kk) { const int k = kp * 64 + kk; const float wv = w[(size_t)k * NMOD + n0 + col];
#pragma unroll
            for (int r = 0; r < 9; ++r) acc[r] += sil[r * 1024 + k] * wv; }
#pragma unroll
        for (int r = 0; r < 9; ++r) red[(kp * 9 + r) * 32 + col] = acc[r];
        __syncthreads();
        if (tid < 288) { const int r = tid >> 5, cl = tid & 31; float s = 0.f;
#pragma unroll
            for (int k2 = 0; k2 < 16; ++k2) s += red[(k2 * 9 + r) * 32 + cl];
            mod[r * NMOD + n0 + cl] = s + bb[n0 + cl]; }
        __syncthreads();
    }
}
__device__ __forceinline__ void ph_rope_table(const Args& a) {
    float* rc = (float*)(a.ws + WS_ROPE); float* rs = rc + 1024;
    for (int i = threadIdx.x; i < 1024; i += 512) { const int pos = i >> 4, f = i & 15;
        const float inv = powf(10000.0f, -(float)f / 16.0f); const float ang = (float)pos * inv;
        rc[i] = cosf(ang); rs[i] = sinf(ang); }
}
template <class DstRow>
__device__ __forceinline__ void transpose_item(const float* W, int K, int N, bf16_t* WT, const DstRow& dr, LAS float* scr, int item, int lane) {
    const int nblk = N / 32, kb = item / nblk, nb = item % nblk, k0 = 64 * kb, n0 = 32 * nb;
#pragma unroll 8
    for (int i = 0; i < 32; ++i) { const int kk = 2 * i + (lane >> 5); scr[kk * 33 + (lane & 31)] = W[(size_t)(k0 + kk) * N + n0 + (lane & 31)]; }
    LDS_WAIT(); asm volatile("" ::: "memory");
    const int c = lane & 7;
#pragma unroll
    for (int j = 0; j < 4; ++j) { const int n = (lane >> 3) + 8 * j; const LAS float* s = scr + (8 * c) * 33 + n;
        u32x4 o; o.x = cvt_pk_bf16(s[0 * 33], s[1 * 33]); o.y = cvt_pk_bf16(s[2 * 33], s[3 * 33]); o.z = cvt_pk_bf16(s[4 * 33], s[5 * 33]); o.w = cvt_pk_bf16(s[6 * 33], s[7 * 33]);
        *(u32x4*)(WT + (size_t)dr(n0 + n) * K + k0 + 8 * c) = o; }
    LDS_WAIT(); asm volatile("" ::: "memory");
}
__host__ __device__ __forceinline__ int qdst(int d) { const int blk = d >> 5, half = (d >> 4) & 1, i = d & 15; return 8 * (4 * blk + (i >> 2)) + 4 * half + (i & 3); }
struct DrWin { __host__ __device__ int operator()(int j) const {
    if (j < 1024) return 256 * (j >> 7) + (j & 127);
    if (j < 2048) { const int jj = j - 1024; return 256 * (jj >> 7) + 128 + (jj & 127); }
    if (j < 4096) { const int jj = j & 1023, base = j - jj; return base + (jj & ~63) + qdst(jj & 63); }
    return j; } };
struct DrId { __host__ __device__ int operator()(int j) const { return j; } };
struct DrGU { int up; __host__ __device__ int operator()(int f) const { return 256 * (f >> 7) + 128 * up + (f & 127); } };

__device__ __forceinline__ void ph_small_weights(const Args& a, LAS unsigned char* lds, int gw, int NGW, int wave, int lane) {
    LAS float* scr = (LAS float*)(lds + 57344 + wave * 8448);
    constexpr int I_IN = (DM / 64) * (NPROJ / 32), I_SQ = (DM / 64) * (DM / 32);
    for (int it = gw; it < I_IN + 3 * I_SQ; it += NGW) {
        int r = it;
        if (r < I_IN) { transpose_item(a.in[I_WIN], DM, NPROJ, (bf16_t*)(a.ws + WS_WIN), DrWin{}, scr, r, lane); continue; } r -= I_IN;
        if (r < I_SQ) { transpose_item(a.in[I_WCO], DM, DM, (bf16_t*)(a.ws + WS_WCO), DrId{}, scr, r, lane); continue; } r -= I_SQ;
        if (r < I_SQ) { transpose_item(a.in[I_WAO], DM, DM, (bf16_t*)(a.ws + WS_WAO), DrId{}, scr, r, lane); continue; } r -= I_SQ;
        transpose_item(a.in[I_WOUT], DM, DM, (bf16_t*)(a.ws + WS_WO), DrId{}, scr, r, lane);
    }
}
__device__ __forceinline__ void ph_wgu(const Args& a, LAS unsigned char* lds, int gw, int NGW, int wave, int lane) {
    LAS float* scr = (LAS float*)(lds + 57344 + wave * 8448);
    constexpr int I_E = (DM / 64) * (DFF / 32);
    for (int it = gw; it < 2 * NEXP * I_E; it += NGW) {
        const int mat = it / I_E, r = it % I_E, e = mat >> 1, up = mat & 1;
        const float* W = (up ? a.in[I_WEU] : a.in[I_WEG]) + (size_t)e * DM * DFF;
        transpose_item(W, DM, DFF, (bf16_t*)(a.ws + WS_WGU) + (size_t)e * 2 * DFF * DM, DrGU{up}, scr, r, lane);
    }
}
__device__ __forceinline__ void ph_wd(const Args& a, LAS unsigned char* lds, int gw, int NGW, int wave, int lane) {
    LAS float* scr = (LAS float*)(lds + 57344 + wave * 8448);
    constexpr int I_E = (DFF / 64) * (DM / 32);
    for (int it = gw; it < NEXP * I_E; it += NGW) {
        const int e = it / I_E, r = it % I_E;
        transpose_item(a.in[I_WED] + (size_t)e * DFF * DM, DFF, DM, (bf16_t*)(a.ws + WS_WD) + (size_t)e * DM * DFF, DrId{}, scr, r, lane);
    }
}

__device__ __forceinline__ void ph_norm_rows(const Args& a, int gw, int NGW, int lane) {
    const float* mod = (const float*)(a.ws + WS_MOD); const float* g = a.in[I_GMIX]; bf16_t* H = (bf16_t*)(a.ws + WS_H);
    for (int row = gw; row < MALL; row += NGW) {
        const float* src = (row < MLAT) ? a.in[I_X] + (size_t)row * DM : a.in[I_CTX] + (size_t)(row - MLAT) * DM;
        const float* mb = mod + (size_t)((row < MLAT) ? (row >> 12) : 8) * NMOD;
        const f32x4* xr = (const f32x4*)src + lane;
        f32x4 v[4]; float s = 0.f;
#pragma unroll
        for (int j = 0; j < 4; ++j) { v[j] = xr[64 * j]; s += (v[j].x * v[j].x + v[j].y * v[j].y) + (v[j].z * v[j].z + v[j].w * v[j].w); }
        const float rstd = 1.0f / sqrtf(wave_sum(s) * (1.0f / DM) + EPS);
        unsigned long long* o8 = (unsigned long long*)(H + (size_t)row * DM) + lane;
#pragma unroll
        for (int j = 0; j < 4; ++j) { const int c = 4 * lane + 256 * j;
            const f32x4 gg = *(const f32x4*)(g + c), sh = *(const f32x4*)(mb + c), sc = *(const f32x4*)(mb + 1024 + c);
            const f32x4 y = (v[j] * rstd) * gg * (sc + 1.0f) + sh;
            o8[64 * j] = (unsigned long long)cvt_pk_bf16(y.x, y.y) | ((unsigned long long)cvt_pk_bf16(y.z, y.w) << 32); }
    }
}

struct SchedInProj {
    const char* A; const char* Bt; int G, c;
    static constexpr int NLAT = 128 * 28, NCTXU = 8 * 8;
    __device__ __forceinline__ bool next(int i, Unit& u) const {
        const int L = i * G + c; if (L >= NLAT + NCTXU) return false;
        if (L < NLAT) { pg8::tile_of(L, 128, 28, u.pm, u.pn); } else { const int v = L - NLAT; u.pm = 128 + (v & 7); u.pn = 12 + (v >> 3); }
        u.aux = 0; return true; }
    __device__ __forceinline__ const char* a_ptr(const Unit& u) const { return A + (size_t)u.pm * (256 * DM * 2); }
    __device__ __forceinline__ const char* b_ptr(const Unit& u) const { return Bt + (size_t)u.pn * (256 * DM * 2); }
    __device__ __forceinline__ bool keep(const Unit&) const { return false; }
};
struct EpiInProj {
    static constexpr bool PERM = true;
    bf16_t *U, *Q, *KA, *VA, *GC, *GA; const float* rope;
    __device__ __forceinline__ void operator()(f32x4 (&acc)[2][2][4][2], const Unit& u, int wr, int wc, int fr, int fq) const {
        const int pn = u.pn, pm = u.pm;
        const int cw = wc * 32 + 8 * fq;
        if (pn < 8) {
#pragma unroll
            for (int ai = 0; ai < 2; ++ai)
#pragma unroll
                for (int m = 0; m < 4; ++m) { const int r = pm * 256 + ai * 128 + wr * 64 + m * 16 + fr;
                    const f32x4 a0 = acc[ai][0][m][0], a1 = acc[ai][0][m][1], b0 = acc[ai][1][m][0], b1 = acc[ai][1][m][1];
                    u32x4 w; w.x = cvt_pk_bf16(a0[0] * sigmoidf_(b0[0]), a0[1] * sigmoidf_(b0[1])); w.y = cvt_pk_bf16(a0[2] * sigmoidf_(b0[2]), a0[3] * sigmoidf_(b0[3]));
                    w.z = cvt_pk_bf16(a1[0] * sigmoidf_(b1[0]), a1[1] * sigmoidf_(b1[1])); w.w = cvt_pk_bf16(a1[2] * sigmoidf_(b1[2]), a1[3] * sigmoidf_(b1[3]));
                    *(u32x4*)(U + (size_t)r * DM + pn * 128 + cw) = w; }
            return;
        }
        if (pn < 16) {
            const bool isq = pn < 12, lat = pm < 128;
            bf16_t* base; size_t row0; int rowpos0 = 0;
            if (isq) { base = Q + (size_t)(pn - 8) * 256; row0 = (size_t)pm * 256; }
            else { base = KA + (size_t)(pn - 12) * 256; row0 = lat ? (size_t)(pm >> 4) * KVR + (size_t)(pm & 15) * 256 : (size_t)(pm - 128) * KVR + NT; }
            if (lat) rowpos0 = (pm & 15) * 4;
            const float sc = isq ? QSCALE : 1.0f;
            const float* rc = rope; const float* rs = rope + 1024;
#pragma unroll
            for (int ai = 0; ai < 2; ++ai)
#pragma unroll
                for (int m = 0; m < 4; ++m) { const int rl = ai * 128 + wr * 64 + m * 16 + fr;
                    f32x4 cs = (f32x4){1.f, 1.f, 1.f, 1.f}, sn = (f32x4){0.f, 0.f, 0.f, 0.f};
                    if (lat) { const int pos = (wc & 1) ? (m * 16 + fr) : (rowpos0 + 2 * ai + wr); cs = *(const f32x4*)(rc + pos * 16 + 4 * fq); sn = *(const f32x4*)(rs + pos * 16 + 4 * fq); }
#pragma unroll
                    for (int bj = 0; bj < 2; ++bj) { const f32x4 x1 = acc[ai][bj][m][0], x2 = acc[ai][bj][m][1];
                        const f32x4 y1 = (x1 * cs - x2 * sn) * sc, y2 = (x1 * sn + x2 * cs) * sc;
                        u32x4 w; w.x = cvt_pk_bf16(y1[0], y1[1]); w.y = cvt_pk_bf16(y1[2], y1[3]); w.z = cvt_pk_bf16(y2[0], y2[1]); w.w = cvt_pk_bf16(y2[2], y2[3]);
                        *(u32x4*)(base + (row0 + rl) * DM + bj * 128 + cw) = w; } }
            return;
        }
        {
            const bool isv = pn < 20, lat = pm < 128;
            bf16_t* base; size_t row0;
            if (isv) { base = VA + (size_t)(pn - 16) * 256; row0 = lat ? (size_t)(pm >> 4) * KVR + (size_t)(pm & 15) * 256 : (size_t)(pm - 128) * KVR + NT; }
            else if (pn < 24) { base = GC + (size_t)(pn - 20) * 256; row0 = (size_t)pm * 256; }
            else { base = GA + (size_t)(pn - 24) * 256; row0 = (size_t)pm * 256; }
#pragma unroll
            for (int ai = 0; ai < 2; ++ai)
#pragma unroll
                for (int m = 0; m < 4; ++m) { const int rl = ai * 128 + wr * 64 + m * 16 + fr;
#pragma unroll
                    for (int bj = 0; bj < 2; ++bj) { f32x4 v0 = acc[ai][bj][m][0], v1 = acc[ai][bj][m][1];
                        if (!isv) {
#pragma unroll
                            for (int j = 0; j < 4; ++j) { v0[j] = sigmoidf_(v0[j]); v1[j] = sigmoidf_(v1[j]); } }
                        u32x4 w; w.x = cvt_pk_bf16(v0[0], v0[1]); w.y = cvt_pk_bf16(v0[2], v0[3]); w.z = cvt_pk_bf16(v1[0], v1[1]); w.w = cvt_pk_bf16(v1[2], v1[3]);
                        *(u32x4*)(base + (row0 + rl) * DM + bj * 128 + cw) = w; } }
        }
    }
};

__device__ __forceinline__ void ph_conv_unit(const Args& a, LAS unsigned char* lds, int unit) {
    const int tid = threadIdx.x, lane = tid & 63, wave = __builtin_amdgcn_readfirstlane(tid >> 6);
    const int b = unit >> 5, t0 = (unit & 31) * 128;
    LAS float* ybuf = (LAS float*)lds;
    const int c0 = 2 * tid;
    f32x2 w[31];
    { const float* wp = a.in[I_WDW]; asm volatile("" : "+s"(wp));
      const __attribute__((address_space(1))) f32x2* wp2 = (const __attribute__((address_space(1))) f32x2*)(wp + c0);
#pragma unroll
      for (int j = 0; j < 31; ++j) w[j] = wp2[j * (DM / 2)]; }
    const f32x2 bias = *(const f32x2*)(a.in[I_BDW] + c0);
    const unsigned* Ub = (const unsigned*)(a.ws + WS_U) + (size_t)b * NT * (DM / 2) + tid;
    bf16_t* CA = (bf16_t*)(a.ws + WS_CACT) + (size_t)(b * NT + t0) * DM;
    const float* lng = a.in[I_LNG]; const float* lnb = a.in[I_LNB];
    f32x2 win[32];
#pragma unroll
    for (int s = 0; s < 32; ++s) win[s] = (f32x2){0.f, 0.f};
    unsigned pf[16];
    const unsigned* up = Ub + ((long)t0 - 15) * (DM / 2);
#define CV_LD(i) ({ const int i_ = (i); const int ti_ = t0 - 15 + i_; (i_ < 158 && ti_ >= 0 && ti_ < NT) ? up[(long)i_ * (DM / 2)] : 0u; })
#pragma unroll
    for (int s = 0; s < 16; ++s) pf[s] = CV_LD(s);
    for (int Q = 0; Q < 5; ++Q) {
#pragma unroll
        for (int hb = 0; hb < 2; ++hb)
#pragma unroll
        for (int s16 = 0; s16 < 16; ++s16) {
            const int s = hb * 16 + s16;
            const unsigned pk = pf[s16];
            pf[s16] = CV_LD(32 * Q + s + 16);
            win[s] = (f32x2){bf_lo(pk), bf_hi(pk)};
            const int to = 32 * Q + s - 30;
            if (to >= 0 && to < 128) {
                f32x2 y = bias;
#pragma unroll
                for (int j = 0; j < 31; ++j) y += w[j] * win[(s + 2 + j) & 31];
                *(LAS f32x2*)(ybuf + (to & 15) * DM + c0) = y;
            }
            if (s == 13 || s == 29) {
                if (Q >= 1) {
                    const int tb = 32 * Q + s - 30 - 15;
                    __syncthreads();
#pragma unroll
                    for (int k = 0; k < 2; ++k) { const int tl = 2 * wave + k;
                        f32x4 v[4]; float sm = 0.f;
#pragma unroll
                        for (int j = 0; j < 4; ++j) { v[j] = *(const LAS f32x4*)(ybuf + tl * DM + 4 * lane + 256 * j); sm += (v[j].x + v[j].y) + (v[j].z + v[j].w); }
                        const float mean = wave_sum(sm) * (1.0f / DM); float s2 = 0.f;
#pragma unroll
                        for (int j = 0; j < 4; ++j) { v[j] = v[j] - mean; s2 += (v[j].x * v[j].x + v[j].y * v[j].y) + (v[j].z * v[j].z + v[j].w * v[j].w); }
                        const float rstd = 1.0f / sqrtf(wave_sum(s2) * (1.0f / DM) + EPS);
                        unsigned long long* o8 = (unsigned long long*)(CA + (size_t)(tb + tl) * DM) + lane;
#pragma unroll
                        for (int j = 0; j < 4; ++j) { const int c = 4 * lane + 256 * j;
                            f32x4 y = v[j] * rstd * *(const f32x4*)(lng + c) + *(const f32x4*)(lnb + c);
#pragma unroll
                            for (int q = 0; q < 4; ++q) y[q] = y[q] * sigmoidf_(y[q]);
                            o8[64 * j] = (unsigned long long)cvt_pk_bf16(y.x, y.y) | ((unsigned long long)cvt_pk_bf16(y.z, y.w) << 32); } }
                    __syncthreads();
                }
            }
        }
    }
#undef CV_LD
}

namespace att {
constexpr int NW = 8, QBLK = 32, KVBLK = 64, NTILE = KVR / KVBLK;
constexpr int SHM_V = KVBLK * 128 * 2, SHM_K = KVBLK * 64 * 2;
constexpr int OFF_V = 0, OFF_K = 2 * SHM_V, OFF_WS = OFF_K + 2 * SHM_K, ATT_LDS = OFF_WS + NW * 64 * 4;
constexpr float THR = 8.0f;
#define KSWZ(row, colB) ((row) * 128 + ((colB) ^ ((((row) >> 1) & 7) << 4)))
#define SBAR() __builtin_amdgcn_sched_barrier(0)
__device__ __forceinline__ int crow(int r, int hi) { return (r & 3) + 8 * (r >> 2) + 4 * hi; }
__device__ __forceinline__ void partialSM(f32x16& p0, f32x16& p1, float& m_reg, float& mn, float& alpha) {
    float pmax = p0[0];
#pragma unroll
    for (int r = 1; r < 16; ++r) pmax = fmaxf(pmax, p0[r]);
#pragma unroll
    for (int r = 0; r < 16; ++r) pmax = fmaxf(pmax, p1[r]);
    { auto rr = __builtin_amdgcn_permlane32_swap(__float_as_uint(pmax), __float_as_uint(pmax), false, false);
      pmax = fmaxf(__uint_as_float(rr[0]), __uint_as_float(rr[1])); }
    if (__builtin_expect(__all(pmax - m_reg <= THR), 1)) { mn = m_reg; alpha = 1.f; }
    else { mn = fmaxf(m_reg, pmax); alpha = __builtin_amdgcn_exp2f(m_reg - mn); m_reg = mn; }
#pragma unroll
    for (int r = 0; r < 16; ++r) p0[r] = p0[r] - mn;
#pragma unroll
    for (int r = 0; r < 16; ++r) p1[r] = p1[r] - mn;
#pragma unroll
    for (int r = 0; r < 16; ++r) p0[r] = __builtin_amdgcn_exp2f(p0[r]);
}
__device__ __forceinline__ void finishSM(f32x16& p0, f32x16& p1, float alpha, float& l_reg, bf16x8& pa0, bf16x8& pa1, bf16x8& pa2, bf16x8& pa3) {
#pragma unroll
    for (int r = 0; r < 16; ++r) p1[r] = __builtin_amdgcn_exp2f(p1[r]);
    float ps = 0;
#pragma unroll
    for (int r = 0; r < 16; ++r) ps += p0[r];
#pragma unroll
    for (int r = 0; r < 16; ++r) ps += p1[r];
    { auto rr = __builtin_amdgcn_permlane32_swap(__float_as_uint(ps), __float_as_uint(ps), false, false);
      ps = __uint_as_float(rr[0]) + __uint_as_float(rr[1]); }
    l_reg = l_reg * alpha + ps;
#define PK4(P, BASE, OUT) do { unsigned a0 = cvt_pk_bf16(P[BASE + 0], P[BASE + 1]), a1 = cvt_pk_bf16(P[BASE + 2], P[BASE + 3]);   \
    unsigned b0 = cvt_pk_bf16(P[BASE + 4], P[BASE + 5]), b1 = cvt_pk_bf16(P[BASE + 6], P[BASE + 7]);                              \
    auto r0 = __builtin_amdgcn_permlane32_swap(a0, b0, false, false); auto r1 = __builtin_amdgcn_permlane32_swap(a1, b1, false, false); \
    u32x4 w = {r0[0], r1[0], r0[1], r1[1]}; OUT = *reinterpret_cast<bf16x8*>(&w); } while (0)
    PK4(p0, 0, pa0); PK4(p0, 8, pa1); PK4(p1, 0, pa2); PK4(p1, 8, pa3);
#undef PK4
}
__device__ __forceinline__ void qkt(f32x16& p0, f32x16& p1, const char* Ks, const bf16x8* qr, int r32, int hi) {
    p0 = f32x16{}; p1 = f32x16{};
#pragma unroll
    for (int d0 = 0; d0 < 4; ++d0) { const int cb = (d0 * 16 + hi * 8) * 2;
        const bf16x8 b0 = *reinterpret_cast<const bf16x8*>(Ks + KSWZ(r32, cb));
        const bf16x8 b1 = *reinterpret_cast<const bf16x8*>(Ks + KSWZ(32 + r32, cb));
        p0 = __builtin_amdgcn_mfma_f32_32x32x16_bf16(b0, qr[d0], p0, 0, 0, 0);
        p1 = __builtin_amdgcn_mfma_f32_32x32x16_bf16(b1, qr[d0], p1, 0, 0, 0); }
}
__device__ __forceinline__ int v_st(int k, int c) { const int kk = (k & ~0xC) | ((k & 4) << 1) | ((k & 8) >> 1); return ((kk >> 3) * 4 + (c >> 5)) * 512 + ((kk & 7) * 32 + (c & 31)) * 2; }
__device__ __forceinline__ int v_rd_base(int lane) { return ((lane & 3) << 3) | (((lane >> 2) & 3) << 6) | (((lane >> 4) & 1) << 5) | (((lane >> 5) & 1) << 8); }
constexpr int v_rd_off(int d0, int ks, int half) { return d0 * 512 + ks * 4096 + half * 2048; }
template <int OFF> __device__ __forceinline__ s16x4 tr_read(int vb) {
    s16x4 r; asm volatile("ds_read_b64_tr_b16 %0, %1 offset:%2" : "=&v"(r) : "v"(vb), "i"(OFF) : "memory"); return r;
}
template <int D0> __device__ __forceinline__ void pv_one(f32x16& od, int vb, bf16x8 pa0, bf16x8 pa1, bf16x8 pa2, bf16x8 pa3) {
    const s16x4 l0 = tr_read<v_rd_off(D0, 0, 0)>(vb), h0 = tr_read<v_rd_off(D0, 0, 1)>(vb), l1 = tr_read<v_rd_off(D0, 1, 0)>(vb), h1 = tr_read<v_rd_off(D0, 1, 1)>(vb);
    const s16x4 l2 = tr_read<v_rd_off(D0, 2, 0)>(vb), h2 = tr_read<v_rd_off(D0, 2, 1)>(vb), l3 = tr_read<v_rd_off(D0, 3, 0)>(vb), h3 = tr_read<v_rd_off(D0, 3, 1)>(vb);
    asm volatile("s_waitcnt lgkmcnt(0)" ::: "memory"); SBAR();
#define PK(L, H) (bf16x8){L[0], L[1], L[2], L[3], H[0], H[1], H[2], H[3]}
    od = __builtin_amdgcn_mfma_f32_32x32x16_bf16(pa0, PK(l0, h0), od, 0, 0, 0);
    od = __builtin_amdgcn_mfma_f32_32x32x16_bf16(pa1, PK(l1, h1), od, 0, 0, 0);
    od = __builtin_amdgcn_mfma_f32_32x32x16_bf16(pa2, PK(l2, h2), od, 0, 0, 0);
    od = __builtin_amdgcn_mfma_f32_32x32x16_bf16(pa3, PK(l3, h3), od, 0, 0, 0);
#undef PK
}
__device__ __forceinline__ void pv_d0(f32x16* o, int vb, bf16x8 pa0, bf16x8 pa1, bf16x8 pa2, bf16x8 pa3) {
    pv_one<0>(o[0], vb, pa0, pa1, pa2, pa3); pv_one<1>(o[1], vb, pa0, pa1, pa2, pa3); pv_one<2>(o[2], vb, pa0, pa1, pa2, pa3); pv_one<3>(o[3], vb, pa0, pa1, pa2, pa3);
}
__device__ __forceinline__ void attn_map(const bf16_t* __restrict__ Qb, const bf16_t* __restrict__ Kh, const bf16_t* __restrict__ Vh, f32x16 (&o)[4], char* lds) {
    const int tid = threadIdx.x, wid = tid >> 6, lane = tid & 63, r32 = lane & 31, hi = lane >> 5;
    char* V_lds = lds + OFF_V; char* K_lds = lds + OFF_K;
    float* ws = (float*)(lds + OFF_WS) + wid * 64; float* li_l = ws; float* al_l = ws + 32;
    float m_reg = -1e30f, l_reg = 0;
#pragma unroll
    for (int d = 0; d < 4; ++d) o[d] = f32x16{};
    bf16x8 qr[4];
    const bf16_t* Qw = Qb + (size_t)(wid * QBLK + r32) * DM + hi * 8;
#pragma unroll
    for (int d0 = 0; d0 < 4; ++d0) qr[d0] = *reinterpret_cast<const bf16x8*>(Qw + d0 * 16);
    const int sr = tid >> 4, sc = (tid & 15) * 8, vst0 = v_st(sr, sc), vst1 = v_st(32 + sr, sc);
    const int kr = tid >> 3, kc = (tid & 7) * 8, kst = KSWZ(kr, kc * 2);
    const int vb0 = (int)(uintptr_t)V_lds + v_rd_base(lane);
    struct { bf16x8 vs0, vs1, ks0; } sr_[2];
#define SLOAD(i, k0) do { sr_[i].vs0 = *reinterpret_cast<const bf16x8*>(&Vh[(size_t)((k0) + sr) * DM + sc]); sr_[i].vs1 = *reinterpret_cast<const bf16x8*>(&Vh[(size_t)((k0) + 32 + sr) * DM + sc]); \
    sr_[i].ks0 = *reinterpret_cast<const bf16x8*>(&Kh[(size_t)((k0) + kr) * DM + kc]); } while (0)
#define SWRITE(b, i) do { *(bf16x8*)(V_lds + (b) * SHM_V + vst0) = sr_[i].vs0; *(bf16x8*)(V_lds + (b) * SHM_V + vst1) = sr_[i].vs1; *(bf16x8*)(K_lds + (b) * SHM_K + kst) = sr_[i].ks0; } while (0)
#define SWAIT() asm volatile("s_waitcnt vmcnt(3)" ::: "memory")
#define RESC(a) do { if (__any((a) < 1.f)) { if (hi == 0) al_l[r32] = (a); asm volatile("s_waitcnt lgkmcnt(0)" ::: "memory"); \
    _Pragma("unroll") for (int d = 0; d < 4; ++d) _Pragma("unroll") for (int r = 0; r < 16; ++r) o[d][r] *= al_l[crow(r, hi)]; } } while (0)
    f32x16 pA0, pA1, pB0, pB1; float mnA, mnB, alA, alB; bf16x8 pa0, pa1, pa2, pa3;
    constexpr int SE = 0, SO = 1;
    SLOAD(SE, 0); asm volatile("s_waitcnt vmcnt(0)" ::: "memory"); SWRITE(0, SE); __syncthreads();
    qkt(pA0, pA1, K_lds, qr, r32, hi); partialSM(pA0, pA1, m_reg, mnA, alA);
    SLOAD(SO, KVBLK); SLOAD(SE, 2 * KVBLK);
    SWAIT(); SWRITE(1, SO); __syncthreads();
    for (int j = 1; j + 1 < NTILE; j += 2) {
        SBAR(); qkt(pB0, pB1, K_lds + SHM_K, qr, r32, hi);
        finishSM(pA0, pA1, alA, l_reg, pa0, pa1, pa2, pa3); SBAR();
        SLOAD(SO, (j + 2) * KVBLK); SBAR();
        pv_d0(o, vb0, pa0, pa1, pa2, pa3); partialSM(pB0, pB1, m_reg, mnB, alB);
        __syncthreads(); SWAIT(); SWRITE(0, SE);
        RESC(alB); __syncthreads();
        SBAR(); qkt(pA0, pA1, K_lds, qr, r32, hi);
        finishSM(pB0, pB1, alB, l_reg, pa0, pa1, pa2, pa3); SBAR();
        if (j + 3 < NTILE) SLOAD(SE, (j + 3) * KVBLK); SBAR();
        pv_d0(o, vb0 + SHM_V, pa0, pa1, pa2, pa3); partialSM(pA0, pA1, m_reg, mnA, alA);
        __syncthreads(); SWAIT(); SWRITE(1, SO);
        RESC(alA); __syncthreads();
    }
    SBAR(); qkt(pB0, pB1, K_lds + SHM_K, qr, r32, hi);
    finishSM(pA0, pA1, alA, l_reg, pa0, pa1, pa2, pa3); SBAR();
    pv_d0(o, vb0, pa0, pa1, pa2, pa3); partialSM(pB0, pB1, m_reg, mnB, alB);
    __syncthreads(); RESC(alB);
    finishSM(pB0, pB1, alB, l_reg, pa0, pa1, pa2, pa3); SBAR();
    pv_d0(o, vb0 + SHM_V, pa0, pa1, pa2, pa3);
    if (hi == 0) li_l[r32] = l_reg; asm volatile("s_waitcnt lgkmcnt(0)" ::: "memory");
#pragma unroll
    for (int r = 0; r < 16; ++r) { const float rl = __builtin_amdgcn_rcpf(li_l[crow(r, hi)]);
#pragma unroll
        for (int d = 0; d < 4; ++d) o[d][r] *= rl; }
    __syncthreads();
#undef SLOAD
#undef SWRITE
#undef SWAIT
#undef RESC
}
__device__ __forceinline__ void attn_unit(const Args& a, int b, int h, int qb, float lam, char* lds) {
    const bf16_t* Q = (const bf16_t*)(a.ws + WS_Q); const bf16_t* KA = (const bf16_t*)(a.ws + WS_K); const bf16_t* VA = (const bf16_t*)(a.ws + WS_V);
    const size_t qrow0 = (size_t)b * NT + (size_t)qb * 256, kvrow0 = (size_t)b * KVR;
    for (int m = 0; m < 2; ++m) {
        f32x16 o[4];
        attn_map(Q + qrow0 * DM + (2 * h + m) * 64, KA + kvrow0 * DM + (2 * h + m) * 64, VA + kvrow0 * DM + h * 128, o, lds);
        int t2 = threadIdx.x; asm volatile("" : "+v"(t2));
        const int wid = t2 >> 6, lane = t2 & 63, r32 = lane & 31, hi = lane >> 5;
        float* o1w = (float*)(a.ws + WS_O1) + (qrow0 + wid * QBLK) * DM + h * 128 + r32;
        if (m == 0) {
#pragma unroll
            for (int r = 0; r < 16; ++r) { const int orow = crow(r, hi);
#pragma unroll
                for (int d = 0; d < 4; ++d) o1w[(size_t)orow * DM + d * 32] = o[d][r]; }
        } else {
            const float* gs = a.in[I_GSUB];
            float g4[4];
#pragma unroll
            for (int d = 0; d < 4; ++d) g4[d] = gs[d * 32 + r32] * 0.8f;
            bf16_t* aow = (bf16_t*)(a.ws + WS_ATTO) + (qrow0 + wid * QBLK) * DM + h * 128 + r32;
#pragma unroll
            for (int r = 0; r < 16; ++r) { const int orow = crow(r, hi);
                float v[4]; float ss = 0.f;
#pragma unroll
                for (int d = 0; d < 4; ++d) { v[d] = o1w[(size_t)orow * DM + d * 32] - lam * o[d][r]; ss += v[d] * v[d]; }
#pragma unroll
                for (int s = 1; s < 32; s <<= 1) ss += __shfl_xor(ss, s);
                const float rstd = 1.0f / sqrtf(ss * (1.0f / 128.0f) + EPS);
#pragma unroll
                for (int d = 0; d < 4; ++d) aow[(size_t)orow * DM + d * 32] = (bf16_t)(cvt_pk_bf16(v[d] * rstd * g4[d], 0.f) & 0xffffu); }
        }
    }
}
#undef KSWZ
#undef SBAR
}

struct SchedDual {
    const char *A0, *A1, *B0, *B1; int G, c;
    __device__ __forceinline__ bool next(int i, Unit& u) const {
        const int L = (i >> 1) * G + c; if (L >= 512) return false;
        pg8::tile_of(L, 128, 4, u.pm, u.pn); u.aux = i & 1; return true; }
    __device__ __forceinline__ const char* a_ptr(const Unit& u) const { return (u.aux ? A1 : A0) + (size_t)u.pm * (256 * DM * 2); }
    __device__ __forceinline__ const char* b_ptr(const Unit& u) const { return (u.aux ? B1 : B0) + (size_t)u.pn * (256 * DM * 2); }
    __device__ __forceinline__ bool keep(const Unit& u) const { return u.aux == 0; }
};
struct EpiDual {
    static constexpr bool PERM = true;
    const bf16_t *GA, *GC; const float* bc; bf16_t* MIX;
    __device__ __forceinline__ void operator()(f32x4 (&acc)[2][2][4][2], const Unit& u, int wr, int wc, int fr, int fq) const {
        const int col0 = u.pn * 256 + wc * 32 + 8 * fq;
        if (u.aux == 0) {
#pragma unroll
            for (int ai = 0; ai < 2; ++ai)
#pragma unroll
                for (int m = 0; m < 4; ++m) { const size_t off = (size_t)(u.pm * 256 + ai * 128 + wr * 64 + m * 16 + fr) * DM + col0;
#pragma unroll
                    for (int bj = 0; bj < 2; ++bj) { const u32x4 ga = *(const u32x4*)(GA + off + bj * 128), gc = *(const u32x4*)(GC + off + bj * 128);
                        f32x4 r0, r1;
                        r0[0] = bf_lo(ga.x) * __builtin_amdgcn_rcpf(bf_lo(gc.x)); r0[1] = bf_hi(ga.x) * __builtin_amdgcn_rcpf(bf_hi(gc.x));
                        r0[2] = bf_lo(ga.y) * __builtin_amdgcn_rcpf(bf_lo(gc.y)); r0[3] = bf_hi(ga.y) * __builtin_amdgcn_rcpf(bf_hi(gc.y));
                        r1[0] = bf_lo(ga.z) * __builtin_amdgcn_rcpf(bf_lo(gc.z)); r1[1] = bf_hi(ga.z) * __builtin_amdgcn_rcpf(bf_hi(gc.z));
                        r1[2] = bf_lo(ga.w) * __builtin_amdgcn_rcpf(bf_lo(gc.w)); r1[3] = bf_hi(ga.w) * __builtin_amdgcn_rcpf(bf_hi(gc.w));
                        acc[ai][bj][m][0] *= r0; acc[ai][bj][m][1] *= r1; }
                    if (m & 1) asm volatile("" ::: "memory"); }
            return;
        }
        f32x4 bv[2][2];
#pragma unroll
        for (int bj = 0; bj < 2; ++bj)
#pragma unroll
            for (int n = 0; n < 2; ++n) bv[bj][n] = *(const f32x4*)(bc + col0 + bj * 128 + 4 * n);
#pragma unroll
        for (int ai = 0; ai < 2; ++ai)
#pragma unroll
            for (int m = 0; m < 4; ++m) { const size_t off = (size_t)(u.pm * 256 + ai * 128 + wr * 64 + m * 16 + fr) * DM + col0;
#pragma unroll
                for (int bj = 0; bj < 2; ++bj) { const u32x4 gc = *(const u32x4*)(GC + off + bj * 128);
                    const f32x4 v0 = acc[ai][bj][m][0] + bv[bj][0], v1 = acc[ai][bj][m][1] + bv[bj][1];
                    u32x4 w; w.x = cvt_pk_bf16(v0[0] * bf_lo(gc.x), v0[1] * bf_hi(gc.x)); w.y = cvt_pk_bf16(v0[2] * bf_lo(gc.y), v0[3] * bf_hi(gc.y));
                    w.z = cvt_pk_bf16(v1[0] * bf_lo(gc.z), v1[1] * bf_hi(gc.z)); w.w = cvt_pk_bf16(v1[2] * bf_lo(gc.w), v1[3] * bf_hi(gc.w));
                    *(u32x4*)(MIX + off + bj * 128) = w; }
                if (m & 1) asm volatile("" ::: "memory"); }
    }
};

struct SchedPlain {
    const char* A; const char* Bt; int G, c, nM, nN, K, bgrp;
    __device__ __forceinline__ bool next(int i, Unit& u) const {
        const int L = i * G + c; if (L >= nM * nN) return false;
        pg8::tile_of(L, nM, nN, u.pm, u.pn); u.aux = 0; return true; }
    __device__ __forceinline__ const char* a_ptr(const Unit& u) const { return A + (size_t)u.pm * ((size_t)256 * K * 2); }
    __device__ __forceinline__ const char* b_ptr(const Unit& u) const { return Bt + (size_t)((u.pm >> 4) * nN * bgrp + u.pn) * ((size_t)256 * K * 2); }
    __device__ __forceinline__ bool keep(const Unit&) const { return false; }
};
struct EpiResid {
    static constexpr bool PERM = false;
    const float* x; const float* mod; float* out;
    __device__ __forceinline__ void operator()(f32x4 (&acc)[2][2][4][2], const Unit& u, int wr, int wc, int fr, int fq) const {
        const int col0 = u.pn * 256 + wc * 32 + 4 * fq; const float* gm = mod + (size_t)(u.pm >> 4) * NMOD + 2048 + col0;
        f32x4 gv[2][2];
#pragma unroll
        for (int bj = 0; bj < 2; ++bj)
#pragma unroll
            for (int n = 0; n < 2; ++n) gv[bj][n] = *(const f32x4*)(gm + bj * 128 + n * 16);
#pragma unroll
        for (int ai = 0; ai < 2; ++ai)
#pragma unroll
            for (int m = 0; m < 4; ++m) { const size_t off = (size_t)(u.pm * 256 + ai * 128 + wr * 64 + m * 16 + fr) * DM + col0;
#pragma unroll
                for (int bj = 0; bj < 2; ++bj)
#pragma unroll
                    for (int n = 0; n < 2; ++n) { const f32x4 xv = *(const f32x4*)(x + off + bj * 128 + n * 16);
                        *(f32x4*)(out + off + bj * 128 + n * 16) = xv + gv[bj][n] * acc[ai][bj][m][n]; }
                if (m & 1) asm volatile("" ::: "memory"); }
    }
};

__device__ __forceinline__ void ph_router(const Args& a, LAS unsigned char* lds, int gw, int NGW, int lane) {
    LAS float* wrt = (LAS float*)lds;
    const float* wr = a.in[I_WR];
    for (int i = threadIdx.x; i < DM * NEXP; i += 512) { const int k = i >> 4, e = i & 15; wrt[e * DM + k] = wr[i]; }
    __syncthreads();
    const float* mod = (const float*)(a.ws + WS_MOD); const float* g = a.in[I_GFFN];
    bf16_t* HF = (bf16_t*)(a.ws + WS_HF); float* AFF = (float*)(a.ws + WS_AFF);
    for (int row = gw; row < MLAT; row += NGW) {
        const float* mb = mod + (size_t)(row >> 12) * NMOD + 3072;
        const f32x4* xr = (const f32x4*)(a.out + (size_t)row * DM) + lane;
        f32x4 v[4]; float s = 0.f;
#pragma unroll
        for (int j = 0; j < 4; ++j) { v[j] = xr[64 * j]; s += (v[j].x * v[j].x + v[j].y * v[j].y) + (v[j].z * v[j].z + v[j].w * v[j].w); }
        const float rstd = 1.0f / sqrtf(wave_sum(s) * (1.0f / DM) + EPS);
        unsigned long long* o8 = (unsigned long long*)(HF + (size_t)row * DM) + lane;
#pragma unroll
        for (int j = 0; j < 4; ++j) { const int c = 4 * lane + 256 * j;
            const f32x4 gg = *(const f32x4*)(g + c), sh = *(const f32x4*)(mb + c), sc = *(const f32x4*)(mb + 1024 + c);
            v[j] = (v[j] * rstd) * gg * (sc + 1.0f) + sh;
            o8[64 * j] = (unsigned long long)cvt_pk_bf16(v[j].x, v[j].y) | ((unsigned long long)cvt_pk_bf16(v[j].z, v[j].w) << 32); }
        float p[16];
#pragma unroll
        for (int e = 0; e < 16; ++e) { float t = 0.f;
#pragma unroll
            for (int j = 0; j < 4; ++j) { const f32x4 wv = *(const LAS f32x4*)(wrt + e * DM + 4 * lane + 256 * j); t += (v[j].x * wv.x + v[j].y * wv.y) + (v[j].z * wv.z + v[j].w * wv.w); }
            p[e] = t; }
        float r8[8], r4[4], r2[2], r1;
        { const bool up = (lane & 32) != 0;
#pragma unroll
          for (int i = 0; i < 8; ++i) { const float send = up ? p[i] : p[i + 8], keepv = up ? p[i + 8] : p[i]; r8[i] = keepv + __shfl_xor(send, 32); } }
        { const bool up = (lane & 16) != 0;
#pragma unroll
          for (int i = 0; i < 4; ++i) { const float send = up ? r8[i] : r8[i + 4], keepv = up ? r8[i + 4] : r8[i]; r4[i] = keepv + __shfl_xor(send, 16); } }
        { const bool up = (lane & 8) != 0;
#pragma unroll
          for (int i = 0; i < 2; ++i) { const float send = up ? r4[i] : r4[i + 2], keepv = up ? r4[i + 2] : r4[i]; r2[i] = keepv + __shfl_xor(send, 8); } }
        { const bool up = (lane & 4) != 0; const float send = up ? r2[0] : r2[1], keepv = up ? r2[1] : r2[0]; r1 = keepv + __shfl_xor(send, 4); }
        r1 += __shfl_xor(r1, 2); r1 += __shfl_xor(r1, 1);
        float mx = r1;
#pragma unroll
        for (int o = 4; o < 64; o <<= 1) mx = fmaxf(mx, __shfl_xor(mx, o));
        const float ex = expf(r1 - mx); float sm = ex;
#pragma unroll
        for (int o = 4; o < 64; o <<= 1) sm += __shfl_xor(sm, o);
        if ((lane & 3) == 0) AFF[(size_t)row * NEXP + (lane >> 2)] = ex / sm;
    }
}

__device__ __forceinline__ void ph_topk_unit(const Args& a, LAS unsigned char* lds, int g  ) {
    const int tid = threadIdx.x, lane = tid & 63, wave = __builtin_amdgcn_readfirstlane(tid >> 6);
    const int b = g >> 4, e = g & 15;
    LAS unsigned long long* S = (LAS unsigned long long*)lds;
    const float* AFF = (const float*)(a.ws + WS_AFF) + (size_t)b * NT * NEXP + e;
    for (int t = tid; t < NT; t += 512) S[t] = ((unsigned long long)__float_as_uint(AFF[(size_t)t * NEXP]) << 32) | (unsigned long long)(0xFFFFFFFFu - (unsigned)t);
    __syncthreads();
    for (int k = 2; k <= NT; k <<= 1)
        for (int j = k >> 1; j > 0; j >>= 1) {
#pragma unroll
            for (int q = 0; q < 4; ++q) { const int t = tid + 512 * q; const int i = 2 * t - (t & (j - 1)), l = i + j;
                const unsigned long long x = S[i], y = S[l]; const bool desc = (i & k) == 0;
                if ((x < y) == desc) { S[i] = y; S[l] = x; } }
            __syncthreads();
        }
    int* SEL = (int*)(a.ws + WS_SEL) + (size_t)b * NT * NEXP + e;
    for (int s = tid; s < NT; s += 512) { const unsigned tok = 0xFFFFFFFFu - (unsigned)S[s]; SEL[(size_t)tok * NEXP] = (s < CAP) ? s : -1; }
    const bf16_t* HF = (const bf16_t*)(a.ws + WS_HF) + (size_t)b * NT * DM;
    bf16_t* XS = (bf16_t*)(a.ws + WS_XS) + (size_t)(e * NB + b) * CAP * DM;
    for (int k = 0; k < 64; k += 4) {
        u32x4 v[4][2];
#pragma unroll
        for (int q = 0; q < 4; ++q) { const int s = wave * 64 + k + q; const unsigned tok = 0xFFFFFFFFu - (unsigned)S[s];
            const u32x4* src = (const u32x4*)(HF + (size_t)tok * DM); v[q][0] = src[lane]; v[q][1] = src[64 + lane]; }
#pragma unroll
        for (int q = 0; q < 4; ++q) { const int s = wave * 64 + k + q; u32x4* dst = (u32x4*)(XS + (size_t)s * DM); dst[lane] = v[q][0]; dst[64 + lane] = v[q][1]; }
    }
    __syncthreads();
}

struct EpiSwiGLU {
    static constexpr bool PERM = true;
    bf16_t* HID;
    __device__ __forceinline__ void operator()(f32x4 (&acc)[2][2][4][2], const Unit& u, int wr, int wc, int fr, int fq) const {
        const int col0 = u.pn * 128 + wc * 32 + 8 * fq;
#pragma unroll
        for (int ai = 0; ai < 2; ++ai)
#pragma unroll
            for (int m = 0; m < 4; ++m) { const size_t r = (size_t)u.pm * 256 + ai * 128 + wr * 64 + m * 16 + fr;
                const f32x4 g0 = acc[ai][0][m][0], g1 = acc[ai][0][m][1], u0 = acc[ai][1][m][0], u1 = acc[ai][1][m][1];
                u32x4 w; w.x = cvt_pk_bf16(g0[0] * sigmoidf_(g0[0]) * u0[0], g0[1] * sigmoidf_(g0[1]) * u0[1]); w.y = cvt_pk_bf16(g0[2] * sigmoidf_(g0[2]) * u0[2], g0[3] * sigmoidf_(g0[3]) * u0[3]);
                w.z = cvt_pk_bf16(g1[0] * sigmoidf_(g1[0]) * u1[0], g1[1] * sigmoidf_(g1[1]) * u1[1]); w.w = cvt_pk_bf16(g1[2] * sigmoidf_(g1[2]) * u1[2], g1[3] * sigmoidf_(g1[3]) * u1[3]);
                *(u32x4*)(HID + r * DFF + col0) = w; }
    }
};
struct EpiPlainBf16 {
    static constexpr bool PERM = true;
    bf16_t* O; int ldc;
    __device__ __forceinline__ void operator()(f32x4 (&acc)[2][2][4][2], const Unit& u, int wr, int wc, int fr, int fq) const {
        const int col0 = u.pn * 256 + wc * 32 + 8 * fq;
#pragma unroll
        for (int ai = 0; ai < 2; ++ai)
#pragma unroll
            for (int m = 0; m < 4; ++m) { bf16_t* rowp = O + ((size_t)u.pm * 256 + ai * 128 + wr * 64 + m * 16 + fr) * ldc + col0;
#pragma unroll
                for (int bj = 0; bj < 2; ++bj) { const f32x4 v0 = acc[ai][bj][m][0], v1 = acc[ai][bj][m][1];
                    u32x4 w; w.x = cvt_pk_bf16(v0[0], v0[1]); w.y = cvt_pk_bf16(v0[2], v0[3]); w.z = cvt_pk_bf16(v1[0], v1[1]); w.w = cvt_pk_bf16(v1[2], v1[3]);
                    *(u32x4*)(rowp + bj * 128) = w; } }
    }
};

__device__ __forceinline__ void ph_final(const Args& a, int gw, int NGW, int lane) {
    const float* mod = (const float*)(a.ws + WS_MOD); const float* gfin = a.in[I_GFIN];
    const float* AFF = (const float*)(a.ws + WS_AFF); const int* SEL = (const int*)(a.ws + WS_SEL); const bf16_t* YS = (const bf16_t*)(a.ws + WS_YS);
    for (int row = gw; row < MLAT; row += NGW) {
        const int b = row >> 12;
        const float* gf = mod + (size_t)b * NMOD + 5120;
        float* xr = a.out + (size_t)row * DM;
        const int selv = (lane < 16) ? SEL[(size_t)row * NEXP + lane] : -1; const float affv = (lane < 16) ? AFF[(size_t)row * NEXP + lane] : 0.f;
        f32x4 acc[2][2];
#pragma unroll
        for (int jj = 0; jj < 2; ++jj) { acc[jj][0] = (f32x4){0.f, 0.f, 0.f, 0.f}; acc[jj][1] = (f32x4){0.f, 0.f, 0.f, 0.f}; }
#pragma unroll
        for (int e = 0; e < NEXP; ++e) { const int s = __builtin_amdgcn_readlane(selv, e); const float gt = __uint_as_float(__builtin_amdgcn_readlane(__float_as_uint(affv), e));
            if (s >= 0) { const bf16_t* yr = YS + ((size_t)(e * NB + b) * CAP + s) * DM;
#pragma unroll
                for (int jj = 0; jj < 2; ++jj) { const u32x4 y = *(const u32x4*)(yr + 8 * lane + 512 * jj);
                    acc[jj][0] += gt * (f32x4){bf_lo(y.x), bf_hi(y.x), bf_lo(y.y), bf_hi(y.y)}; acc[jj][1] += gt * (f32x4){bf_lo(y.z), bf_hi(y.z), bf_lo(y.w), bf_hi(y.w)}; } } }
        f32x4 v[2][2]; float ss = 0.f;
#pragma unroll
        for (int jj = 0; jj < 2; ++jj)
#pragma unroll
            for (int q = 0; q < 2; ++q) { const int c = 8 * lane + 512 * jj + 4 * q;
                v[jj][q] = *(const f32x4*)(xr + c) + *(const f32x4*)(gf + c) * acc[jj][q];
                ss += (v[jj][q].x * v[jj][q].x + v[jj][q].y * v[jj][q].y) + (v[jj][q].z * v[jj][q].z + v[jj][q].w * v[jj][q].w); }
        const float rstd = 1.0f / sqrtf(wave_sum(ss) * (1.0f / DM) + EPS);
#pragma unroll
        for (int jj = 0; jj < 2; ++jj)
#pragma unroll
            for (int q = 0; q < 2; ++q) { const int c = 8 * lane + 512 * jj + 4 * q; *(f32x4*)(xr + c) = v[jj][q] * rstd * *(const f32x4*)(gfin + c); }
    }
}

constexpr int N_PHASES = 12;
__global__ void __launch_bounds__(512, 2) mk_fwd(Args args) {
    extern __shared__ __attribute__((aligned(16))) unsigned char lds_raw[];
    LAS unsigned char* lds = (LAS unsigned char*)lds_raw;
    const int tid = threadIdx.x, lane = tid & 63, wave = __builtin_amdgcn_readfirstlane(tid >> 6);
    const int G = gridDim.x, bid = blockIdx.x;
    const int vcu = (G % 8 == 0) ? (bid % 8) * (G / 8) + bid / 8 : bid;
    const int gw = vcu * 8 + wave, NGW = G * 8;
    volatile LAS unsigned* misc = (volatile LAS unsigned*)(lds + LDSCTL_OFF);
    if (tid < 64) misc[tid] = 0u;
    __syncthreads();
    const int lo = args.ph_lo, hi = args.ph_hi;
    XcdBarrier bar; bar.bar = (unsigned*)(args.ws + WS_CTL) + 1024 + args.li * XCD_BAR_WORDS; bar.x = 0; bar.st = nullptr;
    if (hi - lo > 1) bar = xcd_barrier_post((unsigned*)(args.ws + WS_CTL) + 1024 + args.li * XCD_BAR_WORDS, misc + 8);
#ifndef MK_PHASE_MASK
#define MK_PHASE_MASK 0xFFF
#endif
#define IN(k) (((MK_PHASE_MASK >> (k)) & 1) && lo <= (k) && (k) < hi)
#define SEAM(k) do { if (IN(k) && IN((k) + 1)) xcd_barrier(bar); } while (0)

    if (IN(0)) {
        ph_adaln(args, lds, bid, G);
        if (bid == G - 1) ph_rope_table(args);
        ph_small_weights(args, lds, gw, NGW, wave, lane);
    }
    SEAM(0);
    if (IN(1)) ph_norm_rows(args, gw, NGW, lane);
    SEAM(1);
    if (IN(2)) {
        SchedInProj S{(const char*)(args.ws + WS_H), (const char*)(args.ws + WS_WIN), G, bid};
        EpiInProj E{(bf16_t*)(args.ws + WS_U), (bf16_t*)(args.ws + WS_Q), (bf16_t*)(args.ws + WS_K), (bf16_t*)(args.ws + WS_V), (bf16_t*)(args.ws + WS_GC), (bf16_t*)(args.ws + WS_GA), (const float*)(args.ws + WS_ROPE)};
        pg8::gemm_phase<EpiInProj, SchedInProj, PG8_ALIGN, PG8_SP2>(lds, DM, S, E);
    }
    SEAM(2);
    if (IN(3)) {
#ifndef MK_NO_CONV
        for (int u = vcu; u < 256; u += G) ph_conv_unit(args, lds, u);
        __syncthreads();
#endif
#ifndef MK_NO_ATTN
        float lam;
        { const float s1 = wave_sum(args.in[I_LQ1][lane] * args.in[I_LK1][lane]), s2 = wave_sum(args.in[I_LQ2][lane] * args.in[I_LK2][lane]); lam = __uint_as_float(__builtin_amdgcn_readfirstlane(__float_as_uint(expf(s1) - expf(s2) + 0.2f))); }
        for (int i = 0; i < 4; ++i) { const int u = i * 256 + vcu; if (u >= 1024) break;
            att::attn_unit(args, u >> 7, (u >> 4) & 7, u & 15, lam, (char*)lds_raw); }
#endif
    }
    SEAM(3);
    if (IN(4)) {
        SchedDual S{(const char*)(args.ws + WS_ATTO), (const char*)(args.ws + WS_CACT), (const char*)(args.ws + WS_WAO), (const char*)(args.ws + WS_WCO), G, bid};
        EpiDual E{(const bf16_t*)(args.ws + WS_GA), (const bf16_t*)(args.ws + WS_GC), args.in[I_BCO], (bf16_t*)(args.ws + WS_MIX)};
        pg8::gemm_phase<EpiDual, SchedDual, PG8_ALIGN, PG8_SP2>(lds, DM, S, E);
    }
    SEAM(4);
    if (IN(5)) {
        SchedPlain S{(const char*)(args.ws + WS_MIX), (const char*)(args.ws + WS_WO), G, bid, 128, 4, DM, 0};
        EpiResid E{args.in[I_X], (const float*)(args.ws + WS_MOD), args.out};
        pg8::gemm_phase<EpiResid, SchedPlain, PG8_ALIGN, PG8_SP2>(lds, DM, S, E);
    }
    SEAM(5);
    if (IN(6)) {
        ph_router(args, lds, gw, NGW, lane);
        __syncthreads();
        ph_wgu(args, lds, gw, NGW, wave, lane);
    }
    SEAM(6);
    if (IN(7)) { for (int g = vcu; g < NB * NEXP; g += G) ph_topk_unit(args, lds, g); }
    SEAM(7);
    if (IN(8)) {
        SchedPlain S{(const char*)(args.ws + WS_XS), (const char*)(args.ws + WS_WGU), G, bid, 256, 22, DM, 1};
        EpiSwiGLU E{(bf16_t*)(args.ws + WS_HID)};
        pg8::gemm_phase<EpiSwiGLU, SchedPlain, PG8_ALIGN, PG8_SP2>(lds, DM, S, E);
    }
    SEAM(8);
    if (IN(9)) ph_wd(args, lds, gw, NGW, wave, lane);
    SEAM(9);
    if (IN(10)) {
        SchedPlain S{(const char*)(args.ws + WS_HID), (const char*)(args.ws + WS_WD), G, bid, 256, 4, DFF, 1};
        EpiPlainBf16 E{(bf16_t*)(args.ws + WS_YS), DM};
        pg8::gemm_phase<EpiPlainBf16, SchedPlain, PG8_ALIGN, PG8_SP2>(lds, DFF, S, E);
    }
    SEAM(10);
    if (IN(11)) ph_final(args, gw, NGW, lane);
#undef IN
#undef SEAM
}

extern "C" void kernel_launch(void* const* d_in, const int* in_sizes, int n_in, void* d_out, int out_size, void* d_ws, size_t ws_size, hipStream_t stream) {
    static int grid = 0;
    if (grid == 0) {
        if (n_in != N_IN || out_size != MLAT * DM || ws_size < WS_END) { fprintf(stderr, "kernel_launch: unexpected shapes: n_in %d out %d ws %zu (need %zu)\n", n_in, out_size, ws_size, (size_t)WS_END); grid = -1; return; }
        int dev = 0, cus = 0, per_cu = 0;
        if (hipGetDevice(&dev) != hipSuccess || hipDeviceGetAttribute(&cus, hipDeviceAttributeMultiprocessorCount, dev) != hipSuccess) { grid = -1; return; }
        if (hipFuncSetAttribute((const void*)mk_fwd, hipFuncAttributeMaxDynamicSharedMemorySize, LDS_BYTES) != hipSuccess) { fprintf(stderr, "kernel_launch: hipFuncSetAttribute failed\n"); grid = -1; return; }
        if (hipOccupancyMaxActiveBlocksPerMultiprocessor(&per_cu, (const void*)mk_fwd, 512, LDS_BYTES) != hipSuccess || per_cu < 1) fprintf(stderr, "kernel_launch: occupancy query reports %d\n", per_cu);
        (void)hipGetLastError();
        grid = cus;
    }
    if (grid < 0) return;
    if (hipMemsetAsync((char*)d_ws + WS_CTL, 0, CTL_ZERO_BYTES, stream) != hipSuccess) return;
    Args a{};
    for (int i = 0; i < N_IN; ++i) a.in[i] = (const float*)d_in[i];
    a.out = (float*)d_out; a.ws = (unsigned char*)d_ws;
    constexpr int NL = MK_N_LAUNCHES;
    for (int li = 0; li < NL; ++li) {
        a.ph_lo = (NL == N_PHASES) ? li : (li * N_PHASES) / NL; a.ph_hi = (NL == N_PHASES) ? li + 1 : ((li + 1) * N_PHASES) / NL; a.li = (NL == N_PHASES) ? 0 : li; a.pad = 0;
        hipLaunchKernelGGL(mk_fwd, dim3(grid), dim3(512), LDS_BYTES, stream, a);
    }
}
```

```cpp
#include <hip/hip_runtime.h>
#include <cstdio>
#include <cstdint>

#ifndef MK_N_LAUNCHES
#define MK_N_LAUNCHES 1
#endif

#define LAS __attribute__((address_space(3)))
typedef unsigned short bf16_t;
typedef short bf16x8 __attribute__((ext_vector_type(8)));
typedef short s16x4 __attribute__((ext_vector_type(4)));
typedef float f32x2 __attribute__((ext_vector_type(2)));
typedef float f32x4 __attribute__((ext_vector_type(4)));
typedef float f32x16 __attribute__((ext_vector_type(16)));
typedef unsigned u32x2 __attribute__((ext_vector_type(2)));
typedef unsigned u32x4 __attribute__((ext_vector_type(4)));
typedef int i32x4 __attribute__((ext_vector_type(4)));
typedef int i32x8 __attribute__((ext_vector_type(8)));

constexpr int NB = 8, NT = 4096, DM = 1024, NCX = 256, NHD = 8, NEXP = 16, CAP = 512, DFF = 2816;
constexpr int MLAT = NB * NT, MCTX = NB * NCX, MALL = MLAT + MCTX, KVR = NT + NCX;
constexpr int NPROJ = 7168, NMOD = 6 * DM;
constexpr float EPS = 1e-6f;
constexpr float QSCALE = 0.125f * 1.4426950408889634f;

constexpr size_t MiB = 1u << 20;
constexpr size_t WS_CTL = 0, CTL_ZERO_BYTES = 65536;
constexpr size_t WS_MOD = 65536;
constexpr size_t WS_ROPE = 294912;
constexpr size_t WS_AFF = 1 * MiB;
constexpr size_t WS_SEL = 3 * MiB;
constexpr size_t WS_WIN = 8 * MiB, WS_WCO = 22 * MiB, WS_WAO = 24 * MiB, WS_WO = 26 * MiB;
constexpr size_t WS_H = 28 * MiB;
constexpr size_t WS_ATTO = 28 * MiB;
constexpr size_t WS_U = 96 * MiB;
constexpr size_t WS_MIX = 96 * MiB;
constexpr size_t WS_Q = 160 * MiB;
constexpr size_t WS_K = 224 * MiB;
constexpr size_t WS_V = 292 * MiB;
constexpr size_t WS_GC = 360 * MiB, WS_GA = 424 * MiB;
constexpr size_t WS_CACT = 488 * MiB;
constexpr size_t WS_O1 = 552 * MiB;
constexpr size_t WS_WGU = 8 * MiB;
constexpr size_t WS_XS = 96 * MiB;
constexpr size_t WS_HF = 160 * MiB;
constexpr size_t WS_HID = 192 * MiB;
constexpr size_t WS_WD = 368 * MiB;
constexpr size_t WS_YS = 416 * MiB;
constexpr float WSCALE = 64.0f, WSCALE_INV = 1.0f / 64.0f;
constexpr size_t WS_END = 680 * MiB;

constexpr int RING_BYTES = 131072, LDSCTL_OFF = RING_BYTES, LDS_BYTES = 147456;

#define LDS_WAIT() asm volatile("s_waitcnt lgkmcnt(0)" ::: "memory")
#define VM_WAIT() asm volatile("s_waitcnt vmcnt(0)" ::: "memory")
__device__ __forceinline__ unsigned cvt_pk_bf16(float lo, float hi) { unsigned r; asm volatile("v_cvt_pk_bf16_f32 %0, %1, %2" : "=v"(r) : "v"(lo), "v"(hi)); return r; }
__device__ __forceinline__ unsigned pack4_fp8(float a, float b, float c, float d) { int w = 0; w = __builtin_amdgcn_cvt_pk_fp8_f32(a, b, w, false); w = __builtin_amdgcn_cvt_pk_fp8_f32(c, d, w, true); return (unsigned)w; }
__device__ __forceinline__ float bf_lo(unsigned u) { return __uint_as_float(u << 16); }
__device__ __forceinline__ float bf_hi(unsigned u) { return __uint_as_float(u & 0xffff0000u); }
__device__ __forceinline__ float wave_sum(float v) {
#pragma unroll
    for (int o = 1; o < 64; o <<= 1) v += __shfl_xor(v, o);
    return v;
}
__device__ __forceinline__ float sigmoidf_(float x) { return __builtin_amdgcn_rcpf(1.0f + __expf(-x)); }

#define XB_TMO      128
#define XB_XCNT(j)  (256  + 64 * (j))
#define XB_XSUB(j)  (1280 + 64 * (j))
#define XB_XGEN(j)  (2304 + 64 * (j))
#define XB_TOP      3328
#define XB_TOPGEN   3392
#define XCD_BAR_WORDS 3456
#define XB_SPIN_CAP (1u << 18)
__device__ __forceinline__ unsigned xb_ld(unsigned* p)              { return __hip_atomic_load(p, __ATOMIC_RELAXED, __HIP_MEMORY_SCOPE_AGENT); }
__device__ __forceinline__ unsigned xb_add(unsigned* p, unsigned v) { return __hip_atomic_fetch_add(p, v, __ATOMIC_RELAXED, __HIP_MEMORY_SCOPE_AGENT); }
__device__ __forceinline__ unsigned xb_xcc_id() { return (unsigned)__builtin_amdgcn_s_getreg((3 << 11) | 20) & 0xFu; }
#define XB_SPIN(cond, bar) do { unsigned _sp = 0; while (cond) { __builtin_amdgcn_s_sleep(1); \
    if ((++_sp & 255u) == 0u) { if (xb_ld(&(bar)[XB_TMO])) break; if (_sp > XB_SPIN_CAP) { atomicAdd(&(bar)[XB_TMO], 1u); break; } } } } while (0)
struct XcdBarrier { unsigned* bar; unsigned x; volatile LAS unsigned* st; };
__device__ __forceinline__ XcdBarrier xcd_barrier_post(unsigned* bar, volatile LAS unsigned* st) {
    XcdBarrier b; b.bar = bar; b.x = xb_xcc_id(); b.st = st;
    if (threadIdx.x == 0) (void)xb_add(&bar[XB_XCNT(b.x)], 1u);
    return b;
}
__device__ __forceinline__ void xcd_barrier_complete(unsigned* bar, unsigned x, unsigned& nloc, unsigned& nx) {
    const unsigned G = gridDim.x * gridDim.y * gridDim.z;
    unsigned sum, cnt, mine, sp = 0u;
    for (;;) {
        sum = 0u; cnt = 0u; mine = 0u;
#pragma unroll
        for (unsigned j = 0; j < 16; ++j) { const unsigned c = xb_ld(&bar[XB_XCNT(j)]); sum += c; cnt += (c > 0u) ? 1u : 0u; mine = (j == x) ? c : mine; }
        if (sum == G) break;
        __builtin_amdgcn_s_sleep(1);
        if ((++sp & 255u) == 0u) { if (xb_ld(&bar[XB_TMO])) break; if (sp > XB_SPIN_CAP) { atomicAdd(&bar[XB_TMO], 1u); break; } }
    }
    nloc = mine > 0u ? mine : 1u; nx = cnt > 0u ? cnt : 1u;
}
__device__ __forceinline__ void xcd_barrier(const XcdBarrier& b) {
    asm volatile("s_waitcnt vmcnt(0)" ::: "memory");
    __syncthreads();
    if (threadIdx.x == 0) {
        unsigned* bar = b.bar;
        __builtin_amdgcn_s_waitcnt(0);
        unsigned nloc = b.st[0], nx = b.st[1];
        if (nloc == 0u) { xcd_barrier_complete(bar, b.x, nloc, nx); b.st[0] = nloc; b.st[1] = nx; }
        const unsigned old = xb_add(&bar[XB_XSUB(b.x)], 1u);
        const unsigned gen = old / nloc;
        if (old + 1u == (gen + 1u) * nloc) {
            __builtin_amdgcn_fence(__ATOMIC_RELEASE, "agent");
            asm volatile("s_waitcnt vmcnt(0)" ::: "memory");
            const unsigned og = xb_add(&bar[XB_TOP], 1u);
            const unsigned tg = og / nx;
            if (og + 1u == (tg + 1u) * nx) xb_add(&bar[XB_TOPGEN], 1u);
            else XB_SPIN(xb_ld(&bar[XB_TOPGEN]) == tg, bar);
            __builtin_amdgcn_fence(__ATOMIC_ACQUIRE, "agent");
            xb_add(&bar[XB_XGEN(b.x)], 1u);
            asm volatile("s_waitcnt vmcnt(0)" ::: "memory");
        } else {
            XB_SPIN(xb_ld(&bar[XB_XGEN(b.x)]) == gen, bar);
            __builtin_amdgcn_fence(__ATOMIC_ACQUIRE, "agent");
            asm volatile("s_waitcnt vmcnt(0)" ::: "memory");
        }
    }
    __syncthreads();
}

namespace pg8 {
constexpr int BM = 256, BK = 64, HALF = 128, HTB = HALF * BK * 2, STAGE_BYTES = 8 * HTB, NXCD = 8, WGM = 8;
__host__ __device__ __forceinline__ int lds_byte(int r, int c) { const int st = (r >> 4) * 2 + (c >> 5), rr = r & 15, cc = c & 31, ob = rr * 64 + cc * 2; return st * 1024 + (ob ^ (((ob >> 9) & 1) << 5)); }
__host__ __device__ __forceinline__ void stage_rc(int b, int& R, int& C) { const int st = b / 1024, sb = b % 1024, swz = sb ^ (((sb >> 9) & 1) << 5); R = (st >> 1) * 16 + swz / 64; C = (st & 1) * 32 + (swz % 64) / 2; }
__host__ __device__ __forceinline__ int perm32(int rho) { const int n = rho >> 4, i = rho & 15; return 8 * (i >> 2) + 4 * n + (i & 3); }

struct Unit { int pm, pn, aux; };

__device__ __forceinline__ void tile_of(int L, int nM, int nN, int& pm, int& pn) {
    const int nwg = nM * nN; int wgid = L;
    { const int q = nwg / NXCD, r = nwg % NXCD, xcd = wgid % NXCD, off = wgid / NXCD; wgid = (xcd < r ? xcd * (q + 1) : r * (q + 1) + (xcd - r) * q) + off; }
    const int nig = WGM * nN, gid = wgid / nig, fm = gid * WGM, gsz = (nM - fm) < WGM ? (nM - fm) : WGM;
    pm = fm + ((wgid % nig) % gsz); pn = (wgid % nig) / gsz;
}

template <class Epi, class Sched, bool ALIGN_EPI, bool SP2, bool FP8 = false>
__device__ __forceinline__ void gemm_phase(LAS unsigned char* lds, const int RB, const Sched& S, const Epi& E) {
    const int tid = threadIdx.x, wid = __builtin_amdgcn_readfirstlane(tid >> 6), lane = tid & 63, wr = wid >> 2, wc = wid & 3, fr = lane & 15, fq = lane >> 4;
    const int nt = RB / 128;
    unsigned voffA[2], voffB[2];
#pragma unroll
    for (int i = 0; i < 2; ++i) { int R, C; stage_rc(tid * 16 + i * 8192, R, C); const int Rb = Epi::PERM ? ((R & ~31) + perm32(R & 31)) : R;
        voffA[i] = (unsigned)(R * RB + C * 2); voffB[i] = (unsigned)(Rb * RB + C * 2); }
    const size_t kstep = (size_t)(BK * 2);
    const size_t hstep = (size_t)HALF * RB;
    const unsigned ldsw = (unsigned)wid * 1024u;
    const int aoff = lds_byte(wr * 64 + fr, fq * 8), boff = lds_byte(wc * 32 + fr, fq * 8);
#define PG8_SA(b, h) (((b) * 2 + (h)) * HTB)
#define PG8_SB(b, h) ((4 + (b) * 2 + (h)) * HTB)
#define PG8_STAGE(bufoff, gbase, voff) do { _Pragma("unroll") for (int _i = 0; _i < 2; ++_i) \
        __builtin_amdgcn_global_load_lds((const unsigned*)((const char*)(gbase) + (voff)[_i]), (LAS unsigned*)(lds + (bufoff) + ldsw + _i * 8192), 16, 0, 0); } while (0)
#define PG8_LD8(p) __builtin_shufflevector(*(const LAS i32x4*)(p), *(const LAS i32x4*)((p) + 1024), 0, 1, 2, 3, 4, 5, 6, 7)
#define PG8_LDA(dst, b, h) do { _Pragma("unroll") for (int m = 0; m < 4; ++m) dst[m] = PG8_LD8(lds + PG8_SA(b, h) + aoff + m * 2048); } while (0)
#define PG8_LDB(dst, b, h) do { _Pragma("unroll") for (int n = 0; n < 2; ++n) dst[n] = PG8_LD8(lds + PG8_SB(b, h) + boff + n * 2048); } while (0)
#define PG8_LO(x) __builtin_bit_cast(bf16x8, __builtin_shufflevector(x, x, 0, 1, 2, 3))
#define PG8_HI(x) __builtin_bit_cast(bf16x8, __builtin_shufflevector(x, x, 4, 5, 6, 7))
#define PG8_MMA(ai, bj, At, Bt) do { __builtin_amdgcn_s_setprio(1); _Pragma("unroll") for (int m = 0; m < 4; ++m) _Pragma("unroll") for (int n = 0; n < 2; ++n) { \
        if constexpr (FP8) asm volatile("v_mfma_f32_16x16x128_f8f6f4 %0, %1, %2, %0" : "+v"(acc[ai][bj][m][n]) : "v"(Bt[n]), "v"(At[m]));   \
        else { acc[ai][bj][m][n] = __builtin_amdgcn_mfma_f32_16x16x32_bf16(PG8_LO(Bt[n]), PG8_LO(At[m]), acc[ai][bj][m][n], 0, 0, 0); \
               acc[ai][bj][m][n] = __builtin_amdgcn_mfma_f32_16x16x32_bf16(PG8_HI(Bt[n]), PG8_HI(At[m]), acc[ai][bj][m][n], 0, 0, 0); } } \
        __builtin_amdgcn_s_setprio(0); } while (0)
#define PG8_WAIT_V(n) asm volatile("s_waitcnt vmcnt(" #n ")" ::: "memory")
#define PG8_WAIT_L(n) asm volatile("s_waitcnt lgkmcnt(" #n ")" ::: "memory")
#define PG8_BAR __builtin_amdgcn_s_barrier()
#define PG8_SCHED __builtin_amdgcn_sched_barrier(0)
    Unit cur, nxt; int ui = 0;
    if (!S.next(0, cur)) return;
    f32x4 acc[2][2][4][2];
#pragma unroll
    for (int a = 0; a < 2; ++a)
#pragma unroll
        for (int b = 0; b < 2; ++b)
#pragma unroll
            for (int m = 0; m < 4; ++m)
#pragma unroll
                for (int n = 0; n < 2; ++n) acc[a][b][m][n] = (f32x4){0.f, 0.f, 0.f, 0.f};
    i32x8 At[4], B0[2], B1[2];
    const char* cA = S.a_ptr(cur); const char* cB = S.b_ptr(cur);
    if constexpr (SP2) {
        PG8_STAGE(PG8_SB(0, 0), cB, voffB); PG8_STAGE(PG8_SB(0, 1), cB + hstep, voffB); PG8_STAGE(PG8_SA(0, 0), cA, voffA); PG8_STAGE(PG8_SA(0, 1), cA + hstep, voffA);
        if (wr == 1) PG8_BAR;
        PG8_WAIT_V(2); PG8_BAR;
        PG8_STAGE(PG8_SB(1, 0), cB + kstep, voffB); PG8_STAGE(PG8_SA(1, 0), cA + kstep, voffA); PG8_STAGE(PG8_SB(1, 1), cB + hstep + kstep, voffB);
        PG8_WAIT_V(6); PG8_BAR;
    } else {
        PG8_STAGE(PG8_SB(0, 0), cB, voffB); PG8_STAGE(PG8_SA(0, 0), cA, voffA); PG8_STAGE(PG8_SB(0, 1), cB + hstep, voffB); PG8_STAGE(PG8_SA(0, 1), cA + hstep, voffA);
        if (wr == 1) PG8_BAR;
        PG8_WAIT_V(4); PG8_BAR;
        PG8_STAGE(PG8_SB(1, 0), cB + kstep, voffB); PG8_STAGE(PG8_SA(1, 0), cA + kstep, voffA); PG8_STAGE(PG8_SB(1, 1), cB + hstep + kstep, voffB);
        PG8_WAIT_V(6); PG8_BAR;
    }
    for (;;) {
        const bool has_next = S.next(ui + 1, nxt);
        const char* nA = has_next ? S.a_ptr(nxt) : cA; const char* nB = has_next ? S.b_ptr(nxt) : cB;
#pragma nounroll
        for (int t = 0; t < nt; t += 2) {
            const bool last = (t == nt - 2);
            const char* a1 = cA + (size_t)(t + 1) * kstep;
            const char* a2 = last ? nA : cA + (size_t)(t + 2) * kstep; const char* b2 = last ? nB : cB + (size_t)(t + 2) * kstep;
            const char* a3 = a2 + kstep; const char* b3 = b2 + kstep;
            if constexpr (SP2) {
            PG8_LDB(B0, 0, 0); PG8_LDB(B1, 0, 1); PG8_SCHED; PG8_LDA(At, 0, 0); PG8_STAGE(PG8_SA(1, 1), a1 + hstep, voffA);
            PG8_WAIT_V(8); PG8_WAIT_L(0); PG8_BAR; PG8_MMA(0, 0, At, B0); PG8_MMA(0, 1, At, B1); PG8_BAR; PG8_SCHED;
            PG8_LDA(At, 0, 1); PG8_STAGE(PG8_SB(0, 0), b2, voffB); PG8_STAGE(PG8_SB(0, 1), b2 + hstep, voffB); PG8_STAGE(PG8_SA(0, 0), a2, voffA);
            PG8_WAIT_V(8); PG8_WAIT_L(0); PG8_BAR; PG8_MMA(1, 0, At, B0); PG8_MMA(1, 1, At, B1); PG8_BAR; PG8_SCHED;
            PG8_LDB(B0, 1, 0); PG8_LDB(B1, 1, 1); PG8_SCHED; PG8_LDA(At, 1, 0); PG8_STAGE(PG8_SA(0, 1), a2 + hstep, voffA);
            PG8_WAIT_V(8); PG8_WAIT_L(0); PG8_BAR; PG8_MMA(0, 0, At, B0); PG8_MMA(0, 1, At, B1); PG8_BAR; PG8_SCHED;
            PG8_LDA(At, 1, 1); PG8_STAGE(PG8_SB(1, 0), b3, voffB); PG8_STAGE(PG8_SB(1, 1), b3 + hstep, voffB); PG8_STAGE(PG8_SA(1, 0), a3, voffA);
            PG8_WAIT_V(8); PG8_WAIT_L(0); PG8_BAR; PG8_MMA(1, 0, At, B0); PG8_MMA(1, 1, At, B1); PG8_BAR; PG8_SCHED;
            } else {
            PG8_LDB(B0, 0, 0); PG8_SCHED; PG8_LDA(At, 0, 0); PG8_STAGE(PG8_SA(1, 1), a1 + hstep, voffA);
            PG8_WAIT_L(8); PG8_BAR; PG8_WAIT_L(0); PG8_MMA(0, 0, At, B0); PG8_BAR; PG8_SCHED;
            PG8_LDB(B1, 0, 1); PG8_STAGE(PG8_SB(0, 0), b2, voffB);
            PG8_BAR; PG8_WAIT_L(0); PG8_MMA(0, 1, At, B1); PG8_BAR;
            PG8_LDA(At, 0, 1); PG8_STAGE(PG8_SA(0, 0), a2, voffA);
            PG8_BAR; PG8_WAIT_L(0); PG8_MMA(1, 0, At, B0); PG8_BAR; PG8_SCHED;
            PG8_STAGE(PG8_SB(0, 1), b2 + hstep, voffB);
            PG8_WAIT_V(6); PG8_BAR; PG8_MMA(1, 1, At, B1); PG8_BAR;
            PG8_LDB(B0, 1, 0); PG8_SCHED; PG8_LDA(At, 1, 0); PG8_STAGE(PG8_SA(0, 1), a2 + hstep, voffA);
            PG8_WAIT_L(8); PG8_BAR; PG8_WAIT_L(0); PG8_MMA(0, 0, At, B0); PG8_BAR; PG8_SCHED;
            PG8_LDB(B1, 1, 1); PG8_STAGE(PG8_SB(1, 0), b3, voffB);
            PG8_BAR; PG8_WAIT_L(0); PG8_MMA(0, 1, At, B1); PG8_BAR;
            PG8_LDA(At, 1, 1); PG8_STAGE(PG8_SA(1, 0), a3, voffA);
            PG8_BAR; PG8_WAIT_L(0); PG8_MMA(1, 0, At, B0); PG8_BAR; PG8_SCHED;
            PG8_STAGE(PG8_SB(1, 1), b3 + hstep, voffB);
            PG8_WAIT_V(6); PG8_BAR; PG8_MMA(1, 1, At, B1); PG8_BAR;
            }
        }
        if constexpr (ALIGN_EPI) { if (wr == 0) PG8_BAR; }
        if constexpr (FP8) asm volatile("s_nop 15\n\ts_nop 15" ::: "memory");
        E(acc, cur, wr, wc, fr, fq);
        if (!has_next) break;
        if (!S.keep(cur)) {
#pragma unroll
            for (int a = 0; a < 2; ++a)
#pragma unroll
                for (int b = 0; b < 2; ++b)
#pragma unroll
                    for (int m = 0; m < 4; ++m)
#pragma unroll
                        for (int n = 0; n < 2; ++n) acc[a][b][m][n] = (f32x4){0.f, 0.f, 0.f, 0.f};
        }
        cur = nxt; cA = nA; cB = nB; ++ui;
        if constexpr (ALIGN_EPI) { if (wr == 1) PG8_BAR; }
    }
    PG8_WAIT_V(0);
    if constexpr (!ALIGN_EPI) { if (wr == 0) PG8_BAR; }
    PG8_BAR;
#undef PG8_SA
#undef PG8_SB
#undef PG8_STAGE
#undef PG8_LDA
#undef PG8_LDB
#undef PG8_MMA
#undef PG8_LD8
#undef PG8_LO
#undef PG8_HI
#undef PG8_WAIT_V
#undef PG8_WAIT_L
#undef PG8_BAR
#undef PG8_SCHED
}
}
using pg8::Unit;

#ifndef PG8_SP2
#define PG8_SP2 true
#endif
#ifndef PG8_ALIGN
#define PG8_ALIGN true
#endif

enum InIdx { I_X = 0, I_C, I_CTX, I_CCTX, I_WADA, I_BADA, I_GMIX, I_GFFN, I_WIN, I_WDW, I_BDW, I_LNG, I_LNB, I_WCO, I_BCO, I_LQ1, I_LK1, I_LQ2, I_LK2, I_GSUB, I_WAO, I_WOUT, I_WR, I_WEG, I_WEU, I_WED, I_GFIN, N_IN };
struct Args { const float* in[N_IN]; float* out; unsigned char* ws; int ph_lo, ph_hi, li, pad; };

__device__ __forceinline__ void ph_adaln(const Args& a, LAS unsigned char* lds, int bid, int G) {
    const int tid = threadIdx.x;
    LAS float* sil = (LAS float*)lds;
    LAS float* red = sil + 9 * 1024;
    const float* c = a.in[I_C]; const float* cc = a.in[I_CCTX]; const float* w = a.in[I_WADA]; const float* bb = a.in[I_BADA];
    float* mod = (float*)(a.ws + WS_MOD);
    for (int i = tid; i < 9 * 1024; i += 512) { const float v = (i < 8192) ? c[i] : cc[i - 8192]; sil[i] = v / (1.0f + expf(-v)); }
    __syncthreads();
    for (int unit = bid; unit < NMOD / 32; unit += G) {
        const int n0 = unit * 32, col = tid & 31, kp = tid >> 5;
        float acc[9];
#pragma unroll
        for (int r = 0; r < 9; ++r) acc[r] = 0.f;
#pragma unroll 8
        for (int kk = 0; kk < 64; ++kk) { const int k = kp * 64 + kk; const float wv = w[(size_t)k * NMOD + n0 + col];
#pragma unroll
            for (int r = 0; r < 9; ++r) acc[r] += sil[r * 1024 + k] * wv; }
#pragma unroll
        for (int r = 0; r < 9; ++r) red[(kp * 9 + r) * 32 + col] = acc[r];
        __syncthreads();
        if (tid < 288) { const int r = tid >> 5, cl = tid & 31; float s = 0.f;
#pragma unroll
            for (int k2 = 0; k2 < 16; ++k2) s += red[(k2 * 9 + r) * 32 + cl];
            mod[r * NMOD + n0 + cl] = s + bb[n0 + cl]; }
        __syncthreads();
    }
}
__device__ __forceinline__ void ph_rope_table(const Args& a) {
    float* rc = (float*)(a.ws + WS_ROPE); float* rs = rc + 1024;
    for (int i = threadIdx.x; i < 1024; i += 512) { const int pos = i >> 4, f = i & 15;
        const float inv = powf(10000.0f, -(float)f / 16.0f); const float ang = (float)pos * inv;
        rc[i] = cosf(ang); rs[i] = sinf(ang); }
}
template <class DstRow>
__device__ __forceinline__ void transpose_item(const float* W, int K, int N, bf16_t* WT, const DstRow& dr, LAS float* scr, int item, int lane) {
    const int nblk = N / 32, kb = item / nblk, nb = item % nblk, k0 = 64 * kb, n0 = 32 * nb;
#pragma unroll 8
    for (int i = 0; i < 32; ++i) { const int kk = 2 * i + (lane >> 5); scr[kk * 33 + (lane & 31)] = W[(size_t)(k0 + kk) * N + n0 + (lane & 31)]; }
    LDS_WAIT(); asm volatile("" ::: "memory");
    const int c = lane & 7;
#pragma unroll
    for (int j = 0; j < 4; ++j) { const int n = (lane >> 3) + 8 * j; const LAS float* s = scr + (8 * c) * 33 + n;
        u32x4 o; o.x = cvt_pk_bf16(s[0 * 33], s[1 * 33]); o.y = cvt_pk_bf16(s[2 * 33], s[3 * 33]); o.z = cvt_pk_bf16(s[4 * 33], s[5 * 33]); o.w = cvt_pk_bf16(s[6 * 33], s[7 * 33]);
        *(u32x4*)(WT + (size_t)dr(n0 + n) * K + k0 + 8 * c) = o; }
    LDS_WAIT(); asm volatile("" ::: "memory");
}
template <class DstRow>
__device__ __forceinline__ void transpose_item_fp8(const float* W, int K, int N, unsigned char* WT, const DstRow& dr, LAS float* scr, int item, int lane) {
    const int nblk = N / 32, kb = item / nblk, nb = item % nblk, k0 = 64 * kb, n0 = 32 * nb;
#pragma unroll 8
    for (int i = 0; i < 32; ++i) { const int kk = 2 * i + (lane >> 5); scr[kk * 33 + (lane & 31)] = W[(size_t)(k0 + kk) * N + n0 + (lane & 31)]; }
    LDS_WAIT(); asm volatile("" ::: "memory");
    const int c = lane & 7;
#pragma unroll
    for (int j = 0; j < 4; ++j) { const int n = (lane >> 3) + 8 * j; const LAS float* s = scr + (8 * c) * 33 + n;
        u32x2 o; o.x = pack4_fp8(s[0 * 33] * WSCALE, s[1 * 33] * WSCALE, s[2 * 33] * WSCALE, s[3 * 33] * WSCALE); o.y = pack4_fp8(s[4 * 33] * WSCALE, s[5 * 33] * WSCALE, s[6 * 33] * WSCALE, s[7 * 33] * WSCALE);
        *(u32x2*)(WT + (size_t)dr(n0 + n) * K + k0 + 8 * c) = o; }
    LDS_WAIT(); asm volatile("" ::: "memory");
}
__host__ __device__ __forceinline__ int qdst(int d) { const int blk = d >> 5, half = (d >> 4) & 1, i = d & 15; return 8 * (4 * blk + (i >> 2)) + 4 * half + (i & 3); }
struct DrWin { __host__ __device__ int operator()(int j) const {
    if (j < 1024) return 256 * (j >> 7) + (j & 127);
    if (j < 2048) { const int jj = j - 1024; return 256 * (jj >> 7) + 128 + (jj & 127); }
    if (j < 4096) { const int jj = j & 1023, base = j - jj; return base + (jj & ~63) + qdst(jj & 63); }
    return j; } };
struct DrId { __host__ __device__ int operator()(int j) const { return j; } };
struct DrGU { int up; __host__ __device__ int operator()(int f) const { return 256 * (f >> 7) + 128 * up + (f & 127); } };

__device__ __forceinline__ void ph_small_weights(const Args& a, LAS unsigned char* lds, int gw, int NGW, int wave, int lane) {
    LAS float* scr = (LAS float*)(lds + 57344 + wave * 8448);
    constexpr int I_IN = (DM / 64) * (NPROJ / 32), I_SQ = (DM / 64) * (DM / 32);
    for (int it = gw; it < I_IN + 3 * I_SQ; it += NGW) {
        int r = it;
        if (r < I_IN) { transpose_item(a.in[I_WIN], DM, NPROJ, (bf16_t*)(a.ws + WS_WIN), DrWin{}, scr, r, lane); continue; } r -= I_IN;
        if (r < I_SQ) { transpose_item(a.in[I_WCO], DM, DM, (bf16_t*)(a.ws + WS_WCO), DrId{}, scr, r, lane); continue; } r -= I_SQ;
        if (r < I_SQ) { transpose_item(a.in[I_WAO], DM, DM, (bf16_t*)(a.ws + WS_WAO), DrId{}, scr, r, lane); continue; } r -= I_SQ;
        transpose_item(a.in[I_WOUT], DM, DM, (bf16_t*)(a.ws + WS_WO), DrId{}, scr, r, lane);
    }
}
__device__ __forceinline__ void ph_wgu(const Args& a, LAS unsigned char* lds, int gw, int NGW, int wave, int lane) {
    LAS float* scr = (LAS float*)(lds + 57344 + wave * 8448);
    constexpr int I_E = (DM / 64) * (DFF / 32);
    for (int it = gw; it < 2 * NEXP * I_E; it += NGW) {
        const int mat = it / I_E, r = it % I_E, e = mat >> 1, up = mat & 1;
        const float* W = (up ? a.in[I_WEU] : a.in[I_WEG]) + (size_t)e * DM * DFF;
        transpose_item_fp8(W, DM, DFF, (unsigned char*)(a.ws + WS_WGU) + (size_t)e * 2 * DFF * DM, DrGU{up}, scr, r, lane);
    }
}
__device__ __forceinline__ void ph_wd(const Args& a, LAS unsigned char* lds, int gw, int NGW, int wave, int lane) {
    LAS float* scr = (LAS float*)(lds + 57344 + wave * 8448);
    constexpr int I_E = (DFF / 64) * (DM / 32);
    for (int it = gw; it < NEXP * I_E; it += NGW) {
        const int e = it / I_E, r = it % I_E;
        transpose_item_fp8(a.in[I_WED] + (size_t)e * DFF * DM, DFF, DM, (unsigned char*)(a.ws + WS_WD) + (size_t)e * DM * DFF, DrId{}, scr, r, lane);
    }
}

__device__ __forceinline__ void ph_norm_rows(const Args& a, int gw, int NGW, int lane) {
    const float* mod = (const float*)(a.ws + WS_MOD); const float* g = a.in[I_GMIX]; bf16_t* H = (bf16_t*)(a.ws + WS_H);
    for (int row = gw; row < MALL; row += NGW) {
        const float* src = (row < MLAT) ? a.in[I_X] + (size_t)row * DM : a.in[I_CTX] + (size_t)(row - MLAT) * DM;
        const float* mb = mod + (size_t)((row < MLAT) ? (row >> 12) : 8) * NMOD;
        const f32x4* xr = (const f32x4*)src + lane;
        f32x4 v[4]; float s = 0.f;
#pragma unroll
        for (int j = 0; j < 4; ++j) { v[j] = xr[64 * j]; s += (v[j].x * v[j].x + v[j].y * v[j].y) + (v[j].z * v[j].z + v[j].w * v[j].w); }
        const float rstd = 1.0f / sqrtf(wave_sum(s) * (1.0f / DM) + EPS);
        unsigned long long* o8 = (unsigned long long*)(H + (size_t)row * DM) + lane;
#pragma unroll
        for (int j = 0; j < 4; ++j) { const int c = 4 * lane + 256 * j;
            const f32x4 gg = *(const f32x4*)(g + c), sh = *(const f32x4*)(mb + c), sc = *(const f32x4*)(mb + 1024 + c);
            const f32x4 y = (v[j] * rstd) * gg * (sc + 1.0f) + sh;
            o8[64 * j] = (unsigned long long)cvt_pk_bf16(y.x, y.y) | ((unsigned long long)cvt_pk_bf16(y.z, y.w) << 32); }
    }
}

struct SchedInProj {
    const char* A; const char* Bt; int G, c;
    static constexpr int NLAT = 128 * 28, NCTXU = 8 * 8;
    __device__ __forceinline__ bool next(int i, Unit& u) const {
        const int L = i * G + c; if (L >= NLAT + NCTXU) return false;
        if (L < NLAT) { pg8::tile_of(L, 128, 28, u.pm, u.pn); } else { const int v = L - NLAT; u.pm = 128 + (v & 7); u.pn = 12 + (v >> 3); }
        u.aux = 0; return true; }
    __device__ __forceinline__ const char* a_ptr(const Unit& u) const { return A + (size_t)u.pm * (256 * DM * 2); }
    __device__ __forceinline__ const char* b_ptr(const Unit& u) const { return Bt + (size_t)u.pn * (256 * DM * 2); }
    __device__ __forceinline__ bool keep(const Unit&) const { return false; }
};
struct EpiInProj {
    static constexpr bool PERM = true;
    bf16_t *U, *Q, *KA, *VA, *GC, *GA; const float* rope;
    __device__ __forceinline__ void operator()(f32x4 (&acc)[2][2][4][2], const Unit& u, int wr, int wc, int fr, int fq) const {
        const int pn = u.pn, pm = u.pm;
        const int cw = wc * 32 + 8 * fq;
        if (pn < 8) {
#pragma unroll
            for (int ai = 0; ai < 2; ++ai)
#pragma unroll
                for (int m = 0; m < 4; ++m) { const int r = pm * 256 + ai * 128 + wr * 64 + m * 16 + fr;
                    const f32x4 a0 = acc[ai][0][m][0], a1 = acc[ai][0][m][1], b0 = acc[ai][1][m][0], b1 = acc[ai][1][m][1];
                    u32x4 w; w.x = cvt_pk_bf16(a0[0] * sigmoidf_(b0[0]), a0[1] * sigmoidf_(b0[1])); w.y = cvt_pk_bf16(a0[2] * sigmoidf_(b0[2]), a0[3] * sigmoidf_(b0[3]));
                    w.z = cvt_pk_bf16(a1[0] * sigmoidf_(b1[0]), a1[1] * sigmoidf_(b1[1])); w.w = cvt_pk_bf16(a1[2] * sigmoidf_(b1[2]), a1[3] * sigmoidf_(b1[3]));
                    *(u32x4*)(U + (size_t)r * DM + pn * 128 + cw) = w; }
            return;
        }
        if (pn < 16) {
            const bool isq = pn < 12, lat = pm < 128;
            bf16_t* base; size_t row0; int rowpos0 = 0;
            if (isq) { base = Q + (size_t)(pn - 8) * 256; row0 = (size_t)pm * 256; }
            else { base = KA + (size_t)(pn - 12) * 256; row0 = lat ? (size_t)(pm >> 4) * KVR + (size_t)(pm & 15) * 256 : (size_t)(pm - 128) * KVR + NT; }
            if (lat) rowpos0 = (pm & 15) * 4;
            const float sc = isq ? QSCALE : 1.0f;
            const float* rc = rope; const float* rs = rope + 1024;
#pragma unroll
            for (int ai = 0; ai < 2; ++ai)
#pragma unroll
                for (int m = 0; m < 4; ++m) { const int rl = ai * 128 + wr * 64 + m * 16 + fr;
                    f32x4 cs = (f32x4){1.f, 1.f, 1.f, 1.f}, sn = (f32x4){0.f, 0.f, 0.f, 0.f};
                    if (lat) { const int pos = (wc & 1) ? (m * 16 + fr) : (rowpos0 + 2 * ai + wr); cs = *(const f32x4*)(rc + pos * 16 + 4 * fq); sn = *(const f32x4*)(rs + pos * 16 + 4 * fq); }
#pragma unroll
                    for (int bj = 0; bj < 2; ++bj) { const f32x4 x1 = acc[ai][bj][m][0], x2 = acc[ai][bj][m][1];
                        const f32x4 y1 = (x1 * cs - x2 * sn) * sc, y2 = (x1 * sn + x2 * cs) * sc;
                        u32x4 w; w.x = cvt_pk_bf16(y1[0], y1[1]); w.y = cvt_pk_bf16(y1[2], y1[3]); w.z = cvt_pk_bf16(y2[0], y2[1]); w.w = cvt_pk_bf16(y2[2], y2[3]);
                        *(u32x4*)(base + (row0 + rl) * DM + bj * 128 + cw) = w; } }
            return;
        }
        {
            const bool isv = pn < 20, lat = pm < 128;
            bf16_t* base; size_t row0;
            if (isv) { base = VA + (size_t)(pn - 16) * 256; row0 = lat ? (size_t)(pm >> 4) * KVR + (size_t)(pm & 15) * 256 : (size_t)(pm - 128) * KVR + NT; }
            else if (pn < 24) { base = GC + (size_t)(pn - 20) * 256; row0 = (size_t)pm * 256; }
            else { base = GA + (size_t)(pn - 24) * 256; row0 = (size_t)pm * 256; }
#pragma unroll
            for (int ai = 0; ai < 2; ++ai)
#pragma unroll
                for (int m = 0; m < 4; ++m) { const int rl = ai * 128 + wr * 64 + m * 16 + fr;
#pragma unroll
                    for (int bj = 0; bj < 2; ++bj) { f32x4 v0 = acc[ai][bj][m][0], v1 = acc[ai][bj][m][1];
                        if (!isv) {
#pragma unroll
                            for (int j = 0; j < 4; ++j) { v0[j] = sigmoidf_(v0[j]); v1[j] = sigmoidf_(v1[j]); } }
                        u32x4 w; w.x = cvt_pk_bf16(v0[0], v0[1]); w.y = cvt_pk_bf16(v0[2], v0[3]); w.z = cvt_pk_bf16(v1[0], v1[1]); w.w = cvt_pk_bf16(v1[2], v1[3]);
                        *(u32x4*)(base + (row0 + rl) * DM + bj * 128 + cw) = w; } }
        }
    }
};

__device__ __forceinline__ void ph_conv_unit(const Args& a, LAS unsigned char* lds, int unit) {
    const int tid = threadIdx.x, lane = tid & 63, wave = __builtin_amdgcn_readfirstlane(tid >> 6);
    const int b = unit >> 5, t0 = (unit & 31) * 128;
    LAS float* ybuf = (LAS float*)lds;
    const int c0 = 2 * tid;
    f32x2 w[31];
    { const float* wp = a.in[I_WDW]; asm volatile("" : "+s"(wp));
      const __attribute__((address_space(1))) f32x2* wp2 = (const __attribute__((address_space(1))) f32x2*)(wp + c0);
#pragma unroll
      for (int j = 0; j < 31; ++j) w[j] = wp2[j * (DM / 2)]; }
    const f32x2 bias = *(const f32x2*)(a.in[I_BDW] + c0);
    const unsigned* Ub = (const unsigned*)(a.ws + WS_U) + (size_t)b * NT * (DM / 2) + tid;
    bf16_t* CA = (bf16_t*)(a.ws + WS_CACT) + (size_t)(b * NT + t0) * DM;
    const float* lng = a.in[I_LNG]; const float* lnb = a.in[I_LNB];
    f32x2 win[32];
#pragma unroll
    for (int s = 0; s < 32; ++s) win[s] = (f32x2){0.f, 0.f};
    unsigned pf[16];
    const unsigned* up = Ub + ((long)t0 - 15) * (DM / 2);
#define CV_LD(i) ({ const int i_ = (i); const int ti_ = t0 - 15 + i_; (i_ < 158 && ti_ >= 0 && ti_ < NT) ? up[(long)i_ * (DM / 2)] : 0u; })
#pragma unroll
    for (int s = 0; s < 16; ++s) pf[s] = CV_LD(s);
    for (int Q = 0; Q < 5; ++Q) {
#pragma unroll
        for (int hb = 0; hb < 2; ++hb)
#pragma unroll
        for (int s16 = 0; s16 < 16; ++s16) {
            const int s = hb * 16 + s16;
            const unsigned pk = pf[s16];
            pf[s16] = CV_LD(32 * Q + s + 16);
            win[s] = (f32x2){bf_lo(pk), bf_hi(pk)};
            const int to = 32 * Q + s - 30;
            if (to >= 0 && to < 128) {
                f32x2 y = bias;
#pragma unroll
                for (int j = 0; j < 31; ++j) y += w[j] * win[(s + 2 + j) & 31];
                *(LAS f32x2*)(ybuf + (to & 15) * DM + c0) = y;
            }
            if (s == 13 || s == 29) {
                if (Q >= 1) {
                    const int tb = 32 * Q + s - 30 - 15;
                    __syncthreads();
#pragma unroll
                    for (int k = 0; k < 2; ++k) { const int tl = 2 * wave + k;
                        f32x4 v[4]; float sm = 0.f;
#pragma unroll
                        for (int j = 0; j < 4; ++j) { v[j] = *(const LAS f32x4*)(ybuf + tl * DM + 4 * lane + 256 * j); sm += (v[j].x + v[j].y) + (v[j].z + v[j].w); }
                        const float mean = wave_sum(sm) * (1.0f / DM); float s2 = 0.f;
#pragma unroll
                        for (int j = 0; j < 4; ++j) { v[j] = v[j] - mean; s2 += (v[j].x * v[j].x + v[j].y * v[j].y) + (v[j].z * v[j].z + v[j].w * v[j].w); }
                        const float rstd = 1.0f / sqrtf(wave_sum(s2) * (1.0f / DM) + EPS);
                        unsigned long long* o8 = (unsigned long long*)(CA + (size_t)(tb + tl) * DM) + lane;
#pragma unroll
                        for (int j = 0; j < 4; ++j) { const int c = 4 * lane + 256 * j;
                            f32x4 y = v[j] * rstd * *(const f32x4*)(lng + c) + *(const f32x4*)(lnb + c);
#pragma unroll
                            for (int q = 0; q < 4; ++q) y[q] = y[q] * sigmoidf_(y[q]);
                            o8[64 * j] = (unsigned long long)cvt_pk_bf16(y.x, y.y) | ((unsigned long long)cvt_pk_bf16(y.z, y.w) << 32); } }
                    __syncthreads();
                }
            }
        }
    }
#undef CV_LD
}

namespace att {
constexpr int NW = 8, QBLK = 32, KVBLK = 64, NTILE = KVR / KVBLK;
constexpr int SHM_V = KVBLK * 128 * 2, SHM_K = KVBLK * 64 * 2;
constexpr int BUFB = SHM_V + SHM_K, NBUF = 4, OFF_WS = NBUF * BUFB, ATT_LDS = OFF_WS + NW * 64 * 4;
constexpr float THR = 8.0f;
#define KSWZ(row, colB) ((row) * 128 + ((colB) ^ ((((row) >> 1) & 7) << 4)))
#define SBAR() __builtin_amdgcn_sched_barrier(0)
__device__ __forceinline__ int crow(int r, int hi) { return (r & 3) + 8 * (r >> 2) + 4 * hi; }
__device__ __forceinline__ void partialSM(f32x16& p0, f32x16& p1, float& m_reg, float& mn, float& alpha) {
    float pmax = p0[0];
#pragma unroll
    for (int r = 1; r < 16; ++r) pmax = fmaxf(pmax, p0[r]);
#pragma unroll
    for (int r = 0; r < 16; ++r) pmax = fmaxf(pmax, p1[r]);
    { auto rr = __builtin_amdgcn_permlane32_swap(__float_as_uint(pmax), __float_as_uint(pmax), false, false);
      pmax = fmaxf(__uint_as_float(rr[0]), __uint_as_float(rr[1])); }
    if (__builtin_expect(__all(pmax - m_reg <= THR), 1)) { mn = m_reg; alpha = 1.f; }
    else { mn = fmaxf(m_reg, pmax); alpha = __builtin_amdgcn_exp2f(m_reg - mn); m_reg = mn; }
#pragma unroll
    for (int r = 0; r < 16; ++r) p0[r] = p0[r] - mn;
#pragma unroll
    for (int r = 0; r < 16; ++r) p1[r] = p1[r] - mn;
#pragma unroll
    for (int r = 0; r < 16; ++r) p0[r] = __builtin_amdgcn_exp2f(p0[r]);
}
__device__ __forceinline__ void finishSM(f32x16& p0, f32x16& p1, float alpha, float& l_reg, bf16x8& pa0, bf16x8& pa1, bf16x8& pa2, bf16x8& pa3) {
#pragma unroll
    for (int r = 0; r < 16; ++r) p1[r] = __builtin_amdgcn_exp2f(p1[r]);
    float ps = 0;
#pragma unroll
    for (int r = 0; r < 16; ++r) ps += p0[r];
#pragma unroll
    for (int r = 0; r < 16; ++r) ps += p1[r];
    { auto rr = __builtin_amdgcn_permlane32_swap(__float_as_uint(ps), __float_as_uint(ps), false, false);
      ps = __uint_as_float(rr[0]) + __uint_as_float(rr[1]); }
    l_reg = l_reg * alpha + ps;
#define PK4(P, BASE, OUT) do { unsigned a0 = cvt_pk_bf16(P[BASE + 0], P[BASE + 1]), a1 = cvt_pk_bf16(P[BASE + 2], P[BASE + 3]);   \
    unsigned b0 = cvt_pk_bf16(P[BASE + 4], P[BASE + 5]), b1 = cvt_pk_bf16(P[BASE + 6], P[BASE + 7]);                              \
    auto r0 = __builtin_amdgcn_permlane32_swap(a0, b0, false, false); auto r1 = __builtin_amdgcn_permlane32_swap(a1, b1, false, false); \
    u32x4 w = {r0[0], r1[0], r0[1], r1[1]}; OUT = *reinterpret_cast<bf16x8*>(&w); } while (0)
    PK4(p0, 0, pa0); PK4(p0, 8, pa1); PK4(p1, 0, pa2); PK4(p1, 8, pa3);
#undef PK4
}
__device__ __forceinline__ void qkt(f32x16& p0, f32x16& p1, const char* Ks, const bf16x8* qr, int r32, int hi) {
    p0 = f32x16{}; p1 = f32x16{};
#pragma unroll
    for (int d0 = 0; d0 < 4; ++d0) { const int cb = (d0 * 16 + hi * 8) * 2;
        const bf16x8 b0 = *reinterpret_cast<const bf16x8*>(Ks + KSWZ(r32, cb));
        const bf16x8 b1 = *reinterpret_cast<const bf16x8*>(Ks + KSWZ(32 + r32, cb));
        p0 = __builtin_amdgcn_mfma_f32_32x32x16_bf16(b0, qr[d0], p0, 0, 0, 0);
        p1 = __builtin_amdgcn_mfma_f32_32x32x16_bf16(b1, qr[d0], p1, 0, 0, 0); }
}
__device__ __forceinline__ int v_st(int k, int c) { const int kk = (k & ~0xC) | ((k & 4) << 1) | ((k & 8) >> 1); return ((kk >> 3) * 4 + (c >> 5)) * 512 + ((kk & 7) * 32 + (c & 31)) * 2; }
__device__ __forceinline__ int v_rd_base(int lane) { return ((lane & 3) << 3) | (((lane >> 2) & 3) << 6) | (((lane >> 4) & 1) << 5) | (((lane >> 5) & 1) << 8); }
constexpr int v_rd_off(int d0, int ks, int half) { return d0 * 512 + ks * 4096 + half * 2048; }
template <int OFF> __device__ __forceinline__ s16x4 tr_read(int vb) {
    s16x4 r; asm volatile("ds_read_b64_tr_b16 %0, %1 offset:%2" : "=&v"(r) : "v"(vb), "i"(OFF) : "memory"); return r;
}
template <int D0> __device__ __forceinline__ void pv_one(f32x16& od, int vb, bf16x8 pa0, bf16x8 pa1, bf16x8 pa2, bf16x8 pa3) {
    const s16x4 l0 = tr_read<v_rd_off(D0, 0, 0)>(vb), h0 = tr_read<v_rd_off(D0, 0, 1)>(vb), l1 = tr_read<v_rd_off(D0, 1, 0)>(vb), h1 = tr_read<v_rd_off(D0, 1, 1)>(vb);
    const s16x4 l2 = tr_read<v_rd_off(D0, 2, 0)>(vb), h2 = tr_read<v_rd_off(D0, 2, 1)>(vb), l3 = tr_read<v_rd_off(D0, 3, 0)>(vb), h3 = tr_read<v_rd_off(D0, 3, 1)>(vb);
    asm volatile("s_waitcnt lgkmcnt(0)" ::: "memory"); SBAR();
#define PK(L, H) (bf16x8){L[0], L[1], L[2], L[3], H[0], H[1], H[2], H[3]}
    od = __builtin_amdgcn_mfma_f32_32x32x16_bf16(pa0, PK(l0, h0), od, 0, 0, 0);
    od = __builtin_amdgcn_mfma_f32_32x32x16_bf16(pa1, PK(l1, h1), od, 0, 0, 0);
    od = __builtin_amdgcn_mfma_f32_32x32x16_bf16(pa2, PK(l2, h2), od, 0, 0, 0);
    od = __builtin_amdgcn_mfma_f32_32x32x16_bf16(pa3, PK(l3, h3), od, 0, 0, 0);
#undef PK
}
__device__ __forceinline__ void pv_d0(f32x16* o, int vb, bf16x8 pa0, bf16x8 pa1, bf16x8 pa2, bf16x8 pa3) {
    pv_one<0>(o[0], vb, pa0, pa1, pa2, pa3); pv_one<1>(o[1], vb, pa0, pa1, pa2, pa3); pv_one<2>(o[2], vb, pa0, pa1, pa2, pa3); pv_one<3>(o[3], vb, pa0, pa1, pa2, pa3);
}
__device__ __forceinline__ void glds16(const void* g, unsigned lds_base) {
    unsigned sv; asm volatile("s_mov_b32 %0, m0\n\ts_mov_b32 m0, %2\n\ts_nop 0\n\tglobal_load_lds_dwordx4 %1, off\n\ts_mov_b32 m0, %0" : "=&s"(sv) : "v"(g), "s"(lds_base) : "memory"); }
typedef short v4i16_t __attribute__((ext_vector_type(4)));
__device__ __forceinline__ s16x4 vtr(LAS const char* p) { return __builtin_bit_cast(s16x4, __builtin_amdgcn_ds_read_tr16_b64_v4i16((LAS v4i16_t*)p)); }
__device__ __forceinline__ void attn_map(const bf16_t* __restrict__ Qb, const bf16_t* __restrict__ Kh, const bf16_t* __restrict__ Vh, f32x16 (&o)[4], char* lds) {
    const int tid = threadIdx.x, wid = tid >> 6, lane = tid & 63, r32 = lane & 31, hi = lane >> 5;
    const bool isB = __builtin_amdgcn_readfirstlane(tid >> 6) >= 4;
    float* ws = (float*)(lds + OFF_WS) + wid * 64; float* li_l = ws; float* al_l = ws + 32;
    float m_reg = -1e30f, l_reg = 0;
#pragma unroll
    for (int d = 0; d < 4; ++d) o[d] = f32x16{};
    bf16x8 qr[4];
    const bf16_t* Qw = Qb + (size_t)(wid * QBLK + r32) * DM + hi * 8;
#pragma unroll
    for (int d0 = 0; d0 < 4; ++d0) qr[d0] = *reinterpret_cast<const bf16x8*>(Qw + d0 * 16);
    const int wv = __builtin_amdgcn_readfirstlane(tid >> 6);
    const bf16_t* ksrc = Kh + (size_t)(8 * wv + (lane >> 3)) * DM + (((lane & 7) ^ ((4 * wv + (lane >> 4)) & 7)) << 3);
    const int vkk = 8 * wv + ((lane & 31) >> 2), vk = (vkk & ~0xC) | ((vkk & 4) << 1) | ((vkk & 8) >> 1);
    const bf16_t* vsrc0 = Vh + (size_t)vk * DM + (lane >> 5) * 32 + 8 * (lane & 3);
    const bf16_t* vsrc1 = vsrc0 + 64;
    const unsigned lds0 = (unsigned)(uintptr_t)lds;
    const int vb0 = (int)lds0 + v_rd_base(lane);
#define BUFV(b) (lds + (b) * BUFB)
#define BUFK(b) (lds + (b) * BUFB + SHM_V)
#define DMA(t, b) do { const size_t to_ = (size_t)(t) * (KVBLK * DM); const unsigned bb_ = lds0 + (unsigned)(b) * BUFB; \
    glds16(ksrc + to_, (unsigned)__builtin_amdgcn_readfirstlane(bb_ + SHM_V + 1024 * wv)); \
    glds16(vsrc0 + to_, (unsigned)__builtin_amdgcn_readfirstlane(bb_ + 2048 * wv)); \
    glds16(vsrc1 + to_, (unsigned)__builtin_amdgcn_readfirstlane(bb_ + 2048 * wv + 1024)); } while (0)
#define BARV() asm volatile("s_waitcnt vmcnt(0) lgkmcnt(0)\n\ts_barrier" ::: "memory")
#define BAR() asm volatile("s_waitcnt lgkmcnt(0)\n\ts_barrier" ::: "memory")
#define RESC(a) do { if (__any((a) < 1.f)) { if (hi == 0) al_l[r32] = (a); asm volatile("s_waitcnt lgkmcnt(0)" ::: "memory"); \
    _Pragma("unroll") for (int d = 0; d < 4; ++d) _Pragma("unroll") for (int r = 0; r < 16; ++r) o[d][r] *= al_l[crow(r, hi)]; } } while (0)
    f32x16 pA0, pA1, pB0, pB1; float mnA, mnB, alA, alB; bf16x8 pa0, pa1, pa2, pa3;
    typedef LAS const char* lcp;
    const lcp lds3 = (lcp)(LAS char*)(uintptr_t)(unsigned)(uintptr_t)lds;
    int kaddr[4];
#pragma unroll
    for (int d0 = 0; d0 < 4; ++d0) kaddr[d0] = SHM_V + KSWZ(r32, (d0 * 16 + hi * 8) * 2);
    const lcp vp0 = lds3 + v_rd_base(lane);
    bf16x8 kf[8]; s16x4 va[8], vb[8];
#define PIN(x) asm volatile("" : "+v"(x))
#define MF(a_, b_, c_) __builtin_amdgcn_mfma_f32_32x32x16_bf16(a_, b_, c_, 0, 0, 0)
#define VFR(L, H) (bf16x8){L[0], L[1], L[2], L[3], H[0], H[1], H[2], H[3]}
#define VREAD(dst, vp, D0) do { _Pragma("unroll") for (int ks_ = 0; ks_ < 4; ++ks_) { dst[2 * ks_] = vtr(vp + v_rd_off(D0, ks_, 0)); dst[2 * ks_ + 1] = vtr(vp + v_rd_off(D0, ks_, 1)); } } while (0)
#define PVBLK(od, v) do { od = MF(pa0, VFR(v[0], v[1]), od); od = MF(pa1, VFR(v[2], v[3]), od); od = MF(pa2, VFR(v[4], v[5]), od); od = MF(pa3, VFR(v[6], v[7]), od); } while (0)
#define PK4(P, BASE, OUT) do { unsigned a0_ = cvt_pk_bf16(P[BASE + 0], P[BASE + 1]), a1_ = cvt_pk_bf16(P[BASE + 2], P[BASE + 3]);   \
    unsigned b0_ = cvt_pk_bf16(P[BASE + 4], P[BASE + 5]), b1_ = cvt_pk_bf16(P[BASE + 6], P[BASE + 7]);                              \
    auto r0_ = __builtin_amdgcn_permlane32_swap(a0_, b0_, false, false); auto r1_ = __builtin_amdgcn_permlane32_swap(a1_, b1_, false, false); \
    u32x4 w_ = {r0_[0], r1_[0], r0_[1], r1_[1]}; OUT = *reinterpret_cast<bf16x8*>(&w_); } while (0)
#define S1(C0, C1, P0, P1, al, kbuf) do { SBAR(); \
    { const lcp kb_ = lds3 + (kbuf) * BUFB; \
      _Pragma("unroll") for (int d0 = 0; d0 < 4; ++d0) { kf[2 * d0] = *(const LAS bf16x8*)(kb_ + kaddr[d0]); kf[2 * d0 + 1] = *(const LAS bf16x8*)(kb_ + kaddr[d0] + 4096); } } \
    SBAR(); \
    _Pragma("unroll") for (int r = 0; r < 16; ++r) P1[r] = __builtin_amdgcn_exp2f(P1[r]); \
    PIN(P1); SBAR(); \
    C0 = MF(kf[0], qr[0], f32x16{}); C1 = MF(kf[1], qr[0], f32x16{}); \
    float ps_ = P0[0]; \
    _Pragma("unroll") for (int r = 1; r < 16; ++r) ps_ += P0[r]; \
    _Pragma("unroll") for (int r = 0; r < 16; ++r) ps_ += P1[r]; \
    PIN(ps_); SBAR(); \
    C0 = MF(kf[2], qr[1], C0); C1 = MF(kf[3], qr[1], C1); \
    { auto rr_ = __builtin_amdgcn_permlane32_swap(__float_as_uint(ps_), __float_as_uint(ps_), false, false); ps_ = __uint_as_float(rr_[0]) + __uint_as_float(rr_[1]); } \
    l_reg = l_reg * (al) + ps_; \
    PK4(P0, 0, pa0); PK4(P0, 8, pa1); PIN(pa0); PIN(pa1); PIN(l_reg); SBAR(); \
    C0 = MF(kf[4], qr[2], C0); C1 = MF(kf[5], qr[2], C1); \
    PK4(P1, 0, pa2); PK4(P1, 8, pa3); PIN(pa2); PIN(pa3); SBAR(); \
    C0 = MF(kf[6], qr[3], C0); C1 = MF(kf[7], qr[3], C1); SBAR(); \
    } while (0)
#define S2(C0, C1, mn, al, vbuf) do { SBAR(); \
    const lcp vp_ = vp0 + (vbuf) * BUFB; \
    VREAD(va, vp_, 0); VREAD(vb, vp_, 1); SBAR(); \
    float pm_ = fmaxf(fmaxf(C0[0], C0[1]), C1[0]); \
    _Pragma("unroll") for (int r = 2; r < 16; r += 2) pm_ = fmaxf(fmaxf(pm_, C0[r]), C0[r + 1]); \
    _Pragma("unroll") for (int r = 1; r < 15; r += 2) pm_ = fmaxf(fmaxf(pm_, C1[r]), C1[r + 1]); \
    pm_ = fmaxf(pm_, C1[15]); \
    PIN(pm_); SBAR(); \
    PVBLK(o[0], va); SBAR(); \
    VREAD(va, vp_, 2); \
    { auto rr_ = __builtin_amdgcn_permlane32_swap(__float_as_uint(pm_), __float_as_uint(pm_), false, false); pm_ = fmaxf(__uint_as_float(rr_[0]), __uint_as_float(rr_[1])); } \
    if (__builtin_expect(__all(pm_ - m_reg <= THR), 1)) { mn = m_reg; al = 1.f; } \
    else { mn = fmaxf(m_reg, pm_); al = __builtin_amdgcn_exp2f(m_reg - mn); m_reg = mn; } \
    _Pragma("unroll") for (int r = 0; r < 16; ++r) { C0[r] -= mn; C1[r] -= mn; } \
    PIN(C0); PIN(C1); SBAR(); \
    PVBLK(o[1], vb); SBAR(); \
    VREAD(vb, vp_, 3); \
    _Pragma("unroll") for (int r = 0; r < 16; ++r) C0[r] = __builtin_amdgcn_exp2f(C0[r]); \
    PIN(C0); SBAR(); \
    PVBLK(o[2], va); PVBLK(o[3], vb); SBAR(); \
    RESC(al); \
    } while (0)
    DMA(0, 0); DMA(1, 1);
    BARV();
    if (isB) BAR();
    SBAR(); qkt(pA0, pA1, BUFK(0), qr, r32, hi); SBAR();
    BAR();
    DMA(2, 2);
    partialSM(pA0, pA1, m_reg, mnA, alA);
    BAR();
    for (int j = 1; j + 1 < NTILE; j += 2) {
        S1(pB0, pB1, pA0, pA1, alA, j & 3);
        BARV();
        DMA(j + 2, (j + 2) & 3);
        S2(pB0, pB1, mnB, alB, (j - 1) & 3);
        BAR();
        S1(pA0, pA1, pB0, pB1, alB, (j + 1) & 3);
        BARV();
        if (j + 3 < NTILE) DMA(j + 3, (j + 3) & 3);
        S2(pA0, pA1, mnA, alA, j & 3);
        BAR();
    }
    S1(pB0, pB1, pA0, pA1, alA, (NTILE - 1) & 3);
    BARV();
    S2(pB0, pB1, mnB, alB, (NTILE - 2) & 3);
    BAR();
    finishSM(pB0, pB1, alB, l_reg, pa0, pa1, pa2, pa3); SBAR();
    pv_d0(o, vb0 + ((NTILE - 1) & 3) * BUFB, pa0, pa1, pa2, pa3);
#undef PIN
#undef MF
#undef VFR
#undef VREAD
#undef PVBLK
#undef PK4
#undef S1
#undef S2
    if (!isB) BAR();
    if (hi == 0) li_l[r32] = l_reg; asm volatile("s_waitcnt lgkmcnt(0)" ::: "memory");
#pragma unroll
    for (int r = 0; r < 16; ++r) { const float rl = __builtin_amdgcn_rcpf(li_l[crow(r, hi)]);
#pragma unroll
        for (int d = 0; d < 4; ++d) o[d][r] *= rl; }
    BAR();
#undef BUFV
#undef BUFK
#undef DMA
#undef BARV
#undef BAR
#undef RESC
}
__device__ __forceinline__ void attn_unit(const Args& a, int b, int h, int qb, float lam, char* lds) {
    const bf16_t* Q = (const bf16_t*)(a.ws + WS_Q); const bf16_t* KA = (const bf16_t*)(a.ws + WS_K); const bf16_t* VA = (const bf16_t*)(a.ws + WS_V);
    const size_t qrow0 = (size_t)b * NT + (size_t)qb * 256, kvrow0 = (size_t)b * KVR;
    for (int m = 0; m < 2; ++m) {
        f32x16 o[4];
        attn_map(Q + qrow0 * DM + (2 * h + m) * 64, KA + kvrow0 * DM + (2 * h + m) * 64, VA + kvrow0 * DM + h * 128, o, lds);
        int t2 = threadIdx.x; asm volatile("" : "+v"(t2));
        const int wid = t2 >> 6, lane = t2 & 63, r32 = lane & 31, hi = lane >> 5;
        float* o1w = (float*)(a.ws + WS_O1) + (qrow0 + wid * QBLK) * DM + h * 128 + r32;
        if (m == 0) {
#pragma unroll
            for (int r = 0; r < 16; ++r) { const int orow = crow(r, hi);
#pragma unroll
                for (int d = 0; d < 4; ++d) o1w[(size_t)orow * DM + d * 32] = o[d][r]; }
        } else {
            const float* gs = a.in[I_GSUB];
            float g4[4];
#pragma unroll
            for (int d = 0; d < 4; ++d) g4[d] = gs[d * 32 + r32] * 0.8f;
            bf16_t* aow = (bf16_t*)(a.ws + WS_ATTO) + (qrow0 + wid * QBLK) * DM + h * 128 + r32;
#pragma unroll
            for (int r = 0; r < 16; ++r) { const int orow = crow(r, hi);
                float v[4]; float ss = 0.f;
#pragma unroll
                for (int d = 0; d < 4; ++d) { v[d] = o1w[(size_t)orow * DM + d * 32] - lam * o[d][r]; ss += v[d] * v[d]; }
#pragma unroll
                for (int s = 1; s < 32; s <<= 1) ss += __shfl_xor(ss, s);
                const float rstd = 1.0f / sqrtf(ss * (1.0f / 128.0f) + EPS);
#pragma unroll
                for (int d = 0; d < 4; ++d) aow[(size_t)orow * DM + d * 32] = (bf16_t)(cvt_pk_bf16(v[d] * rstd * g4[d], 0.f) & 0xffffu); }
        }
    }
}
#undef KSWZ
#undef SBAR
}

struct SchedDual {
    const char *A0, *A1, *B0, *B1; int G, c;
    __device__ __forceinline__ bool next(int i, Unit& u) const {
        const int L = (i >> 1) * G + c; if (L >= 512) return false;
        pg8::tile_of(L, 128, 4, u.pm, u.pn); u.aux = i & 1; return true; }
    __device__ __forceinline__ const char* a_ptr(const Unit& u) const { return (u.aux ? A1 : A0) + (size_t)u.pm * (256 * DM * 2); }
    __device__ __forceinline__ const char* b_ptr(const Unit& u) const { return (u.aux ? B1 : B0) + (size_t)u.pn * (256 * DM * 2); }
    __device__ __forceinline__ bool keep(const Unit& u) const { return u.aux == 0; }
};
struct EpiDual {
    static constexpr bool PERM = true;
    const bf16_t *GA, *GC; const float* bc; bf16_t* MIX;
    __device__ __forceinline__ void operator()(f32x4 (&acc)[2][2][4][2], const Unit& u, int wr, int wc, int fr, int fq) const {
        const int col0 = u.pn * 256 + wc * 32 + 8 * fq;
        if (u.aux == 0) {
#pragma unroll
            for (int ai = 0; ai < 2; ++ai)
#pragma unroll
                for (int m = 0; m < 4; ++m) { const size_t off = (size_t)(u.pm * 256 + ai * 128 + wr * 64 + m * 16 + fr) * DM + col0;
#pragma unroll
                    for (int bj = 0; bj < 2; ++bj) { const u32x4 ga = *(const u32x4*)(GA + off + bj * 128), gc = *(const u32x4*)(GC + off + bj * 128);
                        f32x4 r0, r1;
                        r0[0] = bf_lo(ga.x) * __builtin_amdgcn_rcpf(bf_lo(gc.x)); r0[1] = bf_hi(ga.x) * __builtin_amdgcn_rcpf(bf_hi(gc.x));
                        r0[2] = bf_lo(ga.y) * __builtin_amdgcn_rcpf(bf_lo(gc.y)); r0[3] = bf_hi(ga.y) * __builtin_amdgcn_rcpf(bf_hi(gc.y));
                        r1[0] = bf_lo(ga.z) * __builtin_amdgcn_rcpf(bf_lo(gc.z)); r1[1] = bf_hi(ga.z) * __builtin_amdgcn_rcpf(bf_hi(gc.z));
                        r1[2] = bf_lo(ga.w) * __builtin_amdgcn_rcpf(bf_lo(gc.w)); r1[3] = bf_hi(ga.w) * __builtin_amdgcn_rcpf(bf_hi(gc.w));
                        acc[ai][bj][m][0] *= r0; acc[ai][bj][m][1] *= r1; }
                    if (m & 1) asm volatile("" ::: "memory"); }
            return;
        }
        f32x4 bv[2][2];
#pragma unroll
        for (int bj = 0; bj < 2; ++bj)
#pragma unroll
            for (int n = 0; n < 2; ++n) bv[bj][n] = *(const f32x4*)(bc + col0 + bj * 128 + 4 * n);
#pragma unroll
        for (int ai = 0; ai < 2; ++ai)
#pragma unroll
            for (int m = 0; m < 4; ++m) { const size_t off = (size_t)(u.pm * 256 + ai * 128 + wr * 64 + m * 16 + fr) * DM + col0;
#pragma unroll
                for (int bj = 0; bj < 2; ++bj) { const u32x4 gc = *(const u32x4*)(GC + off + bj * 128);
                    const f32x4 v0 = acc[ai][bj][m][0] + bv[bj][0], v1 = acc[ai][bj][m][1] + bv[bj][1];
                    u32x4 w; w.x = cvt_pk_bf16(v0[0] * bf_lo(gc.x), v0[1] * bf_hi(gc.x)); w.y = cvt_pk_bf16(v0[2] * bf_lo(gc.y), v0[3] * bf_hi(gc.y));
                    w.z = cvt_pk_bf16(v1[0] * bf_lo(gc.z), v1[1] * bf_hi(gc.z)); w.w = cvt_pk_bf16(v1[2] * bf_lo(gc.w), v1[3] * bf_hi(gc.w));
                    *(u32x4*)(MIX + off + bj * 128) = w; }
                if (m & 1) asm volatile("" ::: "memory"); }
    }
};

struct SchedPlain {
    const char* A; const char* Bt; int G, c, nM, nN, RB, bgrp;
    __device__ __forceinline__ bool next(int i, Unit& u) const {
        const int L = i * G + c; if (L >= nM * nN) return false;
        pg8::tile_of(L, nM, nN, u.pm, u.pn); u.aux = 0; return true; }
    __device__ __forceinline__ const char* a_ptr(const Unit& u) const { return A + (size_t)u.pm * ((size_t)256 * RB); }
    __device__ __forceinline__ const char* b_ptr(const Unit& u) const { return Bt + (size_t)((u.pm >> 4) * nN * bgrp + u.pn) * ((size_t)256 * RB); }
    __device__ __forceinline__ bool keep(const Unit&) const { return false; }
};
struct EpiResid {
    static constexpr bool PERM = false;
    const float* x; const float* mod; float* out;
    __device__ __forceinline__ void operator()(f32x4 (&acc)[2][2][4][2], const Unit& u, int wr, int wc, int fr, int fq) const {
        const int col0 = u.pn * 256 + wc * 32 + 4 * fq; const float* gm = mod + (size_t)(u.pm >> 4) * NMOD + 2048 + col0;
        f32x4 gv[2][2];
#pragma unroll
        for (int bj = 0; bj < 2; ++bj)
#pragma unroll
            for (int n = 0; n < 2; ++n) gv[bj][n] = *(const f32x4*)(gm + bj * 128 + n * 16);
#pragma unroll
        for (int ai = 0; ai < 2; ++ai)
#pragma unroll
            for (int m = 0; m < 4; ++m) { const size_t off = (size_t)(u.pm * 256 + ai * 128 + wr * 64 + m * 16 + fr) * DM + col0;
#pragma unroll
                for (int bj = 0; bj < 2; ++bj)
#pragma unroll
                    for (int n = 0; n < 2; ++n) { const f32x4 xv = *(const f32x4*)(x + off + bj * 128 + n * 16);
                        *(f32x4*)(out + off + bj * 128 + n * 16) = xv + gv[bj][n] * acc[ai][bj][m][n]; }
                if (m & 1) asm volatile("" ::: "memory"); }
    }
};

__device__ __forceinline__ void ph_router(const Args& a, LAS unsigned char* lds, int gw, int NGW, int lane) {
    LAS float* wrt = (LAS float*)lds;
    const float* wr = a.in[I_WR];
    for (int i = threadIdx.x; i < DM * NEXP; i += 512) { const int k = i >> 4, e = i & 15; wrt[e * DM + k] = wr[i]; }
    __syncthreads();
    const float* mod = (const float*)(a.ws + WS_MOD); const float* g = a.in[I_GFFN];
    unsigned char* HF = (unsigned char*)(a.ws + WS_HF); float* AFF = (float*)(a.ws + WS_AFF);
    for (int row = gw; row < MLAT; row += NGW) {
        const float* mb = mod + (size_t)(row >> 12) * NMOD + 3072;
        const f32x4* xr = (const f32x4*)(a.out + (size_t)row * DM) + lane;
        f32x4 v[4]; float s = 0.f;
#pragma unroll
        for (int j = 0; j < 4; ++j) { v[j] = xr[64 * j]; s += (v[j].x * v[j].x + v[j].y * v[j].y) + (v[j].z * v[j].z + v[j].w * v[j].w); }
        const float rstd = 1.0f / sqrtf(wave_sum(s) * (1.0f / DM) + EPS);
        unsigned* o4 = (unsigned*)(HF + (size_t)row * DM) + lane;
#pragma unroll
        for (int j = 0; j < 4; ++j) { const int c = 4 * lane + 256 * j;
            const f32x4 gg = *(const f32x4*)(g + c), sh = *(const f32x4*)(mb + c), sc = *(const f32x4*)(mb + 1024 + c);
            v[j] = (v[j] * rstd) * gg * (sc + 1.0f) + sh;
            o4[64 * j] = pack4_fp8(v[j].x, v[j].y, v[j].z, v[j].w); }
        float p[16];
#pragma unroll
        for (int e = 0; e < 16; ++e) { float t = 0.f;
#pragma unroll
            for (int j = 0; j < 4; ++j) { const f32x4 wv = *(const LAS f32x4*)(wrt + e * DM + 4 * lane + 256 * j); t += (v[j].x * wv.x + v[j].y * wv.y) + (v[j].z * wv.z + v[j].w * wv.w); }
            p[e] = t; if ((e & 3) == 3) __builtin_amdgcn_sched_barrier(0); }
        float r8[8], r4[4], r2[2], r1;
        { const bool up = (lane & 32) != 0;
#pragma unroll
          for (int i = 0; i < 8; ++i) { const float send = up ? p[i] : p[i + 8], keepv = up ? p[i + 8] : p[i]; r8[i] = keepv + __shfl_xor(send, 32); } }
        { const bool up = (lane & 16) != 0;
#pragma unroll
          for (int i = 0; i < 4; ++i) { const float send = up ? r8[i] : r8[i + 4], keepv = up ? r8[i + 4] : r8[i]; r4[i] = keepv + __shfl_xor(send, 16); } }
        { const bool up = (lane & 8) != 0;
#pragma unroll
          for (int i = 0; i < 2; ++i) { const float send = up ? r4[i] : r4[i + 2], keepv = up ? r4[i + 2] : r4[i]; r2[i] = keepv + __shfl_xor(send, 8); } }
        { const bool up = (lane & 4) != 0; const float send = up ? r2[0] : r2[1], keepv = up ? r2[1] : r2[0]; r1 = keepv + __shfl_xor(send, 4); }
        r1 += __shfl_xor(r1, 2); r1 += __shfl_xor(r1, 1);
        float mx = r1;
#pragma unroll
        for (int o = 4; o < 64; o <<= 1) mx = fmaxf(mx, __shfl_xor(mx, o));
        const float ex = expf(r1 - mx); float sm = ex;
#pragma unroll
        for (int o = 4; o < 64; o <<= 1) sm += __shfl_xor(sm, o);
        if ((lane & 3) == 0) AFF[(size_t)row * NEXP + (lane >> 2)] = ex / sm;
    }
}

__device__ __forceinline__ void ph_topk_unit(const Args& a, LAS unsigned char* lds, int g  ) {
    const int tid = threadIdx.x, lane = tid & 63, wave = __builtin_amdgcn_readfirstlane(tid >> 6);
    const int b = g >> 4, e = g & 15;
    LAS unsigned long long* S = (LAS unsigned long long*)lds;
    const float* AFF = (const float*)(a.ws + WS_AFF) + (size_t)b * NT * NEXP + e;
    for (int t = tid; t < NT; t += 512) S[t] = ((unsigned long long)__float_as_uint(AFF[(size_t)t * NEXP]) << 32) | (unsigned long long)(0xFFFFFFFFu - (unsigned)t);
    __syncthreads();
    for (int k = 2; k <= NT; k <<= 1)
        for (int j = k >> 1; j > 0; j >>= 1) {
#pragma unroll
            for (int q = 0; q < 4; ++q) { const int t = tid + 512 * q; const int i = 2 * t - (t & (j - 1)), l = i + j;
                const unsigned long long x = S[i], y = S[l]; const bool desc = (i & k) == 0;
                if ((x < y) == desc) { S[i] = y; S[l] = x; } }
            __syncthreads();
        }
    int* SEL = (int*)(a.ws + WS_SEL) + (size_t)b * NT * NEXP + e;
    for (int s = tid; s < NT; s += 512) { const unsigned tok = 0xFFFFFFFFu - (unsigned)S[s]; SEL[(size_t)tok * NEXP] = (s < CAP) ? s : -1; }
    const unsigned char* HF = (const unsigned char*)(a.ws + WS_HF) + (size_t)b * NT * DM;
    unsigned char* XS = (unsigned char*)(a.ws + WS_XS) + (size_t)(e * NB + b) * CAP * DM;
    for (int k = 0; k < 64; k += 8) {
        u32x4 v[8];
#pragma unroll
        for (int q = 0; q < 8; ++q) { const int s = wave * 64 + k + q; const unsigned tok = 0xFFFFFFFFu - (unsigned)S[s];
            v[q] = ((const u32x4*)(HF + (size_t)tok * DM))[lane]; }
#pragma unroll
        for (int q = 0; q < 8; ++q) { const int s = wave * 64 + k + q; ((u32x4*)(XS + (size_t)s * DM))[lane] = v[q]; }
    }
    __syncthreads();
}

struct EpiSwiGLU {
    static constexpr bool PERM = true;
    unsigned char* HID;
    __device__ __forceinline__ void operator()(f32x4 (&acc)[2][2][4][2], const Unit& u, int wr, int wc, int fr, int fq) const {
        const int col0 = u.pn * 128 + wc * 32 + 8 * fq;
#pragma unroll
        for (int ai = 0; ai < 2; ++ai)
#pragma unroll
            for (int m = 0; m < 4; ++m) { const size_t r = (size_t)u.pm * 256 + ai * 128 + wr * 64 + m * 16 + fr;
                const f32x4 g0 = acc[ai][0][m][0] * WSCALE_INV, g1 = acc[ai][0][m][1] * WSCALE_INV, u0 = acc[ai][1][m][0] * WSCALE_INV, u1 = acc[ai][1][m][1] * WSCALE_INV;
                u32x2 w; w.x = pack4_fp8(g0[0] * sigmoidf_(g0[0]) * u0[0], g0[1] * sigmoidf_(g0[1]) * u0[1], g0[2] * sigmoidf_(g0[2]) * u0[2], g0[3] * sigmoidf_(g0[3]) * u0[3]);
                w.y = pack4_fp8(g1[0] * sigmoidf_(g1[0]) * u1[0], g1[1] * sigmoidf_(g1[1]) * u1[1], g1[2] * sigmoidf_(g1[2]) * u1[2], g1[3] * sigmoidf_(g1[3]) * u1[3]);
                *(u32x2*)(HID + r * DFF + col0) = w; }
    }
};
struct EpiPlainBf16 {
    static constexpr bool PERM = true;
    bf16_t* O; int ldc; float scale;
    __device__ __forceinline__ void operator()(f32x4 (&acc)[2][2][4][2], const Unit& u, int wr, int wc, int fr, int fq) const {
        const int col0 = u.pn * 256 + wc * 32 + 8 * fq;
#pragma unroll
        for (int ai = 0; ai < 2; ++ai)
#pragma unroll
            for (int m = 0; m < 4; ++m) { bf16_t* rowp = O + ((size_t)u.pm * 256 + ai * 128 + wr * 64 + m * 16 + fr) * ldc + col0;
#pragma unroll
                for (int bj = 0; bj < 2; ++bj) { const f32x4 v0 = acc[ai][bj][m][0] * scale, v1 = acc[ai][bj][m][1] * scale;
                    u32x4 w; w.x = cvt_pk_bf16(v0[0], v0[1]); w.y = cvt_pk_bf16(v0[2], v0[3]); w.z = cvt_pk_bf16(v1[0], v1[1]); w.w = cvt_pk_bf16(v1[2], v1[3]);
                    *(u32x4*)(rowp + bj * 128) = w; } }
    }
};

__device__ __forceinline__ void ph_final(const Args& a, int gw, int NGW, int lane) {
    const float* mod = (const float*)(a.ws + WS_MOD); const float* gfin = a.in[I_GFIN];
    const float* AFF = (const float*)(a.ws + WS_AFF); const int* SEL = (const int*)(a.ws + WS_SEL); const bf16_t* YS = (const bf16_t*)(a.ws + WS_YS);
    for (int row = gw; row < MLAT; row += NGW) {
        const int b = row >> 12;
        const float* gf = mod + (size_t)b * NMOD + 5120;
        float* xr = a.out + (size_t)row * DM;
        const int selv = (lane < 16) ? SEL[(size_t)row * NEXP + lane] : -1; const float affv = (lane < 16) ? AFF[(size_t)row * NEXP + lane] : 0.f;
        f32x4 acc[2][2];
#pragma unroll
        for (int jj = 0; jj < 2; ++jj) { acc[jj][0] = (f32x4){0.f, 0.f, 0.f, 0.f}; acc[jj][1] = (f32x4){0.f, 0.f, 0.f, 0.f}; }
#pragma unroll
        for (int e = 0; e < NEXP; ++e) { const int s = __builtin_amdgcn_readlane(selv, e); const float gt = __uint_as_float(__builtin_amdgcn_readlane(__float_as_uint(affv), e));
            if (s >= 0) { const bf16_t* yr = YS + ((size_t)(e * NB + b) * CAP + s) * DM;
#pragma unroll
                for (int jj = 0; jj < 2; ++jj) { const u32x4 y = *(const u32x4*)(yr + 8 * lane + 512 * jj);
                    acc[jj][0] += gt * (f32x4){bf_lo(y.x), bf_hi(y.x), bf_lo(y.y), bf_hi(y.y)}; acc[jj][1] += gt * (f32x4){bf_lo(y.z), bf_hi(y.z), bf_lo(y.w), bf_hi(y.w)}; } } }
        f32x4 v[2][2]; float ss = 0.f;
#pragma unroll
        for (int jj = 0; jj < 2; ++jj)
#pragma unroll
            for (int q = 0; q < 2; ++q) { const int c = 8 * lane + 512 * jj + 4 * q;
                v[jj][q] = *(const f32x4*)(xr + c) + *(const f32x4*)(gf + c) * acc[jj][q];
                ss += (v[jj][q].x * v[jj][q].x + v[jj][q].y * v[jj][q].y) + (v[jj][q].z * v[jj][q].z + v[jj][q].w * v[jj][q].w); }
        const float rstd = 1.0f / sqrtf(wave_sum(ss) * (1.0f / DM) + EPS);
#pragma unroll
        for (int jj = 0; jj < 2; ++jj)
#pragma unroll
            for (int q = 0; q < 2; ++q) { const int c = 8 * lane + 512 * jj + 4 * q; *(f32x4*)(xr + c) = v[jj][q] * rstd * *(const f32x4*)(gfin + c); }
    }
}

constexpr int N_PHASES = 12;
#ifndef MK_ATTN_REPS
#define MK_ATTN_REPS 1
#endif
struct Ctx { LAS unsigned char* lds; char* lds_gen; int G, bid, vcu, gw, NGW, wave, lane; };
template <int P> __device__ __forceinline__ void run_phase(const Args& args, const Ctx& c) {
    LAS unsigned char* lds = c.lds; const int G = c.G, bid = c.bid, vcu = c.vcu, gw = c.gw, NGW = c.NGW, wave = c.wave, lane = c.lane;
    if constexpr (P == 0) {
        ph_adaln(args, lds, bid, G);
        if (bid == G - 1) ph_rope_table(args);
        ph_small_weights(args, lds, gw, NGW, wave, lane);
    }
    if constexpr (P == 1) ph_norm_rows(args, gw, NGW, lane);
    if constexpr (P == 2) {
        SchedInProj S{(const char*)(args.ws + WS_H), (const char*)(args.ws + WS_WIN), G, bid};
        EpiInProj E{(bf16_t*)(args.ws + WS_U), (bf16_t*)(args.ws + WS_Q), (bf16_t*)(args.ws + WS_K), (bf16_t*)(args.ws + WS_V), (bf16_t*)(args.ws + WS_GC), (bf16_t*)(args.ws + WS_GA), (const float*)(args.ws + WS_ROPE)};
        pg8::gemm_phase<EpiInProj, SchedInProj, PG8_ALIGN, PG8_SP2>(lds, DM * 2, S, E);
    }
    if constexpr (P == 3) {
#ifndef MK_NO_CONV
        for (int u = vcu; u < 256; u += G) ph_conv_unit(args, lds, u);
        __syncthreads();
#endif
#ifndef MK_NO_ATTN
        float lam;
        { const float s1 = wave_sum(args.in[I_LQ1][lane] * args.in[I_LK1][lane]), s2 = wave_sum(args.in[I_LQ2][lane] * args.in[I_LK2][lane]); lam = __uint_as_float(__builtin_amdgcn_readfirstlane(__float_as_uint(expf(s1) - expf(s2) + 0.2f))); }
        for (int i = 0; i < 4 * MK_ATTN_REPS; ++i) { const int u = (i & 3) * 256 + vcu; if (u >= 1024) break;
            att::attn_unit(args, u >> 7, (u >> 4) & 7, u & 15, lam, c.lds_gen); }
#endif
    }
    if constexpr (P == 4) {
        SchedDual S{(const char*)(args.ws + WS_ATTO), (const char*)(args.ws + WS_CACT), (const char*)(args.ws + WS_WAO), (const char*)(args.ws + WS_WCO), G, bid};
        EpiDual E{(const bf16_t*)(args.ws + WS_GA), (const bf16_t*)(args.ws + WS_GC), args.in[I_BCO], (bf16_t*)(args.ws + WS_MIX)};
        pg8::gemm_phase<EpiDual, SchedDual, PG8_ALIGN, PG8_SP2>(lds, DM * 2, S, E);
    }
    if constexpr (P == 5) {
        SchedPlain S{(const char*)(args.ws + WS_MIX), (const char*)(args.ws + WS_WO), G, bid, 128, 4, DM * 2, 0};
        EpiResid E{args.in[I_X], (const float*)(args.ws + WS_MOD), args.out};
        pg8::gemm_phase<EpiResid, SchedPlain, PG8_ALIGN, PG8_SP2>(lds, DM * 2, S, E);
    }
    if constexpr (P == 6) {
        ph_router(args, lds, gw, NGW, lane);
        __syncthreads();
        ph_wgu(args, lds, gw, NGW, wave, lane);
        ph_wd(args, lds, gw, NGW, wave, lane);
    }
    if constexpr (P == 7) { for (int g = vcu; g < NB * NEXP; g += G) ph_topk_unit(args, lds, g); }
    if constexpr (P == 8) {
        SchedPlain S{(const char*)(args.ws + WS_XS), (const char*)(args.ws + WS_WGU), G, bid, 256, 22, DM, 1};
        EpiSwiGLU E{(unsigned char*)(args.ws + WS_HID)};
        pg8::gemm_phase<EpiSwiGLU, SchedPlain, PG8_ALIGN, PG8_SP2, true>(lds, DM, S, E);
    }
    if constexpr (P == 10) {
        SchedPlain S{(const char*)(args.ws + WS_HID), (const char*)(args.ws + WS_WD), G, bid, 256, 4, DFF, 1};
        EpiPlainBf16 E{(bf16_t*)(args.ws + WS_YS), DM, WSCALE_INV};
        pg8::gemm_phase<EpiPlainBf16, SchedPlain, PG8_ALIGN, PG8_SP2, true>(lds, DFF, S, E);
    }
    if constexpr (P == 11) ph_final(args, gw, NGW, lane);
}
#ifndef MK_PHASE_MASK
#define MK_PHASE_MASK 0xFFF
#endif
#ifndef MK_REPEAT_MASK
#define MK_REPEAT_MASK 0
#endif
__global__ void __launch_bounds__(512, 2) mk_fwd(Args args) {
    extern __shared__ __attribute__((aligned(16))) unsigned char lds_raw[];
    LAS unsigned char* lds = (LAS unsigned char*)lds_raw;
    const int tid = threadIdx.x;
    Ctx c; c.lds = lds; c.lds_gen = (char*)lds_raw; c.lane = tid & 63; c.wave = __builtin_amdgcn_readfirstlane(tid >> 6);
    c.G = gridDim.x; c.bid = blockIdx.x;
    c.vcu = (c.G % 8 == 0) ? (c.bid % 8) * (c.G / 8) + c.bid / 8 : c.bid;
    c.gw = c.vcu * 8 + c.wave; c.NGW = c.G * 8;
    volatile LAS unsigned* misc = (volatile LAS unsigned*)(lds + LDSCTL_OFF);
    if (tid < 64) misc[tid] = 0u;
    __syncthreads();
    const int lo = args.ph_lo, hi = args.ph_hi;
    XcdBarrier bar; bar.bar = (unsigned*)(args.ws + WS_CTL) + 1024 + args.li * XCD_BAR_WORDS; bar.x = 0; bar.st = nullptr;
    if (hi - lo > 1) bar = xcd_barrier_post((unsigned*)(args.ws + WS_CTL) + 1024 + args.li * XCD_BAR_WORDS, misc + 8);
#define IN(k) (((MK_PHASE_MASK >> (k)) & 1) && lo <= (k) && (k) < hi)
#define PHASE(k) do { if (IN(k)) { run_phase<k>(args, c); if constexpr ((MK_REPEAT_MASK >> (k)) & 1) { __syncthreads(); run_phase<k>(args, c); } } \
                      if ((k) != 9 && (k) + 1 < N_PHASES && IN(k) && IN((k) + 1)) xcd_barrier(bar); } while (0)
    PHASE(0); PHASE(1); PHASE(2); PHASE(3); PHASE(4); PHASE(5); PHASE(6); PHASE(7); PHASE(8); PHASE(9); PHASE(10); PHASE(11);
#undef IN
#undef PHASE
}

extern "C" void kernel_launch(void* const* d_in, const int* in_sizes, int n_in, void* d_out, int out_size, void* d_ws, size_t ws_size, hipStream_t stream) {
    static int grid = 0;
    if (grid == 0) {
        if (n_in != N_IN || out_size != MLAT * DM || ws_size < WS_END) { fprintf(stderr, "kernel_launch: unexpected shapes: n_in %d out %d ws %zu (need %zu)\n", n_in, out_size, ws_size, (size_t)WS_END); grid = -1; return; }
        int dev = 0, cus = 0, per_cu = 0;
        if (hipGetDevice(&dev) != hipSuccess || hipDeviceGetAttribute(&cus, hipDeviceAttributeMultiprocessorCount, dev) != hipSuccess) { grid = -1; return; }
        if (hipFuncSetAttribute((const void*)mk_fwd, hipFuncAttributeMaxDynamicSharedMemorySize, LDS_BYTES) != hipSuccess) { fprintf(stderr, "kernel_launch: hipFuncSetAttribute failed\n"); grid = -1; return; }
        if (hipOccupancyMaxActiveBlocksPerMultiprocessor(&per_cu, (const void*)mk_fwd, 512, LDS_BYTES) != hipSuccess || per_cu < 1) fprintf(stderr, "kernel_launch: occupancy query reports %d\n", per_cu);
        (void)hipGetLastError();
        grid = cus;
    }
    if (grid < 0) return;
    if (hipMemsetAsync((char*)d_ws + WS_CTL, 0, CTL_ZERO_BYTES, stream) != hipSuccess) return;
    Args a{};
    for (int i = 0; i < N_IN; ++i) a.in[i] = (const float*)d_in[i];
    a.out = (float*)d_out; a.ws = (unsigned char*)d_ws;
    constexpr int NL = MK_N_LAUNCHES;
    for (int li = 0; li < NL; ++li) {
        a.ph_lo = (NL == N_PHASES) ? li : (li * N_PHASES) / NL; a.ph_hi = (NL == N_PHASES) ? li + 1 : ((li + 1) * N_PHASES) / NL; a.li = (NL == N_PHASES) ? 0 : li; a.pad = 0;
        hipLaunchKernelGGL(mk_fwd, dim3(grid), dim3(512), LDS_BYTES, stream, a);
    }
}
```

```cpp
#include <hip/hip_runtime.h>
#include <cstdio>
#include <cstdint>

#ifndef MK_N_LAUNCHES
#define MK_N_LAUNCHES 1
#endif

#define LAS __attribute__((address_space(3)))
typedef unsigned short bf16_t;
typedef short bf16x8 __attribute__((ext_vector_type(8)));
typedef short s16x4 __attribute__((ext_vector_type(4)));
typedef float f32x2 __attribute__((ext_vector_type(2)));
typedef float f32x4 __attribute__((ext_vector_type(4)));
typedef float f32x16 __attribute__((ext_vector_type(16)));
typedef unsigned u32x2 __attribute__((ext_vector_type(2)));
typedef unsigned u32x4 __attribute__((ext_vector_type(4)));
typedef int i32x4 __attribute__((ext_vector_type(4)));
typedef int i32x8 __attribute__((ext_vector_type(8)));

constexpr int NB = 8, NT = 4096, DM = 1024, NCX = 256, NHD = 8, NEXP = 16, CAP = 512, DFF = 2816;
constexpr int MLAT = NB * NT, MCTX = NB * NCX, MALL = MLAT + MCTX, KVR = NT + NCX;
constexpr int NPROJ = 7168, NMOD = 6 * DM;
constexpr float EPS = 1e-6f;
constexpr float QSCALE = 0.125f * 1.4426950408889634f;

constexpr size_t MiB = 1u << 20;
constexpr size_t WS_CTL = 0, CTL_ZERO_BYTES = 65536;
constexpr size_t WS_MOD = 65536;
constexpr size_t WS_ROPE = 294912;
constexpr size_t WS_AFF = 1 * MiB;
constexpr size_t WS_SEL = 3 * MiB;
constexpr size_t WS_WIN = 8 * MiB, WS_WCO = 22 * MiB, WS_WAO = 24 * MiB, WS_WO = 26 * MiB;
constexpr size_t WS_H = 28 * MiB;
constexpr size_t WS_ATTO = 28 * MiB;
constexpr size_t WS_U = 96 * MiB;
constexpr size_t WS_MIX = 96 * MiB;
constexpr size_t WS_Q = 160 * MiB;
constexpr size_t WS_K = 224 * MiB;
constexpr size_t WS_V = 292 * MiB;
constexpr size_t WS_GC = 360 * MiB, WS_GA = 424 * MiB;
constexpr size_t WS_CACT = 488 * MiB;
constexpr size_t WS_O1 = 552 * MiB;
constexpr size_t WS_WGU = 8 * MiB;
constexpr size_t WS_XS = 96 * MiB;
constexpr size_t WS_HF = 160 * MiB;
constexpr size_t WS_HID = 192 * MiB;
constexpr size_t WS_WD = 368 * MiB;
constexpr size_t WS_YS = 416 * MiB;
constexpr float WSCALE = 64.0f, WSCALE_INV = 1.0f / 64.0f;
constexpr size_t WS_END = 680 * MiB;

constexpr int RING_BYTES = 131072, LDSCTL_OFF = RING_BYTES, LDS_BYTES = 147456;

#define LDS_WAIT() asm volatile("s_waitcnt lgkmcnt(0)" ::: "memory")
#define VM_WAIT() asm volatile("s_waitcnt vmcnt(0)" ::: "memory")
__device__ __forceinline__ unsigned cvt_pk_bf16(float lo, float hi) { unsigned r; asm volatile("v_cvt_pk_bf16_f32 %0, %1, %2" : "=v"(r) : "v"(lo), "v"(hi)); return r; }
__device__ __forceinline__ unsigned pack4_fp8(float a, float b, float c, float d) { int w = 0; w = __builtin_amdgcn_cvt_pk_fp8_f32(a, b, w, false); w = __builtin_amdgcn_cvt_pk_fp8_f32(c, d, w, true); return (unsigned)w; }
__device__ __forceinline__ float bf_lo(unsigned u) { return __uint_as_float(u << 16); }
__device__ __forceinline__ float bf_hi(unsigned u) { return __uint_as_float(u & 0xffff0000u); }
__device__ __forceinline__ float wave_sum(float v) {
#pragma unroll
    for (int o = 1; o < 64; o <<= 1) v += __shfl_xor(v, o);
    return v;
}
__device__ __forceinline__ float sigmoidf_(float x) { return __builtin_amdgcn_rcpf(1.0f + __expf(-x)); }

#define XB_TMO      128
#define XB_XCNT(j)  (256  + 64 * (j))
#define XB_XSUB(j)  (1280 + 64 * (j))
#define XB_XGEN(j)  (2304 + 64 * (j))
#define XB_TOP      3328
#define XB_TOPGEN   3392
#define XCD_BAR_WORDS 3456
#define XB_SPIN_CAP (1u << 18)
__device__ __forceinline__ unsigned xb_ld(unsigned* p)              { return __hip_atomic_load(p, __ATOMIC_RELAXED, __HIP_MEMORY_SCOPE_AGENT); }
__device__ __forceinline__ unsigned xb_add(unsigned* p, unsigned v) { return __hip_atomic_fetch_add(p, v, __ATOMIC_RELAXED, __HIP_MEMORY_SCOPE_AGENT); }
__device__ __forceinline__ unsigned xb_xcc_id() { return (unsigned)__builtin_amdgcn_s_getreg((3 << 11) | 20) & 0xFu; }
#define XB_SPIN(cond, bar) do { unsigned _sp = 0; while (cond) { __builtin_amdgcn_s_sleep(1); \
    if ((++_sp & 255u) == 0u) { if (xb_ld(&(bar)[XB_TMO])) break; if (_sp > XB_SPIN_CAP) { atomicAdd(&(bar)[XB_TMO], 1u); break; } } } } while (0)
struct XcdBarrier { unsigned* bar; unsigned x; volatile LAS unsigned* st; };
__device__ __forceinline__ XcdBarrier xcd_barrier_post(unsigned* bar, volatile LAS unsigned* st) {
    XcdBarrier b; b.bar = bar; b.x = xb_xcc_id(); b.st = st;
    if (threadIdx.x == 0) (void)xb_add(&bar[XB_XCNT(b.x)], 1u);
    return b;
}
__device__ __forceinline__ void xcd_barrier_complete(unsigned* bar, unsigned x, unsigned& nloc, unsigned& nx) {
    const unsigned G = gridDim.x * gridDim.y * gridDim.z;
    unsigned sum, cnt, mine, sp = 0u;
    for (;;) {
        sum = 0u; cnt = 0u; mine = 0u;
#pragma unroll
        for (unsigned j = 0; j < 16; ++j) { const unsigned c = xb_ld(&bar[XB_XCNT(j)]); sum += c; cnt += (c > 0u) ? 1u : 0u; mine = (j == x) ? c : mine; }
        if (sum == G) break;
        __builtin_amdgcn_s_sleep(1);
        if ((++sp & 255u) == 0u) { if (xb_ld(&bar[XB_TMO])) break; if (sp > XB_SPIN_CAP) { atomicAdd(&bar[XB_TMO], 1u); break; } }
    }
    nloc = mine > 0u ? mine : 1u; nx = cnt > 0u ? cnt : 1u;
}
__device__ __forceinline__ void xcd_barrier(const XcdBarrier& b) {
    asm volatile("s_waitcnt vmcnt(0)" ::: "memory");
    __syncthreads();
    if (threadIdx.x == 0) {
        unsigned* bar = b.bar;
        __builtin_amdgcn_s_waitcnt(0);
        unsigned nloc = b.st[0], nx = b.st[1];
        if (nloc == 0u) { xcd_barrier_complete(bar, b.x, nloc, nx); b.st[0] = nloc; b.st[1] = nx; }
        const unsigned old = xb_add(&bar[XB_XSUB(b.x)], 1u);
        const unsigned gen = old / nloc;
        if (old + 1u == (gen + 1u) * nloc) {
            __builtin_amdgcn_fence(__ATOMIC_RELEASE, "agent");
            asm volatile("s_waitcnt vmcnt(0)" ::: "memory");
            const unsigned og = xb_add(&bar[XB_TOP], 1u);
            const unsigned tg = og / nx;
            if (og + 1u == (tg + 1u) * nx) xb_add(&bar[XB_TOPGEN], 1u);
            else XB_SPIN(xb_ld(&bar[XB_TOPGEN]) == tg, bar);
            __builtin_amdgcn_fence(__ATOMIC_ACQUIRE, "agent");
            xb_add(&bar[XB_XGEN(b.x)], 1u);
            asm volatile("s_waitcnt vmcnt(0)" ::: "memory");
        } else {
            XB_SPIN(xb_ld(&bar[XB_XGEN(b.x)]) == gen, bar);
            __builtin_amdgcn_fence(__ATOMIC_ACQUIRE, "agent");
            asm volatile("s_waitcnt vmcnt(0)" ::: "memory");
        }
    }
    __syncthreads();
}

namespace pg8 {
constexpr int BM = 256, BK = 64, HALF = 128, HTB = HALF * BK * 2, STAGE_BYTES = 8 * HTB, NXCD = 8, WGM = 8;
__host__ __device__ __forceinline__ int lds_byte(int r, int c) { const int st = (r >> 4) * 2 + (c >> 5), rr = r & 15, cc = c & 31, ob = rr * 64 + cc * 2; return st * 1024 + (ob ^ (((ob >> 9) & 1) << 5)); }
__host__ __device__ __forceinline__ void stage_rc(int b, int& R, int& C) { const int st = b / 1024, sb = b % 1024, swz = sb ^ (((sb >> 9) & 1) << 5); R = (st >> 1) * 16 + swz / 64; C = (st & 1) * 32 + (swz % 64) / 2; }
__host__ __device__ __forceinline__ int perm32(int rho) { const int n = rho >> 4, i = rho & 15; return 8 * (i >> 2) + 4 * n + (i & 3); }

struct Unit { int pm, pn, aux; };

__device__ __forceinline__ void tile_of(int L, int nM, int nN, int& pm, int& pn) {
    const int nwg = nM * nN; int wgid = L;
    { const int q = nwg / NXCD, r = nwg % NXCD, xcd = wgid % NXCD, off = wgid / NXCD; wgid = (xcd < r ? xcd * (q + 1) : r * (q + 1) + (xcd - r) * q) + off; }
    const int nig = WGM * nN, gid = wgid / nig, fm = gid * WGM, gsz = (nM - fm) < WGM ? (nM - fm) : WGM;
    pm = fm + ((wgid % nig) % gsz); pn = (wgid % nig) / gsz;
}

template <class Epi, class Sched, bool ALIGN_EPI, bool SP2, bool FP8 = false>
__device__ __forceinline__ void gemm_phase(LAS unsigned char* lds, const int RB, const Sched& S, const Epi& E) {
    const int tid = threadIdx.x, wid = __builtin_amdgcn_readfirstlane(tid >> 6), lane = tid & 63, wr = wid >> 2, wc = wid & 3, fr = lane & 15, fq = lane >> 4;
    const int nt = RB / 128;
    unsigned voffA[2], voffB[2];
#pragma unroll
    for (int i = 0; i < 2; ++i) { int R, C; stage_rc(tid * 16 + i * 8192, R, C); const int Rb = Epi::PERM ? ((R & ~31) + perm32(R & 31)) : R;
        voffA[i] = (unsigned)(R * RB + C * 2); voffB[i] = (unsigned)(Rb * RB + C * 2); }
    const size_t kstep = (size_t)(BK * 2);
    const size_t hstep = (size_t)HALF * RB;
    const unsigned ldsw = (unsigned)wid * 1024u;
    const int aoff = lds_byte(wr * 64 + fr, fq * 8), boff = lds_byte(wc * 32 + fr, fq * 8);
#define PG8_SA(b, h) (((b) * 2 + (h)) * HTB)
#define PG8_SB(b, h) ((4 + (b) * 2 + (h)) * HTB)
#define PG8_STAGE(bufoff, gbase, voff) do { _Pragma("unroll") for (int _i = 0; _i < 2; ++_i) \
        __builtin_amdgcn_global_load_lds((const unsigned*)((const char*)(gbase) + (voff)[_i]), (LAS unsigned*)(lds + (bufoff) + ldsw + _i * 8192), 16, 0, 0); } while (0)
#define PG8_LD8(p) __builtin_shufflevector(*(const LAS i32x4*)(p), *(const LAS i32x4*)((p) + 1024), 0, 1, 2, 3, 4, 5, 6, 7)
#define PG8_LDA(dst, b, h) do { _Pragma("unroll") for (int m = 0; m < 4; ++m) dst[m] = PG8_LD8(lds + PG8_SA(b, h) + aoff + m * 2048); } while (0)
#define PG8_LDB(dst, b, h) do { _Pragma("unroll") for (int n = 0; n < 2; ++n) dst[n] = PG8_LD8(lds + PG8_SB(b, h) + boff + n * 2048); } while (0)
#define PG8_LO(x) __builtin_bit_cast(bf16x8, __builtin_shufflevector(x, x, 0, 1, 2, 3))
#define PG8_HI(x) __builtin_bit_cast(bf16x8, __builtin_shufflevector(x, x, 4, 5, 6, 7))
#define PG8_MMA(ai, bj, At, Bt) do { __builtin_amdgcn_s_setprio(1); _Pragma("unroll") for (int m = 0; m < 4; ++m) _Pragma("unroll") for (int n = 0; n < 2; ++n) { \
        if constexpr (FP8) asm volatile("v_mfma_f32_16x16x128_f8f6f4 %0, %1, %2, %0" : "+v"(acc[ai][bj][m][n]) : "v"(Bt[n]), "v"(At[m]));   \
        else { acc[ai][bj][m][n] = __builtin_amdgcn_mfma_f32_16x16x32_bf16(PG8_LO(Bt[n]), PG8_LO(At[m]), acc[ai][bj][m][n], 0, 0, 0); \
               acc[ai][bj][m][n] = __builtin_amdgcn_mfma_f32_16x16x32_bf16(PG8_HI(Bt[n]), PG8_HI(At[m]), acc[ai][bj][m][n], 0, 0, 0); } } \
        __builtin_amdgcn_s_setprio(0); } while (0)
#define PG8_WAIT_V(n) asm volatile("s_waitcnt vmcnt(" #n ")" ::: "memory")
#define PG8_WAIT_L(n) asm volatile("s_waitcnt lgkmcnt(" #n ")" ::: "memory")
#define PG8_BAR __builtin_amdgcn_s_barrier()
#define PG8_SCHED __builtin_amdgcn_sched_barrier(0)
    Unit cur, nxt; int ui = 0;
    if (!S.next(0, cur)) return;
    f32x4 acc[2][2][4][2];
#pragma unroll
    for (int a = 0; a < 2; ++a)
#pragma unroll
        for (int b = 0; b < 2; ++b)
#pragma unroll
            for (int m = 0; m < 4; ++m)
#pragma unroll
                for (int n = 0; n < 2; ++n) acc[a][b][m][n] = (f32x4){0.f, 0.f, 0.f, 0.f};
    i32x8 At[4], B0[2], B1[2];
    const char* cA = S.a_ptr(cur); const char* cB = S.b_ptr(cur);
    if constexpr (SP2) {
        PG8_STAGE(PG8_SB(0, 0), cB, voffB); PG8_STAGE(PG8_SB(0, 1), cB + hstep, voffB); PG8_STAGE(PG8_SA(0, 0), cA, voffA); PG8_STAGE(PG8_SA(0, 1), cA + hstep, voffA);
        if (wr == 1) PG8_BAR;
        PG8_WAIT_V(2); PG8_BAR;
        PG8_STAGE(PG8_SB(1, 0), cB + kstep, voffB); PG8_STAGE(PG8_SA(1, 0), cA + kstep, voffA); PG8_STAGE(PG8_SB(1, 1), cB + hstep + kstep, voffB);
        PG8_WAIT_V(6); PG8_BAR;
    } else {
        PG8_STAGE(PG8_SB(0, 0), cB, voffB); PG8_STAGE(PG8_SA(0, 0), cA, voffA); PG8_STAGE(PG8_SB(0, 1), cB + hstep, voffB); PG8_STAGE(PG8_SA(0, 1), cA + hstep, voffA);
        if (wr == 1) PG8_BAR;
        PG8_WAIT_V(4); PG8_BAR;
        PG8_STAGE(PG8_SB(1, 0), cB + kstep, voffB); PG8_STAGE(PG8_SA(1, 0), cA + kstep, voffA); PG8_STAGE(PG8_SB(1, 1), cB + hstep + kstep, voffB);
        PG8_WAIT_V(6); PG8_BAR;
    }
    for (;;) {
        const bool has_next = S.next(ui + 1, nxt);
        const char* nA = has_next ? S.a_ptr(nxt) : cA; const char* nB = has_next ? S.b_ptr(nxt) : cB;
#pragma nounroll
        for (int t = 0; t < nt; t += 2) {
            const bool last = (t == nt - 2);
            const char* a1 = cA + (size_t)(t + 1) * kstep;
            const char* a2 = last ? nA : cA + (size_t)(t + 2) * kstep; const char* b2 = last ? nB : cB + (size_t)(t + 2) * kstep;
            const char* a3 = a2 + kstep; const char* b3 = b2 + kstep;
            if constexpr (SP2) {
            PG8_LDB(B0, 0, 0); PG8_LDB(B1, 0, 1); PG8_SCHED; PG8_LDA(At, 0, 0); PG8_STAGE(PG8_SA(1, 1), a1 + hstep, voffA);
            PG8_WAIT_V(8); PG8_WAIT_L(0); PG8_BAR; PG8_MMA(0, 0, At, B0); PG8_MMA(0, 1, At, B1); PG8_BAR; PG8_SCHED;
            PG8_LDA(At, 0, 1); PG8_STAGE(PG8_SB(0, 0), b2, voffB); PG8_STAGE(PG8_SB(0, 1), b2 + hstep, voffB); PG8_STAGE(PG8_SA(0, 0), a2, voffA);
            PG8_WAIT_V(8); PG8_WAIT_L(0); PG8_BAR; PG8_MMA(1, 0, At, B0); PG8_MMA(1, 1, At, B1); PG8_BAR; PG8_SCHED;
            PG8_LDB(B0, 1, 0); PG8_LDB(B1, 1, 1); PG8_SCHED; PG8_LDA(At, 1, 0); PG8_STAGE(PG8_SA(0, 1), a2 + hstep, voffA);
            PG8_WAIT_V(8); PG8_WAIT_L(0); PG8_BAR; PG8_MMA(0, 0, At, B0); PG8_MMA(0, 1, At, B1); PG8_BAR; PG8_SCHED;
            PG8_LDA(At, 1, 1); PG8_STAGE(PG8_SB(1, 0), b3, voffB); PG8_STAGE(PG8_SB(1, 1), b3 + hstep, voffB); PG8_STAGE(PG8_SA(1, 0), a3, voffA);
            PG8_WAIT_V(8); PG8_WAIT_L(0); PG8_BAR; PG8_MMA(1, 0, At, B0); PG8_MMA(1, 1, At, B1); PG8_BAR; PG8_SCHED;
            } else {
            PG8_LDB(B0, 0, 0); PG8_SCHED; PG8_LDA(At, 0, 0); PG8_STAGE(PG8_SA(1, 1), a1 + hstep, voffA);
            PG8_WAIT_L(8); PG8_BAR; PG8_WAIT_L(0); PG8_MMA(0, 0, At, B0); PG8_BAR; PG8_SCHED;
            PG8_LDB(B1, 0, 1); PG8_STAGE(PG8_SB(0, 0), b2, voffB);
            PG8_BAR; PG8_WAIT_L(0); PG8_MMA(0, 1, At, B1); PG8_BAR;
            PG8_LDA(At, 0, 1); PG8_STAGE(PG8_SA(0, 0), a2, voffA);
            PG8_BAR; PG8_WAIT_L(0); PG8_MMA(1, 0, At, B0); PG8_BAR; PG8_SCHED;
            PG8_STAGE(PG8_SB(0, 1), b2 + hstep, voffB);
            PG8_WAIT_V(6); PG8_BAR; PG8_MMA(1, 1, At, B1); PG8_BAR;
            PG8_LDB(B0, 1, 0); PG8_SCHED; PG8_LDA(At, 1, 0); PG8_STAGE(PG8_SA(0, 1), a2 + hstep, voffA);
            PG8_WAIT_L(8); PG8_BAR; PG8_WAIT_L(0); PG8_MMA(0, 0, At, B0); PG8_BAR; PG8_SCHED;
            PG8_LDB(B1, 1, 1); PG8_STAGE(PG8_SB(1, 0), b3, voffB);
            PG8_BAR; PG8_WAIT_L(0); PG8_MMA(0, 1, At, B1); PG8_BAR;
            PG8_LDA(At, 1, 1); PG8_STAGE(PG8_SA(1, 0), a3, voffA);
            PG8_BAR; PG8_WAIT_L(0); PG8_MMA(1, 0, At, B0); PG8_BAR; PG8_SCHED;
            PG8_STAGE(PG8_SB(1, 1), b3 + hstep, voffB);
            PG8_WAIT_V(6); PG8_BAR; PG8_MMA(1, 1, At, B1); PG8_BAR;
            }
        }
        if constexpr (ALIGN_EPI) { if (wr == 0) PG8_BAR; }
        if constexpr (FP8) asm volatile("s_nop 15\n\ts_nop 15" ::: "memory");
        E(acc, cur, wr, wc, fr, fq);
        if (!has_next) break;
        if (!S.keep(cur)) {
#pragma unroll
            for (int a = 0; a < 2; ++a)
#pragma unroll
                for (int b = 0; b < 2; ++b)
#pragma unroll
                    for (int m = 0; m < 4; ++m)
#pragma unroll
                        for (int n = 0; n < 2; ++n) acc[a][b][m][n] = (f32x4){0.f, 0.f, 0.f, 0.f};
        }
        cur = nxt; cA = nA; cB = nB; ++ui;
        if constexpr (ALIGN_EPI) { if (wr == 1) PG8_BAR; }
    }
    PG8_WAIT_V(0);
    if constexpr (!ALIGN_EPI) { if (wr == 0) PG8_BAR; }
    PG8_BAR;
#undef PG8_SA
#undef PG8_SB
#undef PG8_STAGE
#undef PG8_LDA
#undef PG8_LDB
#undef PG8_MMA
#undef PG8_LD8
#undef PG8_LO
#undef PG8_HI
#undef PG8_WAIT_V
#undef PG8_WAIT_L
#undef PG8_BAR
#undef PG8_SCHED
}
}
using pg8::Unit;

#ifndef PG8_SP2
#define PG8_SP2 true
#endif
#ifndef PG8_ALIGN
#define PG8_ALIGN true
#endif

enum InIdx { I_X = 0, I_C, I_CTX, I_CCTX, I_WADA, I_BADA, I_GMIX, I_GFFN, I_WIN, I_WDW, I_BDW, I_LNG, I_LNB, I_WCO, I_BCO, I_LQ1, I_LK1, I_LQ2, I_LK2, I_GSUB, I_WAO, I_WOUT, I_WR, I_WEG, I_WEU, I_WED, I_GFIN, N_IN };
struct Args { const float* in[N_IN]; float* out; unsigned char* ws; int ph_lo, ph_hi, li, pad; };

__device__ __forceinline__ void ph_adaln(const Args& a, LAS unsigned char* lds, int bid, int G) {
    const int tid = threadIdx.x;
    LAS float* sil = (LAS float*)lds;
    LAS float* red = sil + 9 * 1024;
    const float* c = a.in[I_C]; const float* cc = a.in[I_CCTX]; const float* w = a.in[I_WADA]; const float* bb = a.in[I_BADA];
    float* mod = (float*)(a.ws + WS_MOD);
    for (int i = tid; i < 9 * 1024; i += 512) { const float v = (i < 8192) ? c[i] : cc[i - 8192]; sil[i] = v / (1.0f + expf(-v)); }
    __syncthreads();
    for (int unit = bid; unit < NMOD / 32; unit += G) {
        const int n0 = unit * 32, col = tid & 31, kp = tid >> 5;
        float acc[9];
#pragma unroll
        for (int r = 0; r < 9; ++r) acc[r] = 0.f;
#pragma unroll 8
        for (int kk = 0; kk < 64; ++kk) { const int k = kp * 64 + kk; const float wv = w[(size_t)k * NMOD + n0 + col];
#pragma unroll
            for (int r = 0; r < 9; ++r) acc[r] += sil[r * 1024 + k] * wv; }
#pragma unroll
        for (int r = 0; r < 9; ++r) red[(kp * 9 + r) * 32 + col] = acc[r];
        __syncthreads();
        if (tid < 288) { const int r = tid >> 5, cl = tid & 31; float s = 0.f;
#pragma unroll
            for (int k2 = 0; k2 < 16; ++k2) s += red[(k2 * 9 + r) * 32 + cl];
            mod[r * NMOD + n0 + cl] = s + bb[n0 + cl]; }
        __syncthreads();
    }
}
__device__ __forceinline__ void ph_rope_table(const Args& a) {
    float* rc = (float*)(a.ws + WS_ROPE); float* rs = rc + 1024;
    for (int i = threadIdx.x; i < 1024; i += 512) { const int pos = i >> 4, f = i & 15;
        const float inv = powf(10000.0f, -(float)f / 16.0f); const float ang = (float)pos * inv;
        rc[i] = cosf(ang); rs[i] = sinf(ang); }
}
template <class DstRow>
__device__ __forceinline__ void transpose_item(const float* W, int K, int N, bf16_t* WT, const DstRow& dr, LAS float* scr, int item, int lane) {
    const int nblk = N / 32, kb = item / nblk, nb = item % nblk, k0 = 64 * kb, n0 = 32 * nb;
#pragma unroll 8
    for (int i = 0; i < 32; ++i) { const int kk = 2 * i + (lane >> 5); scr[kk * 33 + (lane & 31)] = W[(size_t)(k0 + kk) * N + n0 + (lane & 31)]; }
    LDS_WAIT(); asm volatile("" ::: "memory");
    const int c = lane & 7;
#pragma unroll
    for (int j = 0; j < 4; ++j) { const int n = (lane >> 3) + 8 * j; const LAS float* s = scr + (8 * c) * 33 + n;
        u32x4 o; o.x = cvt_pk_bf16(s[0 * 33], s[1 * 33]); o.y = cvt_pk_bf16(s[2 * 33], s[3 * 33]); o.z = cvt_pk_bf16(s[4 * 33], s[5 * 33]); o.w = cvt_pk_bf16(s[6 * 33], s[7 * 33]);
        *(u32x4*)(WT + (size_t)dr(n0 + n) * K + k0 + 8 * c) = o; }
    LDS_WAIT(); asm volatile("" ::: "memory");
}
template <class DstRow>
__device__ __forceinline__ void transpose_item_fp8(const float* W, int K, int N, unsigned char* WT, const DstRow& dr, LAS float* scr, int item, int lane) {
    const int nblk = N / 32, kb = item / nblk, nb = item % nblk, k0 = 64 * kb, n0 = 32 * nb;
#pragma unroll 8
    for (int i = 0; i < 32; ++i) { const int kk = 2 * i + (lane >> 5); scr[kk * 33 + (lane & 31)] = W[(size_t)(k0 + kk) * N + n0 + (lane & 31)]; }
    LDS_WAIT(); asm volatile("" ::: "memory");
    const int c = lane & 7;
#pragma unroll
    for (int j = 0; j < 4; ++j) { const int n = (lane >> 3) + 8 * j; const LAS float* s = scr + (8 * c) * 33 + n;
        u32x2 o; o.x = pack4_fp8(s[0 * 33] * WSCALE, s[1 * 33] * WSCALE, s[2 * 33] * WSCALE, s[3 * 33] * WSCALE); o.y = pack4_fp8(s[4 * 33] * WSCALE, s[5 * 33] * WSCALE, s[6 * 33] * WSCALE, s[7 * 33] * WSCALE);
        *(u32x2*)(WT + (size_t)dr(n0 + n) * K + k0 + 8 * c) = o; }
    LDS_WAIT(); asm volatile("" ::: "memory");
}
__host__ __device__ __forceinline__ int qdst(int d) { const int blk = d >> 5, half = (d >> 4) & 1, i = d & 15; return 8 * (4 * blk + (i >> 2)) + 4 * half + (i & 3); }
struct DrWin { __host__ __device__ int operator()(int j) const {
    if (j < 1024) return 256 * (j >> 7) + (j & 127);
    if (j < 2048) { const int jj = j - 1024; return 256 * (jj >> 7) + 128 + (jj & 127); }
    if (j < 4096) { const int jj = j & 1023, base = j - jj; return base + (jj & ~63) + qdst(jj & 63); }
    return j; } };
struct DrId { __host__ __device__ int operator()(int j) const { return j; } };
struct DrGU { int up; __host__ __device__ int operator()(int f) const { return 256 * (f >> 7) + 128 * up + (f & 127); } };

__device__ __forceinline__ void ph_small_weights(const Args& a, LAS unsigned char* lds, int gw, int NGW, int wave, int lane) {
    LAS float* scr = (LAS float*)(lds + 57344 + wave * 8448);
    constexpr int I_IN = (DM / 64) * (NPROJ / 32), I_SQ = (DM / 64) * (DM / 32);
    for (int it = gw; it < I_IN + 3 * I_SQ; it += NGW) {
        int r = it;
        if (r < I_IN) { transpose_item(a.in[I_WIN], DM, NPROJ, (bf16_t*)(a.ws + WS_WIN), DrWin{}, scr, r, lane); continue; } r -= I_IN;
        if (r < I_SQ) { transpose_item(a.in[I_WCO], DM, DM, (bf16_t*)(a.ws + WS_WCO), DrId{}, scr, r, lane); continue; } r -= I_SQ;
        if (r < I_SQ) { transpose_item(a.in[I_WAO], DM, DM, (bf16_t*)(a.ws + WS_WAO), DrId{}, scr, r, lane); continue; } r -= I_SQ;
        transpose_item(a.in[I_WOUT], DM, DM, (bf16_t*)(a.ws + WS_WO), DrId{}, scr, r, lane);
    }
}
__device__ __forceinline__ void ph_wgu(const Args& a, LAS unsigned char* lds, int gw, int NGW, int wave, int lane) {
    LAS float* scr = (LAS float*)(lds + 57344 + wave * 8448);
    constexpr int I_E = (DM / 64) * (DFF / 32);
    for (int it = gw; it < 2 * NEXP * I_E; it += NGW) {
        const int mat = it / I_E, r = it % I_E, e = mat >> 1, up = mat & 1;
        const float* W = (up ? a.in[I_WEU] : a.in[I_WEG]) + (size_t)e * DM * DFF;
        transpose_item_fp8(W, DM, DFF, (unsigned char*)(a.ws + WS_WGU) + (size_t)e * 2 * DFF * DM, DrGU{up}, scr, r, lane);
    }
}
__device__ __forceinline__ void ph_wd(const Args& a, LAS unsigned char* lds, int gw, int NGW, int wave, int lane) {
    LAS float* scr = (LAS float*)(lds + 57344 + wave * 8448);
    constexpr int I_E = (DFF / 64) * (DM / 32);
    for (int it = gw; it < NEXP * I_E; it += NGW) {
        const int e = it / I_E, r = it % I_E;
        transpose_item_fp8(a.in[I_WED] + (size_t)e * DFF * DM, DFF, DM, (unsigned char*)(a.ws + WS_WD) + (size_t)e * DM * DFF, DrId{}, scr, r, lane);
    }
}

__device__ __forceinline__ void ph_norm_rows(const Args& a, int gw, int NGW, int lane) {
    const float* mod = (const float*)(a.ws + WS_MOD); const float* g = a.in[I_GMIX]; bf16_t* H = (bf16_t*)(a.ws + WS_H);
    const int per = (MALL + NGW - 1) / NGW, r0 = gw * per, r1 = (r0 + per < MALL) ? r0 + per : MALL;
    if (r0 >= r1) return;
    auto src_of = [&](int row) { return (const f32x4*)((row < MLAT) ? a.in[I_X] + (size_t)row * DM : a.in[I_CTX] + (size_t)(row - MLAT) * DM) + lane; };
    f32x4 gs[4], sh[4]; int cur_b = -1;
    f32x4 nx[4];
    { const f32x4* xr = src_of(r0);
#pragma unroll
      for (int j = 0; j < 4; ++j) nx[j] = xr[64 * j]; }
    for (int row = r0; row < r1; ++row) {
        f32x4 v[4];
#pragma unroll
        for (int j = 0; j < 4; ++j) v[j] = nx[j];
        if (row + 1 < r1) { const f32x4* xr = src_of(row + 1);
#pragma unroll
            for (int j = 0; j < 4; ++j) nx[j] = xr[64 * j]; }
        const int b = (row < MLAT) ? (row >> 12) : 8;
        if (b != cur_b) { cur_b = b; const float* mb = mod + (size_t)b * NMOD;
#pragma unroll
            for (int j = 0; j < 4; ++j) { const int c = 4 * lane + 256 * j; gs[j] = *(const f32x4*)(g + c) * (*(const f32x4*)(mb + 1024 + c) + 1.0f); sh[j] = *(const f32x4*)(mb + c); } }
        float s = 0.f;
#pragma unroll
        for (int j = 0; j < 4; ++j) s += (v[j].x * v[j].x + v[j].y * v[j].y) + (v[j].z * v[j].z + v[j].w * v[j].w);
        const float rstd = 1.0f / sqrtf(wave_sum(s) * (1.0f / DM) + EPS);
        unsigned long long* o8 = (unsigned long long*)(H + (size_t)row * DM) + lane;
#pragma unroll
        for (int j = 0; j < 4; ++j) { const f32x4 y = (v[j] * rstd) * gs[j] + sh[j];
            o8[64 * j] = (unsigned long long)cvt_pk_bf16(y.x, y.y) | ((unsigned long long)cvt_pk_bf16(y.z, y.w) << 32); }
    }
}

struct SchedInProj {
    const char* A; const char* Bt; int G, c;
    static constexpr int NLAT = 128 * 28, NCTXU = 8 * 8;
    __device__ __forceinline__ bool next(int i, Unit& u) const {
        const int L = i * G + c; if (L >= NLAT + NCTXU) return false;
        if (L < NLAT) { pg8::tile_of(L, 128, 28, u.pm, u.pn); } else { const int v = L - NLAT; u.pm = 128 + (v & 7); u.pn = 12 + (v >> 3); }
        u.aux = 0; return true; }
    __device__ __forceinline__ const char* a_ptr(const Unit& u) const { return (u.pn >= 16 && u.pn < 20) ? Bt + (size_t)u.pn * (256 * DM * 2) : A + (size_t)u.pm * (256 * DM * 2); }
    __device__ __forceinline__ const char* b_ptr(const Unit& u) const { return (u.pn >= 16 && u.pn < 20) ? A + (size_t)u.pm * (256 * DM * 2) : Bt + (size_t)u.pn * (256 * DM * 2); }
    __device__ __forceinline__ bool keep(const Unit&) const { return false; }
};
struct EpiInProj {
    static constexpr bool PERM = true;
    bf16_t *U, *Q, *KA, *VA, *GC, *GA; const float* rope;
    __device__ __forceinline__ void operator()(f32x4 (&acc)[2][2][4][2], const Unit& u, int wr, int wc, int fr, int fq) const {
        const int pn = u.pn, pm = u.pm;
        const int cw = wc * 32 + 8 * fq;
        if (pn < 8) {
#pragma unroll
            for (int ai = 0; ai < 2; ++ai)
#pragma unroll
                for (int m = 0; m < 4; ++m) { const int r = pm * 256 + ai * 128 + wr * 64 + m * 16 + fr;
                    const f32x4 a0 = acc[ai][0][m][0], a1 = acc[ai][0][m][1], b0 = acc[ai][1][m][0], b1 = acc[ai][1][m][1];
                    u32x4 w; w.x = cvt_pk_bf16(a0[0] * sigmoidf_(b0[0]), a0[1] * sigmoidf_(b0[1])); w.y = cvt_pk_bf16(a0[2] * sigmoidf_(b0[2]), a0[3] * sigmoidf_(b0[3]));
                    w.z = cvt_pk_bf16(a1[0] * sigmoidf_(b1[0]), a1[1] * sigmoidf_(b1[1])); w.w = cvt_pk_bf16(a1[2] * sigmoidf_(b1[2]), a1[3] * sigmoidf_(b1[3]));
                    *(u32x4*)(U + (size_t)r * DM + pn * 128 + cw) = w; }
            return;
        }
        if (pn < 16) {
            const bool isq = pn < 12, lat = pm < 128;
            bf16_t* base; size_t row0; int rowpos0 = 0;
            if (isq) { base = Q + (size_t)(pn - 8) * 256; row0 = (size_t)pm * 256; }
            else { base = KA + (size_t)(pn - 12) * 256; row0 = lat ? (size_t)(pm >> 4) * KVR + (size_t)(pm & 15) * 256 : (size_t)(pm - 128) * KVR + NT; }
            if (lat) rowpos0 = (pm & 15) * 4;
            const float sc = isq ? QSCALE : 1.0f;
            const float* rc = rope; const float* rs = rope + 1024;
#pragma unroll
            for (int ai = 0; ai < 2; ++ai)
#pragma unroll
                for (int m = 0; m < 4; ++m) { const int rl = ai * 128 + wr * 64 + m * 16 + fr;
                    f32x4 cs = (f32x4){1.f, 1.f, 1.f, 1.f}, sn = (f32x4){0.f, 0.f, 0.f, 0.f};
                    if (lat) { const int pos = (wc & 1) ? (m * 16 + fr) : (rowpos0 + 2 * ai + wr); cs = *(const f32x4*)(rc + pos * 16 + 4 * fq); sn = *(const f32x4*)(rs + pos * 16 + 4 * fq); }
#pragma unroll
                    for (int bj = 0; bj < 2; ++bj) { const f32x4 x1 = acc[ai][bj][m][0], x2 = acc[ai][bj][m][1];
                        const f32x4 y1 = (x1 * cs - x2 * sn) * sc, y2 = (x1 * sn + x2 * cs) * sc;
                        u32x4 w; w.x = cvt_pk_bf16(y1[0], y1[1]); w.y = cvt_pk_bf16(y1[2], y1[3]); w.z = cvt_pk_bf16(y2[0], y2[1]); w.w = cvt_pk_bf16(y2[2], y2[3]);
                        *(u32x4*)(base + (row0 + rl) * DM + bj * 128 + cw) = w; } }
            return;
        }
        if (pn < 20) {
            const bool lat = pm < 128;
            const int bidx = lat ? (pm >> 4) : (pm - 128), key0 = lat ? (pm & 15) * 256 : NT;
            bf16_t* vt = VA + (size_t)(bidx * NHD + 2 * (pn - 16)) * 128 * KVR + key0;
            int fr_ = fr; asm volatile("" : "+v"(fr_));
#pragma unroll
            for (int ai = 0; ai < 2; ++ai)
#pragma unroll
                for (int m = 0; m < 4; ++m) { bf16_t* rowp = vt + (unsigned)((ai * 128 + wr * 64 + m * 16 + fr_) * KVR);
#pragma unroll
                    for (int bj = 0; bj < 2; ++bj) { const f32x4 v0 = acc[ai][bj][m][0], v1 = acc[ai][bj][m][1];
                        unsigned a0 = cvt_pk_bf16(v0[0], v0[1]), a1 = cvt_pk_bf16(v0[2], v0[3]), b0 = cvt_pk_bf16(v1[0], v1[1]), b1 = cvt_pk_bf16(v1[2], v1[3]);
                        { auto r_ = __builtin_amdgcn_permlane16_swap(a0, b0, false, false); a0 = r_[0]; b0 = r_[1]; }
                        { auto r_ = __builtin_amdgcn_permlane16_swap(a1, b1, false, false); a1 = r_[0]; b1 = r_[1]; }
                        *(u32x4*)(rowp + bj * 128 + wc * 32 + 8 * fq) = (u32x4){a0, a1, b0, b1}; }
                    asm volatile("" ::: "memory"); }
            return;
        }
        {
            bf16_t* base; size_t row0;
            if (pn < 24) { base = GC + (size_t)(pn - 20) * 256; row0 = (size_t)pm * 256; }
            else { base = GA + (size_t)(pn - 24) * 256; row0 = (size_t)pm * 256; }
#pragma unroll
            for (int ai = 0; ai < 2; ++ai)
#pragma unroll
                for (int m = 0; m < 4; ++m) { const int rl = ai * 128 + wr * 64 + m * 16 + fr;
#pragma unroll
                    for (int bj = 0; bj < 2; ++bj) { f32x4 v0 = acc[ai][bj][m][0], v1 = acc[ai][bj][m][1];
#pragma unroll
                        for (int j = 0; j < 4; ++j) { v0[j] = sigmoidf_(v0[j]); v1[j] = sigmoidf_(v1[j]); }
                        u32x4 w; w.x = cvt_pk_bf16(v0[0], v0[1]); w.y = cvt_pk_bf16(v0[2], v0[3]); w.z = cvt_pk_bf16(v1[0], v1[1]); w.w = cvt_pk_bf16(v1[2], v1[3]);
                        *(u32x4*)(base + (row0 + rl) * DM + bj * 128 + cw) = w; } }
        }
    }
};

__device__ __forceinline__ void ph_conv_unit(const Args& a, LAS unsigned char* lds, int unit) {
    const int tid = threadIdx.x, lane = tid & 63, wave = __builtin_amdgcn_readfirstlane(tid >> 6);
    const int b = unit >> 5, t0 = (unit & 31) * 128;
    LAS float* ybuf = (LAS float*)lds;
    const int c0 = 2 * tid;
    f32x2 w[31];
    { const float* wp = a.in[I_WDW]; asm volatile("" : "+s"(wp));
      const __attribute__((address_space(1))) f32x2* wp2 = (const __attribute__((address_space(1))) f32x2*)(wp + c0);
#pragma unroll
      for (int j = 0; j < 31; ++j) w[j] = wp2[j * (DM / 2)]; }
    const f32x2 bias = *(const f32x2*)(a.in[I_BDW] + c0);
    const unsigned* Ub = (const unsigned*)(a.ws + WS_U) + (size_t)b * NT * (DM / 2) + tid;
    bf16_t* CA = (bf16_t*)(a.ws + WS_CACT) + (size_t)(b * NT + t0) * DM;
    const float* lng = a.in[I_LNG]; const float* lnb = a.in[I_LNB];
    f32x2 win[32];
#pragma unroll
    for (int s = 0; s < 32; ++s) win[s] = (f32x2){0.f, 0.f};
    unsigned pf[16];
    const unsigned* up = Ub + ((long)t0 - 15) * (DM / 2);
#define CV_LD(i) ({ const int i_ = (i); const int ti_ = t0 - 15 + i_; (i_ < 158 && ti_ >= 0 && ti_ < NT) ? up[(long)i_ * (DM / 2)] : 0u; })
#pragma unroll
    for (int s = 0; s < 16; ++s) pf[s] = CV_LD(s);
    for (int Q = 0; Q < 5; ++Q) {
#pragma unroll
        for (int hb = 0; hb < 2; ++hb)
#pragma unroll
        for (int s16 = 0; s16 < 16; ++s16) {
            const int s = hb * 16 + s16;
            const unsigned pk = pf[s16];
            pf[s16] = CV_LD(32 * Q + s + 16);
            win[s] = (f32x2){bf_lo(pk), bf_hi(pk)};
            const int to = 32 * Q + s - 30;
            if (to >= 0 && to < 128) {
                f32x2 y = bias;
#pragma unroll
                for (int j = 0; j < 31; ++j) y += w[j] * win[(s + 2 + j) & 31];
                *(LAS f32x2*)(ybuf + (to & 15) * DM + c0) = y;
            }
            if (s == 13 || s == 29) {
                if (Q >= 1) {
                    const int tb = 32 * Q + s - 30 - 15;
                    __syncthreads();
#pragma unroll
                    for (int k = 0; k < 2; ++k) { const int tl = 2 * wave + k;
                        f32x4 v[4]; float sm = 0.f;
#pragma unroll
                        for (int j = 0; j < 4; ++j) { v[j] = *(const LAS f32x4*)(ybuf + tl * DM + 4 * lane + 256 * j); sm += (v[j].x + v[j].y) + (v[j].z + v[j].w); }
                        const float mean = wave_sum(sm) * (1.0f / DM); float s2 = 0.f;
#pragma unroll
                        for (int j = 0; j < 4; ++j) { v[j] = v[j] - mean; s2 += (v[j].x * v[j].x + v[j].y * v[j].y) + (v[j].z * v[j].z + v[j].w * v[j].w); }
                        const float rstd = 1.0f / sqrtf(wave_sum(s2) * (1.0f / DM) + EPS);
                        unsigned long long* o8 = (unsigned long long*)(CA + (size_t)(tb + tl) * DM) + lane;
#pragma unroll
                        for (int j = 0; j < 4; ++j) { const int c = 4 * lane + 256 * j;
                            f32x4 y = v[j] * rstd * *(const f32x4*)(lng + c) + *(const f32x4*)(lnb + c);
#pragma unroll
                            for (int q = 0; q < 4; ++q) y[q] = y[q] * sigmoidf_(y[q]);
                            o8[64 * j] = (unsigned long long)cvt_pk_bf16(y.x, y.y) | ((unsigned long long)cvt_pk_bf16(y.z, y.w) << 32); } }
                    __syncthreads();
                }
            }
        }
    }
#undef CV_LD
}

namespace att {
constexpr int NW = 8, QBLK = 32, KVBLK = 64, NTILE = KVR / KVBLK;
constexpr int SHM_V = 128 * KVBLK * 2, SHM_K = KVBLK * 64 * 2;
constexpr int BUFB = SHM_V + SHM_K, NBUF = 4, ATT_LDS = NBUF * BUFB;
constexpr int VT_PITCH = KVR;
#define KSWZ(row, colB) ((row) * 128 + ((colB) ^ ((((row) >> 1) & 7) << 4)))
#define SBAR() __builtin_amdgcn_sched_barrier(0)
__device__ __forceinline__ int crow(int r, int hi) { return (r & 3) + 8 * (r >> 2) + 4 * hi; }
__device__ __forceinline__ void glds16(const void* g, unsigned lds_base) {
    unsigned sv; asm volatile("s_mov_b32 %0, m0\n\ts_mov_b32 m0, %2\n\ts_nop 0\n\tglobal_load_lds_dwordx4 %1, off\n\ts_mov_b32 m0, %0" : "=&s"(sv) : "v"(g), "s"(lds_base) : "memory"); }
__device__ __forceinline__ void attn_map(const bf16_t* __restrict__ Qb, const bf16_t* __restrict__ Kh, const bf16_t* __restrict__ VTh, long dKn, long dVn, bool pre, bool has_next, f32x16 (&o)[4], char* lds) {
    const int tid = threadIdx.x, wid = tid >> 6, lane = tid & 63, r32 = lane & 31, hi = lane >> 5;
    const int wv = __builtin_amdgcn_readfirstlane(tid >> 6);
    const bool isB = wv >= 4;
    float l_reg = 0.f;
#pragma unroll
    for (int d = 0; d < 4; ++d) o[d] = f32x16{};
    bf16x8 qr[4];
    const bf16_t* Qw = Qb + (size_t)(wid * QBLK + r32) * DM + hi * 8;
#pragma unroll
    for (int d0 = 0; d0 < 4; ++d0) qr[d0] = *reinterpret_cast<const bf16x8*>(Qw + d0 * 16);
    const bf16_t* ksrc = Kh + (size_t)(8 * wv + (lane >> 3)) * DM + (((lane & 7) ^ ((4 * wv + (lane >> 4)) & 7)) << 3);
    const bf16_t* vsrc0 = VTh + (size_t)(16 * wv + (lane >> 3)) * VT_PITCH + (((lane & 7) ^ ((lane >> 4) & 7)) << 3);
    const bf16_t* vsrc1 = VTh + (size_t)(16 * wv + 8 + (lane >> 3)) * VT_PITCH + (((lane & 7) ^ ((4 + (lane >> 4)) & 7)) << 3);
    const unsigned lds0 = (unsigned)(uintptr_t)lds;
#define DMAX(ko, vo, b) do { const unsigned bb_ = lds0 + (unsigned)(b) * BUFB; \
    glds16(ksrc + (ko), (unsigned)__builtin_amdgcn_readfirstlane(bb_ + SHM_V + 1024 * wv)); \
    glds16(vsrc0 + (vo), (unsigned)__builtin_amdgcn_readfirstlane(bb_ + 2048 * wv)); \
    glds16(vsrc1 + (vo), (unsigned)__builtin_amdgcn_readfirstlane(bb_ + 2048 * wv + 1024)); } while (0)
#define DMA(t, b) DMAX((long)(t) * (KVBLK * DM), (long)(t) * KVBLK, b)
#define DMAT(T) do { if ((T) < NTILE) DMA((T), (T) & 3); else if (has_next && (T) - NTILE < 2) DMAX(dKn + (long)((T) - NTILE) * (KVBLK * DM), dVn + (long)((T) - NTILE) * KVBLK, ((T) - NTILE) & 3); } while (0)
#define BAR() asm volatile("s_barrier" ::: "memory")
#define BARV() asm volatile("s_waitcnt vmcnt(0)\n\ts_barrier" ::: "memory")
    f32x16 pA0, pA1, pB0, pB1;
    u32x4 pw0, pw1, pw2, pw3;
    typedef LAS const char* lcp;
    const lcp lds3 = (lcp)(LAS char*)(uintptr_t)lds0;
    int kaddr[4], vaddr[4];
#pragma unroll
    for (int d0 = 0; d0 < 4; ++d0) { kaddr[d0] = SHM_V + KSWZ(r32, (d0 * 16 + hi * 8) * 2); vaddr[d0] = KSWZ(r32, (2 * d0 + hi) * 16); }
    bf16x8 kf[8], va[4], vb[4];
    constexpr float REF_MARGIN = 32.0f;
    f32x16 negm = f32x16{};
#define PIN(x) asm volatile("" : "+v"(x))
#define MF(a_, b_, c_) __builtin_amdgcn_mfma_f32_32x32x16_bf16(a_, b_, c_, 0, 0, 0)
#define PB(w) __builtin_bit_cast(bf16x8, w)
#define PKW(P, i) cvt_pk_bf16(P[i], P[i + 1])
#define ADD6(x, A, a0, a1, a2, B, b0, b1, b2) do { x += A[a0]; x += A[a1]; x += A[a2]; x += B[b0]; x += B[b1]; x += B[b2]; } while (0)
#define KRD(kbuf) do { const lcp kb_ = lds3 + (kbuf) * BUFB; \
      _Pragma("unroll") for (int d0 = 0; d0 < 4; ++d0) { kf[2 * d0] = *(const LAS bf16x8*)(kb_ + kaddr[d0]); kf[2 * d0 + 1] = *(const LAS bf16x8*)(kb_ + kaddr[d0] + 4096); } } while (0)
#define VRD4(dst, vb_, blk) do { const lcp vq_ = lds3 + (vb_) * BUFB; _Pragma("unroll") for (int ks_ = 0; ks_ < 4; ++ks_) dst[ks_] = *(const LAS bf16x8*)(vq_ + vaddr[ks_] + (blk) * 4096); } while (0)
#define S1(C0, C1, P0, P1, kbuf, vnext) do { SBAR(); \
    KRD(kbuf); \
    float ps_ = P0[0] + P0[1]; ps_ += P0[2]; ps_ += P0[3]; ps_ += P0[4]; ps_ += P0[5]; ps_ += P0[6]; ps_ += P0[7]; PIN(ps_); SBAR(); \
    C0 = MF(kf[0], qr[0], negm); ADD6(ps_, P0, 8, 9, 10, P0, 11, 12, 13); PIN(ps_); SBAR(); \
    C1 = MF(kf[1], qr[0], negm); ps_ += P0[14]; ps_ += P0[15]; ps_ += P1[0]; ps_ += P1[1]; ps_ += P1[2]; ps_ += P1[3]; PIN(ps_); SBAR(); \
    C0 = MF(kf[2], qr[1], C0); ADD6(ps_, P1, 4, 5, 6, P1, 7, 8, 9); PIN(ps_); SBAR(); \
    C1 = MF(kf[3], qr[1], C1); ADD6(ps_, P1, 10, 11, 12, P1, 13, 14, 15); l_reg += ps_; PIN(l_reg); SBAR(); \
    C0 = MF(kf[4], qr[2], C0); pw0 = (u32x4){PKW(P0, 0), PKW(P0, 2), PKW(P0, 4), PKW(P0, 6)}; PIN(pw0); SBAR(); \
    C1 = MF(kf[5], qr[2], C1); pw1 = (u32x4){PKW(P0, 8), PKW(P0, 10), PKW(P0, 12), PKW(P0, 14)}; PIN(pw1); SBAR(); \
    C0 = MF(kf[6], qr[3], C0); pw2 = (u32x4){PKW(P1, 0), PKW(P1, 2), PKW(P1, 4), PKW(P1, 6)}; PIN(pw2); SBAR(); \
    C1 = MF(kf[7], qr[3], C1); pw3 = (u32x4){PKW(P1, 8), PKW(P1, 10), PKW(P1, 12), PKW(P1, 14)}; PIN(pw3); PIN(C0); PIN(C1); SBAR(); \
    VRD4(va, vnext, 0); VRD4(vb, vnext, 1); SBAR();     \
    } while (0)
#define VRD1(dst, ks, blk) dst[ks] = *(const LAS bf16x8*)(vp_ + vaddr[ks] + (blk) * 4096)
#define EXP2N(X, lo) do { X[lo] = __builtin_amdgcn_exp2f(X[lo]); X[lo + 1] = __builtin_amdgcn_exp2f(X[lo + 1]); } while (0)
#define S2(C0, C1, vbuf) do { SBAR(); \
    const lcp vp_ = lds3 + (vbuf) * BUFB; \
    o[0] = MF(va[0], PB(pw0), o[0]); VRD1(va, 0, 2); EXP2N(C0, 0); PIN(C0); SBAR(); \
    o[0] = MF(va[1], PB(pw1), o[0]); VRD1(va, 1, 2); EXP2N(C0, 2); PIN(C0); SBAR(); \
    o[0] = MF(va[2], PB(pw2), o[0]); VRD1(va, 2, 2); EXP2N(C0, 4); PIN(C0); SBAR(); \
    o[0] = MF(va[3], PB(pw3), o[0]); VRD1(va, 3, 2); EXP2N(C0, 6); PIN(C0); SBAR(); \
    o[1] = MF(vb[0], PB(pw0), o[1]); VRD1(vb, 0, 3); EXP2N(C0, 8); PIN(C0); SBAR(); \
    o[1] = MF(vb[1], PB(pw1), o[1]); VRD1(vb, 1, 3); EXP2N(C0, 10); PIN(C0); SBAR(); \
    o[1] = MF(vb[2], PB(pw2), o[1]); VRD1(vb, 2, 3); EXP2N(C0, 12); PIN(C0); SBAR(); \
    o[1] = MF(vb[3], PB(pw3), o[1]); VRD1(vb, 3, 3); EXP2N(C0, 14); PIN(C0); SBAR(); \
    o[2] = MF(va[0], PB(pw0), o[2]); EXP2N(C1, 0); PIN(C1); SBAR(); \
    o[2] = MF(va[1], PB(pw1), o[2]); EXP2N(C1, 2); PIN(C1); SBAR(); \
    o[2] = MF(va[2], PB(pw2), o[2]); EXP2N(C1, 4); PIN(C1); SBAR(); \
    o[2] = MF(va[3], PB(pw3), o[2]); EXP2N(C1, 6); PIN(C1); SBAR(); \
    o[3] = MF(vb[0], PB(pw0), o[3]); EXP2N(C1, 8); PIN(C1); SBAR(); \
    o[3] = MF(vb[1], PB(pw1), o[3]); EXP2N(C1, 10); PIN(C1); SBAR(); \
    o[3] = MF(vb[2], PB(pw2), o[3]); EXP2N(C1, 12); PIN(C1); SBAR(); \
    o[3] = MF(vb[3], PB(pw3), o[3]); EXP2N(C1, 14); PIN(C1); SBAR(); \
    } while (0)
    pB0 = f32x16{}; pB1 = f32x16{};
    if (!isB) __builtin_amdgcn_s_setprio(1);
    if (!pre) { DMA(0, 0); DMA(1, 1); BARV(); }
    if (isB) { BARV(); DMA(2, 2); }
    S1(pA0, pA1, pB0, pB1, 0, 0);
    if (!isB) { BARV(); DMA(2, 2); }
    { float pm_ = pA0[0];
#pragma unroll
      for (int r = 1; r < 16; ++r) pm_ = __builtin_fmaxf(pm_, pA0[r]);
#pragma unroll
      for (int r = 0; r < 16; ++r) pm_ = __builtin_fmaxf(pm_, pA1[r]);
      { auto rr_ = __builtin_amdgcn_permlane32_swap(__float_as_uint(pm_), __float_as_uint(pm_), false, false); pm_ = __builtin_fmaxf(__uint_as_float(rr_[0]), __uint_as_float(rr_[1])); }
      const float nm_ = -(pm_ + REF_MARGIN);
#pragma unroll
      for (int r = 0; r < 16; ++r) { negm[r] = nm_; pA0[r] = __builtin_amdgcn_exp2f(pA0[r] + nm_); pA1[r] = __builtin_amdgcn_exp2f(pA1[r] + nm_); }
      PIN(negm); }
    for (int j = 1; j < NTILE; j += 2) {
        if (isB) { BARV(); DMAT(j + 2); }
        S1(pB0, pB1, pA0, pA1, j & 3, (j - 1) & 3);
        if (!isB) { BARV(); DMAT(j + 2); }
        S2(pB0, pB1, (j - 1) & 3);
        if (isB) { BARV(); DMAT(j + 3); }
        { const int kt = (j + 1 < NTILE) ? j + 1 : NTILE - 1;
          S1(pA0, pA1, pB0, pB1, kt & 3, j & 3); }
        if (!isB) { BARV(); DMAT(j + 3); }
        S2(pA0, pA1, j & 3);
    }
    { auto rr_ = __builtin_amdgcn_permlane32_swap(__float_as_uint(l_reg), __float_as_uint(l_reg), false, false);
      const float rl = __builtin_amdgcn_rcpf(__uint_as_float(rr_[0]) + __uint_as_float(rr_[1]));
#pragma unroll
      for (int d = 0; d < 4; ++d) o[d] = o[d] * rl; }
    __builtin_amdgcn_s_setprio(0);
    if (!has_next) BAR();
#undef DMA
#undef DMAX
#undef DMAT
#undef BAR
#undef BARV
#undef PIN
#undef MF
#undef PB
#undef PKW
#undef ADD6
#undef S1
#undef S2
#undef KRD
#undef VRD4
#undef VRD1
#undef EXP2N
}
__device__ __forceinline__ void attn_unit(const Args& a, int b, int h, int qb, float lam, char* lds, bool first, bool has_nu, int nb, int nh) {
    const bf16_t* Q = (const bf16_t*)(a.ws + WS_Q); const bf16_t* KA = (const bf16_t*)(a.ws + WS_K); const bf16_t* VT = (const bf16_t*)(a.ws + WS_V);
    const size_t qrow0 = (size_t)b * NT + (size_t)qb * 256, kvrow0 = (size_t)b * KVR;
    for (int m = 0; m < 2; ++m) {
        f32x16 o[4];
        const bf16_t* Kc = KA + kvrow0 * DM + (2 * h + m) * 64; const bf16_t* Vc = VT + (size_t)((b * NHD + h) * 128) * VT_PITCH;
        const bf16_t* Kn = m == 0 ? Kc + 64 : KA + (size_t)nb * KVR * DM + (2 * nh) * 64; const bf16_t* Vn = m == 0 ? Vc : VT + (size_t)((nb * NHD + nh) * 128) * VT_PITCH;
        attn_map(Q + qrow0 * DM + (2 * h + m) * 64, Kc, Vc, (long)(Kn - Kc), (long)(Vn - Vc), !(first && m == 0), m == 0 || has_nu, o, lds);
        int t2 = threadIdx.x; asm volatile("" : "+v"(t2));
        const int wid = t2 >> 6, lane = t2 & 63, r32 = lane & 31, hi = lane >> 5;
        float* o1p = (float*)(a.ws + WS_O1) + (size_t)blockIdx.x * (64 * 512) + t2;
        if (m == 0) {
#pragma unroll
            for (int d = 0; d < 4; ++d)
#pragma unroll
                for (int r = 0; r < 16; ++r) o1p[(d * 16 + r) * 512] = o[d][r];
        } else {
            float ss = 0.f;
#pragma unroll
            for (int d = 0; d < 4; ++d)
#pragma unroll
                for (int r = 0; r < 16; ++r) { const float v = o1p[(d * 16 + r) * 512] - lam * o[d][r]; o[d][r] = v; ss += v * v; }
            { auto rr_ = __builtin_amdgcn_permlane32_swap(__float_as_uint(ss), __float_as_uint(ss), false, false); ss = __uint_as_float(rr_[0]) + __uint_as_float(rr_[1]); }
            const float rstd = 0.8f / sqrtf(ss * (1.0f / 128.0f) + EPS);
            const float* gs = a.in[I_GSUB] + 4 * hi;
            bf16_t* aow = (bf16_t*)(a.ws + WS_ATTO) + (qrow0 + wid * QBLK + r32) * DM + h * 128 + 4 * hi;
#pragma unroll
            for (int d = 0; d < 4; ++d)
#pragma unroll
                for (int rg = 0; rg < 4; ++rg) { const f32x4 g = *(const f32x4*)(gs + 32 * d + 8 * rg);
                    u32x2 w; w.x = cvt_pk_bf16(o[d][4 * rg] * rstd * g[0], o[d][4 * rg + 1] * rstd * g[1]); w.y = cvt_pk_bf16(o[d][4 * rg + 2] * rstd * g[2], o[d][4 * rg + 3] * rstd * g[3]);
                    *(u32x2*)(aow + 32 * d + 8 * rg) = w; }
        }
    }
}
#undef KSWZ
#undef SBAR
}

struct SchedDual {
    const char *A0, *A1, *B0, *B1; int G, c;
    __device__ __forceinline__ bool next(int i, Unit& u) const {
        const int L = (i >> 1) * G + c; if (L >= 512) return false;
        pg8::tile_of(L, 128, 4, u.pm, u.pn); u.aux = i & 1; return true; }
    __device__ __forceinline__ const char* a_ptr(const Unit& u) const { return (u.aux ? A1 : A0) + (size_t)u.pm * (256 * DM * 2); }
    __device__ __forceinline__ const char* b_ptr(const Unit& u) const { return (u.aux ? B1 : B0) + (size_t)u.pn * (256 * DM * 2); }
    __device__ __forceinline__ bool keep(const Unit& u) const { return u.aux == 0; }
};
struct EpiDual {
    static constexpr bool PERM = true;
    const bf16_t *GA, *GC; const float* bc; bf16_t* MIX;
    __device__ __forceinline__ void operator()(f32x4 (&acc)[2][2][4][2], const Unit& u, int wr, int wc, int fr, int fq) const {
        const int col0 = u.pn * 256 + wc * 32 + 8 * fq;
        if (u.aux == 0) {
            u32x4 ga[2][2], gc[2][2];
#define EDL(i, g) do { const int ai_ = (g) >> 2, m_ = (g) & 3; const size_t off_ = (size_t)(u.pm * 256 + ai_ * 128 + wr * 64 + m_ * 16 + fr) * DM + col0; \
    ga[i][0] = *(const u32x4*)(GA + off_); ga[i][1] = *(const u32x4*)(GA + off_ + 128); gc[i][0] = *(const u32x4*)(GC + off_); gc[i][1] = *(const u32x4*)(GC + off_ + 128); } while (0)
            EDL(0, 0);
#pragma unroll
            for (int g = 0; g < 8; ++g) { const int ai = g >> 2, m = g & 3, cur = g & 1;
                if (g + 1 < 8) { if (cur) EDL(0, g + 1); else EDL(1, g + 1); }
#pragma unroll
                for (int bj = 0; bj < 2; ++bj) { const u32x4 a4 = ga[cur][bj], c4 = gc[cur][bj];
                    f32x4 r0, r1;
                    r0[0] = bf_lo(a4.x) * __builtin_amdgcn_rcpf(bf_lo(c4.x)); r0[1] = bf_hi(a4.x) * __builtin_amdgcn_rcpf(bf_hi(c4.x));
                    r0[2] = bf_lo(a4.y) * __builtin_amdgcn_rcpf(bf_lo(c4.y)); r0[3] = bf_hi(a4.y) * __builtin_amdgcn_rcpf(bf_hi(c4.y));
                    r1[0] = bf_lo(a4.z) * __builtin_amdgcn_rcpf(bf_lo(c4.z)); r1[1] = bf_hi(a4.z) * __builtin_amdgcn_rcpf(bf_hi(c4.z));
                    r1[2] = bf_lo(a4.w) * __builtin_amdgcn_rcpf(bf_lo(c4.w)); r1[3] = bf_hi(a4.w) * __builtin_amdgcn_rcpf(bf_hi(c4.w));
                    acc[ai][bj][m][0] *= r0; acc[ai][bj][m][1] *= r1; }
                asm volatile("" ::: "memory"); }
#undef EDL
            return;
        }
        f32x4 bv[2][2];
#pragma unroll
        for (int bj = 0; bj < 2; ++bj)
#pragma unroll
            for (int n = 0; n < 2; ++n) bv[bj][n] = *(const f32x4*)(bc + col0 + bj * 128 + 4 * n);
        u32x4 gc[2][2];
#define EDL(i, g) do { const int ai_ = (g) >> 2, m_ = (g) & 3; const size_t off_ = (size_t)(u.pm * 256 + ai_ * 128 + wr * 64 + m_ * 16 + fr) * DM + col0; \
    gc[i][0] = *(const u32x4*)(GC + off_); gc[i][1] = *(const u32x4*)(GC + off_ + 128); } while (0)
        EDL(0, 0);
#pragma unroll
        for (int g = 0; g < 8; ++g) { const int ai = g >> 2, m = g & 3, cur = g & 1;
            if (g + 1 < 8) { if (cur) EDL(0, g + 1); else EDL(1, g + 1); }
            const size_t off = (size_t)(u.pm * 256 + ai * 128 + wr * 64 + m * 16 + fr) * DM + col0;
#pragma unroll
            for (int bj = 0; bj < 2; ++bj) { const u32x4 c4 = gc[cur][bj];
                const f32x4 v0 = acc[ai][bj][m][0] + bv[bj][0], v1 = acc[ai][bj][m][1] + bv[bj][1];
                u32x4 w; w.x = cvt_pk_bf16(v0[0] * bf_lo(c4.x), v0[1] * bf_hi(c4.x)); w.y = cvt_pk_bf16(v0[2] * bf_lo(c4.y), v0[3] * bf_hi(c4.y));
                w.z = cvt_pk_bf16(v1[0] * bf_lo(c4.z), v1[1] * bf_hi(c4.z)); w.w = cvt_pk_bf16(v1[2] * bf_lo(c4.w), v1[3] * bf_hi(c4.w));
                *(u32x4*)(MIX + off + bj * 128) = w; }
            asm volatile("" ::: "memory"); }
#undef EDL
    }
};

struct SchedPlain {
    const char* A; const char* Bt; int G, c, nM, nN, RB, bgrp;
    __device__ __forceinline__ bool next(int i, Unit& u) const {
        const int L = i * G + c; if (L >= nM * nN) return false;
        pg8::tile_of(L, nM, nN, u.pm, u.pn); u.aux = 0; return true; }
    __device__ __forceinline__ const char* a_ptr(const Unit& u) const { return A + (size_t)u.pm * ((size_t)256 * RB); }
    __device__ __forceinline__ const char* b_ptr(const Unit& u) const { return Bt + (size_t)((u.pm >> 4) * nN * bgrp + u.pn) * ((size_t)256 * RB); }
    __device__ __forceinline__ bool keep(const Unit&) const { return false; }
};
struct EpiResid {
    static constexpr bool PERM = false;
    const float* x; const float* mod; float* out;
    __device__ __forceinline__ void operator()(f32x4 (&acc)[2][2][4][2], const Unit& u, int wr, int wc, int fr, int fq) const {
        const int col0 = u.pn * 256 + wc * 32 + 4 * fq; const float* gm = mod + (size_t)(u.pm >> 4) * NMOD + 2048 + col0;
        f32x4 gv[2][2];
#pragma unroll
        for (int bj = 0; bj < 2; ++bj)
#pragma unroll
            for (int n = 0; n < 2; ++n) gv[bj][n] = *(const f32x4*)(gm + bj * 128 + n * 16);
        f32x4 xv[2][2][2];
#define ERL(i, g) do { const int ai_ = (g) >> 2, m_ = (g) & 3; const size_t off_ = (size_t)(u.pm * 256 + ai_ * 128 + wr * 64 + m_ * 16 + fr) * DM + col0; \
    _Pragma("unroll") for (int bj_ = 0; bj_ < 2; ++bj_) _Pragma("unroll") for (int n_ = 0; n_ < 2; ++n_) xv[i][bj_][n_] = *(const f32x4*)(x + off_ + bj_ * 128 + n_ * 16); } while (0)
        ERL(0, 0);
#pragma unroll
        for (int g = 0; g < 8; ++g) { const int ai = g >> 2, m = g & 3, cur = g & 1;
            if (g + 1 < 8) { if (cur) ERL(0, g + 1); else ERL(1, g + 1); }
            const size_t off = (size_t)(u.pm * 256 + ai * 128 + wr * 64 + m * 16 + fr) * DM + col0;
#pragma unroll
            for (int bj = 0; bj < 2; ++bj)
#pragma unroll
                for (int n = 0; n < 2; ++n) *(f32x4*)(out + off + bj * 128 + n * 16) = xv[cur][bj][n] + gv[bj][n] * acc[ai][bj][m][n];
            asm volatile("" ::: "memory"); }
#undef ERL
    }
};

__device__ __forceinline__ void ph_router(const Args& a, LAS unsigned char* lds, int gw, int NGW, int lane) {
    LAS float* wrt = (LAS float*)lds;
    const float* wr = a.in[I_WR];
    for (int i = threadIdx.x; i < DM * NEXP; i += 512) { const int k = i >> 4, e = i & 15; wrt[e * DM + k] = wr[i]; }
    __syncthreads();
    const float* mod = (const float*)(a.ws + WS_MOD); const float* g = a.in[I_GFFN];
    unsigned char* HF = (unsigned char*)(a.ws + WS_HF); float* AFF = (float*)(a.ws + WS_AFF);
    f32x4 gs[4], shv[4]; int cur_b = -1;
    f32x4 nx[4];
    { const f32x4* xr = (const f32x4*)(a.out + (size_t)gw * DM) + lane;
#pragma unroll
      for (int j = 0; j < 4; ++j) nx[j] = xr[64 * j]; }
    for (int row = gw; row < MLAT; row += NGW) {
        f32x4 v[4]; float s = 0.f;
#pragma unroll
        for (int j = 0; j < 4; ++j) { v[j] = nx[j]; s += (v[j].x * v[j].x + v[j].y * v[j].y) + (v[j].z * v[j].z + v[j].w * v[j].w); }
        if (row + NGW < MLAT) { const f32x4* xr = (const f32x4*)(a.out + (size_t)(row + NGW) * DM) + lane;
#pragma unroll
            for (int j = 0; j < 4; ++j) nx[j] = xr[64 * j]; }
        if ((row >> 12) != cur_b) { cur_b = row >> 12; const float* mb = mod + (size_t)cur_b * NMOD + 3072;
#pragma unroll
            for (int j = 0; j < 4; ++j) { const int c = 4 * lane + 256 * j; gs[j] = *(const f32x4*)(g + c) * (*(const f32x4*)(mb + 1024 + c) + 1.0f); shv[j] = *(const f32x4*)(mb + c); } }
        const float rstd = 1.0f / sqrtf(wave_sum(s) * (1.0f / DM) + EPS);
        unsigned* o4 = (unsigned*)(HF + (size_t)row * DM) + lane;
#pragma unroll
        for (int j = 0; j < 4; ++j) { v[j] = (v[j] * rstd) * gs[j] + shv[j];
            o4[64 * j] = pack4_fp8(v[j].x, v[j].y, v[j].z, v[j].w); }
        float p[16];
#pragma unroll
        for (int e = 0; e < 16; ++e) { float t = 0.f;
#pragma unroll
            for (int j = 0; j < 4; ++j) { const f32x4 wv = *(const LAS f32x4*)(wrt + e * DM + 4 * lane + 256 * j); t += (v[j].x * wv.x + v[j].y * wv.y) + (v[j].z * wv.z + v[j].w * wv.w); }
            p[e] = t; if ((e & 3) == 3) __builtin_amdgcn_sched_barrier(0); }
        float r8[8], r4[4], r2[2], r1;
        { const bool up = (lane & 32) != 0;
#pragma unroll
          for (int i = 0; i < 8; ++i) { const float send = up ? p[i] : p[i + 8], keepv = up ? p[i + 8] : p[i]; r8[i] = keepv + __shfl_xor(send, 32); } }
        { const bool up = (lane & 16) != 0;
#pragma unroll
          for (int i = 0; i < 4; ++i) { const float send = up ? r8[i] : r8[i + 4], keepv = up ? r8[i + 4] : r8[i]; r4[i] = keepv + __shfl_xor(send, 16); } }
        { const bool up = (lane & 8) != 0;
#pragma unroll
          for (int i = 0; i < 2; ++i) { const float send = up ? r4[i] : r4[i + 2], keepv = up ? r4[i + 2] : r4[i]; r2[i] = keepv + __shfl_xor(send, 8); } }
        { const bool up = (lane & 4) != 0; const float send = up ? r2[0] : r2[1], keepv = up ? r2[1] : r2[0]; r1 = keepv + __shfl_xor(send, 4); }
        r1 += __shfl_xor(r1, 2); r1 += __shfl_xor(r1, 1);
        float mx = r1;
#pragma unroll
        for (int o = 4; o < 64; o <<= 1) mx = fmaxf(mx, __shfl_xor(mx, o));
        const float ex = expf(r1 - mx); float sm = ex;
#pragma unroll
        for (int o = 4; o < 64; o <<= 1) sm += __shfl_xor(sm, o);
        if ((lane & 3) == 0) AFF[(size_t)row * NEXP + (lane >> 2)] = ex / sm;
    }
}

__device__ __forceinline__ void ph_topk_unit(const Args& a, LAS unsigned char* lds, int g  ) {
    const int tid = threadIdx.x, lane = tid & 63, wave = __builtin_amdgcn_readfirstlane(tid >> 6);
    const int b = g >> 4, e = g & 15;
    LAS unsigned long long* S = (LAS unsigned long long*)lds;
    const float* AFF = (const float*)(a.ws + WS_AFF) + (size_t)b * NT * NEXP + e;
    for (int t = tid; t < NT; t += 512) S[t] = ((unsigned long long)__float_as_uint(AFF[(size_t)t * NEXP]) << 32) | (unsigned long long)(0xFFFFFFFFu - (unsigned)t);
    __syncthreads();
    for (int k = 2; k <= NT; k <<= 1)
        for (int j = k >> 1; j > 0; j >>= 1) {
#pragma unroll
            for (int q = 0; q < 4; ++q) { const int t = tid + 512 * q; const int i = 2 * t - (t & (j - 1)), l = i + j;
                const unsigned long long x = S[i], y = S[l]; const bool desc = (i & k) == 0;
                if ((x < y) == desc) { S[i] = y; S[l] = x; } }
            __syncthreads();
        }
    int* SEL = (int*)(a.ws + WS_SEL) + (size_t)b * NT * NEXP + e;
    for (int s = tid; s < NT; s += 512) { const unsigned tok = 0xFFFFFFFFu - (unsigned)S[s]; SEL[(size_t)tok * NEXP] = (s < CAP) ? s : -1; }
    const unsigned char* HF = (const unsigned char*)(a.ws + WS_HF) + (size_t)b * NT * DM;
    unsigned char* XS = (unsigned char*)(a.ws + WS_XS) + (size_t)(e * NB + b) * CAP * DM;
    for (int k = 0; k < 64; k += 8) {
        u32x4 v[8];
#pragma unroll
        for (int q = 0; q < 8; ++q) { const int s = wave * 64 + k + q; const unsigned tok = 0xFFFFFFFFu - (unsigned)S[s];
            v[q] = ((const u32x4*)(HF + (size_t)tok * DM))[lane]; }
#pragma unroll
        for (int q = 0; q < 8; ++q) { const int s = wave * 64 + k + q; ((u32x4*)(XS + (size_t)s * DM))[lane] = v[q]; }
    }
    __syncthreads();
}

struct EpiSwiGLU {
    static constexpr bool PERM = true;
    unsigned char* HID;
    __device__ __forceinline__ void operator()(f32x4 (&acc)[2][2][4][2], const Unit& u, int wr, int wc, int fr, int fq) const {
        const int col0 = u.pn * 128 + wc * 32 + 8 * fq;
#pragma unroll
        for (int ai = 0; ai < 2; ++ai)
#pragma unroll
            for (int m = 0; m < 4; ++m) { const size_t r = (size_t)u.pm * 256 + ai * 128 + wr * 64 + m * 16 + fr;
                const f32x4 g0 = acc[ai][0][m][0] * WSCALE_INV, g1 = acc[ai][0][m][1] * WSCALE_INV, u0 = acc[ai][1][m][0] * WSCALE_INV, u1 = acc[ai][1][m][1] * WSCALE_INV;
                u32x2 w; w.x = pack4_fp8(g0[0] * sigmoidf_(g0[0]) * u0[0], g0[1] * sigmoidf_(g0[1]) * u0[1], g0[2] * sigmoidf_(g0[2]) * u0[2], g0[3] * sigmoidf_(g0[3]) * u0[3]);
                w.y = pack4_fp8(g1[0] * sigmoidf_(g1[0]) * u1[0], g1[1] * sigmoidf_(g1[1]) * u1[1], g1[2] * sigmoidf_(g1[2]) * u1[2], g1[3] * sigmoidf_(g1[3]) * u1[3]);
                *(u32x2*)(HID + r * DFF + col0) = w; }
    }
};
struct EpiPlainBf16 {
    static constexpr bool PERM = true;
    bf16_t* O; int ldc; float scale;
    __device__ __forceinline__ void operator()(f32x4 (&acc)[2][2][4][2], const Unit& u, int wr, int wc, int fr, int fq) const {
        const int col0 = u.pn * 256 + wc * 32 + 8 * fq;
#pragma unroll
        for (int ai = 0; ai < 2; ++ai)
#pragma unroll
            for (int m = 0; m < 4; ++m) { bf16_t* rowp = O + ((size_t)u.pm * 256 + ai * 128 + wr * 64 + m * 16 + fr) * ldc + col0;
#pragma unroll
                for (int bj = 0; bj < 2; ++bj) { const f32x4 v0 = acc[ai][bj][m][0] * scale, v1 = acc[ai][bj][m][1] * scale;
                    u32x4 w; w.x = cvt_pk_bf16(v0[0], v0[1]); w.y = cvt_pk_bf16(v0[2], v0[3]); w.z = cvt_pk_bf16(v1[0], v1[1]); w.w = cvt_pk_bf16(v1[2], v1[3]);
                    *(u32x4*)(rowp + bj * 128) = w; } }
    }
};

__device__ __forceinline__ void ph_final(const Args& a, int gw, int NGW, int lane) {
    const float* mod = (const float*)(a.ws + WS_MOD); const float* gfin = a.in[I_GFIN];
    const float* AFF = (const float*)(a.ws + WS_AFF); const int* SEL = (const int*)(a.ws + WS_SEL); const bf16_t* YS = (const bf16_t*)(a.ws + WS_YS);
    const int per = MLAT / NGW, r0 = gw * per, b = r0 >> 12;
    f32x4 gfv[2][2], gnv[2][2];
    { const float* gf = mod + (size_t)b * NMOD + 5120;
#pragma unroll
      for (int jj = 0; jj < 2; ++jj)
#pragma unroll
          for (int q = 0; q < 2; ++q) { const int c = 8 * lane + 512 * jj + 4 * q; gfv[jj][q] = *(const f32x4*)(gf + c); gnv[jj][q] = *(const f32x4*)(gfin + c); } }
    for (int row = r0; row < r0 + per; ++row) {
        float* xr = a.out + (size_t)row * DM;
        const int selv = (lane < 16) ? SEL[(size_t)row * NEXP + lane] : -1; const float affv = (lane < 16) ? AFF[(size_t)row * NEXP + lane] : 0.f;
        f32x4 acc[2][2];
#pragma unroll
        for (int jj = 0; jj < 2; ++jj) { acc[jj][0] = (f32x4){0.f, 0.f, 0.f, 0.f}; acc[jj][1] = (f32x4){0.f, 0.f, 0.f, 0.f}; }
#pragma unroll
        for (int e = 0; e < NEXP; ++e) { const int s = __builtin_amdgcn_readlane(selv, e); const float gt = __uint_as_float(__builtin_amdgcn_readlane(__float_as_uint(affv), e));
            if (s >= 0) { const bf16_t* yr = YS + ((size_t)(e * NB + b) * CAP + s) * DM;
#pragma unroll
                for (int jj = 0; jj < 2; ++jj) { const u32x4 y = *(const u32x4*)(yr + 8 * lane + 512 * jj);
                    acc[jj][0] += gt * (f32x4){bf_lo(y.x), bf_hi(y.x), bf_lo(y.y), bf_hi(y.y)}; acc[jj][1] += gt * (f32x4){bf_lo(y.z), bf_hi(y.z), bf_lo(y.w), bf_hi(y.w)}; } } }
        f32x4 v[2][2]; float ss = 0.f;
#pragma unroll
        for (int jj = 0; jj < 2; ++jj)
#pragma unroll
            for (int q = 0; q < 2; ++q) { const int c = 8 * lane + 512 * jj + 4 * q;
                v[jj][q] = *(const f32x4*)(xr + c) + gfv[jj][q] * acc[jj][q];
                ss += (v[jj][q].x * v[jj][q].x + v[jj][q].y * v[jj][q].y) + (v[jj][q].z * v[jj][q].z + v[jj][q].w * v[jj][q].w); }
        const float rstd = 1.0f / sqrtf(wave_sum(ss) * (1.0f / DM) + EPS);
#pragma unroll
        for (int jj = 0; jj < 2; ++jj)
#pragma unroll
            for (int q = 0; q < 2; ++q) { const int c = 8 * lane + 512 * jj + 4 * q; *(f32x4*)(xr + c) = v[jj][q] * rstd * gnv[jj][q]; }
    }
}

constexpr int N_PHASES = 12;
#ifndef MK_ATTN_REPS
#define MK_ATTN_REPS 1
#endif
struct Ctx { LAS unsigned char* lds; char* lds_gen; int G, bid, vcu, gw, NGW, wave, lane; };
template <int P> __device__ __forceinline__ void run_phase(const Args& args, const Ctx& c) {
    LAS unsigned char* lds = c.lds; const int G = c.G, bid = c.bid, vcu = c.vcu, gw = c.gw, NGW = c.NGW, wave = c.wave, lane = c.lane;
    if constexpr (P == 0) {
        ph_adaln(args, lds, bid, G);
        if (bid == G - 1) ph_rope_table(args);
        ph_small_weights(args, lds, gw, NGW, wave, lane);
    }
    if constexpr (P == 1) ph_norm_rows(args, gw, NGW, lane);
    if constexpr (P == 2) {
        SchedInProj S{(const char*)(args.ws + WS_H), (const char*)(args.ws + WS_WIN), G, bid};
        EpiInProj E{(bf16_t*)(args.ws + WS_U), (bf16_t*)(args.ws + WS_Q), (bf16_t*)(args.ws + WS_K), (bf16_t*)(args.ws + WS_V), (bf16_t*)(args.ws + WS_GC), (bf16_t*)(args.ws + WS_GA), (const float*)(args.ws + WS_ROPE)};
        pg8::gemm_phase<EpiInProj, SchedInProj, PG8_ALIGN, PG8_SP2>(lds, DM * 2, S, E);
    }
    if constexpr (P == 3) {
#ifndef MK_NO_CONV
        for (int u = vcu; u < 256; u += G) ph_conv_unit(args, lds, u);
        __syncthreads();
#endif
#ifndef MK_NO_ATTN
        float lam;
        { const float s1 = wave_sum(args.in[I_LQ1][lane] * args.in[I_LK1][lane]), s2 = wave_sum(args.in[I_LQ2][lane] * args.in[I_LK2][lane]); lam = __uint_as_float(__builtin_amdgcn_readfirstlane(__float_as_uint(expf(s1) - expf(s2) + 0.2f))); }
#if defined(MK_PROBE_CLOCK)
        const unsigned long long pc0_ = __builtin_amdgcn_s_memtime(), pr0_ = __builtin_amdgcn_s_memrealtime();
#endif
        for (int i = 0; i < 4 * MK_ATTN_REPS; ++i) { const int u = (i & 3) * 256 + vcu; if (u >= 1024) break;
            const int un = ((i + 1) & 3) * 256 + vcu; const bool has_nu = (i + 1 < 4 * MK_ATTN_REPS) && un < 1024;
            att::attn_unit(args, u >> 7, (u >> 4) & 7, u & 15, lam, c.lds_gen, i == 0, has_nu, un >> 7, (un >> 4) & 7); }
#if defined(MK_PROBE_CLOCK)
        { const unsigned long long pc1_ = __builtin_amdgcn_s_memtime(), pr1_ = __builtin_amdgcn_s_memrealtime();
          if (threadIdx.x == 0) { volatile LAS unsigned* mw = (volatile LAS unsigned*)(c.lds + LDSCTL_OFF); mw[16] = (unsigned)(pc1_ - pc0_); mw[17] = (unsigned)(pr1_ - pr0_);
              unsigned* pw_ = (unsigned*)(args.ws + WS_CTL) + 15000;
              atomicMax(pw_, (unsigned)(pr1_ - pr0_)); atomicAdd(pw_ + 1, (unsigned)(pr1_ - pr0_)); atomicMax(pw_ + 2, 0xFFFFFFFFu - (unsigned)(pr1_ - pr0_)); } }
#endif
#endif
    }
    if constexpr (P == 4) {
        SchedDual S{(const char*)(args.ws + WS_ATTO), (const char*)(args.ws + WS_CACT), (const char*)(args.ws + WS_WAO), (const char*)(args.ws + WS_WCO), G, bid};
        EpiDual E{(const bf16_t*)(args.ws + WS_GA), (const bf16_t*)(args.ws + WS_GC), args.in[I_BCO], (bf16_t*)(args.ws + WS_MIX)};
        pg8::gemm_phase<EpiDual, SchedDual, PG8_ALIGN, PG8_SP2>(lds, DM * 2, S, E);
    }
    if constexpr (P == 5) {
        SchedPlain S{(const char*)(args.ws + WS_MIX), (const char*)(args.ws + WS_WO), G, bid, 128, 4, DM * 2, 0};
        EpiResid E{args.in[I_X], (const float*)(args.ws + WS_MOD), args.out};
        pg8::gemm_phase<EpiResid, SchedPlain, PG8_ALIGN, PG8_SP2>(lds, DM * 2, S, E);
    }
    if constexpr (P == 6) {
        ph_router(args, lds, gw, NGW, lane);
        __syncthreads();
        ph_wgu(args, lds, gw, NGW, wave, lane);
        ph_wd(args, lds, gw, NGW, wave, lane);
    }
    if constexpr (P == 7) { for (int g = vcu; g < NB * NEXP; g += G) ph_topk_unit(args, lds, g); }
    if constexpr (P == 8) {
        SchedPlain S{(const char*)(args.ws + WS_XS), (const char*)(args.ws + WS_WGU), G, bid, 256, 22, DM, 1};
        EpiSwiGLU E{(unsigned char*)(args.ws + WS_HID)};
        pg8::gemm_phase<EpiSwiGLU, SchedPlain, PG8_ALIGN, PG8_SP2, true>(lds, DM, S, E);
    }
    if constexpr (P == 10) {
        SchedPlain S{(const char*)(args.ws + WS_HID), (const char*)(args.ws + WS_WD), G, bid, 256, 4, DFF, 1};
        EpiPlainBf16 E{(bf16_t*)(args.ws + WS_YS), DM, WSCALE_INV};
        pg8::gemm_phase<EpiPlainBf16, SchedPlain, PG8_ALIGN, PG8_SP2, true>(lds, DFF, S, E);
    }
    if constexpr (P == 11) ph_final(args, gw, NGW, lane);
}
#ifndef MK_PHASE_MASK
#define MK_PHASE_MASK 0xFFF
#endif
#ifndef MK_REPEAT_MASK
#define MK_REPEAT_MASK 0
#endif
__global__ void __launch_bounds__(512, 2) mk_fwd(Args args) {
    extern __shared__ __attribute__((aligned(16))) unsigned char lds_raw[];
    LAS unsigned char* lds = (LAS unsigned char*)lds_raw;
    const int tid = threadIdx.x;
    Ctx c; c.lds = lds; c.lds_gen = (char*)lds_raw; c.lane = tid & 63; c.wave = __builtin_amdgcn_readfirstlane(tid >> 6);
    c.G = gridDim.x; c.bid = blockIdx.x;
    c.vcu = (c.G % 8 == 0) ? (c.bid % 8) * (c.G / 8) + c.bid / 8 : c.bid;
    c.gw = c.vcu * 8 + c.wave; c.NGW = c.G * 8;
    volatile LAS unsigned* misc = (volatile LAS unsigned*)(lds + LDSCTL_OFF);
    if (tid < 64) misc[tid] = 0u;
    __syncthreads();
#if defined(MK_PROBE_TS)
    const unsigned long long kstart_ = __builtin_amdgcn_s_memrealtime();
#endif
    const int lo = args.ph_lo, hi = args.ph_hi;
    XcdBarrier bar; bar.bar = (unsigned*)(args.ws + WS_CTL) + 1024 + args.li * XCD_BAR_WORDS; bar.x = 0; bar.st = nullptr;
    if (hi - lo > 1) bar = xcd_barrier_post((unsigned*)(args.ws + WS_CTL) + 1024 + args.li * XCD_BAR_WORDS, misc + 8);
#define IN(k) (((MK_PHASE_MASK >> (k)) & 1) && lo <= (k) && (k) < hi)
#if defined(MK_PROBE_PHASE)
#define PH_T0() const unsigned long long pt0_ = __builtin_amdgcn_s_memrealtime()
#define PH_T1(k) do { const unsigned long long pt1_ = __builtin_amdgcn_s_memrealtime(); if (threadIdx.x == 0) atomicMax((unsigned*)(args.ws + WS_CTL) + 15100 + (k), (unsigned)(pt1_ - pt0_)); } while (0)
#else
#define PH_T0() do { } while (0)
#define PH_T1(k) do { } while (0)
#endif
#if defined(MK_PROBE_BAR)
#define PB_T0() const unsigned long long bt0_ = __builtin_amdgcn_s_memrealtime()
#define PB_T1(k) do { const unsigned long long bt1_ = __builtin_amdgcn_s_memrealtime(); if (threadIdx.x == 0) atomicMax((unsigned*)(args.ws + WS_CTL) + 15200 + (k), 0xFFFFFFFFu - (unsigned)(bt1_ - bt0_)); } while (0)
#else
#define PB_T0() do { } while (0)
#define PB_T1(k) do { } while (0)
#endif
#if defined(MK_PROBE_TS)
#define PH_TS(k) do { if ((k) == MK_PROBE_TS && blockIdx.x == 0 && threadIdx.x == 0) misc[20] = (unsigned)(__builtin_amdgcn_s_memrealtime() - kstart_); } while (0)
#else
#define PH_TS(k) do { } while (0)
#endif
#define PHASE(k) do { PH_TS(k); if (IN(k)) { PH_T0(); run_phase<k>(args, c); if constexpr ((MK_REPEAT_MASK >> (k)) & 1) { __syncthreads(); run_phase<k>(args, c); } PH_T1(k); PH_TS((k) + 100); } \
                      if ((k) != 9 && (k) + 1 < N_PHASES && IN(k) && IN((k) + 1)) { PB_T0(); xcd_barrier(bar); PB_T1(k); } } while (0)
    PHASE(0); PHASE(1); PHASE(2); PHASE(3); PHASE(4); PHASE(5); PHASE(6); PHASE(7); PHASE(8); PHASE(9); PHASE(10); PHASE(11);
#if defined(MK_PROBE_TS)
    PH_TS(12);
    if (blockIdx.x == 0 && threadIdx.x == 0) {
        const unsigned long long wait_ticks = misc[20];
        const unsigned long long w0 = __builtin_amdgcn_s_memrealtime();
        while (__builtin_amdgcn_s_memrealtime() - w0 < wait_ticks) __builtin_amdgcn_s_sleep(8);
    }
#endif
#if defined(MK_PROBE_BAR)
    if (blockIdx.x == 0 && threadIdx.x == 0) {
        unsigned long long wait_ticks = 0;
        for (int k = 0; k < 10; ++k) { const unsigned v = __hip_atomic_load((unsigned*)(args.ws + WS_CTL) + 15200 + k, __ATOMIC_RELAXED, __HIP_MEMORY_SCOPE_AGENT); if (v) wait_ticks += 0xFFFFFFFFu - v; }
        wait_ticks *= 10;
        const unsigned long long w0 = __builtin_amdgcn_s_memrealtime();
        while (__builtin_amdgcn_s_memrealtime() - w0 < wait_ticks) __builtin_amdgcn_s_sleep(8);
    }
#endif
#if defined(MK_PROBE_PHASE)
    if (blockIdx.x == 0 && threadIdx.x == 0) {
        const unsigned long long wait_ticks = __hip_atomic_load((unsigned*)(args.ws + WS_CTL) + 15100 + MK_PROBE_PHASE, __ATOMIC_RELAXED, __HIP_MEMORY_SCOPE_AGENT);
        const unsigned long long w0 = __builtin_amdgcn_s_memrealtime();
        while (__builtin_amdgcn_s_memrealtime() - w0 < wait_ticks) __builtin_amdgcn_s_sleep(8);
    }
#endif
#if defined(MK_PROBE_CLOCK)
    if (blockIdx.x == 0 && threadIdx.x == 0) {
        const unsigned dc = misc[16], dr = misc[17];
        unsigned* pw_ = (unsigned*)(args.ws + WS_CTL) + 15000;
        const unsigned long long wait_ticks = (MK_PROBE_CLOCK == 1) ? (unsigned long long)(((double)dc / (double)dr) * 0.1 * 500.0 * 100.0) : (MK_PROBE_CLOCK == 2) ? (unsigned long long)dr
            : (MK_PROBE_CLOCK == 3) ? (unsigned long long)__hip_atomic_load(pw_, __ATOMIC_RELAXED, __HIP_MEMORY_SCOPE_AGENT)
            : (MK_PROBE_CLOCK == 4) ? (unsigned long long)(__hip_atomic_load(pw_ + 1, __ATOMIC_RELAXED, __HIP_MEMORY_SCOPE_AGENT) / gridDim.x)
            : (unsigned long long)(0xFFFFFFFFu - __hip_atomic_load(pw_ + 2, __ATOMIC_RELAXED, __HIP_MEMORY_SCOPE_AGENT));
        const unsigned long long w0 = __builtin_amdgcn_s_memrealtime();
        while (__builtin_amdgcn_s_memrealtime() - w0 < wait_ticks) __builtin_amdgcn_s_sleep(8);
    }
#endif
#undef IN
#undef PHASE
}

extern "C" void kernel_launch(void* const* d_in, const int* in_sizes, int n_in, void* d_out, int out_size, void* d_ws, size_t ws_size, hipStream_t stream) {
    static int grid = 0;
    if (grid == 0) {
        if (n_in != N_IN || out_size != MLAT * DM || ws_size < WS_END) { fprintf(stderr, "kernel_launch: unexpected shapes: n_in %d out %d ws %zu (need %zu)\n", n_in, out_size, ws_size, (size_t)WS_END); grid = -1; return; }
        int dev = 0, cus = 0, per_cu = 0;
        if (hipGetDevice(&dev) != hipSuccess || hipDeviceGetAttribute(&cus, hipDeviceAttributeMultiprocessorCount, dev) != hipSuccess) { grid = -1; return; }
        if (hipFuncSetAttribute((const void*)mk_fwd, hipFuncAttributeMaxDynamicSharedMemorySize, LDS_BYTES) != hipSuccess) { fprintf(stderr, "kernel_launch: hipFuncSetAttribute failed\n"); grid = -1; return; }
        if (hipOccupancyMaxActiveBlocksPerMultiprocessor(&per_cu, (const void*)mk_fwd, 512, LDS_BYTES) != hipSuccess || per_cu < 1) fprintf(stderr, "kernel_launch: occupancy query reports %d\n", per_cu);
        (void)hipGetLastError();
        grid = cus;
    }
    if (grid < 0) return;
    if (hipMemsetAsync((char*)d_ws + WS_CTL, 0, CTL_ZERO_BYTES, stream) != hipSuccess) return;
    Args a{};
    for (int i = 0; i < N_IN; ++i) a.in[i] = (const float*)d_in[i];
    a.out = (float*)d_out; a.ws = (unsigned char*)d_ws;
    constexpr int NL = MK_N_LAUNCHES;
    for (int li = 0; li < NL; ++li) {
        a.ph_lo = (NL == N_PHASES) ? li : (li * N_PHASES) / NL; a.ph_hi = (NL == N_PHASES) ? li + 1 : ((li + 1) * N_PHASES) / NL; a.li = (NL == N_PHASES) ? 0 : li; a.pad = 0;
        hipLaunchKernelGGL(mk_fwd, dim3(grid), dim3(512), LDS_BYTES, stream, a);
    }
}
```

```cpp
#include <hip/hip_runtime.h>
#include <cstdio>
#include <cstdint>

#ifndef MK_N_LAUNCHES
#define MK_N_LAUNCHES 1
#endif

#define LAS __attribute__((address_space(3)))
typedef unsigned short bf16_t;
typedef short bf16x8 __attribute__((ext_vector_type(8)));
typedef short s16x4 __attribute__((ext_vector_type(4)));
typedef float f32x2 __attribute__((ext_vector_type(2)));
typedef float f32x4 __attribute__((ext_vector_type(4)));
typedef float f32x16 __attribute__((ext_vector_type(16)));
typedef unsigned u32x2 __attribute__((ext_vector_type(2)));
typedef unsigned u32x4 __attribute__((ext_vector_type(4)));
typedef int i32x4 __attribute__((ext_vector_type(4)));
typedef int i32x8 __attribute__((ext_vector_type(8)));

constexpr int NB = 8, NT = 4096, DM = 1024, NCX = 256, NHD = 8, NEXP = 16, CAP = 512, DFF = 2816;
constexpr int MLAT = NB * NT, MCTX = NB * NCX, MALL = MLAT + MCTX, KVR = NT + NCX;
constexpr int NPROJ = 7168, NMOD = 6 * DM;
constexpr float EPS = 1e-6f;
constexpr float QSCALE = 0.125f * 1.4426950408889634f;

constexpr size_t MiB = 1u << 20;
constexpr size_t WS_CTL = 0, CTL_ZERO_BYTES = 65536;
constexpr size_t WS_MOD = 65536;
constexpr size_t WS_ROPE = 294912;
constexpr size_t WS_AFF = 1 * MiB;
constexpr size_t WS_SEL = 3 * MiB;
constexpr size_t WS_WIN = 8 * MiB, WS_WCO = 22 * MiB, WS_WAO = 24 * MiB, WS_WO = 26 * MiB;
constexpr size_t WS_H = 28 * MiB;
constexpr size_t WS_ATTO = 28 * MiB;
constexpr size_t WS_U = 96 * MiB;
constexpr size_t WS_MIX = 96 * MiB;
constexpr size_t WS_Q = 160 * MiB;
constexpr size_t WS_K = 224 * MiB;
constexpr size_t WS_V = 292 * MiB;
constexpr size_t WS_GC = 360 * MiB, WS_GA = 424 * MiB;
constexpr size_t WS_CACT = 488 * MiB;
constexpr size_t WS_O1 = 552 * MiB;
constexpr size_t WS_WGU = 8 * MiB;
constexpr size_t WS_XS = 96 * MiB;
constexpr size_t WS_HF = 160 * MiB;
constexpr size_t WS_HID = 192 * MiB;
constexpr size_t WS_WD = 368 * MiB;
constexpr size_t WS_YS = 416 * MiB;
constexpr float WSCALE = 64.0f, WSCALE_INV = 1.0f / 64.0f;
constexpr size_t WS_END = 680 * MiB;

constexpr int RING_BYTES = 131072, LDSCTL_OFF = RING_BYTES, LDS_BYTES = 147456;

#define LDS_WAIT() asm volatile("s_waitcnt lgkmcnt(0)" ::: "memory")
#define VM_WAIT() asm volatile("s_waitcnt vmcnt(0)" ::: "memory")
__device__ __forceinline__ unsigned cvt_pk_bf16(float lo, float hi) { unsigned r; asm volatile("v_cvt_pk_bf16_f32 %0, %1, %2" : "=v"(r) : "v"(lo), "v"(hi)); return r; }
__device__ __forceinline__ unsigned pack4_fp8(float a, float b, float c, float d) { int w = 0; w = __builtin_amdgcn_cvt_pk_fp8_f32(a, b, w, false); w = __builtin_amdgcn_cvt_pk_fp8_f32(c, d, w, true); return (unsigned)w; }
__device__ __forceinline__ float bf_lo(unsigned u) { return __uint_as_float(u << 16); }
__device__ __forceinline__ float bf_hi(unsigned u) { return __uint_as_float(u & 0xffff0000u); }
__device__ __forceinline__ float wave_sum(float v) {
#pragma unroll
    for (int o = 1; o < 64; o <<= 1) v += __shfl_xor(v, o);
    return v;
}
__device__ __forceinline__ float sigmoidf_(float x) { return __builtin_amdgcn_rcpf(1.0f + __expf(-x)); }

#define XB_TMO      128
#define XB_XCNT(j)  (256  + 64 * (j))
#define XB_XSUB(j)  (1280 + 64 * (j))
#define XB_XGEN(j)  (2304 + 64 * (j))
#define XB_TOP      3328
#define XB_TOPGEN   3392
#define XCD_BAR_WORDS 3456
#define XB_SPIN_CAP (1u << 18)
__device__ __forceinline__ unsigned xb_ld(unsigned* p)              { return __hip_atomic_load(p, __ATOMIC_RELAXED, __HIP_MEMORY_SCOPE_AGENT); }
__device__ __forceinline__ unsigned xb_add(unsigned* p, unsigned v) { return __hip_atomic_fetch_add(p, v, __ATOMIC_RELAXED, __HIP_MEMORY_SCOPE_AGENT); }
__device__ __forceinline__ unsigned xb_xcc_id() { return (unsigned)__builtin_amdgcn_s_getreg((3 << 11) | 20) & 0xFu; }
#define XB_SPIN(cond, bar) do { unsigned _sp = 0; while (cond) { __builtin_amdgcn_s_sleep(1); \
    if ((++_sp & 255u) == 0u) { if (xb_ld(&(bar)[XB_TMO])) break; if (_sp > XB_SPIN_CAP) { atomicAdd(&(bar)[XB_TMO], 1u); break; } } } } while (0)
struct XcdBarrier { unsigned* bar; unsigned x; volatile LAS unsigned* st; };
__device__ __forceinline__ XcdBarrier xcd_barrier_post(unsigned* bar, volatile LAS unsigned* st) {
    XcdBarrier b; b.bar = bar; b.x = xb_xcc_id(); b.st = st;
    if (threadIdx.x == 0) (void)xb_add(&bar[XB_XCNT(b.x)], 1u);
    return b;
}
__device__ __forceinline__ void xcd_barrier_complete(unsigned* bar, unsigned x, unsigned& nloc, unsigned& nx) {
    const unsigned G = gridDim.x * gridDim.y * gridDim.z;
    unsigned sum, cnt, mine, sp = 0u;
    for (;;) {
        sum = 0u; cnt = 0u; mine = 0u;
#pragma unroll
        for (unsigned j = 0; j < 16; ++j) { const unsigned c = xb_ld(&bar[XB_XCNT(j)]); sum += c; cnt += (c > 0u) ? 1u : 0u; mine = (j == x) ? c : mine; }
        if (sum == G) break;
        __builtin_amdgcn_s_sleep(1);
        if ((++sp & 255u) == 0u) { if (xb_ld(&bar[XB_TMO])) break; if (sp > XB_SPIN_CAP) { atomicAdd(&bar[XB_TMO], 1u); break; } }
    }
    nloc = mine > 0u ? mine : 1u; nx = cnt > 0u ? cnt : 1u;
}
__device__ __forceinline__ void xcd_barrier(const XcdBarrier& b) {
    asm volatile("s_waitcnt vmcnt(0)" ::: "memory");
    __syncthreads();
    if (threadIdx.x == 0) {
        unsigned* bar = b.bar;
        __builtin_amdgcn_s_waitcnt(0);
        unsigned nloc = b.st[0], nx = b.st[1];
        if (nloc == 0u) { xcd_barrier_complete(bar, b.x, nloc, nx); b.st[0] = nloc; b.st[1] = nx; }
        const unsigned old = xb_add(&bar[XB_XSUB(b.x)], 1u);
        const unsigned gen = old / nloc;
        if (old + 1u == (gen + 1u) * nloc) {
            __builtin_amdgcn_fence(__ATOMIC_RELEASE, "agent");
            asm volatile("s_waitcnt vmcnt(0)" ::: "memory");
            const unsigned og = xb_add(&bar[XB_TOP], 1u);
            const unsigned tg = og / nx;
            if (og + 1u == (tg + 1u) * nx) xb_add(&bar[XB_TOPGEN], 1u);
            else XB_SPIN(xb_ld(&bar[XB_TOPGEN]) == tg, bar);
            __builtin_amdgcn_fence(__ATOMIC_ACQUIRE, "agent");
            xb_add(&bar[XB_XGEN(b.x)], 1u);
            asm volatile("s_waitcnt vmcnt(0)" ::: "memory");
        } else {
            XB_SPIN(xb_ld(&bar[XB_XGEN(b.x)]) == gen, bar);
            __builtin_amdgcn_fence(__ATOMIC_ACQUIRE, "agent");
            asm volatile("s_waitcnt vmcnt(0)" ::: "memory");
        }
    }
    __syncthreads();
}

namespace pg8 {
constexpr int BM = 256, BK = 64, HALF = 128, HTB = HALF * BK * 2, STAGE_BYTES = 8 * HTB, NXCD = 8, WGM = 8;
__host__ __device__ __forceinline__ int lds_byte(int r, int c) { const int st = (r >> 4) * 2 + (c >> 5), rr = r & 15, cc = c & 31, ob = rr * 64 + cc * 2; return st * 1024 + (ob ^ (((ob >> 9) & 1) << 5)); }
__host__ __device__ __forceinline__ void stage_rc(int b, int& R, int& C) { const int st = b / 1024, sb = b % 1024, swz = sb ^ (((sb >> 9) & 1) << 5); R = (st >> 1) * 16 + swz / 64; C = (st & 1) * 32 + (swz % 64) / 2; }
__host__ __device__ __forceinline__ int perm32(int rho) { const int n = rho >> 4, i = rho & 15; return 8 * (i >> 2) + 4 * n + (i & 3); }

struct Unit { int pm, pn, aux; };

__device__ __forceinline__ void tile_of(int L, int nM, int nN, int& pm, int& pn) {
    const int nwg = nM * nN; int wgid = L;
    { const int q = nwg / NXCD, r = nwg % NXCD, xcd = wgid % NXCD, off = wgid / NXCD; wgid = (xcd < r ? xcd * (q + 1) : r * (q + 1) + (xcd - r) * q) + off; }
    const int nig = WGM * nN, gid = wgid / nig, fm = gid * WGM, gsz = (nM - fm) < WGM ? (nM - fm) : WGM;
    pm = fm + ((wgid % nig) % gsz); pn = (wgid % nig) / gsz;
}

template <class Epi, class Sched, bool ALIGN_EPI, bool SP2, bool FP8 = false>
__device__ __forceinline__ void gemm_phase(LAS unsigned char* lds, const int RB, const Sched& S, const Epi& E) {
    const int tid = threadIdx.x, wid = __builtin_amdgcn_readfirstlane(tid >> 6), lane = tid & 63, wr = wid >> 2, wc = wid & 3, fr = lane & 15, fq = lane >> 4;
    const int nt = RB / 128;
    unsigned voffA[2], voffB[2];
#pragma unroll
    for (int i = 0; i < 2; ++i) { int R, C; stage_rc(tid * 16 + i * 8192, R, C); const int Rb = Epi::PERM ? ((R & ~31) + perm32(R & 31)) : R;
        voffA[i] = (unsigned)(R * RB + C * 2); voffB[i] = (unsigned)(Rb * RB + C * 2); }
    const size_t kstep = (size_t)(BK * 2);
    const size_t hstep = (size_t)HALF * RB;
    const unsigned ldsw = (unsigned)wid * 1024u;
    const int aoff = lds_byte(wr * 64 + fr, fq * 8), boff = lds_byte(wc * 32 + fr, fq * 8);
#define PG8_SA(b, h) (((b) * 2 + (h)) * HTB)
#define PG8_SB(b, h) ((4 + (b) * 2 + (h)) * HTB)
#define PG8_STAGE(bufoff, gbase, voff) do { _Pragma("unroll") for (int _i = 0; _i < 2; ++_i) \
        __builtin_amdgcn_global_load_lds((const unsigned*)((const char*)(gbase) + (voff)[_i]), (LAS unsigned*)(lds + (bufoff) + ldsw + _i * 8192), 16, 0, 0); } while (0)
#define PG8_LD8(p) __builtin_shufflevector(*(const LAS i32x4*)(p), *(const LAS i32x4*)((p) + 1024), 0, 1, 2, 3, 4, 5, 6, 7)
#define PG8_LDA(dst, b, h) do { _Pragma("unroll") for (int m = 0; m < 4; ++m) dst[m] = PG8_LD8(lds + PG8_SA(b, h) + aoff + m * 2048); } while (0)
#define PG8_LDB(dst, b, h) do { _Pragma("unroll") for (int n = 0; n < 2; ++n) dst[n] = PG8_LD8(lds + PG8_SB(b, h) + boff + n * 2048); } while (0)
#define PG8_LO(x) __builtin_bit_cast(bf16x8, __builtin_shufflevector(x, x, 0, 1, 2, 3))
#define PG8_HI(x) __builtin_bit_cast(bf16x8, __builtin_shufflevector(x, x, 4, 5, 6, 7))
#define PG8_MMA(ai, bj, At, Bt) do { __builtin_amdgcn_s_setprio(1); _Pragma("unroll") for (int m = 0; m < 4; ++m) _Pragma("unroll") for (int n = 0; n < 2; ++n) { \
        if constexpr (FP8) asm volatile("v_mfma_f32_16x16x128_f8f6f4 %0, %1, %2, %0" : "+v"(acc[ai][bj][m][n]) : "v"(Bt[n]), "v"(At[m]));   \
        else { acc[ai][bj][m][n] = __builtin_amdgcn_mfma_f32_16x16x32_bf16(PG8_LO(Bt[n]), PG8_LO(At[m]), acc[ai][bj][m][n], 0, 0, 0); \
               acc[ai][bj][m][n] = __builtin_amdgcn_mfma_f32_16x16x32_bf16(PG8_HI(Bt[n]), PG8_HI(At[m]), acc[ai][bj][m][n], 0, 0, 0); } } \
        __builtin_amdgcn_s_setprio(0); } while (0)
#define PG8_WAIT_V(n) asm volatile("s_waitcnt vmcnt(" #n ")" ::: "memory")
#define PG8_WAIT_L(n) asm volatile("s_waitcnt lgkmcnt(" #n ")" ::: "memory")
#define PG8_BAR __builtin_amdgcn_s_barrier()
#define PG8_SCHED __builtin_amdgcn_sched_barrier(0)
    Unit cur, nxt; int ui = 0;
    if (!S.next(0, cur)) return;
    f32x4 acc[2][2][4][2];
#pragma unroll
    for (int a = 0; a < 2; ++a)
#pragma unroll
        for (int b = 0; b < 2; ++b)
#pragma unroll
            for (int m = 0; m < 4; ++m)
#pragma unroll
                for (int n = 0; n < 2; ++n) acc[a][b][m][n] = (f32x4){0.f, 0.f, 0.f, 0.f};
    i32x8 At[4], B0[2], B1[2];
    const char* cA = S.a_ptr(cur); const char* cB = S.b_ptr(cur);
    if constexpr (SP2) {
        PG8_STAGE(PG8_SB(0, 0), cB, voffB); PG8_STAGE(PG8_SB(0, 1), cB + hstep, voffB); PG8_STAGE(PG8_SA(0, 0), cA, voffA); PG8_STAGE(PG8_SA(0, 1), cA + hstep, voffA);
        if (wr == 1) PG8_BAR;
        PG8_WAIT_V(2); PG8_BAR;
        PG8_STAGE(PG8_SB(1, 0), cB + kstep, voffB); PG8_STAGE(PG8_SA(1, 0), cA + kstep, voffA); PG8_STAGE(PG8_SB(1, 1), cB + hstep + kstep, voffB);
        PG8_WAIT_V(6); PG8_BAR;
    } else {
        PG8_STAGE(PG8_SB(0, 0), cB, voffB); PG8_STAGE(PG8_SA(0, 0), cA, voffA); PG8_STAGE(PG8_SB(0, 1), cB + hstep, voffB); PG8_STAGE(PG8_SA(0, 1), cA + hstep, voffA);
        if (wr == 1) PG8_BAR;
        PG8_WAIT_V(4); PG8_BAR;
        PG8_STAGE(PG8_SB(1, 0), cB + kstep, voffB); PG8_STAGE(PG8_SA(1, 0), cA + kstep, voffA); PG8_STAGE(PG8_SB(1, 1), cB + hstep + kstep, voffB);
        PG8_WAIT_V(6); PG8_BAR;
    }
    for (;;) {
        const bool has_next = S.next(ui + 1, nxt);
        const char* nA = has_next ? S.a_ptr(nxt) : cA; const char* nB = has_next ? S.b_ptr(nxt) : cB;
#pragma nounroll
        for (int t = 0; t < nt; t += 2) {
            const bool last = (t == nt - 2);
            const char* a1 = cA + (size_t)(t + 1) * kstep;
            const char* a2 = last ? nA : cA + (size_t)(t + 2) * kstep; const char* b2 = last ? nB : cB + (size_t)(t + 2) * kstep;
            const char* a3 = a2 + kstep; const char* b3 = b2 + kstep;
            if constexpr (SP2) {
            PG8_LDB(B0, 0, 0); PG8_LDB(B1, 0, 1); PG8_SCHED; PG8_LDA(At, 0, 0); PG8_STAGE(PG8_SA(1, 1), a1 + hstep, voffA);
            PG8_WAIT_V(8); PG8_WAIT_L(0); PG8_BAR; PG8_MMA(0, 0, At, B0); PG8_MMA(0, 1, At, B1); PG8_BAR; PG8_SCHED;
            PG8_LDA(At, 0, 1); PG8_STAGE(PG8_SB(0, 0), b2, voffB); PG8_STAGE(PG8_SB(0, 1), b2 + hstep, voffB); PG8_STAGE(PG8_SA(0, 0), a2, voffA);
            PG8_WAIT_V(8); PG8_WAIT_L(0); PG8_BAR; PG8_MMA(1, 0, At, B0); PG8_MMA(1, 1, At, B1); PG8_BAR; PG8_SCHED;
            PG8_LDB(B0, 1, 0); PG8_LDB(B1, 1, 1); PG8_SCHED; PG8_LDA(At, 1, 0); PG8_STAGE(PG8_SA(0, 1), a2 + hstep, voffA);
            PG8_WAIT_V(8); PG8_WAIT_L(0); PG8_BAR; PG8_MMA(0, 0, At, B0); PG8_MMA(0, 1, At, B1); PG8_BAR; PG8_SCHED;
            PG8_LDA(At, 1, 1); PG8_STAGE(PG8_SB(1, 0), b3, voffB); PG8_STAGE(PG8_SB(1, 1), b3 + hstep, voffB); PG8_STAGE(PG8_SA(1, 0), a3, voffA);
            PG8_WAIT_V(8); PG8_WAIT_L(0); PG8_BAR; PG8_MMA(1, 0, At, B0); PG8_MMA(1, 1, At, B1); PG8_BAR; PG8_SCHED;
            } else {
            PG8_LDB(B0, 0, 0); PG8_SCHED; PG8_LDA(At, 0, 0); PG8_STAGE(PG8_SA(1, 1), a1 + hstep, voffA);
            PG8_WAIT_L(8); PG8_BAR; PG8_WAIT_L(0); PG8_MMA(0, 0, At, B0); PG8_BAR; PG8_SCHED;
            PG8_LDB(B1, 0, 1); PG8_STAGE(PG8_SB(0, 0), b2, voffB);
            PG8_BAR; PG8_WAIT_L(0); PG8_MMA(0, 1, At, B1); PG8_BAR;
            PG8_LDA(At, 0, 1); PG8_STAGE(PG8_SA(0, 0), a2, voffA);
            PG8_BAR; PG8_WAIT_L(0); PG8_MMA(1, 0, At, B0); PG8_BAR; PG8_SCHED;
            PG8_STAGE(PG8_SB(0, 1), b2 + hstep, voffB);
            PG8_WAIT_V(6); PG8_BAR; PG8_MMA(1, 1, At, B1); PG8_BAR;
            PG8_LDB(B0, 1, 0); PG8_SCHED; PG8_LDA(At, 1, 0); PG8_STAGE(PG8_SA(0, 1), a2 + hstep, voffA);
            PG8_WAIT_L(8); PG8_BAR; PG8_WAIT_L(0); PG8_MMA(0, 0, At, B0); PG8_BAR; PG8_SCHED;
            PG8_LDB(B1, 1, 1); PG8_STAGE(PG8_SB(1, 0), b3, voffB);
            PG8_BAR; PG8_WAIT_L(0); PG8_MMA(0, 1, At, B1); PG8_BAR;
            PG8_LDA(At, 1, 1); PG8_STAGE(PG8_SA(1, 0), a3, voffA);
            PG8_BAR; PG8_WAIT_L(0); PG8_MMA(1, 0, At, B0); PG8_BAR; PG8_SCHED;
            PG8_STAGE(PG8_SB(1, 1), b3 + hstep, voffB);
            PG8_WAIT_V(6); PG8_BAR; PG8_MMA(1, 1, At, B1); PG8_BAR;
            }
        }
        if constexpr (ALIGN_EPI) { if (wr == 0) PG8_BAR; }
        if constexpr (FP8) asm volatile("s_nop 15\n\ts_nop 15" ::: "memory");
        E(acc, cur, wr, wc, fr, fq);
        if (!has_next) break;
        if (!S.keep(cur)) {
#pragma unroll
            for (int a = 0; a < 2; ++a)
#pragma unroll
                for (int b = 0; b < 2; ++b)
#pragma unroll
                    for (int m = 0; m < 4; ++m)
#pragma unroll
                        for (int n = 0; n < 2; ++n) acc[a][b][m][n] = (f32x4){0.f, 0.f, 0.f, 0.f};
        }
        cur = nxt; cA = nA; cB = nB; ++ui;
        if constexpr (ALIGN_EPI) { if (wr == 1) PG8_BAR; }
    }
    PG8_WAIT_V(0);
    if constexpr (!ALIGN_EPI) { if (wr == 0) PG8_BAR; }
    PG8_BAR;
#undef PG8_SA
#undef PG8_SB
#undef PG8_STAGE
#undef PG8_LDA
#undef PG8_LDB
#undef PG8_MMA
#undef PG8_LD8
#undef PG8_LO
#undef PG8_HI
#undef PG8_WAIT_V
#undef PG8_WAIT_L
#undef PG8_BAR
#undef PG8_SCHED
}
}
using pg8::Unit;

#ifndef PG8_SP2
#define PG8_SP2 true
#endif
#ifndef PG8_ALIGN
#define PG8_ALIGN true
#endif

enum InIdx { I_X = 0, I_C, I_CTX, I_CCTX, I_WADA, I_BADA, I_GMIX, I_GFFN, I_WIN, I_WDW, I_BDW, I_LNG, I_LNB, I_WCO, I_BCO, I_LQ1, I_LK1, I_LQ2, I_LK2, I_GSUB, I_WAO, I_WOUT, I_WR, I_WEG, I_WEU, I_WED, I_GFIN, N_IN };
struct Args { const float* in[N_IN]; float* out; unsigned char* ws; int ph_lo, ph_hi, li, pad; };

__device__ __forceinline__ void ph_adaln(const Args& a, LAS unsigned char* lds, int bid, int G) {
    const int tid = threadIdx.x;
    LAS float* sil = (LAS float*)lds;
    LAS float* red = sil + 9 * 1024;
    const float* c = a.in[I_C]; const float* cc = a.in[I_CCTX]; const float* w = a.in[I_WADA]; const float* bb = a.in[I_BADA];
    float* mod = (float*)(a.ws + WS_MOD);
    for (int i = tid; i < 9 * 1024; i += 512) { const float v = (i < 8192) ? c[i] : cc[i - 8192]; sil[i] = v / (1.0f + expf(-v)); }
    __syncthreads();
    for (int unit = bid; unit < NMOD / 32; unit += G) {
        const int n0 = unit * 32, col = tid & 31, kp = tid >> 5;
        float acc[9];
#pragma unroll
        for (int r = 0; r < 9; ++r) acc[r] = 0.f;
#pragma unroll 8
        for (int kk = 0; kk < 64; ++kk) { const int k = kp * 64 + kk; const float wv = w[(size_t)k * NMOD + n0 + col];
#pragma unroll
            for (int r = 0; r < 9; ++r) acc[r] += sil[r * 1024 + k] * wv; }
#pragma unroll
        for (int r = 0; r < 9; ++r) red[(kp * 9 + r) * 32 + col] = acc[r];
        __syncthreads();
        if (tid < 288) { const int r = tid >> 5, cl = tid & 31; float s = 0.f;
#pragma unroll
            for (int k2 = 0; k2 < 16; ++k2) s += red[(k2 * 9 + r) * 32 + cl];
            mod[r * NMOD + n0 + cl] = s + bb[n0 + cl]; }
        __syncthreads();
    }
}
__device__ __forceinline__ void ph_rope_table(const Args& a) {
    float* rc = (float*)(a.ws + WS_ROPE); float* rs = rc + 1024;
    for (int i = threadIdx.x; i < 1024; i += 512) { const int pos = i >> 4, f = i & 15;
        const float inv = powf(10000.0f, -(float)f / 16.0f); const float ang = (float)pos * inv;
        rc[i] = cosf(ang); rs[i] = sinf(ang); }
}
template <class DstRow>
__device__ __forceinline__ void transpose_item(const float* W, int K, int N, bf16_t* WT, const DstRow& dr, LAS float* scr, int item, int lane) {
    const int nblk = N / 32, kb = item / nblk, nb = item % nblk, k0 = 64 * kb, n0 = 32 * nb;
#pragma unroll 8
    for (int i = 0; i < 32; ++i) { const int kk = 2 * i + (lane >> 5); scr[kk * 33 + (lane & 31)] = __builtin_nontemporal_load(W + (size_t)(k0 + kk) * N + n0 + (lane & 31)); }
    LDS_WAIT(); asm volatile("" ::: "memory");
    const int c = lane & 7;
#pragma unroll
    for (int j = 0; j < 4; ++j) { const int n = (lane >> 3) + 8 * j; const LAS float* s = scr + (8 * c) * 33 + n;
        u32x4 o; o.x = cvt_pk_bf16(s[0 * 33], s[1 * 33]); o.y = cvt_pk_bf16(s[2 * 33], s[3 * 33]); o.z = cvt_pk_bf16(s[4 * 33], s[5 * 33]); o.w = cvt_pk_bf16(s[6 * 33], s[7 * 33]);
        *(u32x4*)(WT + (size_t)dr(n0 + n) * K + k0 + 8 * c) = o; }
    LDS_WAIT(); asm volatile("" ::: "memory");
}
template <class DstRow>
__device__ __forceinline__ void transpose_item_fp8(const float* W, int K, int N, unsigned char* WT, const DstRow& dr, LAS float* scr, int item, int lane) {
    const int nblk = N / 32, kb = item / nblk, nb = item % nblk, k0 = 64 * kb, n0 = 32 * nb;
#pragma unroll 8
    for (int i = 0; i < 32; ++i) { const int kk = 2 * i + (lane >> 5); scr[kk * 33 + (lane & 31)] = __builtin_nontemporal_load(W + (size_t)(k0 + kk) * N + n0 + (lane & 31)); }
    LDS_WAIT(); asm volatile("" ::: "memory");
    const int c = lane & 7;
#pragma unroll
    for (int j = 0; j < 4; ++j) { const int n = (lane >> 3) + 8 * j; const LAS float* s = scr + (8 * c) * 33 + n;
        u32x2 o; o.x = pack4_fp8(s[0 * 33] * WSCALE, s[1 * 33] * WSCALE, s[2 * 33] * WSCALE, s[3 * 33] * WSCALE); o.y = pack4_fp8(s[4 * 33] * WSCALE, s[5 * 33] * WSCALE, s[6 * 33] * WSCALE, s[7 * 33] * WSCALE);
        *(u32x2*)(WT + (size_t)dr(n0 + n) * K + k0 + 8 * c) = o; }
    LDS_WAIT(); asm volatile("" ::: "memory");
}
__host__ __device__ __forceinline__ int qdst(int d) { const int blk = d >> 5, half = (d >> 4) & 1, i = d & 15; return 8 * (4 * blk + (i >> 2)) + 4 * half + (i & 3); }
struct DrWin { __host__ __device__ int operator()(int j) const {
    if (j < 1024) return 256 * (j >> 7) + (j & 127);
    if (j < 2048) { const int jj = j - 1024; return 256 * (jj >> 7) + 128 + (jj & 127); }
    if (j < 4096) { const int jj = j & 1023, base = j - jj; return base + (jj & ~63) + qdst(jj & 63); }
    return j; } };
struct DrId { __host__ __device__ int operator()(int j) const { return j; } };
struct DrGU { int up; __host__ __device__ int operator()(int f) const { return 256 * (f >> 7) + 128 * up + (f & 127); } };

__device__ __forceinline__ void ph_small_weights(const Args& a, LAS unsigned char* lds, int gw, int NGW, int wave, int lane) {
    LAS float* scr = (LAS float*)(lds + 57344 + wave * 8448);
    constexpr int I_IN = (DM / 64) * (NPROJ / 32), I_SQ = (DM / 64) * (DM / 32);
    for (int it = gw; it < I_IN + 3 * I_SQ; it += NGW) {
        int r = it;
        if (r < I_IN) { transpose_item(a.in[I_WIN], DM, NPROJ, (bf16_t*)(a.ws + WS_WIN), DrWin{}, scr, r, lane); continue; } r -= I_IN;
        if (r < I_SQ) { transpose_item(a.in[I_WCO], DM, DM, (bf16_t*)(a.ws + WS_WCO), DrId{}, scr, r, lane); continue; } r -= I_SQ;
        if (r < I_SQ) { transpose_item(a.in[I_WAO], DM, DM, (bf16_t*)(a.ws + WS_WAO), DrId{}, scr, r, lane); continue; } r -= I_SQ;
        transpose_item(a.in[I_WOUT], DM, DM, (bf16_t*)(a.ws + WS_WO), DrId{}, scr, r, lane);
    }
}
__device__ __forceinline__ void ph_wgu(const Args& a, LAS unsigned char* lds, int gw, int NGW, int wave, int lane) {
    LAS float* scr = (LAS float*)(lds + 57344 + wave * 8448);
    constexpr int I_E = (DM / 64) * (DFF / 32);
    for (int it = gw; it < 2 * NEXP * I_E; it += NGW) {
        const int mat = it / I_E, r = it % I_E, e = mat >> 1, up = mat & 1;
        const float* W = (up ? a.in[I_WEU] : a.in[I_WEG]) + (size_t)e * DM * DFF;
        transpose_item_fp8(W, DM, DFF, (unsigned char*)(a.ws + WS_WGU) + (size_t)e * 2 * DFF * DM, DrGU{up}, scr, r, lane);
    }
}
__device__ __forceinline__ void ph_wd(const Args& a, LAS unsigned char* lds, int gw, int NGW, int wave, int lane) {
    LAS float* scr = (LAS float*)(lds + 57344 + wave * 8448);
    constexpr int I_E = (DFF / 64) * (DM / 32);
    for (int it = gw; it < NEXP * I_E; it += NGW) {
        const int e = it / I_E, r = it % I_E;
        transpose_item_fp8(a.in[I_WED] + (size_t)e * DFF * DM, DFF, DM, (unsigned char*)(a.ws + WS_WD) + (size_t)e * DM * DFF, DrId{}, scr, r, lane);
    }
}

__device__ __forceinline__ void ph_norm_rows(const Args& a, int gw, int NGW, int lane) {
    const float* mod = (const float*)(a.ws + WS_MOD); const float* g = a.in[I_GMIX]; bf16_t* H = (bf16_t*)(a.ws + WS_H);
    const int per = (MALL + NGW - 1) / NGW, r0 = gw * per, r1 = (r0 + per < MALL) ? r0 + per : MALL;
    if (r0 >= r1) return;
    auto src_of = [&](int row) { return (const f32x4*)((row < MLAT) ? a.in[I_X] + (size_t)row * DM : a.in[I_CTX] + (size_t)(row - MLAT) * DM) + lane; };
    f32x4 gs[4], sh[4]; int cur_b = -1;
    f32x4 nx[4];
    { const f32x4* xr = src_of(r0);
#pragma unroll
      for (int j = 0; j < 4; ++j) nx[j] = __builtin_nontemporal_load(xr + 64 * j); }
    for (int row = r0; row < r1; ++row) {
        f32x4 v[4];
#pragma unroll
        for (int j = 0; j < 4; ++j) v[j] = nx[j];
        if (row + 1 < r1) { const f32x4* xr = src_of(row + 1);
#pragma unroll
            for (int j = 0; j < 4; ++j) nx[j] = __builtin_nontemporal_load(xr + 64 * j); }
        const int b = (row < MLAT) ? (row >> 12) : 8;
        if (b != cur_b) { cur_b = b; const float* mb = mod + (size_t)b * NMOD;
#pragma unroll
            for (int j = 0; j < 4; ++j) { const int c = 4 * lane + 256 * j; gs[j] = *(const f32x4*)(g + c) * (*(const f32x4*)(mb + 1024 + c) + 1.0f); sh[j] = *(const f32x4*)(mb + c); } }
        float s = 0.f;
#pragma unroll
        for (int j = 0; j < 4; ++j) s += (v[j].x * v[j].x + v[j].y * v[j].y) + (v[j].z * v[j].z + v[j].w * v[j].w);
        const float rstd = 1.0f / sqrtf(wave_sum(s) * (1.0f / DM) + EPS);
        unsigned long long* o8 = (unsigned long long*)(H + (size_t)row * DM) + lane;
#pragma unroll
        for (int j = 0; j < 4; ++j) { const f32x4 y = (v[j] * rstd) * gs[j] + sh[j];
            o8[64 * j] = (unsigned long long)cvt_pk_bf16(y.x, y.y) | ((unsigned long long)cvt_pk_bf16(y.z, y.w) << 32); }
    }
}

struct SchedInProj {
    const char* A; const char* Bt; int G, c;
    static constexpr int NLAT = 128 * 28, NCTXU = 8 * 8;
    __device__ __forceinline__ bool next(int i, Unit& u) const {
        const int L = i * G + c; if (L >= NLAT + NCTXU) return false;
        if (L < NLAT) { pg8::tile_of(L, 128, 28, u.pm, u.pn); } else { const int v = L - NLAT; u.pm = 128 + (v & 7); u.pn = 12 + (v >> 3); }
        u.aux = 0; return true; }
    __device__ __forceinline__ const char* a_ptr(const Unit& u) const { return (u.pn >= 16 && u.pn < 20) ? Bt + (size_t)u.pn * (256 * DM * 2) : A + (size_t)u.pm * (256 * DM * 2); }
    __device__ __forceinline__ const char* b_ptr(const Unit& u) const { return (u.pn >= 16 && u.pn < 20) ? A + (size_t)u.pm * (256 * DM * 2) : Bt + (size_t)u.pn * (256 * DM * 2); }
    __device__ __forceinline__ bool keep(const Unit&) const { return false; }
};
struct EpiInProj {
    static constexpr bool PERM = true;
    bf16_t *U, *Q, *KA, *VA, *GC, *GA; const float* rope;
    __device__ __forceinline__ void operator()(f32x4 (&acc)[2][2][4][2], const Unit& u, int wr, int wc, int fr, int fq) const {
        const int pn = u.pn, pm = u.pm;
        const int cw = wc * 32 + 8 * fq;
        if (pn < 8) {
#pragma unroll
            for (int ai = 0; ai < 2; ++ai)
#pragma unroll
                for (int m = 0; m < 4; ++m) { const int r = pm * 256 + ai * 128 + wr * 64 + m * 16 + fr;
                    const f32x4 a0 = acc[ai][0][m][0], a1 = acc[ai][0][m][1], b0 = acc[ai][1][m][0], b1 = acc[ai][1][m][1];
                    u32x4 w; w.x = cvt_pk_bf16(a0[0] * sigmoidf_(b0[0]), a0[1] * sigmoidf_(b0[1])); w.y = cvt_pk_bf16(a0[2] * sigmoidf_(b0[2]), a0[3] * sigmoidf_(b0[3]));
                    w.z = cvt_pk_bf16(a1[0] * sigmoidf_(b1[0]), a1[1] * sigmoidf_(b1[1])); w.w = cvt_pk_bf16(a1[2] * sigmoidf_(b1[2]), a1[3] * sigmoidf_(b1[3]));
                    *(u32x4*)(U + (size_t)r * DM + pn * 128 + cw) = w; }
            return;
        }
        if (pn < 16) {
            const bool isq = pn < 12, lat = pm < 128;
            bf16_t* base; size_t row0; int rowpos0 = 0;
            if (isq) { base = Q + (size_t)(pn - 8) * 256; row0 = (size_t)pm * 256; }
            else { base = KA + (size_t)(pn - 12) * 256; row0 = lat ? (size_t)(pm >> 4) * KVR + (size_t)(pm & 15) * 256 : (size_t)(pm - 128) * KVR + NT; }
            if (lat) rowpos0 = (pm & 15) * 4;
            const float sc = isq ? QSCALE : 1.0f;
            const float* rc = rope; const float* rs = rope + 1024;
#pragma unroll
            for (int ai = 0; ai < 2; ++ai)
#pragma unroll
                for (int m = 0; m < 4; ++m) { const int rl = ai * 128 + wr * 64 + m * 16 + fr;
                    f32x4 cs = (f32x4){1.f, 1.f, 1.f, 1.f}, sn = (f32x4){0.f, 0.f, 0.f, 0.f};
                    if (lat) { const int pos = (wc & 1) ? (m * 16 + fr) : (rowpos0 + 2 * ai + wr); cs = *(const f32x4*)(rc + pos * 16 + 4 * fq); sn = *(const f32x4*)(rs + pos * 16 + 4 * fq); }
#pragma unroll
                    for (int bj = 0; bj < 2; ++bj) { const f32x4 x1 = acc[ai][bj][m][0], x2 = acc[ai][bj][m][1];
                        const f32x4 y1 = (x1 * cs - x2 * sn) * sc, y2 = (x1 * sn + x2 * cs) * sc;
                        u32x4 w; w.x = cvt_pk_bf16(y1[0], y1[1]); w.y = cvt_pk_bf16(y1[2], y1[3]); w.z = cvt_pk_bf16(y2[0], y2[1]); w.w = cvt_pk_bf16(y2[2], y2[3]);
                        *(u32x4*)(base + (row0 + rl) * DM + bj * 128 + cw) = w; } }
            return;
        }
        if (pn < 20) {
            const bool lat = pm < 128;
            const int bidx = lat ? (pm >> 4) : (pm - 128), key0 = lat ? (pm & 15) * 256 : NT;
            bf16_t* vt = VA + (size_t)(bidx * NHD + 2 * (pn - 16)) * 128 * KVR + key0;
            int fr_ = fr; asm volatile("" : "+v"(fr_));
#pragma unroll
            for (int ai = 0; ai < 2; ++ai)
#pragma unroll
                for (int m = 0; m < 4; ++m) { bf16_t* rowp = vt + (unsigned)((ai * 128 + wr * 64 + m * 16 + fr_) * KVR);
#pragma unroll
                    for (int bj = 0; bj < 2; ++bj) { const f32x4 v0 = acc[ai][bj][m][0], v1 = acc[ai][bj][m][1];
                        unsigned a0 = cvt_pk_bf16(v0[0], v0[1]), a1 = cvt_pk_bf16(v0[2], v0[3]), b0 = cvt_pk_bf16(v1[0], v1[1]), b1 = cvt_pk_bf16(v1[2], v1[3]);
                        { auto r_ = __builtin_amdgcn_permlane16_swap(a0, b0, false, false); a0 = r_[0]; b0 = r_[1]; }
                        { auto r_ = __builtin_amdgcn_permlane16_swap(a1, b1, false, false); a1 = r_[0]; b1 = r_[1]; }
                        *(u32x4*)(rowp + bj * 128 + wc * 32 + 8 * fq) = (u32x4){a0, a1, b0, b1}; }
                    asm volatile("" ::: "memory"); }
            return;
        }
        {
            bf16_t* base; size_t row0;
            if (pn < 24) { base = GC + (size_t)(pn - 20) * 256; row0 = (size_t)pm * 256; }
            else { base = GA + (size_t)(pn - 24) * 256; row0 = (size_t)pm * 256; }
#pragma unroll
            for (int ai = 0; ai < 2; ++ai)
#pragma unroll
                for (int m = 0; m < 4; ++m) { const int rl = ai * 128 + wr * 64 + m * 16 + fr;
#pragma unroll
                    for (int bj = 0; bj < 2; ++bj) { f32x4 v0 = acc[ai][bj][m][0], v1 = acc[ai][bj][m][1];
#pragma unroll
                        for (int j = 0; j < 4; ++j) { v0[j] = sigmoidf_(v0[j]); v1[j] = sigmoidf_(v1[j]); }
                        u32x4 w; w.x = cvt_pk_bf16(v0[0], v0[1]); w.y = cvt_pk_bf16(v0[2], v0[3]); w.z = cvt_pk_bf16(v1[0], v1[1]); w.w = cvt_pk_bf16(v1[2], v1[3]);
                        *(u32x4*)(base + (row0 + rl) * DM + bj * 128 + cw) = w; } }
        }
    }
};

__device__ __forceinline__ void ph_conv_unit(const Args& a, LAS unsigned char* lds, int unit) {
    const int tid = threadIdx.x, lane = tid & 63, wave = __builtin_amdgcn_readfirstlane(tid >> 6);
    const int b = unit >> 5, t0 = (unit & 31) * 128;
    LAS float* ybuf = (LAS float*)lds;
    const int c0 = 2 * tid;
    f32x2 w[31];
    { const float* wp = a.in[I_WDW]; asm volatile("" : "+s"(wp));
      const __attribute__((address_space(1))) f32x2* wp2 = (const __attribute__((address_space(1))) f32x2*)(wp + c0);
#pragma unroll
      for (int j = 0; j < 31; ++j) w[j] = wp2[j * (DM / 2)]; }
    const f32x2 bias = *(const f32x2*)(a.in[I_BDW] + c0);
    const unsigned* Ub = (const unsigned*)(a.ws + WS_U) + (size_t)b * NT * (DM / 2) + tid;
    bf16_t* CA = (bf16_t*)(a.ws + WS_CACT) + (size_t)(b * NT + t0) * DM;
    const float* lng = a.in[I_LNG]; const float* lnb = a.in[I_LNB];
    f32x2 win[32];
#pragma unroll
    for (int s = 0; s < 32; ++s) win[s] = (f32x2){0.f, 0.f};
    unsigned pf[16];
    const unsigned* up = Ub + ((long)t0 - 15) * (DM / 2);
#define CV_LD(i) ({ const int i_ = (i); const int ti_ = t0 - 15 + i_; (i_ < 158 && ti_ >= 0 && ti_ < NT) ? up[(long)i_ * (DM / 2)] : 0u; })
#pragma unroll
    for (int s = 0; s < 16; ++s) pf[s] = CV_LD(s);
    for (int Q = 0; Q < 5; ++Q) {
#pragma unroll
        for (int hb = 0; hb < 2; ++hb)
#pragma unroll
        for (int s16 = 0; s16 < 16; ++s16) {
            const int s = hb * 16 + s16;
            const unsigned pk = pf[s16];
            pf[s16] = CV_LD(32 * Q + s + 16);
            win[s] = (f32x2){bf_lo(pk), bf_hi(pk)};
            const int to = 32 * Q + s - 30;
            if (to >= 0 && to < 128) {
                f32x2 y = bias;
#pragma unroll
                for (int j = 0; j < 31; ++j) y += w[j] * win[(s + 2 + j) & 31];
                *(LAS f32x2*)(ybuf + (to & 15) * DM + c0) = y;
            }
            if (s == 13 || s == 29) {
                if (Q >= 1) {
                    const int tb = 32 * Q + s - 30 - 15;
                    __syncthreads();
#pragma unroll
                    for (int k = 0; k < 2; ++k) { const int tl = 2 * wave + k;
                        f32x4 v[4]; float sm = 0.f;
#pragma unroll
                        for (int j = 0; j < 4; ++j) { v[j] = *(const LAS f32x4*)(ybuf + tl * DM + 4 * lane + 256 * j); sm += (v[j].x + v[j].y) + (v[j].z + v[j].w); }
                        const float mean = wave_sum(sm) * (1.0f / DM); float s2 = 0.f;
#pragma unroll
                        for (int j = 0; j < 4; ++j) { v[j] = v[j] - mean; s2 += (v[j].x * v[j].x + v[j].y * v[j].y) + (v[j].z * v[j].z + v[j].w * v[j].w); }
                        const float rstd = 1.0f / sqrtf(wave_sum(s2) * (1.0f / DM) + EPS);
                        unsigned long long* o8 = (unsigned long long*)(CA + (size_t)(tb + tl) * DM) + lane;
#pragma unroll
                        for (int j = 0; j < 4; ++j) { const int c = 4 * lane + 256 * j;
                            f32x4 y = v[j] * rstd * *(const f32x4*)(lng + c) + *(const f32x4*)(lnb + c);
#pragma unroll
                            for (int q = 0; q < 4; ++q) y[q] = y[q] * sigmoidf_(y[q]);
                            o8[64 * j] = (unsigned long long)cvt_pk_bf16(y.x, y.y) | ((unsigned long long)cvt_pk_bf16(y.z, y.w) << 32); } }
                    __syncthreads();
                }
            }
        }
    }
#undef CV_LD
}

namespace att {
constexpr int NW = 8, QBLK = 32, KVBLK = 64, NTILE = KVR / KVBLK;
constexpr int SHM_V = 128 * KVBLK * 2, SHM_K = KVBLK * 64 * 2;
constexpr int BUFB = SHM_V + SHM_K, NBUF = 4, ATT_LDS = NBUF * BUFB;
constexpr int VT_PITCH = KVR;
#define KSWZ(row, colB) ((row) * 128 + ((colB) ^ ((((row) >> 1) & 7) << 4)))
#define SBAR() __builtin_amdgcn_sched_barrier(0)
__device__ __forceinline__ int crow(int r, int hi) { return (r & 3) + 8 * (r >> 2) + 4 * hi; }
__device__ __forceinline__ void glds16(const void* g, unsigned lds_base) {
    unsigned sv; asm volatile("s_mov_b32 %0, m0\n\ts_mov_b32 m0, %2\n\ts_nop 0\n\tglobal_load_lds_dwordx4 %1, off\n\ts_mov_b32 m0, %0" : "=&s"(sv) : "v"(g), "s"(lds_base) : "memory"); }
__device__ __forceinline__ void attn_map(const bf16_t* __restrict__ Qb, const bf16_t* __restrict__ Kh, const bf16_t* __restrict__ VTh, long dKn, long dVn, bool pre, bool has_next, f32x16 (&o)[4], char* lds) {
    const int tid = threadIdx.x, wid = tid >> 6, lane = tid & 63, r32 = lane & 31, hi = lane >> 5;
    const int wv = __builtin_amdgcn_readfirstlane(tid >> 6);
    const bool isB = wv >= 4;
    float l_reg = 0.f;
#pragma unroll
    for (int d = 0; d < 4; ++d) o[d] = f32x16{};
    bf16x8 qr[4];
    const bf16_t* Qw = Qb + (size_t)(wid * QBLK + r32) * DM + hi * 8;
#pragma unroll
    for (int d0 = 0; d0 < 4; ++d0) qr[d0] = *reinterpret_cast<const bf16x8*>(Qw + d0 * 16);
    const bf16_t* ksrc = Kh + (size_t)(8 * wv + (lane >> 3)) * DM + (((lane & 7) ^ ((4 * wv + (lane >> 4)) & 7)) << 3);
    const bf16_t* vsrc0 = VTh + (size_t)(16 * wv + (lane >> 3)) * VT_PITCH + (((lane & 7) ^ ((lane >> 4) & 7)) << 3);
    const bf16_t* vsrc1 = VTh + (size_t)(16 * wv + 8 + (lane >> 3)) * VT_PITCH + (((lane & 7) ^ ((4 + (lane >> 4)) & 7)) << 3);
    const unsigned lds0 = (unsigned)(uintptr_t)lds;
#define DMAX(ko, vo, b) do { const unsigned bb_ = lds0 + (unsigned)(b) * BUFB; \
    glds16(ksrc + (ko), (unsigned)__builtin_amdgcn_readfirstlane(bb_ + SHM_V + 1024 * wv)); \
    glds16(vsrc0 + (vo), (unsigned)__builtin_amdgcn_readfirstlane(bb_ + 2048 * wv)); \
    glds16(vsrc1 + (vo), (unsigned)__builtin_amdgcn_readfirstlane(bb_ + 2048 * wv + 1024)); } while (0)
#define DMA(t, b) DMAX((long)(t) * (KVBLK * DM), (long)(t) * KVBLK, b)
#define DMAT(T) do { if ((T) < NTILE) DMA((T), (T) & 3); else if (has_next && (T) - NTILE < 2) DMAX(dKn + (long)((T) - NTILE) * (KVBLK * DM), dVn + (long)((T) - NTILE) * KVBLK, ((T) - NTILE) & 3); } while (0)
#define BAR() asm volatile("s_barrier" ::: "memory")
#define BARV() asm volatile("s_waitcnt vmcnt(0)\n\ts_barrier" ::: "memory")
    f32x16 pA0, pA1, pB0, pB1;
    u32x4 pw0, pw1, pw2, pw3;
    typedef LAS const char* lcp;
    const lcp lds3 = (lcp)(LAS char*)(uintptr_t)lds0;
    int kaddr[4], vaddr[4];
#pragma unroll
    for (int d0 = 0; d0 < 4; ++d0) { kaddr[d0] = SHM_V + KSWZ(r32, (d0 * 16 + hi * 8) * 2); vaddr[d0] = KSWZ(r32, (2 * d0 + hi) * 16); }
    bf16x8 kf[8], va[4], vb[4];
    constexpr float REF_MARGIN = 32.0f;
    f32x16 negm = f32x16{};
#define PIN(x) asm volatile("" : "+v"(x))
#define MF(a_, b_, c_) __builtin_amdgcn_mfma_f32_32x32x16_bf16(a_, b_, c_, 0, 0, 0)
#define PB(w) __builtin_bit_cast(bf16x8, w)
#define PKW(P, i) cvt_pk_bf16(P[i], P[i + 1])
#define ADD6(x, A, a0, a1, a2, B, b0, b1, b2) do { x += A[a0]; x += A[a1]; x += A[a2]; x += B[b0]; x += B[b1]; x += B[b2]; } while (0)
#define KRD(kbuf) do { const lcp kb_ = lds3 + (kbuf) * BUFB; \
      _Pragma("unroll") for (int d0 = 0; d0 < 4; ++d0) { kf[2 * d0] = *(const LAS bf16x8*)(kb_ + kaddr[d0]); kf[2 * d0 + 1] = *(const LAS bf16x8*)(kb_ + kaddr[d0] + 4096); } } while (0)
#define VRD4(dst, vb_, blk) do { const lcp vq_ = lds3 + (vb_) * BUFB; _Pragma("unroll") for (int ks_ = 0; ks_ < 4; ++ks_) dst[ks_] = *(const LAS bf16x8*)(vq_ + vaddr[ks_] + (blk) * 4096); } while (0)
#define S1(C0, C1, P0, P1, kbuf, vnext) do { SBAR(); \
    KRD(kbuf); \
    float ps_ = P0[0] + P0[1]; ps_ += P0[2]; ps_ += P0[3]; ps_ += P0[4]; ps_ += P0[5]; ps_ += P0[6]; ps_ += P0[7]; PIN(ps_); SBAR(); \
    C0 = MF(kf[0], qr[0], negm); ADD6(ps_, P0, 8, 9, 10, P0, 11, 12, 13); PIN(ps_); SBAR(); \
    C1 = MF(kf[1], qr[0], negm); ps_ += P0[14]; ps_ += P0[15]; ps_ += P1[0]; ps_ += P1[1]; ps_ += P1[2]; ps_ += P1[3]; PIN(ps_); SBAR(); \
    C0 = MF(kf[2], qr[1], C0); ADD6(ps_, P1, 4, 5, 6, P1, 7, 8, 9); PIN(ps_); SBAR(); \
    C1 = MF(kf[3], qr[1], C1); ADD6(ps_, P1, 10, 11, 12, P1, 13, 14, 15); l_reg += ps_; PIN(l_reg); SBAR(); \
    C0 = MF(kf[4], qr[2], C0); pw0 = (u32x4){PKW(P0, 0), PKW(P0, 2), PKW(P0, 4), PKW(P0, 6)}; PIN(pw0); SBAR(); \
    C1 = MF(kf[5], qr[2], C1); pw1 = (u32x4){PKW(P0, 8), PKW(P0, 10), PKW(P0, 12), PKW(P0, 14)}; PIN(pw1); SBAR(); \
    C0 = MF(kf[6], qr[3], C0); pw2 = (u32x4){PKW(P1, 0), PKW(P1, 2), PKW(P1, 4), PKW(P1, 6)}; PIN(pw2); SBAR(); \
    C1 = MF(kf[7], qr[3], C1); pw3 = (u32x4){PKW(P1, 8), PKW(P1, 10), PKW(P1, 12), PKW(P1, 14)}; PIN(pw3); PIN(C0); PIN(C1); SBAR(); \
    VRD4(va, vnext, 0); VRD4(vb, vnext, 1); SBAR();     \
    } while (0)
#define VRD1(dst, ks, blk) dst[ks] = *(const LAS bf16x8*)(vp_ + vaddr[ks] + (blk) * 4096)
#define EXP2N(X, lo) do { X[lo] = __builtin_amdgcn_exp2f(X[lo]); X[lo + 1] = __builtin_amdgcn_exp2f(X[lo + 1]); } while (0)
#define S2(C0, C1, vbuf) do { SBAR(); \
    const lcp vp_ = lds3 + (vbuf) * BUFB; \
    o[0] = MF(va[0], PB(pw0), o[0]); VRD1(va, 0, 2); EXP2N(C0, 0); PIN(C0); SBAR(); \
    o[0] = MF(va[1], PB(pw1), o[0]); VRD1(va, 1, 2); EXP2N(C0, 2); PIN(C0); SBAR(); \
    o[0] = MF(va[2], PB(pw2), o[0]); VRD1(va, 2, 2); EXP2N(C0, 4); PIN(C0); SBAR(); \
    o[0] = MF(va[3], PB(pw3), o[0]); VRD1(va, 3, 2); EXP2N(C0, 6); PIN(C0); SBAR(); \
    o[1] = MF(vb[0], PB(pw0), o[1]); VRD1(vb, 0, 3); EXP2N(C0, 8); PIN(C0); SBAR(); \
    o[1] = MF(vb[1], PB(pw1), o[1]); VRD1(vb, 1, 3); EXP2N(C0, 10); PIN(C0); SBAR(); \
    o[1] = MF(vb[2], PB(pw2), o[1]); VRD1(vb, 2, 3); EXP2N(C0, 12); PIN(C0); SBAR(); \
    o[1] = MF(vb[3], PB(pw3), o[1]); VRD1(vb, 3, 3); EXP2N(C0, 14); PIN(C0); SBAR(); \
    o[2] = MF(va[0], PB(pw0), o[2]); EXP2N(C1, 0); PIN(C1); SBAR(); \
    o[2] = MF(va[1], PB(pw1), o[2]); EXP2N(C1, 2); PIN(C1); SBAR(); \
    o[2] = MF(va[2], PB(pw2), o[2]); EXP2N(C1, 4); PIN(C1); SBAR(); \
    o[2] = MF(va[3], PB(pw3), o[2]); EXP2N(C1, 6); PIN(C1); SBAR(); \
    o[3] = MF(vb[0], PB(pw0), o[3]); EXP2N(C1, 8); PIN(C1); SBAR(); \
    o[3] = MF(vb[1], PB(pw1), o[3]); EXP2N(C1, 10); PIN(C1); SBAR(); \
    o[3] = MF(vb[2], PB(pw2), o[3]); EXP2N(C1, 12); PIN(C1); SBAR(); \
    o[3] = MF(vb[3], PB(pw3), o[3]); EXP2N(C1, 14); PIN(C1); SBAR(); \
    } while (0)
    pB0 = f32x16{}; pB1 = f32x16{};
    if (!pre) { DMA(0, 0); DMA(1, 1); BARV(); }
    if (isB) { BARV(); DMA(2, 2); }
    S1(pA0, pA1, pB0, pB1, 0, 0);
    if (!isB) { BARV(); DMA(2, 2); }
    { float pm_ = pA0[0];
#pragma unroll
      for (int r = 1; r < 16; ++r) pm_ = __builtin_fmaxf(pm_, pA0[r]);
#pragma unroll
      for (int r = 0; r < 16; ++r) pm_ = __builtin_fmaxf(pm_, pA1[r]);
      { auto rr_ = __builtin_amdgcn_permlane32_swap(__float_as_uint(pm_), __float_as_uint(pm_), false, false); pm_ = __builtin_fmaxf(__uint_as_float(rr_[0]), __uint_as_float(rr_[1])); }
      const float nm_ = -(pm_ + REF_MARGIN);
#pragma unroll
      for (int r = 0; r < 16; ++r) { negm[r] = nm_; pA0[r] = __builtin_amdgcn_exp2f(pA0[r] + nm_); pA1[r] = __builtin_amdgcn_exp2f(pA1[r] + nm_); }
      PIN(negm); }
    for (int j = 1; j < NTILE; j += 2) {
        if (isB) { BARV(); DMAT(j + 2); }
        S1(pB0, pB1, pA0, pA1, j & 3, (j - 1) & 3);
        if (!isB) { BARV(); DMAT(j + 2); }
        S2(pB0, pB1, (j - 1) & 3);
        if (isB) { BARV(); DMAT(j + 3); }
        { const int kt = (j + 1 < NTILE) ? j + 1 : NTILE - 1;
          S1(pA0, pA1, pB0, pB1, kt & 3, j & 3); }
        if (!isB) { BARV(); DMAT(j + 3); }
        S2(pA0, pA1, j & 3);
    }
    { auto rr_ = __builtin_amdgcn_permlane32_swap(__float_as_uint(l_reg), __float_as_uint(l_reg), false, false);
      const float rl = __builtin_amdgcn_rcpf(__uint_as_float(rr_[0]) + __uint_as_float(rr_[1]));
#pragma unroll
      for (int d = 0; d < 4; ++d) o[d] = o[d] * rl; }
    if (!has_next) BAR();
#undef DMA
#undef DMAX
#undef DMAT
#undef BAR
#undef BARV
#undef PIN
#undef MF
#undef PB
#undef PKW
#undef ADD6
#undef S1
#undef S2
#undef KRD
#undef VRD4
#undef VRD1
#undef EXP2N
}
__device__ __forceinline__ void attn_unit(const Args& a, int b, int h, int qb, float lam, char* lds, bool first, bool has_nu, int nb, int nh) {
    const bf16_t* Q = (const bf16_t*)(a.ws + WS_Q); const bf16_t* KA = (const bf16_t*)(a.ws + WS_K); const bf16_t* VT = (const bf16_t*)(a.ws + WS_V);
    const size_t qrow0 = (size_t)b * NT + (size_t)qb * 256, kvrow0 = (size_t)b * KVR;
    for (int m = 0; m < 2; ++m) {
        f32x16 o[4];
        const bf16_t* Kc = KA + kvrow0 * DM + (2 * h + m) * 64; const bf16_t* Vc = VT + (size_t)((b * NHD + h) * 128) * VT_PITCH;
        const bf16_t* Kn = m == 0 ? Kc + 64 : KA + (size_t)nb * KVR * DM + (2 * nh) * 64; const bf16_t* Vn = m == 0 ? Vc : VT + (size_t)((nb * NHD + nh) * 128) * VT_PITCH;
        attn_map(Q + qrow0 * DM + (2 * h + m) * 64, Kc, Vc, (long)(Kn - Kc), (long)(Vn - Vc), !(first && m == 0), m == 0 || has_nu, o, lds);
        int t2 = threadIdx.x; asm volatile("" : "+v"(t2));
        const int wid = t2 >> 6, lane = t2 & 63, r32 = lane & 31, hi = lane >> 5;
        float* o1p = (float*)(a.ws + WS_O1) + (size_t)blockIdx.x * (64 * 512) + t2;
        if (m == 0) {
#pragma unroll
            for (int d = 0; d < 4; ++d)
#pragma unroll
                for (int r = 0; r < 16; ++r) o1p[(d * 16 + r) * 512] = o[d][r];
        } else {
            float ss = 0.f;
#pragma unroll
            for (int d = 0; d < 4; ++d)
#pragma unroll
                for (int r = 0; r < 16; ++r) { const float v = o1p[(d * 16 + r) * 512] - lam * o[d][r]; o[d][r] = v; ss += v * v; }
            { auto rr_ = __builtin_amdgcn_permlane32_swap(__float_as_uint(ss), __float_as_uint(ss), false, false); ss = __uint_as_float(rr_[0]) + __uint_as_float(rr_[1]); }
            const float rstd = 0.8f / sqrtf(ss * (1.0f / 128.0f) + EPS);
            const float* gs = a.in[I_GSUB] + 4 * hi;
            bf16_t* aow = (bf16_t*)(a.ws + WS_ATTO) + (qrow0 + wid * QBLK + r32) * DM + h * 128 + 4 * hi;
#pragma unroll
            for (int d = 0; d < 4; ++d)
#pragma unroll
                for (int rg = 0; rg < 4; ++rg) { const f32x4 g = *(const f32x4*)(gs + 32 * d + 8 * rg);
                    u32x2 w; w.x = cvt_pk_bf16(o[d][4 * rg] * rstd * g[0], o[d][4 * rg + 1] * rstd * g[1]); w.y = cvt_pk_bf16(o[d][4 * rg + 2] * rstd * g[2], o[d][4 * rg + 3] * rstd * g[3]);
                    *(u32x2*)(aow + 32 * d + 8 * rg) = w; }
        }
    }
}
#undef KSWZ
#undef SBAR
}

struct SchedDual {
    const char *A0, *A1, *B0, *B1; int G, c;
    __device__ __forceinline__ bool next(int i, Unit& u) const {
        const int L = (i >> 1) * G + c; if (L >= 512) return false;
        pg8::tile_of(L, 128, 4, u.pm, u.pn); u.aux = i & 1; return true; }
    __device__ __forceinline__ const char* a_ptr(const Unit& u) const { return (u.aux ? A1 : A0) + (size_t)u.pm * (256 * DM * 2); }
    __device__ __forceinline__ const char* b_ptr(const Unit& u) const { return (u.aux ? B1 : B0) + (size_t)u.pn * (256 * DM * 2); }
    __device__ __forceinline__ bool keep(const Unit& u) const { return u.aux == 0; }
};
struct EpiDual {
    static constexpr bool PERM = true;
    const bf16_t *GA, *GC; const float* bc; bf16_t* MIX;
    __device__ __forceinline__ void operator()(f32x4 (&acc)[2][2][4][2], const Unit& u, int wr, int wc, int fr, int fq) const {
        const int col0 = u.pn * 256 + wc * 32 + 8 * fq;
        if (u.aux == 0) {
            u32x4 ga[2][2], gc[2][2];
#define EDL(i, g) do { const int ai_ = (g) >> 2, m_ = (g) & 3; const size_t off_ = (size_t)(u.pm * 256 + ai_ * 128 + wr * 64 + m_ * 16 + fr) * DM + col0; \
    ga[i][0] = *(const u32x4*)(GA + off_); ga[i][1] = *(const u32x4*)(GA + off_ + 128); gc[i][0] = *(const u32x4*)(GC + off_); gc[i][1] = *(const u32x4*)(GC + off_ + 128); } while (0)
            EDL(0, 0);
#pragma unroll
            for (int g = 0; g < 8; ++g) { const int ai = g >> 2, m = g & 3, cur = g & 1;
                if (g + 1 < 8) { if (cur) EDL(0, g + 1); else EDL(1, g + 1); }
#pragma unroll
                for (int bj = 0; bj < 2; ++bj) { const u32x4 a4 = ga[cur][bj], c4 = gc[cur][bj];
                    f32x4 r0, r1;
                    r0[0] = bf_lo(a4.x) * __builtin_amdgcn_rcpf(bf_lo(c4.x)); r0[1] = bf_hi(a4.x) * __builtin_amdgcn_rcpf(bf_hi(c4.x));
                    r0[2] = bf_lo(a4.y) * __builtin_amdgcn_rcpf(bf_lo(c4.y)); r0[3] = bf_hi(a4.y) * __builtin_amdgcn_rcpf(bf_hi(c4.y));
                    r1[0] = bf_lo(a4.z) * __builtin_amdgcn_rcpf(bf_lo(c4.z)); r1[1] = bf_hi(a4.z) * __builtin_amdgcn_rcpf(bf_hi(c4.z));
                    r1[2] = bf_lo(a4.w) * __builtin_amdgcn_rcpf(bf_lo(c4.w)); r1[3] = bf_hi(a4.w) * __builtin_amdgcn_rcpf(bf_hi(c4.w));
                    acc[ai][bj][m][0] *= r0; acc[ai][bj][m][1] *= r1; }
                asm volatile("" ::: "memory"); }
#undef EDL
            return;
        }
        f32x4 bv[2][2];
#pragma unroll
        for (int bj = 0; bj < 2; ++bj)
#pragma unroll
            for (int n = 0; n < 2; ++n) bv[bj][n] = *(const f32x4*)(bc + col0 + bj * 128 + 4 * n);
        u32x4 gc[2][2];
#define EDL(i, g) do { const int ai_ = (g) >> 2, m_ = (g) & 3; const size_t off_ = (size_t)(u.pm * 256 + ai_ * 128 + wr * 64 + m_ * 16 + fr) * DM + col0; \
    gc[i][0] = *(const u32x4*)(GC + off_); gc[i][1] = *(const u32x4*)(GC + off_ + 128); } while (0)
        EDL(0, 0);
#pragma unroll
        for (int g = 0; g < 8; ++g) { const int ai = g >> 2, m = g & 3, cur = g & 1;
            if (g + 1 < 8) { if (cur) EDL(0, g + 1); else EDL(1, g + 1); }
            const size_t off = (size_t)(u.pm * 256 + ai * 128 + wr * 64 + m * 16 + fr) * DM + col0;
#pragma unroll
            for (int bj = 0; bj < 2; ++bj) { const u32x4 c4 = gc[cur][bj];
                const f32x4 v0 = acc[ai][bj][m][0] + bv[bj][0], v1 = acc[ai][bj][m][1] + bv[bj][1];
                u32x4 w; w.x = cvt_pk_bf16(v0[0] * bf_lo(c4.x), v0[1] * bf_hi(c4.x)); w.y = cvt_pk_bf16(v0[2] * bf_lo(c4.y), v0[3] * bf_hi(c4.y));
                w.z = cvt_pk_bf16(v1[0] * bf_lo(c4.z), v1[1] * bf_hi(c4.z)); w.w = cvt_pk_bf16(v1[2] * bf_lo(c4.w), v1[3] * bf_hi(c4.w));
                *(u32x4*)(MIX + off + bj * 128) = w; }
            asm volatile("" ::: "memory"); }
#undef EDL
    }
};

struct SchedPlain {
    const char* A; const char* Bt; int G, c, nM, nN, RB, bgrp;
    __device__ __forceinline__ bool next(int i, Unit& u) const {
        const int L = i * G + c; if (L >= nM * nN) return false;
        pg8::tile_of(L, nM, nN, u.pm, u.pn); u.aux = 0; return true; }
    __device__ __forceinline__ const char* a_ptr(const Unit& u) const { return A + (size_t)u.pm * ((size_t)256 * RB); }
    __device__ __forceinline__ const char* b_ptr(const Unit& u) const { return Bt + (size_t)((u.pm >> 4) * nN * bgrp + u.pn) * ((size_t)256 * RB); }
    __device__ __forceinline__ bool keep(const Unit&) const { return false; }
};
struct EpiResid {
    static constexpr bool PERM = false;
    const float* x; const float* mod; float* out;
    __device__ __forceinline__ void operator()(f32x4 (&acc)[2][2][4][2], const Unit& u, int wr, int wc, int fr, int fq) const {
        const int col0 = u.pn * 256 + wc * 32 + 4 * fq; const float* gm = mod + (size_t)(u.pm >> 4) * NMOD + 2048 + col0;
        f32x4 gv[2][2];
#pragma unroll
        for (int bj = 0; bj < 2; ++bj)
#pragma unroll
            for (int n = 0; n < 2; ++n) gv[bj][n] = *(const f32x4*)(gm + bj * 128 + n * 16);
        f32x4 xv[2][2][2];
#define ERL(i, g) do { const int ai_ = (g) >> 2, m_ = (g) & 3; const size_t off_ = (size_t)(u.pm * 256 + ai_ * 128 + wr * 64 + m_ * 16 + fr) * DM + col0; \
    _Pragma("unroll") for (int bj_ = 0; bj_ < 2; ++bj_) _Pragma("unroll") for (int n_ = 0; n_ < 2; ++n_) xv[i][bj_][n_] = __builtin_nontemporal_load((const f32x4*)(x + off_ + bj_ * 128 + n_ * 16)); } while (0)
        ERL(0, 0);
#pragma unroll
        for (int g = 0; g < 8; ++g) { const int ai = g >> 2, m = g & 3, cur = g & 1;
            if (g + 1 < 8) { if (cur) ERL(0, g + 1); else ERL(1, g + 1); }
            const size_t off = (size_t)(u.pm * 256 + ai * 128 + wr * 64 + m * 16 + fr) * DM + col0;
#pragma unroll
            for (int bj = 0; bj < 2; ++bj)
#pragma unroll
                for (int n = 0; n < 2; ++n) *(f32x4*)(out + off + bj * 128 + n * 16) = xv[cur][bj][n] + gv[bj][n] * acc[ai][bj][m][n];
            asm volatile("" ::: "memory"); }
#undef ERL
    }
};

__device__ __forceinline__ void ph_router(const Args& a, LAS unsigned char* lds, int gw, int NGW, int lane) {
    LAS float* wrt = (LAS float*)lds;
    const float* wr = a.in[I_WR];
    for (int i = threadIdx.x; i < DM * NEXP; i += 512) { const int k = i >> 4, e = i & 15; wrt[e * DM + k] = wr[i]; }
    __syncthreads();
    const float* mod = (const float*)(a.ws + WS_MOD); const float* g = a.in[I_GFFN];
    unsigned char* HF = (unsigned char*)(a.ws + WS_HF); float* AFF = (float*)(a.ws + WS_AFF);
    f32x4 gs[4], shv[4]; int cur_b = -1;
    f32x4 nx[4];
    { const f32x4* xr = (const f32x4*)(a.out + (size_t)gw * DM) + lane;
#pragma unroll
      for (int j = 0; j < 4; ++j) nx[j] = __builtin_nontemporal_load(xr + 64 * j); }
    for (int row = gw; row < MLAT; row += NGW) {
        f32x4 v[4]; float s = 0.f;
#pragma unroll
        for (int j = 0; j < 4; ++j) { v[j] = nx[j]; s += (v[j].x * v[j].x + v[j].y * v[j].y) + (v[j].z * v[j].z + v[j].w * v[j].w); }
        if (row + NGW < MLAT) { const f32x4* xr = (const f32x4*)(a.out + (size_t)(row + NGW) * DM) + lane;
#pragma unroll
            for (int j = 0; j < 4; ++j) nx[j] = __builtin_nontemporal_load(xr + 64 * j); }
        if ((row >> 12) != cur_b) { cur_b = row >> 12; const float* mb = mod + (size_t)cur_b * NMOD + 3072;
#pragma unroll
            for (int j = 0; j < 4; ++j) { const int c = 4 * lane + 256 * j; gs[j] = *(const f32x4*)(g + c) * (*(const f32x4*)(mb + 1024 + c) + 1.0f); shv[j] = *(const f32x4*)(mb + c); } }
        const float rstd = 1.0f / sqrtf(wave_sum(s) * (1.0f / DM) + EPS);
        unsigned* o4 = (unsigned*)(HF + (size_t)row * DM) + lane;
#pragma unroll
        for (int j = 0; j < 4; ++j) { v[j] = (v[j] * rstd) * gs[j] + shv[j];
            o4[64 * j] = pack4_fp8(v[j].x, v[j].y, v[j].z, v[j].w); }
        float p[16];
#pragma unroll
        for (int e = 0; e < 16; ++e) { float t = 0.f;
#pragma unroll
            for (int j = 0; j < 4; ++j) { const f32x4 wv = *(const LAS f32x4*)(wrt + e * DM + 4 * lane + 256 * j); t += (v[j].x * wv.x + v[j].y * wv.y) + (v[j].z * wv.z + v[j].w * wv.w); }
            p[e] = t; if ((e & 3) == 3) __builtin_amdgcn_sched_barrier(0); }
        float r8[8], r4[4], r2[2], r1;
        { const bool up = (lane & 32) != 0;
#pragma unroll
          for (int i = 0; i < 8; ++i) { const float send = up ? p[i] : p[i + 8], keepv = up ? p[i + 8] : p[i]; r8[i] = keepv + __shfl_xor(send, 32); } }
        { const bool up = (lane & 16) != 0;
#pragma unroll
          for (int i = 0; i < 4; ++i) { const float send = up ? r8[i] : r8[i + 4], keepv = up ? r8[i + 4] : r8[i]; r4[i] = keepv + __shfl_xor(send, 16); } }
        { const bool up = (lane & 8) != 0;
#pragma unroll
          for (int i = 0; i < 2; ++i) { const float send = up ? r4[i] : r4[i + 2], keepv = up ? r4[i + 2] : r4[i]; r2[i] = keepv + __shfl_xor(send, 8); } }
        { const bool up = (lane & 4) != 0; const float send = up ? r2[0] : r2[1], keepv = up ? r2[1] : r2[0]; r1 = keepv + __shfl_xor(send, 4); }
        r1 += __shfl_xor(r1, 2); r1 += __shfl_xor(r1, 1);
        float mx = r1;
#pragma unroll
        for (int o = 4; o < 64; o <<= 1) mx = fmaxf(mx, __shfl_xor(mx, o));
        const float ex = expf(r1 - mx); float sm = ex;
#pragma unroll
        for (int o = 4; o < 64; o <<= 1) sm += __shfl_xor(sm, o);
        if ((lane & 3) == 0) AFF[(size_t)row * NEXP + (lane >> 2)] = ex / sm;
    }
}

__device__ __forceinline__ void ph_topk_unit(const Args& a, LAS unsigned char* lds, int g  ) {
    const int tid = threadIdx.x, lane = tid & 63, wave = __builtin_amdgcn_readfirstlane(tid >> 6);
    const int b = g >> 4, e = g & 15;
    LAS unsigned long long* S = (LAS unsigned long long*)lds;
    const float* AFF = (const float*)(a.ws + WS_AFF) + (size_t)b * NT * NEXP + e;
    for (int t = tid; t < NT; t += 512) S[t] = ((unsigned long long)__float_as_uint(AFF[(size_t)t * NEXP]) << 32) | (unsigned long long)(0xFFFFFFFFu - (unsigned)t);
    __syncthreads();
    for (int k = 2; k <= NT; k <<= 1)
        for (int j = k >> 1; j > 0; j >>= 1) {
#pragma unroll
            for (int q = 0; q < 4; ++q) { const int t = tid + 512 * q; const int i = 2 * t - (t & (j - 1)), l = i + j;
                const unsigned long long x = S[i], y = S[l]; const bool desc = (i & k) == 0;
                if ((x < y) == desc) { S[i] = y; S[l] = x; } }
            __syncthreads();
        }
    int* SEL = (int*)(a.ws + WS_SEL) + (size_t)b * NT * NEXP + e;
    for (int s = tid; s < NT; s += 512) { const unsigned tok = 0xFFFFFFFFu - (unsigned)S[s]; SEL[(size_t)tok * NEXP] = (s < CAP) ? s : -1; }
    const unsigned char* HF = (const unsigned char*)(a.ws + WS_HF) + (size_t)b * NT * DM;
    unsigned char* XS = (unsigned char*)(a.ws + WS_XS) + (size_t)(e * NB + b) * CAP * DM;
    for (int k = 0; k < 64; k += 8) {
        u32x4 v[8];
#pragma unroll
        for (int q = 0; q < 8; ++q) { const int s = wave * 64 + k + q; const unsigned tok = 0xFFFFFFFFu - (unsigned)S[s];
            v[q] = ((const u32x4*)(HF + (size_t)tok * DM))[lane]; }
#pragma unroll
        for (int q = 0; q < 8; ++q) { const int s = wave * 64 + k + q; ((u32x4*)(XS + (size_t)s * DM))[lane] = v[q]; }
    }
    __syncthreads();
}

struct EpiSwiGLU {
    static constexpr bool PERM = true;
    unsigned char* HID;
    __device__ __forceinline__ void operator()(f32x4 (&acc)[2][2][4][2], const Unit& u, int wr, int wc, int fr, int fq) const {
        const int col0 = u.pn * 128 + wc * 32 + 8 * fq;
#pragma unroll
        for (int ai = 0; ai < 2; ++ai)
#pragma unroll
            for (int m = 0; m < 4; ++m) { const size_t r = (size_t)u.pm * 256 + ai * 128 + wr * 64 + m * 16 + fr;
                const f32x4 g0 = acc[ai][0][m][0] * WSCALE_INV, g1 = acc[ai][0][m][1] * WSCALE_INV, u0 = acc[ai][1][m][0] * WSCALE_INV, u1 = acc[ai][1][m][1] * WSCALE_INV;
                u32x2 w; w.x = pack4_fp8(g0[0] * sigmoidf_(g0[0]) * u0[0], g0[1] * sigmoidf_(g0[1]) * u0[1], g0[2] * sigmoidf_(g0[2]) * u0[2], g0[3] * sigmoidf_(g0[3]) * u0[3]);
                w.y = pack4_fp8(g1[0] * sigmoidf_(g1[0]) * u1[0], g1[1] * sigmoidf_(g1[1]) * u1[1], g1[2] * sigmoidf_(g1[2]) * u1[2], g1[3] * sigmoidf_(g1[3]) * u1[3]);
                *(u32x2*)(HID + r * DFF + col0) = w; }
    }
};
struct EpiPlainBf16 {
    static constexpr bool PERM = true;
    bf16_t* O; int ldc; float scale;
    __device__ __forceinline__ void operator()(f32x4 (&acc)[2][2][4][2], const Unit& u, int wr, int wc, int fr, int fq) const {
        const int col0 = u.pn * 256 + wc * 32 + 8 * fq;
#pragma unroll
        for (int ai = 0; ai < 2; ++ai)
#pragma unroll
            for (int m = 0; m < 4; ++m) { bf16_t* rowp = O + ((size_t)u.pm * 256 + ai * 128 + wr * 64 + m * 16 + fr) * ldc + col0;
#pragma unroll
                for (int bj = 0; bj < 2; ++bj) { const f32x4 v0 = acc[ai][bj][m][0] * scale, v1 = acc[ai][bj][m][1] * scale;
                    u32x4 w; w.x = cvt_pk_bf16(v0[0], v0[1]); w.y = cvt_pk_bf16(v0[2], v0[3]); w.z = cvt_pk_bf16(v1[0], v1[1]); w.w = cvt_pk_bf16(v1[2], v1[3]);
                    *(u32x4*)(rowp + bj * 128) = w; } }
    }
};

__device__ __forceinline__ void ph_final(const Args& a, int gw, int NGW, int lane) {
    const float* mod = (const float*)(a.ws + WS_MOD); const float* gfin = a.in[I_GFIN];
    const float* AFF = (const float*)(a.ws + WS_AFF); const int* SEL = (const int*)(a.ws + WS_SEL); const bf16_t* YS = (const bf16_t*)(a.ws + WS_YS);
    const int per = MLAT / NGW, r0 = gw * per, b = r0 >> 12;
    f32x4 gfv[2][2], gnv[2][2];
    { const float* gf = mod + (size_t)b * NMOD + 5120;
#pragma unroll
      for (int jj = 0; jj < 2; ++jj)
#pragma unroll
          for (int q = 0; q < 2; ++q) { const int c = 8 * lane + 512 * jj + 4 * q; gfv[jj][q] = *(const f32x4*)(gf + c); gnv[jj][q] = *(const f32x4*)(gfin + c); } }
    for (int row = r0; row < r0 + per; ++row) {
        float* xr = a.out + (size_t)row * DM;
        const int selv = (lane < 16) ? SEL[(size_t)row * NEXP + lane] : -1; const float affv = (lane < 16) ? AFF[(size_t)row * NEXP + lane] : 0.f;
        f32x4 acc[2][2];
#pragma unroll
        for (int jj = 0; jj < 2; ++jj) { acc[jj][0] = (f32x4){0.f, 0.f, 0.f, 0.f}; acc[jj][1] = (f32x4){0.f, 0.f, 0.f, 0.f}; }
#pragma unroll
        for (int e = 0; e < NEXP; ++e) { const int s = __builtin_amdgcn_readlane(selv, e); const float gt = __uint_as_float(__builtin_amdgcn_readlane(__float_as_uint(affv), e));
            if (s >= 0) { const bf16_t* yr = YS + ((size_t)(e * NB + b) * CAP + s) * DM;
#pragma unroll
                for (int jj = 0; jj < 2; ++jj) { const u32x4 y = *(const u32x4*)(yr + 8 * lane + 512 * jj);
                    acc[jj][0] += gt * (f32x4){bf_lo(y.x), bf_hi(y.x), bf_lo(y.y), bf_hi(y.y)}; acc[jj][1] += gt * (f32x4){bf_lo(y.z), bf_hi(y.z), bf_lo(y.w), bf_hi(y.w)}; } } }
        f32x4 v[2][2]; float ss = 0.f;
#pragma unroll
        for (int jj = 0; jj < 2; ++jj)
#pragma unroll
            for (int q = 0; q < 2; ++q) { const int c = 8 * lane + 512 * jj + 4 * q;
                v[jj][q] = __builtin_nontemporal_load((const f32x4*)(xr + c)) + gfv[jj][q] * acc[jj][q];
                ss += (v[jj][q].x * v[jj][q].x + v[jj][q].y * v[jj][q].y) + (v[jj][q].z * v[jj][q].z + v[jj][q].w * v[jj][q].w); }
        const float rstd = 1.0f / sqrtf(wave_sum(ss) * (1.0f / DM) + EPS);
#pragma unroll
        for (int jj = 0; jj < 2; ++jj)
#pragma unroll
            for (int q = 0; q < 2; ++q) { const int c = 8 * lane + 512 * jj + 4 * q; __builtin_nontemporal_store(v[jj][q] * rstd * gnv[jj][q], (f32x4*)(xr + c)); }
    }
}

constexpr int N_PHASES = 12;
#ifndef MK_ATTN_REPS
#define MK_ATTN_REPS 1
#endif
struct Ctx { LAS unsigned char* lds; char* lds_gen; int G, bid, vcu, gw, NGW, wave, lane; };
template <int P> __device__ __forceinline__ void run_phase(const Args& args, const Ctx& c) {
    LAS unsigned char* lds = c.lds; const int G = c.G, bid = c.bid, vcu = c.vcu, gw = c.gw, NGW = c.NGW, wave = c.wave, lane = c.lane;
    if constexpr (P == 0) {
        ph_adaln(args, lds, bid, G);
        if (bid == G - 1) ph_rope_table(args);
        ph_small_weights(args, lds, gw, NGW, wave, lane);
    }
    if constexpr (P == 1) ph_norm_rows(args, gw, NGW, lane);
    if constexpr (P == 2) {
        SchedInProj S{(const char*)(args.ws + WS_H), (const char*)(args.ws + WS_WIN), G, bid};
        EpiInProj E{(bf16_t*)(args.ws + WS_U), (bf16_t*)(args.ws + WS_Q), (bf16_t*)(args.ws + WS_K), (bf16_t*)(args.ws + WS_V), (bf16_t*)(args.ws + WS_GC), (bf16_t*)(args.ws + WS_GA), (const float*)(args.ws + WS_ROPE)};
        pg8::gemm_phase<EpiInProj, SchedInProj, PG8_ALIGN, PG8_SP2>(lds, DM * 2, S, E);
    }
    if constexpr (P == 3) {
#ifndef MK_NO_CONV
        for (int u = vcu; u < 256; u += G) ph_conv_unit(args, lds, u);
        __syncthreads();
#endif
#ifndef MK_NO_ATTN
        float lam;
        { const float s1 = wave_sum(args.in[I_LQ1][lane] * args.in[I_LK1][lane]), s2 = wave_sum(args.in[I_LQ2][lane] * args.in[I_LK2][lane]); lam = __uint_as_float(__builtin_amdgcn_readfirstlane(__float_as_uint(expf(s1) - expf(s2) + 0.2f))); }
#if defined(MK_PROBE_CLOCK)
        const unsigned long long pc0_ = __builtin_amdgcn_s_memtime(), pr0_ = __builtin_amdgcn_s_memrealtime();
#endif
        for (int i = 0; i < 4 * MK_ATTN_REPS; ++i) { const int u = (i & 3) * 256 + vcu; if (u >= 1024) break;
            const int un = ((i + 1) & 3) * 256 + vcu; const bool has_nu = (i + 1 < 4 * MK_ATTN_REPS) && un < 1024;
            att::attn_unit(args, u >> 7, (u >> 4) & 7, u & 15, lam, c.lds_gen, i == 0, has_nu, un >> 7, (un >> 4) & 7); }
#if defined(MK_PROBE_CLOCK)
        { const unsigned long long pc1_ = __builtin_amdgcn_s_memtime(), pr1_ = __builtin_amdgcn_s_memrealtime();
          if (threadIdx.x == 0) { volatile LAS unsigned* mw = (volatile LAS unsigned*)(c.lds + LDSCTL_OFF); mw[16] = (unsigned)(pc1_ - pc0_); mw[17] = (unsigned)(pr1_ - pr0_);
              unsigned* pw_ = (unsigned*)(args.ws + WS_CTL) + 15000;
              atomicMax(pw_, (unsigned)(pr1_ - pr0_)); atomicAdd(pw_ + 1, (unsigned)(pr1_ - pr0_)); atomicMax(pw_ + 2, 0xFFFFFFFFu - (unsigned)(pr1_ - pr0_)); } }
#endif
#endif
    }
    if constexpr (P == 4) {
        SchedDual S{(const char*)(args.ws + WS_ATTO), (const char*)(args.ws + WS_CACT), (const char*)(args.ws + WS_WAO), (const char*)(args.ws + WS_WCO), G, bid};
        EpiDual E{(const bf16_t*)(args.ws + WS_GA), (const bf16_t*)(args.ws + WS_GC), args.in[I_BCO], (bf16_t*)(args.ws + WS_MIX)};
        pg8::gemm_phase<EpiDual, SchedDual, PG8_ALIGN, PG8_SP2>(lds, DM * 2, S, E);
    }
    if constexpr (P == 5) {
        SchedPlain S{(const char*)(args.ws + WS_MIX), (const char*)(args.ws + WS_WO), G, bid, 128, 4, DM * 2, 0};
        EpiResid E{args.in[I_X], (const float*)(args.ws + WS_MOD), args.out};
        pg8::gemm_phase<EpiResid, SchedPlain, PG8_ALIGN, PG8_SP2>(lds, DM * 2, S, E);
    }
    if constexpr (P == 6) {
        ph_router(args, lds, gw, NGW, lane);
        __syncthreads();
        ph_wgu(args, lds, gw, NGW, wave, lane);
        ph_wd(args, lds, gw, NGW, wave, lane);
    }
    if constexpr (P == 7) { for (int g = vcu; g < NB * NEXP; g += G) ph_topk_unit(args, lds, g); }
    if constexpr (P == 8) {
        SchedPlain S{(const char*)(args.ws + WS_XS), (const char*)(args.ws + WS_WGU), G, bid, 256, 22, DM, 1};
        EpiSwiGLU E{(unsigned char*)(args.ws + WS_HID)};
        pg8::gemm_phase<EpiSwiGLU, SchedPlain, PG8_ALIGN, PG8_SP2, true>(lds, DM, S, E);
    }
    if constexpr (P == 10) {
        SchedPlain S{(const char*)(args.ws + WS_HID), (const char*)(args.ws + WS_WD), G, bid, 256, 4, DFF, 1};
        EpiPlainBf16 E{(bf16_t*)(args.ws + WS_YS), DM, WSCALE_INV};
        pg8::gemm_phase<EpiPlainBf16, SchedPlain, PG8_ALIGN, PG8_SP2, true>(lds, DFF, S, E);
    }
    if constexpr (P == 11) ph_final(args, gw, NGW, lane);
}
#ifndef MK_PHASE_MASK
#define MK_PHASE_MASK 0xFFF
#endif
#ifndef MK_REPEAT_MASK
#define MK_REPEAT_MASK 0
#endif
__global__ void __launch_bounds__(512, 2) mk_fwd(Args args) {
    extern __shared__ __attribute__((aligned(16))) unsigned char lds_raw[];
    LAS unsigned char* lds = (LAS unsigned char*)lds_raw;
    const int tid = threadIdx.x;
    Ctx c; c.lds = lds; c.lds_gen = (char*)lds_raw; c.lane = tid & 63; c.wave = __builtin_amdgcn_readfirstlane(tid >> 6);
    c.G = gridDim.x; c.bid = blockIdx.x;
    c.vcu = (c.G % 8 == 0) ? (c.bid % 8) * (c.G / 8) + c.bid / 8 : c.bid;
    c.gw = c.vcu * 8 + c.wave; c.NGW = c.G * 8;
    volatile LAS unsigned* misc = (volatile LAS unsigned*)(lds + LDSCTL_OFF);
    if (tid < 64) misc[tid] = 0u;
    __syncthreads();
#if defined(MK_PROBE_TS)
    const unsigned long long kstart_ = __builtin_amdgcn_s_memrealtime();
#endif
    const int lo = args.ph_lo, hi = args.ph_hi;
    XcdBarrier bar; bar.bar = (unsigned*)(args.ws + WS_CTL) + 1024 + args.li * XCD_BAR_WORDS; bar.x = 0; bar.st = nullptr;
    if (hi - lo > 1) bar = xcd_barrier_post((unsigned*)(args.ws + WS_CTL) + 1024 + args.li * XCD_BAR_WORDS, misc + 8);
#define IN(k) (((MK_PHASE_MASK >> (k)) & 1) && lo <= (k) && (k) < hi)
#if defined(MK_PROBE_PHASE)
#define PH_T0() const unsigned long long pt0_ = __builtin_amdgcn_s_memrealtime()
#define PH_T1(k) do { const unsigned long long pt1_ = __builtin_amdgcn_s_memrealtime(); if (threadIdx.x == 0) atomicMax((unsigned*)(args.ws + WS_CTL) + 15100 + (k), (unsigned)(pt1_ - pt0_)); } while (0)
#else
#define PH_T0() do { } while (0)
#define PH_T1(k) do { } while (0)
#endif
#if defined(MK_PROBE_BAR)
#define PB_T0() const unsigned long long bt0_ = __builtin_amdgcn_s_memrealtime()
#define PB_T1(k) do { const unsigned long long bt1_ = __builtin_amdgcn_s_memrealtime(); if (threadIdx.x == 0) atomicMax((unsigned*)(args.ws + WS_CTL) + 15200 + (k), 0xFFFFFFFFu - (unsigned)(bt1_ - bt0_)); } while (0)
#else
#define PB_T0() do { } while (0)
#define PB_T1(k) do { } while (0)
#endif
#if defined(MK_PROBE_TS)
#define PH_TS(k) do { if ((k) == MK_PROBE_TS && blockIdx.x == 0 && threadIdx.x == 0) misc[20] = (unsigned)(__builtin_amdgcn_s_memrealtime() - kstart_); } while (0)
#else
#define PH_TS(k) do { } while (0)
#endif
#define PHASE(k) do { PH_TS(k); if (IN(k)) { PH_T0(); run_phase<k>(args, c); if constexpr ((MK_REPEAT_MASK >> (k)) & 1) { __syncthreads(); run_phase<k>(args, c); } PH_T1(k); PH_TS((k) + 100); } \
                      if ((k) != 9 && (k) + 1 < N_PHASES && IN(k) && IN((k) + 1)) { PB_T0(); xcd_barrier(bar); PB_T1(k); } } while (0)
    PHASE(0); PHASE(1); PHASE(2); PHASE(3); PHASE(4); PHASE(5); PHASE(6); PHASE(7); PHASE(8); PHASE(9); PHASE(10); PHASE(11);
#if defined(MK_PROBE_TS)
    PH_TS(12);
    if (blockIdx.x == 0 && threadIdx.x == 0) {
        const unsigned long long wait_ticks = misc[20];
        const unsigned long long w0 = __builtin_amdgcn_s_memrealtime();
        while (__builtin_amdgcn_s_memrealtime() - w0 < wait_ticks) __builtin_amdgcn_s_sleep(8);
    }
#endif
#if defined(MK_PROBE_BAR)
    if (blockIdx.x == 0 && threadIdx.x == 0) {
        unsigned long long wait_ticks = 0;
        for (int k = 0; k < 10; ++k) { const unsigned v = __hip_atomic_load((unsigned*)(args.ws + WS_CTL) + 15200 + k, __ATOMIC_RELAXED, __HIP_MEMORY_SCOPE_AGENT); if (v) wait_ticks += 0xFFFFFFFFu - v; }
        wait_ticks *= 10;
        const unsigned long long w0 = __builtin_amdgcn_s_memrealtime();
        while (__builtin_amdgcn_s_memrealtime() - w0 < wait_ticks) __builtin_amdgcn_s_sleep(8);
    }
#endif
#if defined(MK_PROBE_PHASE)
    if (blockIdx.x == 0 && threadIdx.x == 0) {
        const unsigned long long wait_ticks = __hip_atomic_load((unsigned*)(args.ws + WS_CTL) + 15100 + MK_PROBE_PHASE, __ATOMIC_RELAXED, __HIP_MEMORY_SCOPE_AGENT);
        const unsigned long long w0 = __builtin_amdgcn_s_memrealtime();
        while (__builtin_amdgcn_s_memrealtime() - w0 < wait_ticks) __builtin_amdgcn_s_sleep(8);
    }
#endif
#if defined(MK_PROBE_CLOCK)
    if (blockIdx.x == 0 && threadIdx.x == 0) {
        const unsigned dc = misc[16], dr = misc[17];
        unsigned* pw_ = (unsigned*)(args.ws + WS_CTL) + 15000;
        const unsigned long long wait_ticks = (MK_PROBE_CLOCK == 1) ? (unsigned long long)(((double)dc / (double)dr) * 0.1 * 500.0 * 100.0) : (MK_PROBE_CLOCK == 2) ? (unsigned long long)dr
            : (MK_PROBE_CLOCK == 3) ? (unsigned long long)__hip_atomic_load(pw_, __ATOMIC_RELAXED, __HIP_MEMORY_SCOPE_AGENT)
            : (MK_PROBE_CLOCK == 4) ? (unsigned long long)(__hip_atomic_load(pw_ + 1, __ATOMIC_RELAXED, __HIP_MEMORY_SCOPE_AGENT) / gridDim.x)
            : (unsigned long long)(0xFFFFFFFFu - __hip_atomic_load(pw_ + 2, __ATOMIC_RELAXED, __HIP_MEMORY_SCOPE_AGENT));
        const unsigned long long w0 = __builtin_amdgcn_s_memrealtime();
        while (__builtin_amdgcn_s_memrealtime() - w0 < wait_ticks) __builtin_amdgcn_s_sleep(8);
    }
#endif
#undef IN
#undef PHASE
}

extern "C" void kernel_launch(void* const* d_in, const int* in_sizes, int n_in, void* d_out, int out_size, void* d_ws, size_t ws_size, hipStream_t stream) {
    static int grid = 0;
    if (grid == 0) {
        if (n_in != N_IN || out_size != MLAT * DM || ws_size < WS_END) { fprintf(stderr, "kernel_launch: unexpected shapes: n_in %d out %d ws %zu (need %zu)\n", n_in, out_size, ws_size, (size_t)WS_END); grid = -1; return; }
        int dev = 0, cus = 0, per_cu = 0;
        if (hipGetDevice(&dev) != hipSuccess || hipDeviceGetAttribute(&cus, hipDeviceAttributeMultiprocessorCount, dev) != hipSuccess) { grid = -1; return; }
        if (hipFuncSetAttribute((const void*)mk_fwd, hipFuncAttributeMaxDynamicSharedMemorySize, LDS_BYTES) != hipSuccess) { fprintf(stderr, "kernel_launch: hipFuncSetAttribute failed\n"); grid = -1; return; }
        if (hipOccupancyMaxActiveBlocksPerMultiprocessor(&per_cu, (const void*)mk_fwd, 512, LDS_BYTES) != hipSuccess || per_cu < 1) fprintf(stderr, "kernel_launch: occupancy query reports %d\n", per_cu);
        (void)hipGetLastError();
        grid = cus;
    }
    if (grid < 0) return;
    if (hipMemsetAsync((char*)d_ws + WS_CTL, 0, CTL_ZERO_BYTES, stream) != hipSuccess) return;
    Args a{};
    for (int i = 0; i < N_IN; ++i) a.in[i] = (const float*)d_in[i];
    a.out = (float*)d_out; a.ws = (unsigned char*)d_ws;
    constexpr int NL = MK_N_LAUNCHES;
    for (int li = 0; li < NL; ++li) {
        a.ph_lo = (NL == N_PHASES) ? li : (li * N_PHASES) / NL; a.ph_hi = (NL == N_PHASES) ? li + 1 : ((li + 1) * N_PHASES) / NL; a.li = (NL == N_PHASES) ? 0 : li; a.pad = 0;
        hipLaunchKernelGGL(mk_fwd, dim3(grid), dim3(512), LDS_BYTES, stream, a);
    }
}
```

```cpp
#include <hip/hip_runtime.h>
#include <cstdio>
#include <cstdint>

#ifndef MK_N_LAUNCHES
#define MK_N_LAUNCHES 1
#endif

#define LAS __attribute__((address_space(3)))
typedef unsigned short bf16_t;
typedef short bf16x8 __attribute__((ext_vector_type(8)));
typedef short s16x4 __attribute__((ext_vector_type(4)));
typedef float f32x2 __attribute__((ext_vector_type(2)));
typedef float f32x4 __attribute__((ext_vector_type(4)));
typedef float f32x16 __attribute__((ext_vector_type(16)));
typedef unsigned u32x2 __attribute__((ext_vector_type(2)));
typedef unsigned u32x4 __attribute__((ext_vector_type(4)));
typedef int i32x4 __attribute__((ext_vector_type(4)));
typedef int i32x8 __attribute__((ext_vector_type(8)));

constexpr int NB = 8, NT = 4096, DM = 1024, NCX = 256, NHD = 8, NEXP = 16, CAP = 512, DFF = 2816;
constexpr int MLAT = NB * NT, MCTX = NB * NCX, MALL = MLAT + MCTX, KVR = NT + NCX;
constexpr int NPROJ = 7168, NMOD = 6 * DM;
constexpr float EPS = 1e-6f;
constexpr float QSCALE = 0.125f * 1.4426950408889634f;

constexpr size_t MiB = 1u << 20;
constexpr size_t WS_CTL = 0, CTL_ZERO_BYTES = 65536;
constexpr size_t WS_MOD = 65536;
constexpr size_t WS_ROPE = 294912;
constexpr size_t WS_AFF = 1 * MiB;
constexpr size_t WS_SEL = 3 * MiB;
constexpr size_t WS_WIN = 8 * MiB, WS_WCO = 22 * MiB, WS_WAO = 24 * MiB, WS_WO = 26 * MiB;
constexpr size_t WS_H = 28 * MiB;
constexpr size_t WS_ATTO = 28 * MiB;
constexpr size_t WS_U = 96 * MiB;
constexpr size_t WS_MIX = 96 * MiB;
constexpr size_t WS_Q = 160 * MiB;
constexpr size_t WS_K = 224 * MiB;
constexpr size_t WS_V = 292 * MiB;
constexpr size_t WS_GC = 360 * MiB, WS_GA = 424 * MiB;
constexpr size_t WS_CACT = 488 * MiB;
constexpr size_t WS_O1 = 552 * MiB;
constexpr size_t WS_WGU = 8 * MiB;
constexpr size_t WS_XS = 96 * MiB;
constexpr size_t WS_HF = 160 * MiB;
constexpr size_t WS_HID = 192 * MiB;
constexpr size_t WS_WD = 368 * MiB;
constexpr size_t WS_YS = 416 * MiB;
constexpr float WSCALE = 64.0f, WSCALE_INV = 1.0f / 64.0f;
constexpr size_t WS_END = 680 * MiB;

constexpr int RING_BYTES = 131072, LDSCTL_OFF = RING_BYTES, LDS_BYTES = 147456;

#define LDS_WAIT() asm volatile("s_waitcnt lgkmcnt(0)" ::: "memory")
#define VM_WAIT() asm volatile("s_waitcnt vmcnt(0)" ::: "memory")
__device__ __forceinline__ unsigned cvt_pk_bf16(float lo, float hi) { unsigned r; asm volatile("v_cvt_pk_bf16_f32 %0, %1, %2" : "=v"(r) : "v"(lo), "v"(hi)); return r; }
__device__ __forceinline__ unsigned pack4_fp8(float a, float b, float c, float d) { int w = 0; w = __builtin_amdgcn_cvt_pk_fp8_f32(a, b, w, false); w = __builtin_amdgcn_cvt_pk_fp8_f32(c, d, w, true); return (unsigned)w; }
__device__ __forceinline__ float bf_lo(unsigned u) { return __uint_as_float(u << 16); }
__device__ __forceinline__ float bf_hi(unsigned u) { return __uint_as_float(u & 0xffff0000u); }
__device__ __forceinline__ float wave_sum(float v) {
#pragma unroll
    for (int o = 1; o < 64; o <<= 1) v += __shfl_xor(v, o);
    return v;
}
__device__ __forceinline__ float sigmoidf_(float x) { return __builtin_amdgcn_rcpf(1.0f + __expf(-x)); }

#define XB_TMO      128
#define XB_XCNT(j)  (256  + 64 * (j))
#define XB_XSUB(j)  (1280 + 64 * (j))
#define XB_XGEN(j)  (2304 + 64 * (j))
#define XB_TOP      3328
#define XB_TOPGEN   3392
#define XCD_BAR_WORDS 3456
#define XB_SPIN_CAP (1u << 18)
__device__ __forceinline__ unsigned xb_ld(unsigned* p)              { return __hip_atomic_load(p, __ATOMIC_RELAXED, __HIP_MEMORY_SCOPE_AGENT); }
__device__ __forceinline__ unsigned xb_add(unsigned* p, unsigned v) { return __hip_atomic_fetch_add(p, v, __ATOMIC_RELAXED, __HIP_MEMORY_SCOPE_AGENT); }
__device__ __forceinline__ unsigned xb_xcc_id() { return (unsigned)__builtin_amdgcn_s_getreg((3 << 11) | 20) & 0xFu; }
#define XB_SPIN(cond, bar) do { unsigned _sp = 0; while (cond) { __builtin_amdgcn_s_sleep(1); \
    if ((++_sp & 255u) == 0u) { if (xb_ld(&(bar)[XB_TMO])) break; if (_sp > XB_SPIN_CAP) { atomicAdd(&(bar)[XB_TMO], 1u); break; } } } } while (0)
struct XcdBarrier { unsigned* bar; unsigned x; volatile LAS unsigned* st; };
__device__ __forceinline__ XcdBarrier xcd_barrier_post(unsigned* bar, volatile LAS unsigned* st) {
    XcdBarrier b; b.bar = bar; b.x = xb_xcc_id(); b.st = st;
    if (threadIdx.x == 0) (void)xb_add(&bar[XB_XCNT(b.x)], 1u);
    return b;
}
__device__ __forceinline__ void xcd_barrier_complete(unsigned* bar, unsigned x, unsigned& nloc, unsigned& nx) {
    const unsigned G = gridDim.x * gridDim.y * gridDim.z;
    unsigned sum, cnt, mine, sp = 0u;
    for (;;) {
        sum = 0u; cnt = 0u; mine = 0u;
#pragma unroll
        for (unsigned j = 0; j < 16; ++j) { const unsigned c = xb_ld(&bar[XB_XCNT(j)]); sum += c; cnt += (c > 0u) ? 1u : 0u; mine = (j == x) ? c : mine; }
        if (sum == G) break;
        __builtin_amdgcn_s_sleep(1);
        if ((++sp & 255u) == 0u) { if (xb_ld(&bar[XB_TMO])) break; if (sp > XB_SPIN_CAP) { atomicAdd(&bar[XB_TMO], 1u); break; } }
    }
    nloc = mine > 0u ? mine : 1u; nx = cnt > 0u ? cnt : 1u;
}
__device__ __forceinline__ void xcd_barrier(const XcdBarrier& b) {
    asm volatile("s_waitcnt vmcnt(0)" ::: "memory");
    __syncthreads();
    if (threadIdx.x == 0) {
        unsigned* bar = b.bar;
        __builtin_amdgcn_s_waitcnt(0);
        unsigned nloc = b.st[0], nx = b.st[1];
        if (nloc == 0u) { xcd_barrier_complete(bar, b.x, nloc, nx); b.st[0] = nloc; b.st[1] = nx; }
        const unsigned old = xb_add(&bar[XB_XSUB(b.x)], 1u);
        const unsigned gen = old / nloc;
        if (old + 1u == (gen + 1u) * nloc) {
            __builtin_amdgcn_fence(__ATOMIC_RELEASE, "agent");
            asm volatile("s_waitcnt vmcnt(0)" ::: "memory");
            const unsigned og = xb_add(&bar[XB_TOP], 1u);
            const unsigned tg = og / nx;
            if (og + 1u == (tg + 1u) * nx) xb_add(&bar[XB_TOPGEN], 1u);
            else XB_SPIN(xb_ld(&bar[XB_TOPGEN]) == tg, bar);
            __builtin_amdgcn_fence(__ATOMIC_ACQUIRE, "agent");
            xb_add(&bar[XB_XGEN(b.x)], 1u);
            asm volatile("s_waitcnt vmcnt(0)" ::: "memory");
        } else {
            XB_SPIN(xb_ld(&bar[XB_XGEN(b.x)]) == gen, bar);
            __builtin_amdgcn_fence(__ATOMIC_ACQUIRE, "agent");
            asm volatile("s_waitcnt vmcnt(0)" ::: "memory");
        }
    }
    __syncthreads();
}

namespace pg8 {
constexpr int BM = 256, BK = 64, HALF = 128, HTB = HALF * BK * 2, STAGE_BYTES = 8 * HTB, NXCD = 8, WGM = 8;
__host__ __device__ __forceinline__ int lds_byte(int r, int c) { const int st = (r >> 4) * 2 + (c >> 5), rr = r & 15, cc = c & 31, ob = rr * 64 + cc * 2; return st * 1024 + (ob ^ (((ob >> 9) & 1) << 5)); }
__host__ __device__ __forceinline__ void stage_rc(int b, int& R, int& C) { const int st = b / 1024, sb = b % 1024, swz = sb ^ (((sb >> 9) & 1) << 5); R = (st >> 1) * 16 + swz / 64; C = (st & 1) * 32 + (swz % 64) / 2; }
__host__ __device__ __forceinline__ int perm32(int rho) { const int n = rho >> 4, i = rho & 15; return 8 * (i >> 2) + 4 * n + (i & 3); }

struct Unit { int pm, pn, aux; };

__device__ __forceinline__ void tile_of(int L, int nM, int nN, int& pm, int& pn) {
    const int nwg = nM * nN; int wgid = L;
    { const int q = nwg / NXCD, r = nwg % NXCD, xcd = wgid % NXCD, off = wgid / NXCD; wgid = (xcd < r ? xcd * (q + 1) : r * (q + 1) + (xcd - r) * q) + off; }
    const int nig = WGM * nN, gid = wgid / nig, fm = gid * WGM, gsz = (nM - fm) < WGM ? (nM - fm) : WGM;
    pm = fm + ((wgid % nig) % gsz); pn = (wgid % nig) / gsz;
}

template <class Epi, class Sched, bool ALIGN_EPI, bool SP2, bool FP8 = false>
__device__ __forceinline__ void gemm_phase(LAS unsigned char* lds, const int RB, const Sched& S, const Epi& E) {
    const int tid = threadIdx.x, wid = __builtin_amdgcn_readfirstlane(tid >> 6), lane = tid & 63, wr = wid >> 2, wc = wid & 3, fr = lane & 15, fq = lane >> 4;
    const int nt = RB / 128;
    unsigned voffA[2], voffB[2];
#pragma unroll
    for (int i = 0; i < 2; ++i) { int R, C; stage_rc(tid * 16 + i * 8192, R, C); const int Rb = Epi::PERM ? ((R & ~31) + perm32(R & 31)) : R;
        voffA[i] = (unsigned)(R * RB + C * 2); voffB[i] = (unsigned)(Rb * RB + C * 2); }
    const size_t kstep = (size_t)(BK * 2);
    const size_t hstep = (size_t)HALF * RB;
    const unsigned ldsw = (unsigned)wid * 1024u;
    const int aoff = lds_byte(wr * 64 + fr, fq * 8), boff = lds_byte(wc * 32 + fr, fq * 8);
#define PG8_SA(b, h) (((b) * 2 + (h)) * HTB)
#define PG8_SB(b, h) ((4 + (b) * 2 + (h)) * HTB)
#define PG8_STAGE(bufoff, gbase, voff) do { _Pragma("unroll") for (int _i = 0; _i < 2; ++_i) \
        __builtin_amdgcn_global_load_lds((const unsigned*)((const char*)(gbase) + (voff)[_i]), (LAS unsigned*)(lds + (bufoff) + ldsw + _i * 8192), 16, 0, 0); } while (0)
#define PG8_LD8(p) __builtin_shufflevector(*(const LAS i32x4*)(p), *(const LAS i32x4*)((p) + 1024), 0, 1, 2, 3, 4, 5, 6, 7)
#define PG8_LDA(dst, b, h) do { _Pragma("unroll") for (int m = 0; m < 4; ++m) dst[m] = PG8_LD8(lds + PG8_SA(b, h) + aoff + m * 2048); } while (0)
#define PG8_LDB(dst, b, h) do { _Pragma("unroll") for (int n = 0; n < 2; ++n) dst[n] = PG8_LD8(lds + PG8_SB(b, h) + boff + n * 2048); } while (0)
#define PG8_LO(x) __builtin_bit_cast(bf16x8, __builtin_shufflevector(x, x, 0, 1, 2, 3))
#define PG8_HI(x) __builtin_bit_cast(bf16x8, __builtin_shufflevector(x, x, 4, 5, 6, 7))
#define PG8_MMA(ai, bj, At, Bt) do { __builtin_amdgcn_s_setprio(1); _Pragma("unroll") for (int m = 0; m < 4; ++m) _Pragma("unroll") for (int n = 0; n < 2; ++n) { \
        if constexpr (FP8) asm volatile("v_mfma_f32_16x16x128_f8f6f4 %0, %1, %2, %0" : "+v"(acc[ai][bj][m][n]) : "v"(Bt[n]), "v"(At[m]));   \
        else { acc[ai][bj][m][n] = __builtin_amdgcn_mfma_f32_16x16x32_bf16(PG8_LO(Bt[n]), PG8_LO(At[m]), acc[ai][bj][m][n], 0, 0, 0); \
               acc[ai][bj][m][n] = __builtin_amdgcn_mfma_f32_16x16x32_bf16(PG8_HI(Bt[n]), PG8_HI(At[m]), acc[ai][bj][m][n], 0, 0, 0); } } \
        __builtin_amdgcn_s_setprio(0); } while (0)
#define PG8_WAIT_V(n) asm volatile("s_waitcnt vmcnt(" #n ")" ::: "memory")
#define PG8_WAIT_L(n) asm volatile("s_waitcnt lgkmcnt(" #n ")" ::: "memory")
#define PG8_BAR __builtin_amdgcn_s_barrier()
#define PG8_SCHED __builtin_amdgcn_sched_barrier(0)
    Unit cur, nxt; int ui = 0;
    if (!S.next(0, cur)) return;
    f32x4 acc[2][2][4][2];
#pragma unroll
    for (int a = 0; a < 2; ++a)
#pragma unroll
        for (int b = 0; b < 2; ++b)
#pragma unroll
            for (int m = 0; m < 4; ++m)
#pragma unroll
                for (int n = 0; n < 2; ++n) acc[a][b][m][n] = (f32x4){0.f, 0.f, 0.f, 0.f};
    i32x8 At[4], B0[2], B1[2];
    const char* cA = S.a_ptr(cur); const char* cB = S.b_ptr(cur);
    if constexpr (SP2) {
        PG8_STAGE(PG8_SB(0, 0), cB, voffB); PG8_STAGE(PG8_SB(0, 1), cB + hstep, voffB); PG8_STAGE(PG8_SA(0, 0), cA, voffA); PG8_STAGE(PG8_SA(0, 1), cA + hstep, voffA);
        if (wr == 1) PG8_BAR;
        PG8_WAIT_V(2); PG8_BAR;
        PG8_STAGE(PG8_SB(1, 0), cB + kstep, voffB); PG8_STAGE(PG8_SA(1, 0), cA + kstep, voffA); PG8_STAGE(PG8_SB(1, 1), cB + hstep + kstep, voffB);
        PG8_WAIT_V(6); PG8_BAR;
    } else {
        PG8_STAGE(PG8_SB(0, 0), cB, voffB); PG8_STAGE(PG8_SA(0, 0), cA, voffA); PG8_STAGE(PG8_SB(0, 1), cB + hstep, voffB); PG8_STAGE(PG8_SA(0, 1), cA + hstep, voffA);
        if (wr == 1) PG8_BAR;
        PG8_WAIT_V(4); PG8_BAR;
        PG8_STAGE(PG8_SB(1, 0), cB + kstep, voffB); PG8_STAGE(PG8_SA(1, 0), cA + kstep, voffA); PG8_STAGE(PG8_SB(1, 1), cB + hstep + kstep, voffB);
        PG8_WAIT_V(6); PG8_BAR;
    }
    for (;;) {
        const bool has_next = S.next(ui + 1, nxt);
        const char* nA = has_next ? S.a_ptr(nxt) : cA; const char* nB = has_next ? S.b_ptr(nxt) : cB;
#pragma nounroll
        for (int t = 0; t < nt; t += 2) {
            const bool last = (t == nt - 2);
            const char* a1 = cA + (size_t)(t + 1) * kstep;
            const char* a2 = last ? nA : cA + (size_t)(t + 2) * kstep; const char* b2 = last ? nB : cB + (size_t)(t + 2) * kstep;
            const char* a3 = a2 + kstep; const char* b3 = b2 + kstep;
            if constexpr (SP2) {
            PG8_LDB(B0, 0, 0); PG8_LDB(B1, 0, 1); PG8_SCHED; PG8_LDA(At, 0, 0); PG8_STAGE(PG8_SA(1, 1), a1 + hstep, voffA);
            PG8_WAIT_V(8); PG8_WAIT_L(0); PG8_BAR; PG8_MMA(0, 0, At, B0); PG8_MMA(0, 1, At, B1); PG8_BAR; PG8_SCHED;
            PG8_LDA(At, 0, 1); PG8_STAGE(PG8_SB(0, 0), b2, voffB); PG8_STAGE(PG8_SB(0, 1), b2 + hstep, voffB); PG8_STAGE(PG8_SA(0, 0), a2, voffA);
            PG8_WAIT_V(8); PG8_WAIT_L(0); PG8_BAR; PG8_MMA(1, 0, At, B0); PG8_MMA(1, 1, At, B1); PG8_BAR; PG8_SCHED;
            PG8_LDB(B0, 1, 0); PG8_LDB(B1, 1, 1); PG8_SCHED; PG8_LDA(At, 1, 0); PG8_STAGE(PG8_SA(0, 1), a2 + hstep, voffA);
            PG8_WAIT_V(8); PG8_WAIT_L(0); PG8_BAR; PG8_MMA(0, 0, At, B0); PG8_MMA(0, 1, At, B1); PG8_BAR; PG8_SCHED;
            PG8_LDA(At, 1, 1); PG8_STAGE(PG8_SB(1, 0), b3, voffB); PG8_STAGE(PG8_SB(1, 1), b3 + hstep, voffB); PG8_STAGE(PG8_SA(1, 0), a3, voffA);
            PG8_WAIT_V(8); PG8_WAIT_L(0); PG8_BAR; PG8_MMA(1, 0, At, B0); PG8_MMA(1, 1, At, B1); PG8_BAR; PG8_SCHED;
            } else {
            PG8_LDB(B0, 0, 0); PG8_SCHED; PG8_LDA(At, 0, 0); PG8_STAGE(PG8_SA(1, 1), a1 + hstep, voffA);
            PG8_WAIT_L(8); PG8_BAR; PG8_WAIT_L(0); PG8_MMA(0, 0, At, B0); PG8_BAR; PG8_SCHED;
            PG8_LDB(B1, 0, 1); PG8_STAGE(PG8_SB(0, 0), b2, voffB);
            PG8_BAR; PG8_WAIT_L(0); PG8_MMA(0, 1, At, B1); PG8_BAR;
            PG8_LDA(At, 0, 1); PG8_STAGE(PG8_SA(0, 0), a2, voffA);
            PG8_BAR; PG8_WAIT_L(0); PG8_MMA(1, 0, At, B0); PG8_BAR; PG8_SCHED;
            PG8_STAGE(PG8_SB(0, 1), b2 + hstep, voffB);
            PG8_WAIT_V(6); PG8_BAR; PG8_MMA(1, 1, At, B1); PG8_BAR;
            PG8_LDB(B0, 1, 0); PG8_SCHED; PG8_LDA(At, 1, 0); PG8_STAGE(PG8_SA(0, 1), a2 + hstep, voffA);
            PG8_WAIT_L(8); PG8_BAR; PG8_WAIT_L(0); PG8_MMA(0, 0, At, B0); PG8_BAR; PG8_SCHED;
            PG8_LDB(B1, 1, 1); PG8_STAGE(PG8_SB(1, 0), b3, voffB);
            PG8_BAR; PG8_WAIT_L(0); PG8_MMA(0, 1, At, B1); PG8_BAR;
            PG8_LDA(At, 1, 1); PG8_STAGE(PG8_SA(1, 0), a3, voffA);
            PG8_BAR; PG8_WAIT_L(0); PG8_MMA(1, 0, At, B0); PG8_BAR; PG8_SCHED;
            PG8_STAGE(PG8_SB(1, 1), b3 + hstep, voffB);
            PG8_WAIT_V(6); PG8_BAR; PG8_MMA(1, 1, At, B1); PG8_BAR;
            }
        }
        if constexpr (ALIGN_EPI) { if (wr == 0) PG8_BAR; }
        if constexpr (FP8) asm volatile("s_nop 15\n\ts_nop 15" ::: "memory");
        E(acc, cur, wr, wc, fr, fq);
        if (!has_next) break;
        if (!S.keep(cur)) {
#pragma unroll
            for (int a = 0; a < 2; ++a)
#pragma unroll
                for (int b = 0; b < 2; ++b)
#pragma unroll
                    for (int m = 0; m < 4; ++m)
#pragma unroll
                        for (int n = 0; n < 2; ++n) acc[a][b][m][n] = (f32x4){0.f, 0.f, 0.f, 0.f};
        }
        cur = nxt; cA = nA; cB = nB; ++ui;
        if constexpr (ALIGN_EPI) { if (wr == 1) PG8_BAR; }
    }
    PG8_WAIT_V(0);
    if constexpr (!ALIGN_EPI) { if (wr == 0) PG8_BAR; }
    PG8_BAR;
#undef PG8_SA
#undef PG8_SB
#undef PG8_STAGE
#undef PG8_LDA
#undef PG8_LDB
#undef PG8_MMA
#undef PG8_LD8
#undef PG8_LO
#undef PG8_HI
#undef PG8_WAIT_V
#undef PG8_WAIT_L
#undef PG8_BAR
#undef PG8_SCHED
}
}
using pg8::Unit;

#ifndef PG8_SP2
#define PG8_SP2 true
#endif
#ifndef PG8_ALIGN
#define PG8_ALIGN true
#endif

enum InIdx { I_X = 0, I_C, I_CTX, I_CCTX, I_WADA, I_BADA, I_GMIX, I_GFFN, I_WIN, I_WDW, I_BDW, I_LNG, I_LNB, I_WCO, I_BCO, I_LQ1, I_LK1, I_LQ2, I_LK2, I_GSUB, I_WAO, I_WOUT, I_WR, I_WEG, I_WEU, I_WED, I_GFIN, N_IN };
struct Args { const float* in[N_IN]; float* out; unsigned char* ws; int ph_lo, ph_hi, li, pad; };

__device__ __forceinline__ void ph_adaln(const Args& a, LAS unsigned char* lds, int bid, int G) {
    const int tid = threadIdx.x;
    LAS float* sil = (LAS float*)lds;
    LAS float* red = sil + 9 * 1024;
    const float* c = a.in[I_C]; const float* cc = a.in[I_CCTX]; const float* w = a.in[I_WADA]; const float* bb = a.in[I_BADA];
    float* mod = (float*)(a.ws + WS_MOD);
    for (int i = tid; i < 9 * 1024; i += 512) { const float v = (i < 8192) ? c[i] : cc[i - 8192]; sil[i] = v / (1.0f + expf(-v)); }
    __syncthreads();
    for (int unit = bid; unit < NMOD / 32; unit += G) {
        const int n0 = unit * 32, col = tid & 31, kp = tid >> 5;
        float acc[9];
#pragma unroll
        for (int r = 0; r < 9; ++r) acc[r] = 0.f;
#pragma unroll 8
        for (int kk = 0; kk < 64; ++kk) { const int k = kp * 64 + kk; const float wv = w[(size_t)k * NMOD + n0 + col];
#pragma unroll
            for (int r = 0; r < 9; ++r) acc[r] += sil[r * 1024 + k] * wv; }
#pragma unroll
        for (int r = 0; r < 9; ++r) red[(kp * 9 + r) * 32 + col] = acc[r];
        __syncthreads();
        if (tid < 288) { const int r = tid >> 5, cl = tid & 31; float s = 0.f;
#pragma unroll
            for (int k2 = 0; k2 < 16; ++k2) s += red[(k2 * 9 + r) * 32 + cl];
            mod[r * NMOD + n0 + cl] = s + bb[n0 + cl]; }
        __syncthreads();
    }
}
__device__ __forceinline__ void ph_rope_table(const Args& a) {
    float* rc = (float*)(a.ws + WS_ROPE); float* rs = rc + 1024;
    for (int i = threadIdx.x; i < 1024; i += 512) { const int pos = i >> 4, f = i & 15;
        const float inv = powf(10000.0f, -(float)f / 16.0f); const float ang = (float)pos * inv;
        rc[i] = cosf(ang); rs[i] = sinf(ang); }
}
template <class DstRow>
__device__ __forceinline__ void transpose_item(const float* W, int K, int N, bf16_t* WT, const DstRow& dr, LAS float* scr, int item, int lane) {
    const int nblk = N / 32, kb = item / nblk, nb = item % nblk, k0 = 64 * kb, n0 = 32 * nb;
#pragma unroll 8
    for (int i = 0; i < 32; ++i) { const int kk = 2 * i + (lane >> 5); scr[kk * 33 + (lane & 31)] = __builtin_nontemporal_load(W + (size_t)(k0 + kk) * N + n0 + (lane & 31)); }
    LDS_WAIT(); asm volatile("" ::: "memory");
    const int c = lane & 7;
#pragma unroll
    for (int j = 0; j < 4; ++j) { const int n = (lane >> 3) + 8 * j; const LAS float* s = scr + (8 * c) * 33 + n;
        u32x4 o; o.x = cvt_pk_bf16(s[0 * 33], s[1 * 33]); o.y = cvt_pk_bf16(s[2 * 33], s[3 * 33]); o.z = cvt_pk_bf16(s[4 * 33], s[5 * 33]); o.w = cvt_pk_bf16(s[6 * 33], s[7 * 33]);
        *(u32x4*)(WT + (size_t)dr(n0 + n) * K + k0 + 8 * c) = o; }
    LDS_WAIT(); asm volatile("" ::: "memory");
}
template <class DstRow>
__device__ __forceinline__ void transpose_item_fp8(const float* W, int K, int N, unsigned char* WT, const DstRow& dr, LAS float* scr, int item, int lane) {
    const int nblk = N / 32, kb = item / nblk, nb = item % nblk, k0 = 64 * kb, n0 = 32 * nb;
#pragma unroll 8
    for (int i = 0; i < 32; ++i) { const int kk = 2 * i + (lane >> 5); scr[kk * 33 + (lane & 31)] = __builtin_nontemporal_load(W + (size_t)(k0 + kk) * N + n0 + (lane & 31)); }
    LDS_WAIT(); asm volatile("" ::: "memory");
    const int c = lane & 7;
#pragma unroll
    for (int j = 0; j < 4; ++j) { const int n = (lane >> 3) + 8 * j; const LAS float* s = scr + (8 * c) * 33 + n;
        u32x2 o; o.x = pack4_fp8(s[0 * 33] * WSCALE, s[1 * 33] * WSCALE, s[2 * 33] * WSCALE, s[3 * 33] * WSCALE); o.y = pack4_fp8(s[4 * 33] * WSCALE, s[5 * 33] * WSCALE, s[6 * 33] * WSCALE, s[7 * 33] * WSCALE);
        *(u32x2*)(WT + (size_t)dr(n0 + n) * K + k0 + 8 * c) = o; }
    LDS_WAIT(); asm volatile("" ::: "memory");
}
__host__ __device__ __forceinline__ int qdst(int d) { const int blk = d >> 5, half = (d >> 4) & 1, i = d & 15; return 8 * (4 * blk + (i >> 2)) + 4 * half + (i & 3); }
struct DrWin { __host__ __device__ int operator()(int j) const {
    if (j < 1024) return 256 * (j >> 7) + (j & 127);
    if (j < 2048) { const int jj = j - 1024; return 256 * (jj >> 7) + 128 + (jj & 127); }
    if (j < 4096) { const int jj = j & 1023, base = j - jj; return base + (jj & ~63) + qdst(jj & 63); }
    return j; } };
struct DrId { __host__ __device__ int operator()(int j) const { return j; } };
struct DrGU { int up; __host__ __device__ int operator()(int f) const { return 256 * (f >> 7) + 128 * up + (f & 127); } };

__device__ __forceinline__ void ph_small_weights(const Args& a, LAS unsigned char* lds, int gw, int NGW, int wave, int lane) {
    LAS float* scr = (LAS float*)(lds + 57344 + wave * 8448);
    constexpr int I_IN = (DM / 64) * (NPROJ / 32), I_SQ = (DM / 64) * (DM / 32);
    for (int it = gw; it < I_IN + 3 * I_SQ; it += NGW) {
        int r = it;
        if (r < I_IN) { transpose_item(a.in[I_WIN], DM, NPROJ, (bf16_t*)(a.ws + WS_WIN), DrWin{}, scr, r, lane); continue; } r -= I_IN;
        if (r < I_SQ) { transpose_item(a.in[I_WCO], DM, DM, (bf16_t*)(a.ws + WS_WCO), DrId{}, scr, r, lane); continue; } r -= I_SQ;
        if (r < I_SQ) { transpose_item(a.in[I_WAO], DM, DM, (bf16_t*)(a.ws + WS_WAO), DrId{}, scr, r, lane); continue; } r -= I_SQ;
        transpose_item(a.in[I_WOUT], DM, DM, (bf16_t*)(a.ws + WS_WO), DrId{}, scr, r, lane);
    }
}
__device__ __forceinline__ void ph_wgu(const Args& a, LAS unsigned char* lds, int gw, int NGW, int wave, int lane) {
    LAS float* scr = (LAS float*)(lds + 57344 + wave * 8448);
    constexpr int I_E = (DM / 64) * (DFF / 32);
    for (int it = gw; it < 2 * NEXP * I_E; it += NGW) {
        const int mat = it / I_E, r = it % I_E, e = mat >> 1, up = mat & 1;
        const float* W = (up ? a.in[I_WEU] : a.in[I_WEG]) + (size_t)e * DM * DFF;
        transpose_item_fp8(W, DM, DFF, (unsigned char*)(a.ws + WS_WGU) + (size_t)e * 2 * DFF * DM, DrGU{up}, scr, r, lane);
    }
}
__device__ __forceinline__ void ph_wd(const Args& a, LAS unsigned char* lds, int gw, int NGW, int wave, int lane) {
    LAS float* scr = (LAS float*)(lds + 57344 + wave * 8448);
    constexpr int I_E = (DFF / 64) * (DM / 32);
    for (int it = gw; it < NEXP * I_E; it += NGW) {
        const int e = it / I_E, r = it % I_E;
        transpose_item_fp8(a.in[I_WED] + (size_t)e * DFF * DM, DFF, DM, (unsigned char*)(a.ws + WS_WD) + (size_t)e * DM * DFF, DrId{}, scr, r, lane);
    }
}

__device__ __forceinline__ void ph_norm_rows(const Args& a, int gw, int NGW, int lane) {
    const float* mod = (const float*)(a.ws + WS_MOD); const float* g = a.in[I_GMIX]; bf16_t* H = (bf16_t*)(a.ws + WS_H);
    const int per = (MALL + NGW - 1) / NGW, r0 = gw * per, r1 = (r0 + per < MALL) ? r0 + per : MALL;
    if (r0 >= r1) return;
    auto src_of = [&](int row) { return (const f32x4*)((row < MLAT) ? a.in[I_X] + (size_t)row * DM : a.in[I_CTX] + (size_t)(row - MLAT) * DM) + lane; };
    f32x4 gs[4], sh[4]; int cur_b = -1;
    f32x4 nx[4];
    { const f32x4* xr = src_of(r0);
#pragma unroll
      for (int j = 0; j < 4; ++j) nx[j] = __builtin_nontemporal_load(xr + 64 * j); }
    for (int row = r0; row < r1; ++row) {
        f32x4 v[4];
#pragma unroll
        for (int j = 0; j < 4; ++j) v[j] = nx[j];
        if (row + 1 < r1) { const f32x4* xr = src_of(row + 1);
#pragma unroll
            for (int j = 0; j < 4; ++j) nx[j] = __builtin_nontemporal_load(xr + 64 * j); }
        const int b = (row < MLAT) ? (row >> 12) : 8;
        if (b != cur_b) { cur_b = b; const float* mb = mod + (size_t)b * NMOD;
#pragma unroll
            for (int j = 0; j < 4; ++j) { const int c = 4 * lane + 256 * j; gs[j] = *(const f32x4*)(g + c) * (*(const f32x4*)(mb + 1024 + c) + 1.0f); sh[j] = *(const f32x4*)(mb + c); } }
        float s = 0.f;
#pragma unroll
        for (int j = 0; j < 4; ++j) s += (v[j].x * v[j].x + v[j].y * v[j].y) + (v[j].z * v[j].z + v[j].w * v[j].w);
        const float rstd = 1.0f / sqrtf(wave_sum(s) * (1.0f / DM) + EPS);
        unsigned long long* o8 = (unsigned long long*)(H + (size_t)row * DM) + lane;
#pragma unroll
        for (int j = 0; j < 4; ++j) { const f32x4 y = (v[j] * rstd) * gs[j] + sh[j];
            o8[64 * j] = (unsigned long long)cvt_pk_bf16(y.x, y.y) | ((unsigned long long)cvt_pk_bf16(y.z, y.w) << 32); }
    }
}

struct SchedInProj {
    const char* A; const char* Bt; int G, c;
    static constexpr int NLAT = 128 * 28, NCTXU = 8 * 8;
    __device__ __forceinline__ bool next(int i, Unit& u) const {
        const int L = i * G + c; if (L >= NLAT + NCTXU) return false;
        if (L < NLAT) { pg8::tile_of(L, 128, 28, u.pm, u.pn); } else { const int v = L - NLAT; u.pm = 128 + (v & 7); u.pn = 12 + (v >> 3); }
        u.aux = 0; return true; }
    __device__ __forceinline__ const char* a_ptr(const Unit& u) const { return (u.pn >= 16 && u.pn < 20) ? Bt + (size_t)u.pn * (256 * DM * 2) : A + (size_t)u.pm * (256 * DM * 2); }
    __device__ __forceinline__ const char* b_ptr(const Unit& u) const { return (u.pn >= 16 && u.pn < 20) ? A + (size_t)u.pm * (256 * DM * 2) : Bt + (size_t)u.pn * (256 * DM * 2); }
    __device__ __forceinline__ bool keep(const Unit&) const { return false; }
};
struct EpiInProj {
    static constexpr bool PERM = true;
    bf16_t *U, *Q, *KA, *VA, *GC, *GA; const float* rope;
    __device__ __forceinline__ void operator()(f32x4 (&acc)[2][2][4][2], const Unit& u, int wr, int wc, int fr, int fq) const {
        const int pn = u.pn, pm = u.pm;
        const int cw = wc * 32 + 8 * fq;
        if (pn < 8) {
#pragma unroll
            for (int ai = 0; ai < 2; ++ai)
#pragma unroll
                for (int m = 0; m < 4; ++m) { const int r = pm * 256 + ai * 128 + wr * 64 + m * 16 + fr;
                    const f32x4 a0 = acc[ai][0][m][0], a1 = acc[ai][0][m][1], b0 = acc[ai][1][m][0], b1 = acc[ai][1][m][1];
                    u32x4 w; w.x = cvt_pk_bf16(a0[0] * sigmoidf_(b0[0]), a0[1] * sigmoidf_(b0[1])); w.y = cvt_pk_bf16(a0[2] * sigmoidf_(b0[2]), a0[3] * sigmoidf_(b0[3]));
                    w.z = cvt_pk_bf16(a1[0] * sigmoidf_(b1[0]), a1[1] * sigmoidf_(b1[1])); w.w = cvt_pk_bf16(a1[2] * sigmoidf_(b1[2]), a1[3] * sigmoidf_(b1[3]));
                    *(u32x4*)(U + (size_t)r * DM + pn * 128 + cw) = w; }
            return;
        }
        if (pn < 16) {
            const bool isq = pn < 12, lat = pm < 128;
            bf16_t* base; size_t row0; int rowpos0 = 0;
            if (isq) { base = Q + (size_t)(pn - 8) * 256; row0 = (size_t)pm * 256; }
            else { base = KA + (size_t)(pn - 12) * 256; row0 = lat ? (size_t)(pm >> 4) * KVR + (size_t)(pm & 15) * 256 : (size_t)(pm - 128) * KVR + NT; }
            if (lat) rowpos0 = (pm & 15) * 4;
            const float sc = isq ? QSCALE : 1.0f;
            const float* rc = rope; const float* rs = rope + 1024;
#pragma unroll
            for (int ai = 0; ai < 2; ++ai)
#pragma unroll
                for (int m = 0; m < 4; ++m) { const int rl = ai * 128 + wr * 64 + m * 16 + fr;
                    f32x4 cs = (f32x4){1.f, 1.f, 1.f, 1.f}, sn = (f32x4){0.f, 0.f, 0.f, 0.f};
                    if (lat) { const int pos = (wc & 1) ? (m * 16 + fr) : (rowpos0 + 2 * ai + wr); cs = *(const f32x4*)(rc + pos * 16 + 4 * fq); sn = *(const f32x4*)(rs + pos * 16 + 4 * fq); }
#pragma unroll
                    for (int bj = 0; bj < 2; ++bj) { const f32x4 x1 = acc[ai][bj][m][0], x2 = acc[ai][bj][m][1];
                        const f32x4 y1 = (x1 * cs - x2 * sn) * sc, y2 = (x1 * sn + x2 * cs) * sc;
                        u32x4 w; w.x = cvt_pk_bf16(y1[0], y1[1]); w.y = cvt_pk_bf16(y1[2], y1[3]); w.z = cvt_pk_bf16(y2[0], y2[1]); w.w = cvt_pk_bf16(y2[2], y2[3]);
                        *(u32x4*)(base + (row0 + rl) * DM + bj * 128 + cw) = w; } }
            return;
        }
        if (pn < 20) {
            const bool lat = pm < 128;
            const int bidx = lat ? (pm >> 4) : (pm - 128), key0 = lat ? (pm & 15) * 256 : NT;
            bf16_t* vt = VA + (size_t)(bidx * NHD + 2 * (pn - 16)) * 128 * KVR + key0;
            int fr_ = fr; asm volatile("" : "+v"(fr_));
#pragma unroll
            for (int ai = 0; ai < 2; ++ai)
#pragma unroll
                for (int m = 0; m < 4; ++m) { bf16_t* rowp = vt + (unsigned)((ai * 128 + wr * 64 + m * 16 + fr_) * KVR);
#pragma unroll
                    for (int bj = 0; bj < 2; ++bj) { const f32x4 v0 = acc[ai][bj][m][0], v1 = acc[ai][bj][m][1];
                        unsigned a0 = cvt_pk_bf16(v0[0], v0[1]), a1 = cvt_pk_bf16(v0[2], v0[3]), b0 = cvt_pk_bf16(v1[0], v1[1]), b1 = cvt_pk_bf16(v1[2], v1[3]);
                        { auto r_ = __builtin_amdgcn_permlane16_swap(a0, b0, false, false); a0 = r_[0]; b0 = r_[1]; }
                        { auto r_ = __builtin_amdgcn_permlane16_swap(a1, b1, false, false); a1 = r_[0]; b1 = r_[1]; }
                        *(u32x4*)(rowp + bj * 128 + wc * 32 + 8 * fq) = (u32x4){a0, a1, b0, b1}; }
                    asm volatile("" ::: "memory"); }
            return;
        }
        {
            bf16_t* base; size_t row0;
            if (pn < 24) { base = GC + (size_t)(pn - 20) * 256; row0 = (size_t)pm * 256; }
            else { base = GA + (size_t)(pn - 24) * 256; row0 = (size_t)pm * 256; }
#pragma unroll
            for (int ai = 0; ai < 2; ++ai)
#pragma unroll
                for (int m = 0; m < 4; ++m) { const int rl = ai * 128 + wr * 64 + m * 16 + fr;
#pragma unroll
                    for (int bj = 0; bj < 2; ++bj) { f32x4 v0 = acc[ai][bj][m][0], v1 = acc[ai][bj][m][1];
#pragma unroll
                        for (int j = 0; j < 4; ++j) { v0[j] = sigmoidf_(v0[j]); v1[j] = sigmoidf_(v1[j]); }
                        u32x4 w; w.x = cvt_pk_bf16(v0[0], v0[1]); w.y = cvt_pk_bf16(v0[2], v0[3]); w.z = cvt_pk_bf16(v1[0], v1[1]); w.w = cvt_pk_bf16(v1[2], v1[3]);
                        *(u32x4*)(base + (row0 + rl) * DM + bj * 128 + cw) = w; } }
        }
    }
};

__device__ __forceinline__ void ph_conv_unit(const Args& a, LAS unsigned char* lds, int unit) {
    const int tid = threadIdx.x, lane = tid & 63, wave = __builtin_amdgcn_readfirstlane(tid >> 6);
    const int b = unit >> 5, t0 = (unit & 31) * 128;
    LAS float* ybuf = (LAS float*)lds;
    const int c0 = 2 * tid;
    f32x2 w[31];
    { const float* wp = a.in[I_WDW]; asm volatile("" : "+s"(wp));
      const __attribute__((address_space(1))) f32x2* wp2 = (const __attribute__((address_space(1))) f32x2*)(wp + c0);
#pragma unroll
      for (int j = 0; j < 31; ++j) w[j] = wp2[j * (DM / 2)]; }
    const f32x2 bias = *(const f32x2*)(a.in[I_BDW] + c0);
    const unsigned* Ub = (const unsigned*)(a.ws + WS_U) + (size_t)b * NT * (DM / 2) + tid;
    bf16_t* CA = (bf16_t*)(a.ws + WS_CACT) + (size_t)(b * NT + t0) * DM;
    const float* lng = a.in[I_LNG]; const float* lnb = a.in[I_LNB];
    f32x2 win[32];
#pragma unroll
    for (int s = 0; s < 32; ++s) win[s] = (f32x2){0.f, 0.f};
    unsigned pf[16];
    const unsigned* up = Ub + ((long)t0 - 15) * (DM / 2);
#define CV_LD(i) ({ const int i_ = (i); const int ti_ = t0 - 15 + i_; (i_ < 158 && ti_ >= 0 && ti_ < NT) ? up[(long)i_ * (DM / 2)] : 0u; })
#pragma unroll
    for (int s = 0; s < 16; ++s) pf[s] = CV_LD(s);
    for (int Q = 0; Q < 5; ++Q) {
#pragma unroll
        for (int hb = 0; hb < 2; ++hb)
#pragma unroll
        for (int s16 = 0; s16 < 16; ++s16) {
            const int s = hb * 16 + s16;
            const unsigned pk = pf[s16];
            pf[s16] = CV_LD(32 * Q + s + 16);
            win[s] = (f32x2){bf_lo(pk), bf_hi(pk)};
            const int to = 32 * Q + s - 30;
            if (to >= 0 && to < 128) {
                f32x2 y = bias;
#pragma unroll
                for (int j = 0; j < 31; ++j) y += w[j] * win[(s + 2 + j) & 31];
                *(LAS f32x2*)(ybuf + (to & 15) * DM + c0) = y;
            }
            if (s == 13 || s == 29) {
                if (Q >= 1) {
                    const int tb = 32 * Q + s - 30 - 15;
                    __syncthreads();
#pragma unroll
                    for (int k = 0; k < 2; ++k) { const int tl = 2 * wave + k;
                        f32x4 v[4]; float sm = 0.f;
#pragma unroll
                        for (int j = 0; j < 4; ++j) { v[j] = *(const LAS f32x4*)(ybuf + tl * DM + 4 * lane + 256 * j); sm += (v[j].x + v[j].y) + (v[j].z + v[j].w); }
                        const float mean = wave_sum(sm) * (1.0f / DM); float s2 = 0.f;
#pragma unroll
                        for (int j = 0; j < 4; ++j) { v[j] = v[j] - mean; s2 += (v[j].x * v[j].x + v[j].y * v[j].y) + (v[j].z * v[j].z + v[j].w * v[j].w); }
                        const float rstd = 1.0f / sqrtf(wave_sum(s2) * (1.0f / DM) + EPS);
                        unsigned long long* o8 = (unsigned long long*)(CA + (size_t)(tb + tl) * DM) + lane;
#pragma unroll
                        for (int j = 0; j < 4; ++j) { const int c = 4 * lane + 256 * j;
                            f32x4 y = v[j] * rstd * *(const f32x4*)(lng + c) + *(const f32x4*)(lnb + c);
#pragma unroll
                            for (int q = 0; q < 4; ++q) y[q] = y[q] * sigmoidf_(y[q]);
                            o8[64 * j] = (unsigned long long)cvt_pk_bf16(y.x, y.y) | ((unsigned long long)cvt_pk_bf16(y.z, y.w) << 32); } }
                    __syncthreads();
                }
            }
        }
    }
#undef CV_LD
}

namespace att {
constexpr int NW = 8, QBLK = 32, KVBLK = 64, NTILE = KVR / KVBLK;
constexpr int SHM_V = 128 * KVBLK * 2, SHM_K = KVBLK * 64 * 2;
constexpr int BUFB = SHM_V + SHM_K, NBUF = 4, ATT_LDS = NBUF * BUFB;
constexpr int VT_PITCH = KVR;
#define KSWZ(row, colB) ((row) * 128 + ((colB) ^ ((((row) >> 1) & 7) << 4)))
#define SBAR() __builtin_amdgcn_sched_barrier(0)
__device__ __forceinline__ int crow(int r, int hi) { return (r & 3) + 8 * (r >> 2) + 4 * hi; }
__device__ __forceinline__ void glds16(const void* g, unsigned lds_base) {
    unsigned sv; asm volatile("s_mov_b32 %0, m0\n\ts_mov_b32 m0, %2\n\ts_nop 0\n\tglobal_load_lds_dwordx4 %1, off\n\ts_mov_b32 m0, %0" : "=&s"(sv) : "v"(g), "s"(lds_base) : "memory"); }
__device__ __forceinline__ void attn_map(const bf16_t* __restrict__ Qb, const bf16_t* __restrict__ Kh, const bf16_t* __restrict__ VTh, long dKn, long dVn, bool pre, bool has_next, f32x16 (&o)[4], char* lds) {
    const int tid = threadIdx.x, wid = tid >> 6, lane = tid & 63, r32 = lane & 31, hi = lane >> 5;
    const int wv = __builtin_amdgcn_readfirstlane(tid >> 6);
    const bool isB = wv >= 4;
    float l_reg = 0.f;
#pragma unroll
    for (int d = 0; d < 4; ++d) o[d] = f32x16{};
    bf16x8 qr[4];
    const bf16_t* Qw = Qb + (size_t)(wid * QBLK + r32) * DM + hi * 8;
#pragma unroll
    for (int d0 = 0; d0 < 4; ++d0) qr[d0] = *reinterpret_cast<const bf16x8*>(Qw + d0 * 16);
    const bf16_t* ksrc = Kh + (size_t)(8 * wv + (lane >> 3)) * DM + (((lane & 7) ^ ((4 * wv + (lane >> 4)) & 7)) << 3);
    const bf16_t* vsrc0 = VTh + (size_t)(16 * wv + (lane >> 3)) * VT_PITCH + (((lane & 7) ^ ((lane >> 4) & 7)) << 3);
    const bf16_t* vsrc1 = VTh + (size_t)(16 * wv + 8 + (lane >> 3)) * VT_PITCH + (((lane & 7) ^ ((4 + (lane >> 4)) & 7)) << 3);
    const unsigned lds0 = (unsigned)(uintptr_t)lds;
#define DMAX(ko, vo, b) do { const unsigned bb_ = lds0 + (unsigned)(b) * BUFB; \
    glds16(ksrc + (ko), (unsigned)__builtin_amdgcn_readfirstlane(bb_ + SHM_V + 1024 * wv)); \
    glds16(vsrc0 + (vo), (unsigned)__builtin_amdgcn_readfirstlane(bb_ + 2048 * wv)); \
    glds16(vsrc1 + (vo), (unsigned)__builtin_amdgcn_readfirstlane(bb_ + 2048 * wv + 1024)); } while (0)
#define DMA(t, b) DMAX((long)(t) * (KVBLK * DM), (long)(t) * KVBLK, b)
#define DMAT(T) do { if ((T) < NTILE) DMA((T), (T) & 3); else if (has_next && (T) - NTILE < 2) DMAX(dKn + (long)((T) - NTILE) * (KVBLK * DM), dVn + (long)((T) - NTILE) * KVBLK, ((T) - NTILE) & 3); } while (0)
#define BAR() asm volatile("s_barrier" ::: "memory")
#define BARV() asm volatile("s_waitcnt vmcnt(0)\n\ts_barrier" ::: "memory")
    f32x16 pA0, pA1, pB0, pB1;
    u32x4 pw0, pw1, pw2, pw3;
    typedef LAS const char* lcp;
    const lcp lds3 = (lcp)(LAS char*)(uintptr_t)lds0;
    int kaddr[4], vaddr[4];
#pragma unroll
    for (int d0 = 0; d0 < 4; ++d0) { kaddr[d0] = SHM_V + KSWZ(r32, (d0 * 16 + hi * 8) * 2); vaddr[d0] = KSWZ(r32, (2 * d0 + hi) * 16); }
    bf16x8 kf[8], va[4], vb[4];
    constexpr float REF_MARGIN = 32.0f;
    f32x16 negm = f32x16{};
#define PIN(x) asm volatile("" : "+v"(x))
#define MF(a_, b_, c_) __builtin_amdgcn_mfma_f32_32x32x16_bf16(a_, b_, c_, 0, 0, 0)
#define PB(w) __builtin_bit_cast(bf16x8, w)
#define PKW(P, i) cvt_pk_bf16(P[i], P[i + 1])
#define ADD6(x, A, a0, a1, a2, B, b0, b1, b2) do { x += A[a0]; x += A[a1]; x += A[a2]; x += B[b0]; x += B[b1]; x += B[b2]; } while (0)
#define KRD(kbuf) do { const lcp kb_ = lds3 + (kbuf) * BUFB; \
      _Pragma("unroll") for (int d0 = 0; d0 < 4; ++d0) { kf[2 * d0] = *(const LAS bf16x8*)(kb_ + kaddr[d0]); kf[2 * d0 + 1] = *(const LAS bf16x8*)(kb_ + kaddr[d0] + 4096); } } while (0)
#define VRD4(dst, vb_, blk) do { const lcp vq_ = lds3 + (vb_) * BUFB; _Pragma("unroll") for (int ks_ = 0; ks_ < 4; ++ks_) dst[ks_] = *(const LAS bf16x8*)(vq_ + vaddr[ks_] + (blk) * 4096); } while (0)
#define S1(C0, C1, P0, P1, kbuf, vnext) do { SBAR(); \
    KRD(kbuf); \
    float ps_ = P0[0] + P0[1]; ps_ += P0[2]; ps_ += P0[3]; ps_ += P0[4]; ps_ += P0[5]; ps_ += P0[6]; ps_ += P0[7]; PIN(ps_); SBAR(); \
    C0 = MF(kf[0], qr[0], negm); ADD6(ps_, P0, 8, 9, 10, P0, 11, 12, 13); PIN(ps_); SBAR(); \
    C1 = MF(kf[1], qr[0], negm); ps_ += P0[14]; ps_ += P0[15]; ps_ += P1[0]; ps_ += P1[1]; ps_ += P1[2]; ps_ += P1[3]; PIN(ps_); SBAR(); \
    C0 = MF(kf[2], qr[1], C0); ADD6(ps_, P1, 4, 5, 6, P1, 7, 8, 9); PIN(ps_); SBAR(); \
    C1 = MF(kf[3], qr[1], C1); ADD6(ps_, P1, 10, 11, 12, P1, 13, 14, 15); l_reg += ps_; PIN(l_reg); SBAR(); \
    C0 = MF(kf[4], qr[2], C0); pw0 = (u32x4){PKW(P0, 0), PKW(P0, 2), PKW(P0, 4), PKW(P0, 6)}; PIN(pw0); SBAR(); \
    C1 = MF(kf[5], qr[2], C1); pw1 = (u32x4){PKW(P0, 8), PKW(P0, 10), PKW(P0, 12), PKW(P0, 14)}; PIN(pw1); SBAR(); \
    C0 = MF(kf[6], qr[3], C0); pw2 = (u32x4){PKW(P1, 0), PKW(P1, 2), PKW(P1, 4), PKW(P1, 6)}; PIN(pw2); SBAR(); \
    C1 = MF(kf[7], qr[3], C1); pw3 = (u32x4){PKW(P1, 8), PKW(P1, 10), PKW(P1, 12), PKW(P1, 14)}; PIN(pw3); PIN(C0); PIN(C1); SBAR(); \
    VRD4(va, vnext, 0); VRD4(vb, vnext, 1); SBAR();     \
    } while (0)
#define VRD1(dst, ks, blk) dst[ks] = *(const LAS bf16x8*)(vp_ + vaddr[ks] + (blk) * 4096)
#define EXP2N(X, lo) do { X[lo] = __builtin_amdgcn_exp2f(X[lo]); X[lo + 1] = __builtin_amdgcn_exp2f(X[lo + 1]); } while (0)
#define S2(C0, C1, vbuf) do { SBAR(); \
    const lcp vp_ = lds3 + (vbuf) * BUFB; \
    o[0] = MF(va[0], PB(pw0), o[0]); VRD1(va, 0, 2); EXP2N(C0, 0); PIN(C0); SBAR(); \
    o[0] = MF(va[1], PB(pw1), o[0]); VRD1(va, 1, 2); EXP2N(C0, 2); PIN(C0); SBAR(); \
    o[0] = MF(va[2], PB(pw2), o[0]); VRD1(va, 2, 2); EXP2N(C0, 4); PIN(C0); SBAR(); \
    o[0] = MF(va[3], PB(pw3), o[0]); VRD1(va, 3, 2); EXP2N(C0, 6); PIN(C0); SBAR(); \
    o[1] = MF(vb[0], PB(pw0), o[1]); VRD1(vb, 0, 3); EXP2N(C0, 8); PIN(C0); SBAR(); \
    o[1] = MF(vb[1], PB(pw1), o[1]); VRD1(vb, 1, 3); EXP2N(C0, 10); PIN(C0); SBAR(); \
    o[1] = MF(vb[2], PB(pw2), o[1]); VRD1(vb, 2, 3); EXP2N(C0, 12); PIN(C0); SBAR(); \
    o[1] = MF(vb[3], PB(pw3), o[1]); VRD1(vb, 3, 3); EXP2N(C0, 14); PIN(C0); SBAR(); \
    o[2] = MF(va[0], PB(pw0), o[2]); EXP2N(C1, 0); PIN(C1); SBAR(); \
    o[2] = MF(va[1], PB(pw1), o[2]); EXP2N(C1, 2); PIN(C1); SBAR(); \
    o[2] = MF(va[2], PB(pw2), o[2]); EXP2N(C1, 4); PIN(C1); SBAR(); \
    o[2] = MF(va[3], PB(pw3), o[2]); EXP2N(C1, 6); PIN(C1); SBAR(); \
    o[3] = MF(vb[0], PB(pw0), o[3]); EXP2N(C1, 8); PIN(C1); SBAR(); \
    o[3] = MF(vb[1], PB(pw1), o[3]); EXP2N(C1, 10); PIN(C1); SBAR(); \
    o[3] = MF(vb[2], PB(pw2), o[3]); EXP2N(C1, 12); PIN(C1); SBAR(); \
    o[3] = MF(vb[3], PB(pw3), o[3]); EXP2N(C1, 14); PIN(C1); SBAR(); \
    } while (0)
    pB0 = f32x16{}; pB1 = f32x16{};
    if (!pre) { DMA(0, 0); DMA(1, 1); BARV(); }
    if (isB) { BARV(); DMA(2, 2); }
    S1(pA0, pA1, pB0, pB1, 0, 0);
    if (!isB) { BARV(); DMA(2, 2); }
    { float pm_ = pA0[0];
#pragma unroll
      for (int r = 1; r < 16; ++r) pm_ = __builtin_fmaxf(pm_, pA0[r]);
#pragma unroll
      for (int r = 0; r < 16; ++r) pm_ = __builtin_fmaxf(pm_, pA1[r]);
      { auto rr_ = __builtin_amdgcn_permlane32_swap(__float_as_uint(pm_), __float_as_uint(pm_), false, false); pm_ = __builtin_fmaxf(__uint_as_float(rr_[0]), __uint_as_float(rr_[1])); }
      const float nm_ = -(pm_ + REF_MARGIN);
#pragma unroll
      for (int r = 0; r < 16; ++r) { negm[r] = nm_; pA0[r] = __builtin_amdgcn_exp2f(pA0[r] + nm_); pA1[r] = __builtin_amdgcn_exp2f(pA1[r] + nm_); }
      PIN(negm); }
    for (int j = 1; j < NTILE; j += 2) {
        if (isB) { BARV(); DMAT(j + 2); }
        S1(pB0, pB1, pA0, pA1, j & 3, (j - 1) & 3);
        if (!isB) { BARV(); DMAT(j + 2); }
        S2(pB0, pB1, (j - 1) & 3);
        if (isB) { BARV(); DMAT(j + 3); }
        { const int kt = (j + 1 < NTILE) ? j + 1 : NTILE - 1;
          S1(pA0, pA1, pB0, pB1, kt & 3, j & 3); }
        if (!isB) { BARV(); DMAT(j + 3); }
        S2(pA0, pA1, j & 3);
    }
    { auto rr_ = __builtin_amdgcn_permlane32_swap(__float_as_uint(l_reg), __float_as_uint(l_reg), false, false);
      const float rl = __builtin_amdgcn_rcpf(__uint_as_float(rr_[0]) + __uint_as_float(rr_[1]));
#pragma unroll
      for (int d = 0; d < 4; ++d) o[d] = o[d] * rl; }
    if (!has_next) BAR();
#undef DMA
#undef DMAX
#undef DMAT
#undef BAR
#undef BARV
#undef PIN
#undef MF
#undef PB
#undef PKW
#undef ADD6
#undef S1
#undef S2
#undef KRD
#undef VRD4
#undef VRD1
#undef EXP2N
}
__device__ __forceinline__ void attn_unit(const Args& a, int b, int h, int qb, float lam, char* lds, bool first, bool has_nu, int nb, int nh) {
    const bf16_t* Q = (const bf16_t*)(a.ws + WS_Q); const bf16_t* KA = (const bf16_t*)(a.ws + WS_K); const bf16_t* VT = (const bf16_t*)(a.ws + WS_V);
    const size_t qrow0 = (size_t)b * NT + (size_t)qb * 256, kvrow0 = (size_t)b * KVR;
    for (int m = 0; m < 2; ++m) {
        f32x16 o[4];
        const bf16_t* Kc = KA + kvrow0 * DM + (2 * h + m) * 64; const bf16_t* Vc = VT + (size_t)((b * NHD + h) * 128) * VT_PITCH;
        const bf16_t* Kn = m == 0 ? Kc + 64 : KA + (size_t)nb * KVR * DM + (2 * nh) * 64; const bf16_t* Vn = m == 0 ? Vc : VT + (size_t)((nb * NHD + nh) * 128) * VT_PITCH;
        attn_map(Q + qrow0 * DM + (2 * h + m) * 64, Kc, Vc, (long)(Kn - Kc), (long)(Vn - Vc), !(first && m == 0), m == 0 || has_nu, o, lds);
        int t2 = threadIdx.x; asm volatile("" : "+v"(t2));
        const int wid = t2 >> 6, lane = t2 & 63, r32 = lane & 31, hi = lane >> 5;
        float* o1p = (float*)(a.ws + WS_O1) + (size_t)blockIdx.x * (64 * 512) + t2;
        if (m == 0) {
#pragma unroll
            for (int d = 0; d < 4; ++d)
#pragma unroll
                for (int r = 0; r < 16; ++r) o1p[(d * 16 + r) * 512] = o[d][r];
        } else {
            float ss = 0.f;
#pragma unroll
            for (int d = 0; d < 4; ++d)
#pragma unroll
                for (int r = 0; r < 16; ++r) { const float v = o1p[(d * 16 + r) * 512] - lam * o[d][r]; o[d][r] = v; ss += v * v; }
            { auto rr_ = __builtin_amdgcn_permlane32_swap(__float_as_uint(ss), __float_as_uint(ss), false, false); ss = __uint_as_float(rr_[0]) + __uint_as_float(rr_[1]); }
            const float rstd = 0.8f / sqrtf(ss * (1.0f / 128.0f) + EPS);
            const float* gs = a.in[I_GSUB] + 4 * hi;
            bf16_t* aow = (bf16_t*)(a.ws + WS_ATTO) + (qrow0 + wid * QBLK + r32) * DM + h * 128 + 4 * hi;
#pragma unroll
            for (int d = 0; d < 4; ++d)
#pragma unroll
                for (int rg = 0; rg < 4; ++rg) { const f32x4 g = *(const f32x4*)(gs + 32 * d + 8 * rg);
                    u32x2 w; w.x = cvt_pk_bf16(o[d][4 * rg] * rstd * g[0], o[d][4 * rg + 1] * rstd * g[1]); w.y = cvt_pk_bf16(o[d][4 * rg + 2] * rstd * g[2], o[d][4 * rg + 3] * rstd * g[3]);
                    *(u32x2*)(aow + 32 * d + 8 * rg) = w; }
        }
    }
}
#undef KSWZ
#undef SBAR
}

struct SchedDual {
    const char *A0, *A1, *B0, *B1; int G, c;
    __device__ __forceinline__ bool next(int i, Unit& u) const {
        const int L = (i >> 1) * G + c; if (L >= 512) return false;
        pg8::tile_of(L, 128, 4, u.pm, u.pn); u.aux = i & 1; return true; }
    __device__ __forceinline__ const char* a_ptr(const Unit& u) const { return (u.aux ? A1 : A0) + (size_t)u.pm * (256 * DM * 2); }
    __device__ __forceinline__ const char* b_ptr(const Unit& u) const { return (u.aux ? B1 : B0) + (size_t)u.pn * (256 * DM * 2); }
    __device__ __forceinline__ bool keep(const Unit& u) const { return u.aux == 0; }
};
struct EpiDual {
    static constexpr bool PERM = true;
    const bf16_t *GA, *GC; const float* bc; bf16_t* MIX;
    __device__ __forceinline__ void operator()(f32x4 (&acc)[2][2][4][2], const Unit& u, int wr, int wc, int fr, int fq) const {
        const int col0 = u.pn * 256 + wc * 32 + 8 * fq;
        if (u.aux == 0) {
            u32x4 ga[2][2], gc[2][2];
#define EDL(i, g) do { const int ai_ = (g) >> 2, m_ = (g) & 3; const size_t off_ = (size_t)(u.pm * 256 + ai_ * 128 + wr * 64 + m_ * 16 + fr) * DM + col0; \
    ga[i][0] = *(const u32x4*)(GA + off_); ga[i][1] = *(const u32x4*)(GA + off_ + 128); gc[i][0] = *(const u32x4*)(GC + off_); gc[i][1] = *(const u32x4*)(GC + off_ + 128); } while (0)
            EDL(0, 0);
#pragma unroll
            for (int g = 0; g < 8; ++g) { const int ai = g >> 2, m = g & 3, cur = g & 1;
                if (g + 1 < 8) { if (cur) EDL(0, g + 1); else EDL(1, g + 1); }
#pragma unroll
                for (int bj = 0; bj < 2; ++bj) { const u32x4 a4 = ga[cur][bj], c4 = gc[cur][bj];
                    f32x4 r0, r1;
                    r0[0] = bf_lo(a4.x) * __builtin_amdgcn_rcpf(bf_lo(c4.x)); r0[1] = bf_hi(a4.x) * __builtin_amdgcn_rcpf(bf_hi(c4.x));
                    r0[2] = bf_lo(a4.y) * __builtin_amdgcn_rcpf(bf_lo(c4.y)); r0[3] = bf_hi(a4.y) * __builtin_amdgcn_rcpf(bf_hi(c4.y));
                    r1[0] = bf_lo(a4.z) * __builtin_amdgcn_rcpf(bf_lo(c4.z)); r1[1] = bf_hi(a4.z) * __builtin_amdgcn_rcpf(bf_hi(c4.z));
                    r1[2] = bf_lo(a4.w) * __builtin_amdgcn_rcpf(bf_lo(c4.w)); r1[3] = bf_hi(a4.w) * __builtin_amdgcn_rcpf(bf_hi(c4.w));
                    acc[ai][bj][m][0] *= r0; acc[ai][bj][m][1] *= r1; }
                asm volatile("" ::: "memory"); }
#undef EDL
            return;
        }
        f32x4 bv[2][2];
#pragma unroll
        for (int bj = 0; bj < 2; ++bj)
#pragma unroll
            for (int n = 0; n < 2; ++n) bv[bj][n] = *(const f32x4*)(bc + col0 + bj * 128 + 4 * n);
        u32x4 gc[2][2];
#define EDL(i, g) do { const int ai_ = (g) >> 2, m_ = (g) & 3; const size_t off_ = (size_t)(u.pm * 256 + ai_ * 128 + wr * 64 + m_ * 16 + fr) * DM + col0; \
    gc[i][0] = *(const u32x4*)(GC + off_); gc[i][1] = *(const u32x4*)(GC + off_ + 128); } while (0)
        EDL(0, 0);
#pragma unroll
        for (int g = 0; g < 8; ++g) { const int ai = g >> 2, m = g & 3, cur = g & 1;
            if (g + 1 < 8) { if (cur) EDL(0, g + 1); else EDL(1, g + 1); }
            const size_t off = (size_t)(u.pm * 256 + ai * 128 + wr * 64 + m * 16 + fr) * DM + col0;
#pragma unroll
            for (int bj = 0; bj < 2; ++bj) { const u32x4 c4 = gc[cur][bj];
                const f32x4 v0 = acc[ai][bj][m][0] + bv[bj][0], v1 = acc[ai][bj][m][1] + bv[bj][1];
                u32x4 w; w.x = cvt_pk_bf16(v0[0] * bf_lo(c4.x), v0[1] * bf_hi(c4.x)); w.y = cvt_pk_bf16(v0[2] * bf_lo(c4.y), v0[3] * bf_hi(c4.y));
                w.z = cvt_pk_bf16(v1[0] * bf_lo(c4.z), v1[1] * bf_hi(c4.z)); w.w = cvt_pk_bf16(v1[2] * bf_lo(c4.w), v1[3] * bf_hi(c4.w));
                *(u32x4*)(MIX + off + bj * 128) = w; }
            asm volatile("" ::: "memory"); }
#undef EDL
    }
};

struct SchedPlain {
    const char* A; const char* Bt; int G, c, nM, nN, RB, bgrp;
    __device__ __forceinline__ bool next(int i, Unit& u) const {
        const int L = i * G + c; if (L >= nM * nN) return false;
        pg8::tile_of(L, nM, nN, u.pm, u.pn); u.aux = 0; return true; }
    __device__ __forceinline__ const char* a_ptr(const Unit& u) const { return A + (size_t)u.pm * ((size_t)256 * RB); }
    __device__ __forceinline__ const char* b_ptr(const Unit& u) const { return Bt + (size_t)((u.pm >> 4) * nN * bgrp + u.pn) * ((size_t)256 * RB); }
    __device__ __forceinline__ bool keep(const Unit&) const { return false; }
};
struct EpiResid {
    static constexpr bool PERM = false;
    const float* x; const float* mod; float* out;
    __device__ __forceinline__ void operator()(f32x4 (&acc)[2][2][4][2], const Unit& u, int wr, int wc, int fr, int fq) const {
        const int col0 = u.pn * 256 + wc * 32 + 4 * fq; const float* gm = mod + (size_t)(u.pm >> 4) * NMOD + 2048 + col0;
        f32x4 gv[2][2];
#pragma unroll
        for (int bj = 0; bj < 2; ++bj)
#pragma unroll
            for (int n = 0; n < 2; ++n) gv[bj][n] = *(const f32x4*)(gm + bj * 128 + n * 16);
        f32x4 xv[2][2][2];
#define ERL(i, g) do { const int ai_ = (g) >> 2, m_ = (g) & 3; const size_t off_ = (size_t)(u.pm * 256 + ai_ * 128 + wr * 64 + m_ * 16 + fr) * DM + col0; \
    _Pragma("unroll") for (int bj_ = 0; bj_ < 2; ++bj_) _Pragma("unroll") for (int n_ = 0; n_ < 2; ++n_) xv[i][bj_][n_] = __builtin_nontemporal_load((const f32x4*)(x + off_ + bj_ * 128 + n_ * 16)); } while (0)
        ERL(0, 0);
#pragma unroll
        for (int g = 0; g < 8; ++g) { const int ai = g >> 2, m = g & 3, cur = g & 1;
            if (g + 1 < 8) { if (cur) ERL(0, g + 1); else ERL(1, g + 1); }
            const size_t off = (size_t)(u.pm * 256 + ai * 128 + wr * 64 + m * 16 + fr) * DM + col0;
#pragma unroll
            for (int bj = 0; bj < 2; ++bj)
#pragma unroll
                for (int n = 0; n < 2; ++n) *(f32x4*)(out + off + bj * 128 + n * 16) = xv[cur][bj][n] + gv[bj][n] * acc[ai][bj][m][n];
            asm volatile("" ::: "memory"); }
#undef ERL
    }
};

__device__ __forceinline__ void ph_router(const Args& a, LAS unsigned char* lds, int gw, int NGW, int lane) {
    LAS float* wrt = (LAS float*)lds;
    const float* wr = a.in[I_WR];
    for (int i = threadIdx.x; i < DM * NEXP; i += 512) { const int k = i >> 4, e = i & 15; wrt[e * DM + k] = wr[i]; }
    __syncthreads();
    const float* mod = (const float*)(a.ws + WS_MOD); const float* g = a.in[I_GFFN];
    unsigned char* HF = (unsigned char*)(a.ws + WS_HF); float* AFF = (float*)(a.ws + WS_AFF);
    f32x4 gs[4], shv[4]; int cur_b = -1;
    f32x4 nx[4];
    { const f32x4* xr = (const f32x4*)(a.out + (size_t)gw * DM) + lane;
#pragma unroll
      for (int j = 0; j < 4; ++j) nx[j] = __builtin_nontemporal_load(xr + 64 * j); }
    for (int row = gw; row < MLAT; row += NGW) {
        f32x4 v[4]; float s = 0.f;
#pragma unroll
        for (int j = 0; j < 4; ++j) { v[j] = nx[j]; s += (v[j].x * v[j].x + v[j].y * v[j].y) + (v[j].z * v[j].z + v[j].w * v[j].w); }
        if (row + NGW < MLAT) { const f32x4* xr = (const f32x4*)(a.out + (size_t)(row + NGW) * DM) + lane;
#pragma unroll
            for (int j = 0; j < 4; ++j) nx[j] = __builtin_nontemporal_load(xr + 64 * j); }
        if ((row >> 12) != cur_b) { cur_b = row >> 12; const float* mb = mod + (size_t)cur_b * NMOD + 3072;
#pragma unroll
            for (int j = 0; j < 4; ++j) { const int c = 4 * lane + 256 * j; gs[j] = *(const f32x4*)(g + c) * (*(const f32x4*)(mb + 1024 + c) + 1.0f); shv[j] = *(const f32x4*)(mb + c); } }
        const float rstd = 1.0f / sqrtf(wave_sum(s) * (1.0f / DM) + EPS);
        unsigned* o4 = (unsigned*)(HF + (size_t)row * DM) + lane;
#pragma unroll
        for (int j = 0; j < 4; ++j) { v[j] = (v[j] * rstd) * gs[j] + shv[j];
            o4[64 * j] = pack4_fp8(v[j].x, v[j].y, v[j].z, v[j].w); }
        float p[16];
#pragma unroll
        for (int e = 0; e < 16; ++e) { float t = 0.f;
#pragma unroll
            for (int j = 0; j < 4; ++j) { const f32x4 wv = *(const LAS f32x4*)(wrt + e * DM + 4 * lane + 256 * j); t += (v[j].x * wv.x + v[j].y * wv.y) + (v[j].z * wv.z + v[j].w * wv.w); }
            p[e] = t; if ((e & 3) == 3) __builtin_amdgcn_sched_barrier(0); }
        float r8[8], r4[4], r2[2], r1;
        { const bool up = (lane & 32) != 0;
#pragma unroll
          for (int i = 0; i < 8; ++i) { const float send = up ? p[i] : p[i + 8], keepv = up ? p[i + 8] : p[i]; r8[i] = keepv + __shfl_xor(send, 32); } }
        { const bool up = (lane & 16) != 0;
#pragma unroll
          for (int i = 0; i < 4; ++i) { const float send = up ? r8[i] : r8[i + 4], keepv = up ? r8[i + 4] : r8[i]; r4[i] = keepv + __shfl_xor(send, 16); } }
        { const bool up = (lane & 8) != 0;
#pragma unroll
          for (int i = 0; i < 2; ++i) { const float send = up ? r4[i] : r4[i + 2], keepv = up ? r4[i + 2] : r4[i]; r2[i] = keepv + __shfl_xor(send, 8); } }
        { const bool up = (lane & 4) != 0; const float send = up ? r2[0] : r2[1], keepv = up ? r2[1] : r2[0]; r1 = keepv + __shfl_xor(send, 4); }
        r1 += __shfl_xor(r1, 2); r1 += __shfl_xor(r1, 1);
        float mx = r1;
#pragma unroll
        for (int o = 4; o < 64; o <<= 1) mx = fmaxf(mx, __shfl_xor(mx, o));
        const float ex = expf(r1 - mx); float sm = ex;
#pragma unroll
        for (int o = 4; o < 64; o <<= 1) sm += __shfl_xor(sm, o);
        if ((lane & 3) == 0) AFF[(size_t)row * NEXP + (lane >> 2)] = ex / sm;
    }
}

__device__ __forceinline__ void ph_topk_unit(const Args& a, LAS unsigned char* lds, int g  ) {
    const int tid = threadIdx.x, lane = tid & 63, wave = __builtin_amdgcn_readfirstlane(tid >> 6);
    const int b = g >> 4, e = g & 15;
    LAS unsigned long long* S = (LAS unsigned long long*)lds;
    const float* AFF = (const float*)(a.ws + WS_AFF) + (size_t)b * NT * NEXP + e;
    for (int t = tid; t < NT; t += 512) S[t] = ((unsigned long long)__float_as_uint(AFF[(size_t)t * NEXP]) << 32) | (unsigned long long)(0xFFFFFFFFu - (unsigned)t);
    __syncthreads();
    for (int k = 2; k <= NT; k <<= 1)
        for (int j = k >> 1; j > 0; j >>= 1) {
#pragma unroll
            for (int q = 0; q < 4; ++q) { const int t = tid + 512 * q; const int i = 2 * t - (t & (j - 1)), l = i + j;
                const unsigned long long x = S[i], y = S[l]; const bool desc = (i & k) == 0;
                if ((x < y) == desc) { S[i] = y; S[l] = x; } }
            __syncthreads();
        }
    int* SEL = (int*)(a.ws + WS_SEL) + (size_t)b * NT * NEXP + e;
    for (int s = tid; s < NT; s += 512) { const unsigned tok = 0xFFFFFFFFu - (unsigned)S[s]; SEL[(size_t)tok * NEXP] = (s < CAP) ? s : -1; }
    const unsigned char* HF = (const unsigned char*)(a.ws + WS_HF) + (size_t)b * NT * DM;
    unsigned char* XS = (unsigned char*)(a.ws + WS_XS) + (size_t)(e * NB + b) * CAP * DM;
    for (int k = 0; k < 64; k += 8) {
        u32x4 v[8];
#pragma unroll
        for (int q = 0; q < 8; ++q) { const int s = wave * 64 + k + q; const unsigned tok = 0xFFFFFFFFu - (unsigned)S[s];
            v[q] = ((const u32x4*)(HF + (size_t)tok * DM))[lane]; }
#pragma unroll
        for (int q = 0; q < 8; ++q) { const int s = wave * 64 + k + q; ((u32x4*)(XS + (size_t)s * DM))[lane] = v[q]; }
    }
    __syncthreads();
}

struct EpiSwiGLU {
    static constexpr bool PERM = true;
    unsigned char* HID;
    __device__ __forceinline__ void operator()(f32x4 (&acc)[2][2][4][2], const Unit& u, int wr, int wc, int fr, int fq) const {
        const int col0 = u.pn * 128 + wc * 32 + 8 * fq;
#pragma unroll
        for (int ai = 0; ai < 2; ++ai)
#pragma unroll
            for (int m = 0; m < 4; ++m) { const size_t r = (size_t)u.pm * 256 + ai * 128 + wr * 64 + m * 16 + fr;
                const f32x4 g0 = acc[ai][0][m][0] * WSCALE_INV, g1 = acc[ai][0][m][1] * WSCALE_INV, u0 = acc[ai][1][m][0] * WSCALE_INV, u1 = acc[ai][1][m][1] * WSCALE_INV;
                u32x2 w; w.x = pack4_fp8(g0[0] * sigmoidf_(g0[0]) * u0[0], g0[1] * sigmoidf_(g0[1]) * u0[1], g0[2] * sigmoidf_(g0[2]) * u0[2], g0[3] * sigmoidf_(g0[3]) * u0[3]);
                w.y = pack4_fp8(g1[0] * sigmoidf_(g1[0]) * u1[0], g1[1] * sigmoidf_(g1[1]) * u1[1], g1[2] * sigmoidf_(g1[2]) * u1[2], g1[3] * sigmoidf_(g1[3]) * u1[3]);
                *(u32x2*)(HID + r * DFF + col0) = w; }
    }
};
struct EpiPlainBf16 {
    static constexpr bool PERM = true;
    bf16_t* O; int ldc; float scale;
    __device__ __forceinline__ void operator()(f32x4 (&acc)[2][2][4][2], const Unit& u, int wr, int wc, int fr, int fq) const {
        const int col0 = u.pn * 256 + wc * 32 + 8 * fq;
#pragma unroll
        for (int ai = 0; ai < 2; ++ai)
#pragma unroll
            for (int m = 0; m < 4; ++m) { bf16_t* rowp = O + ((size_t)u.pm * 256 + ai * 128 + wr * 64 + m * 16 + fr) * ldc + col0;
#pragma unroll
                for (int bj = 0; bj < 2; ++bj) { const f32x4 v0 = acc[ai][bj][m][0] * scale, v1 = acc[ai][bj][m][1] * scale;
                    u32x4 w; w.x = cvt_pk_bf16(v0[0], v0[1]); w.y = cvt_pk_bf16(v0[2], v0[3]); w.z = cvt_pk_bf16(v1[0], v1[1]); w.w = cvt_pk_bf16(v1[2], v1[3]);
                    *(u32x4*)(rowp + bj * 128) = w; } }
    }
};

__device__ __forceinline__ void ph_final(const Args& a, int gw, int NGW, int lane) {
    const float* mod = (const float*)(a.ws + WS_MOD); const float* gfin = a.in[I_GFIN];
    const float* AFF = (const float*)(a.ws + WS_AFF); const int* SEL = (const int*)(a.ws + WS_SEL); const bf16_t* YS = (const bf16_t*)(a.ws + WS_YS);
    const int per = MLAT / NGW, r0 = gw * per, b = r0 >> 12;
    f32x4 gfv[2][2], gnv[2][2];
    { const float* gf = mod + (size_t)b * NMOD + 5120;
#pragma unroll
      for (int jj = 0; jj < 2; ++jj)
#pragma unroll
          for (int q = 0; q < 2; ++q) { const int c = 8 * lane + 512 * jj + 4 * q; gfv[jj][q] = *(const f32x4*)(gf + c); gnv[jj][q] = *(const f32x4*)(gfin + c); } }
    for (int row = r0; row < r0 + per; ++row) {
        float* xr = a.out + (size_t)row * DM;
        const int selv = (lane < 16) ? SEL[(size_t)row * NEXP + lane] : -1; const float affv = (lane < 16) ? AFF[(size_t)row * NEXP + lane] : 0.f;
        f32x4 acc[2][2];
#pragma unroll
        for (int jj = 0; jj < 2; ++jj) { acc[jj][0] = (f32x4){0.f, 0.f, 0.f, 0.f}; acc[jj][1] = (f32x4){0.f, 0.f, 0.f, 0.f}; }
#pragma unroll
        for (int e = 0; e < NEXP; ++e) { const int s = __builtin_amdgcn_readlane(selv, e); const float gt = __uint_as_float(__builtin_amdgcn_readlane(__float_as_uint(affv), e));
            if (s >= 0) { const bf16_t* yr = YS + ((size_t)(e * NB + b) * CAP + s) * DM;
#pragma unroll
                for (int jj = 0; jj < 2; ++jj) { const u32x4 y = *(const u32x4*)(yr + 8 * lane + 512 * jj);
                    acc[jj][0] += gt * (f32x4){bf_lo(y.x), bf_hi(y.x), bf_lo(y.y), bf_hi(y.y)}; acc[jj][1] += gt * (f32x4){bf_lo(y.z), bf_hi(y.z), bf_lo(y.w), bf_hi(y.w)}; } } }
        f32x4 v[2][2]; float ss = 0.f;
#pragma unroll
        for (int jj = 0; jj < 2; ++jj)
#pragma unroll
            for (int q = 0; q < 2; ++q) { const int c = 8 * lane + 512 * jj + 4 * q;
                v[jj][q] = __builtin_nontemporal_load((const f32x4*)(xr + c)) + gfv[jj][q] * acc[jj][q];
                ss += (v[jj][q].x * v[jj][q].x + v[jj][q].y * v[jj][q].y) + (v[jj][q].z * v[jj][q].z + v[jj][q].w * v[jj][q].w); }
        const float rstd = 1.0f / sqrtf(wave_sum(ss) * (1.0f / DM) + EPS);
#pragma unroll
        for (int jj = 0; jj < 2; ++jj)
#pragma unroll
            for (int q = 0; q < 2; ++q) { const int c = 8 * lane + 512 * jj + 4 * q; __builtin_nontemporal_store(v[jj][q] * rstd * gnv[jj][q], (f32x4*)(xr + c)); }
    }
}

constexpr int N_PHASES = 12;
#ifndef MK_ATTN_REPS
#define MK_ATTN_REPS 1
#endif
struct Ctx { LAS unsigned char* lds; char* lds_gen; int G, bid, vcu, gw, NGW, wave, lane; };
template <int P> __device__ __forceinline__ void run_phase(const Args& args, const Ctx& c) {
    LAS unsigned char* lds = c.lds; const int G = c.G, bid = c.bid, vcu = c.vcu, gw = c.gw, NGW = c.NGW, wave = c.wave, lane = c.lane;
    if constexpr (P == 0) {
        ph_adaln(args, lds, bid, G);
        if (bid == G - 1) ph_rope_table(args);
        ph_small_weights(args, lds, gw, NGW, wave, lane);
    }
    if constexpr (P == 1) ph_norm_rows(args, gw, NGW, lane);
    if constexpr (P == 2) {
        SchedInProj S{(const char*)(args.ws + WS_H), (const char*)(args.ws + WS_WIN), G, bid};
        EpiInProj E{(bf16_t*)(args.ws + WS_U), (bf16_t*)(args.ws + WS_Q), (bf16_t*)(args.ws + WS_K), (bf16_t*)(args.ws + WS_V), (bf16_t*)(args.ws + WS_GC), (bf16_t*)(args.ws + WS_GA), (const float*)(args.ws + WS_ROPE)};
        pg8::gemm_phase<EpiInProj, SchedInProj, PG8_ALIGN, PG8_SP2>(lds, DM * 2, S, E);
    }
    if constexpr (P == 3) {
#ifndef MK_NO_CONV
        for (int u = vcu; u < 256; u += G) ph_conv_unit(args, lds, u);
        __syncthreads();
#endif
#ifndef MK_NO_ATTN
        float lam;
        { const float s1 = wave_sum(args.in[I_LQ1][lane] * args.in[I_LK1][lane]), s2 = wave_sum(args.in[I_LQ2][lane] * args.in[I_LK2][lane]); lam = __uint_as_float(__builtin_amdgcn_readfirstlane(__float_as_uint(expf(s1) - expf(s2) + 0.2f))); }
#if defined(MK_PROBE_CLOCK)
        const unsigned long long pc0_ = __builtin_amdgcn_s_memtime(), pr0_ = __builtin_amdgcn_s_memrealtime();
#endif
        for (int i = 0; i < 4 * MK_ATTN_REPS; ++i) { const int u = (i & 3) * 256 + vcu; if (u >= 1024) break;
            const int un = ((i + 1) & 3) * 256 + vcu; const bool has_nu = (i + 1 < 4 * MK_ATTN_REPS) && un < 1024;
            att::attn_unit(args, u >> 7, (u >> 4) & 7, u & 15, lam, c.lds_gen, i == 0, has_nu, un >> 7, (un >> 4) & 7); }
#if defined(MK_PROBE_CLOCK)
        { const unsigned long long pc1_ = __builtin_amdgcn_s_memtime(), pr1_ = __builtin_amdgcn_s_memrealtime();
          if (threadIdx.x == 0) { volatile LAS unsigned* mw = (volatile LAS unsigned*)(c.lds + LDSCTL_OFF); mw[16] = (unsigned)(pc1_ - pc0_); mw[17] = (unsigned)(pr1_ - pr0_);
              unsigned* pw_ = (unsigned*)(args.ws + WS_CTL) + 15000;
              atomicMax(pw_, (unsigned)(pr1_ - pr0_)); atomicAdd(pw_ + 1, (unsigned)(pr1_ - pr0_)); atomicMax(pw_ + 2, 0xFFFFFFFFu - (unsigned)(pr1_ - pr0_)); } }
#endif
#endif
    }
    if constexpr (P == 4) {
        SchedDual S{(const char*)(args.ws + WS_ATTO), (const char*)(args.ws + WS_CACT), (const char*)(args.ws + WS_WAO), (const char*)(args.ws + WS_WCO), G, bid};
        EpiDual E{(const bf16_t*)(args.ws + WS_GA), (const bf16_t*)(args.ws + WS_GC), args.in[I_BCO], (bf16_t*)(args.ws + WS_MIX)};
        pg8::gemm_phase<EpiDual, SchedDual, PG8_ALIGN, PG8_SP2>(lds, DM * 2, S, E);
    }
    if constexpr (P == 5) {
        SchedPlain S{(const char*)(args.ws + WS_MIX), (const char*)(args.ws + WS_WO), G, bid, 128, 4, DM * 2, 0};
        EpiResid E{args.in[I_X], (const float*)(args.ws + WS_MOD), args.out};
        pg8::gemm_phase<EpiResid, SchedPlain, PG8_ALIGN, PG8_SP2>(lds, DM * 2, S, E);
    }
    if constexpr (P == 6) {
        ph_router(args, lds, gw, NGW, lane);
        __syncthreads();
        ph_wgu(args, lds, gw, NGW, wave, lane);
    }
    if constexpr (P == 7) {
        if (G < 2) { for (int g = 0; g < NB * NEXP; ++g) ph_topk_unit(args, lds, g); __syncthreads(); ph_wd(args, lds, wave, 8, wave, lane); }
        else if ((vcu & 1) == 0) { for (int g = vcu >> 1; g < NB * NEXP; g += (G + 1) / 2) ph_topk_unit(args, lds, g); }
        else ph_wd(args, lds, (vcu >> 1) * 8 + wave, (G / 2) * 8, wave, lane);
    }
    if constexpr (P == 8) {
        SchedPlain S{(const char*)(args.ws + WS_XS), (const char*)(args.ws + WS_WGU), G, bid, 256, 22, DM, 1};
        EpiSwiGLU E{(unsigned char*)(args.ws + WS_HID)};
        pg8::gemm_phase<EpiSwiGLU, SchedPlain, PG8_ALIGN, PG8_SP2, true>(lds, DM, S, E);
    }
    if constexpr (P == 10) {
        SchedPlain S{(const char*)(args.ws + WS_HID), (const char*)(args.ws + WS_WD), G, bid, 256, 4, DFF, 1};
        EpiPlainBf16 E{(bf16_t*)(args.ws + WS_YS), DM, WSCALE_INV};
        pg8::gemm_phase<EpiPlainBf16, SchedPlain, PG8_ALIGN, PG8_SP2, true>(lds, DFF, S, E);
    }
    if constexpr (P == 11) ph_final(args, gw, NGW, lane);
}
#ifndef MK_PHASE_MASK
#define MK_PHASE_MASK 0xFFF
#endif
#ifndef MK_REPEAT_MASK
#define MK_REPEAT_MASK 0
#endif
__global__ void __launch_bounds__(512, 2) mk_fwd(Args args) {
    extern __shared__ __attribute__((aligned(16))) unsigned char lds_raw[];
    LAS unsigned char* lds = (LAS unsigned char*)lds_raw;
    const int tid = threadIdx.x;
    Ctx c; c.lds = lds; c.lds_gen = (char*)lds_raw; c.lane = tid & 63; c.wave = __builtin_amdgcn_readfirstlane(tid >> 6);
    c.G = gridDim.x; c.bid = blockIdx.x;
    c.vcu = (c.G % 8 == 0) ? (c.bid % 8) * (c.G / 8) + c.bid / 8 : c.bid;
    c.gw = c.vcu * 8 + c.wave; c.NGW = c.G * 8;
    volatile LAS unsigned* misc = (volatile LAS unsigned*)(lds + LDSCTL_OFF);
    if (tid < 64) misc[tid] = 0u;
    __syncthreads();
#if defined(MK_PROBE_TS)
    const unsigned long long kstart_ = __builtin_amdgcn_s_memrealtime();
#endif
    const int lo = args.ph_lo, hi = args.ph_hi;
    XcdBarrier bar; bar.bar = (unsigned*)(args.ws + WS_CTL) + 1024 + args.li * XCD_BAR_WORDS; bar.x = 0; bar.st = nullptr;
    if (hi - lo > 1) bar = xcd_barrier_post((unsigned*)(args.ws + WS_CTL) + 1024 + args.li * XCD_BAR_WORDS, misc + 8);
#define IN(k) (((MK_PHASE_MASK >> (k)) & 1) && lo <= (k) && (k) < hi)
#if defined(MK_PROBE_PHASE)
#define PH_T0() const unsigned long long pt0_ = __builtin_amdgcn_s_memrealtime()
#define PH_T1(k) do { const unsigned long long pt1_ = __builtin_amdgcn_s_memrealtime(); if (threadIdx.x == 0) atomicMax((unsigned*)(args.ws + WS_CTL) + 15100 + (k), (unsigned)(pt1_ - pt0_)); } while (0)
#else
#define PH_T0() do { } while (0)
#define PH_T1(k) do { } while (0)
#endif
#if defined(MK_PROBE_BAR)
#define PB_T0() const unsigned long long bt0_ = __builtin_amdgcn_s_memrealtime()
#define PB_T1(k) do { const unsigned long long bt1_ = __builtin_amdgcn_s_memrealtime(); if (threadIdx.x == 0) atomicMax((unsigned*)(args.ws + WS_CTL) + 15200 + (k), 0xFFFFFFFFu - (unsigned)(bt1_ - bt0_)); } while (0)
#else
#define PB_T0() do { } while (0)
#define PB_T1(k) do { } while (0)
#endif
#if defined(MK_PROBE_TS)
#define PH_TS(k) do { if ((k) == MK_PROBE_TS && blockIdx.x == 0 && threadIdx.x == 0) misc[20] = (unsigned)(__builtin_amdgcn_s_memrealtime() - kstart_); } while (0)
#else
#define PH_TS(k) do { } while (0)
#endif
#define PHASE(k) do { PH_TS(k); if (IN(k)) { PH_T0(); run_phase<k>(args, c); if constexpr ((MK_REPEAT_MASK >> (k)) & 1) { __syncthreads(); run_phase<k>(args, c); } PH_T1(k); PH_TS((k) + 100); } \
                      if ((k) != 9 && (k) + 1 < N_PHASES && IN(k) && IN((k) + 1)) { PB_T0(); xcd_barrier(bar); PB_T1(k); } } while (0)
    PHASE(0); PHASE(1); PHASE(2); PHASE(3); PHASE(4); PHASE(5); PHASE(6); PHASE(7); PHASE(8); PHASE(9); PHASE(10); PHASE(11);
#if defined(MK_PROBE_TS)
    PH_TS(12);
    if (blockIdx.x == 0 && threadIdx.x == 0) {
        const unsigned long long wait_ticks = misc[20];
        const unsigned long long w0 = __builtin_amdgcn_s_memrealtime();
        while (__builtin_amdgcn_s_memrealtime() - w0 < wait_ticks) __builtin_amdgcn_s_sleep(8);
    }
#endif
#if defined(MK_PROBE_BAR)
    if (blockIdx.x == 0 && threadIdx.x == 0) {
        unsigned long long wait_ticks = 0;
        for (int k = 0; k < 10; ++k) { const unsigned v = __hip_atomic_load((unsigned*)(args.ws + WS_CTL) + 15200 + k, __ATOMIC_RELAXED, __HIP_MEMORY_SCOPE_AGENT); if (v) wait_ticks += 0xFFFFFFFFu - v; }
        wait_ticks *= 10;
        const unsigned long long w0 = __builtin_amdgcn_s_memrealtime();
        while (__builtin_amdgcn_s_memrealtime() - w0 < wait_ticks) __builtin_amdgcn_s_sleep(8);
    }
#endif
#if defined(MK_PROBE_PHASE)
    if (blockIdx.x == 0 && threadIdx.x == 0) {
        const unsigned long long wait_ticks = __hip_atomic_load((unsigned*)(args.ws + WS_CTL) + 15100 + MK_PROBE_PHASE, __ATOMIC_RELAXED, __HIP_MEMORY_SCOPE_AGENT);
        const unsigned long long w0 = __builtin_amdgcn_s_memrealtime();
        while (__builtin_amdgcn_s_memrealtime() - w0 < wait_ticks) __builtin_amdgcn_s_sleep(8);
    }
#endif
#if defined(MK_PROBE_CLOCK)
    if (blockIdx.x == 0 && threadIdx.x == 0) {
        const unsigned dc = misc[16], dr = misc[17];
        unsigned* pw_ = (unsigned*)(args.ws + WS_CTL) + 15000;
        const unsigned long long wait_ticks = (MK_PROBE_CLOCK == 1) ? (unsigned long long)(((double)dc / (double)dr) * 0.1 * 500.0 * 100.0) : (MK_PROBE_CLOCK == 2) ? (unsigned long long)dr
            : (MK_PROBE_CLOCK == 3) ? (unsigned long long)__hip_atomic_load(pw_, __ATOMIC_RELAXED, __HIP_MEMORY_SCOPE_AGENT)
            : (MK_PROBE_CLOCK == 4) ? (unsigned long long)(__hip_atomic_load(pw_ + 1, __ATOMIC_RELAXED, __HIP_MEMORY_SCOPE_AGENT) / gridDim.x)
            : (unsigned long long)(0xFFFFFFFFu - __hip_atomic_load(pw_ + 2, __ATOMIC_RELAXED, __HIP_MEMORY_SCOPE_AGENT));
        const unsigned long long w0 = __builtin_amdgcn_s_memrealtime();
        while (__builtin_amdgcn_s_memrealtime() - w0 < wait_ticks) __builtin_amdgcn_s_sleep(8);
    }
#endif
#undef IN
#undef PHASE
}

extern "C" void kernel_launch(void* const* d_in, const int* in_sizes, int n_in, void* d_out, int out_size, void* d_ws, size_t ws_size, hipStream_t stream) {
    static int grid = 0;
    if (grid == 0) {
        if (n_in != N_IN || out_size != MLAT * DM || ws_size < WS_END) { fprintf(stderr, "kernel_launch: unexpected shapes: n_in %d out %d ws %zu (need %zu)\n", n_in, out_size, ws_size, (size_t)WS_END); grid = -1; return; }
        int dev = 0, cus = 0, per_cu = 0;
        if (hipGetDevice(&dev) != hipSuccess || hipDeviceGetAttribute(&cus, hipDeviceAttributeMultiprocessorCount, dev) != hipSuccess) { grid = -1; return; }
        if (hipFuncSetAttribute((const void*)mk_fwd, hipFuncAttributeMaxDynamicSharedMemorySize, LDS_BYTES) != hipSuccess) { fprintf(stderr, "kernel_launch: hipFuncSetAttribute failed\n"); grid = -1; return; }
        if (hipOccupancyMaxActiveBlocksPerMultiprocessor(&per_cu, (const void*)mk_fwd, 512, LDS_BYTES) != hipSuccess || per_cu < 1) fprintf(stderr, "kernel_launch: occupancy query reports %d\n", per_cu);
        (void)hipGetLastError();
        grid = cus;
    }
    if (grid < 0) return;
    if (hipMemsetAsync((char*)d_ws + WS_CTL, 0, CTL_ZERO_BYTES, stream) != hipSuccess) return;
    Args a{};
    for (int i = 0; i < N_IN; ++i) a.in[i] = (const float*)d_in[i];
    a.out = (float*)d_out; a.ws = (unsigned char*)d_ws;
    constexpr int NL = MK_N_LAUNCHES;
    for (int li = 0; li < NL; ++li) {
        a.ph_lo = (NL == N_PHASES) ? li : (li * N_PHASES) / NL; a.ph_hi = (NL == N_PHASES) ? li + 1 : ((li + 1) * N_PHASES) / NL; a.li = (NL == N_PHASES) ? 0 : li; a.pad = 0;
        hipLaunchKernelGGL(mk_fwd, dim3(grid), dim3(512), LDS_BYTES, stream, a);
    }
}
```

```cpp
#include <hip/hip_runtime.h>
#include <cstdio>
#include <cstdint>

#ifndef MK_N_LAUNCHES
#define MK_N_LAUNCHES 1
#endif

#define LAS __attribute__((address_space(3)))
typedef unsigned short bf16_t;
typedef short bf16x8 __attribute__((ext_vector_type(8)));
typedef short s16x4 __attribute__((ext_vector_type(4)));
typedef float f32x2 __attribute__((ext_vector_type(2)));
typedef float f32x4 __attribute__((ext_vector_type(4)));
typedef float f32x16 __attribute__((ext_vector_type(16)));
typedef unsigned u32x2 __attribute__((ext_vector_type(2)));
typedef unsigned u32x4 __attribute__((ext_vector_type(4)));
typedef int i32x4 __attribute__((ext_vector_type(4)));
typedef int i32x8 __attribute__((ext_vector_type(8)));

constexpr int NB = 8, NT = 4096, DM = 1024, NCX = 256, NHD = 8, NEXP = 16, CAP = 512, DFF = 2816;
constexpr int MLAT = NB * NT, MCTX = NB * NCX, MALL = MLAT + MCTX, KVR = NT + NCX;
constexpr int NPROJ = 7168, NMOD = 6 * DM;
constexpr float EPS = 1e-6f;
constexpr float QSCALE = 0.125f * 1.4426950408889634f;

constexpr size_t MiB = 1u << 20;
constexpr size_t WS_CTL = 0, CTL_ZERO_BYTES = 65536;
constexpr size_t WS_MOD = 65536;
constexpr size_t WS_ROPE = 294912;
constexpr size_t WS_AFF = 1 * MiB;
constexpr size_t WS_SEL = 3 * MiB;
constexpr size_t WS_WIN = 8 * MiB, WS_WCO = 22 * MiB, WS_WAO = 24 * MiB, WS_WO = 26 * MiB;
constexpr size_t WS_H = 28 * MiB;
constexpr size_t WS_ATTO = 28 * MiB;
constexpr size_t WS_U = 96 * MiB;
constexpr size_t WS_MIX = 96 * MiB;
constexpr size_t WS_Q = 160 * MiB;
constexpr size_t WS_K = 224 * MiB;
constexpr size_t WS_V = 292 * MiB;
constexpr size_t WS_GC = 360 * MiB, WS_GA = 424 * MiB;
constexpr size_t WS_CACT = 488 * MiB;
constexpr size_t WS_O1 = 552 * MiB;
constexpr size_t WS_WGU = 8 * MiB;
constexpr size_t WS_XS = 96 * MiB;
constexpr size_t WS_HF = 160 * MiB;
constexpr size_t WS_HID = 192 * MiB;
constexpr size_t WS_WD = 368 * MiB;
constexpr size_t WS_YS = 416 * MiB;
constexpr float WSCALE = 64.0f, WSCALE_INV = 1.0f / 64.0f;
constexpr size_t WS_END = 680 * MiB;

constexpr int RING_BYTES = 131072, LDSCTL_OFF = RING_BYTES, LDS_BYTES = 147456;

#define LDS_WAIT() asm volatile("s_waitcnt lgkmcnt(0)" ::: "memory")
#define VM_WAIT() asm volatile("s_waitcnt vmcnt(0)" ::: "memory")
__device__ __forceinline__ unsigned cvt_pk_bf16(float lo, float hi) { unsigned r; asm volatile("v_cvt_pk_bf16_f32 %0, %1, %2" : "=v"(r) : "v"(lo), "v"(hi)); return r; }
__device__ __forceinline__ unsigned pack4_fp8(float a, float b, float c, float d) { int w = 0; w = __builtin_amdgcn_cvt_pk_fp8_f32(a, b, w, false); w = __builtin_amdgcn_cvt_pk_fp8_f32(c, d, w, true); return (unsigned)w; }
__device__ __forceinline__ float bf_lo(unsigned u) { return __uint_as_float(u << 16); }
__device__ __forceinline__ float bf_hi(unsigned u) { return __uint_as_float(u & 0xffff0000u); }
__device__ __forceinline__ float wave_sum(float v) {
#pragma unroll
    for (int o = 1; o < 64; o <<= 1) v += __shfl_xor(v, o);
    return v;
}
__device__ __forceinline__ float sigmoidf_(float x) { return __builtin_amdgcn_rcpf(1.0f + __expf(-x)); }

#define XB_TMO      128
#define XB_XCNT(j)  (256  + 64 * (j))
#define XB_XSUB(j)  (1280 + 64 * (j))
#define XB_XGEN(j)  (2304 + 64 * (j))
#define XB_TOP      3328
#define XB_TOPGEN   3392
#define XCD_BAR_WORDS 3456
#define XB_SPIN_CAP (1u << 18)
__device__ __forceinline__ unsigned xb_ld(unsigned* p)              { return __hip_atomic_load(p, __ATOMIC_RELAXED, __HIP_MEMORY_SCOPE_AGENT); }
__device__ __forceinline__ unsigned xb_add(unsigned* p, unsigned v) { return __hip_atomic_fetch_add(p, v, __ATOMIC_RELAXED, __HIP_MEMORY_SCOPE_AGENT); }
__device__ __forceinline__ unsigned xb_xcc_id() { return (unsigned)__builtin_amdgcn_s_getreg((3 << 11) | 20) & 0xFu; }
#define XB_SPIN(cond, bar) do { unsigned _sp = 0; while (cond) { __builtin_amdgcn_s_sleep(1); \
    if ((++_sp & 255u) == 0u) { if (xb_ld(&(bar)[XB_TMO])) break; if (_sp > XB_SPIN_CAP) { atomicAdd(&(bar)[XB_TMO], 1u); break; } } } } while (0)
struct XcdBarrier { unsigned* bar; unsigned x; volatile LAS unsigned* st; };
__device__ __forceinline__ XcdBarrier xcd_barrier_post(unsigned* bar, volatile LAS unsigned* st) {
    XcdBarrier b; b.bar = bar; b.x = xb_xcc_id(); b.st = st;
    if (threadIdx.x == 0) (void)xb_add(&bar[XB_XCNT(b.x)], 1u);
    return b;
}
__device__ __forceinline__ void xcd_barrier_complete(unsigned* bar, unsigned x, unsigned& nloc, unsigned& nx) {
    const unsigned G = gridDim.x * gridDim.y * gridDim.z;
    unsigned sum, cnt, mine, sp = 0u;
    for (;;) {
        sum = 0u; cnt = 0u; mine = 0u;
#pragma unroll
        for (unsigned j = 0; j < 16; ++j) { const unsigned c = xb_ld(&bar[XB_XCNT(j)]); sum += c; cnt += (c > 0u) ? 1u : 0u; mine = (j == x) ? c : mine; }
        if (sum == G) break;
        __builtin_amdgcn_s_sleep(1);
        if ((++sp & 255u) == 0u) { if (xb_ld(&bar[XB_TMO])) break; if (sp > XB_SPIN_CAP) { atomicAdd(&bar[XB_TMO], 1u); break; } }
    }
    nloc = mine > 0u ? mine : 1u; nx = cnt > 0u ? cnt : 1u;
}
__device__ __forceinline__ void xcd_barrier(const XcdBarrier& b) {
    asm volatile("s_waitcnt vmcnt(0)" ::: "memory");
    __syncthreads();
    if (threadIdx.x == 0) {
        unsigned* bar = b.bar;
        __builtin_amdgcn_s_waitcnt(0);
        unsigned nloc = b.st[0], nx = b.st[1];
        if (nloc == 0u) { xcd_barrier_complete(bar, b.x, nloc, nx); b.st[0] = nloc; b.st[1] = nx; }
        const unsigned old = xb_add(&bar[XB_XSUB(b.x)], 1u);
        const unsigned gen = old / nloc;
        if (old + 1u == (gen + 1u) * nloc) {
            __builtin_amdgcn_fence(__ATOMIC_RELEASE, "agent");
            asm volatile("s_waitcnt vmcnt(0)" ::: "memory");
            const unsigned og = xb_add(&bar[XB_TOP], 1u);
            const unsigned tg = og / nx;
            if (og + 1u == (tg + 1u) * nx) xb_add(&bar[XB_TOPGEN], 1u);
            else XB_SPIN(xb_ld(&bar[XB_TOPGEN]) == tg, bar);
            __builtin_amdgcn_fence(__ATOMIC_ACQUIRE, "agent");
            xb_add(&bar[XB_XGEN(b.x)], 1u);
            asm volatile("s_waitcnt vmcnt(0)" ::: "memory");
        } else {
            XB_SPIN(xb_ld(&bar[XB_XGEN(b.x)]) == gen, bar);
            __builtin_amdgcn_fence(__ATOMIC_ACQUIRE, "agent");
            asm volatile("s_waitcnt vmcnt(0)" ::: "memory");
        }
    }
    __syncthreads();
}

namespace pg8 {
constexpr int BM = 256, BK = 64, HALF = 128, HTB = HALF * BK * 2, STAGE_BYTES = 8 * HTB, NXCD = 8, WGM = 8;
__host__ __device__ __forceinline__ int lds_byte(int r, int c) { const int st = (r >> 4) * 2 + (c >> 5), rr = r & 15, cc = c & 31, ob = rr * 64 + cc * 2; return st * 1024 + (ob ^ (((ob >> 9) & 1) << 5)); }
__host__ __device__ __forceinline__ void stage_rc(int b, int& R, int& C) { const int st = b / 1024, sb = b % 1024, swz = sb ^ (((sb >> 9) & 1) << 5); R = (st >> 1) * 16 + swz / 64; C = (st & 1) * 32 + (swz % 64) / 2; }
__host__ __device__ __forceinline__ int perm32(int rho) { const int n = rho >> 4, i = rho & 15; return 8 * (i >> 2) + 4 * n + (i & 3); }

struct Unit { int pm, pn, aux; };

__device__ __forceinline__ void tile_of(int L, int nM, int nN, int& pm, int& pn) {
    const int nwg = nM * nN; int wgid = L;
    { const int q = nwg / NXCD, r = nwg % NXCD, xcd = wgid % NXCD, off = wgid / NXCD; wgid = (xcd < r ? xcd * (q + 1) : r * (q + 1) + (xcd - r) * q) + off; }
    const int nig = WGM * nN, gid = wgid / nig, fm = gid * WGM, gsz = (nM - fm) < WGM ? (nM - fm) : WGM;
    pm = fm + ((wgid % nig) % gsz); pn = (wgid % nig) / gsz;
}

template <class Epi, class Sched, bool ALIGN_EPI, bool SP2, bool FP8 = false>
__device__ __forceinline__ void gemm_phase(LAS unsigned char* lds, const int RB, const Sched& S, const Epi& E) {
    const int tid = threadIdx.x, wid = __builtin_amdgcn_readfirstlane(tid >> 6), lane = tid & 63, wr = wid >> 2, wc = wid & 3, fr = lane & 15, fq = lane >> 4;
    const int nt = RB / 128;
    unsigned voffA[2], voffB[2];
#pragma unroll
    for (int i = 0; i < 2; ++i) { int R, C; stage_rc(tid * 16 + i * 8192, R, C); const int Rb = Epi::PERM ? ((R & ~31) + perm32(R & 31)) : R;
        voffA[i] = (unsigned)(R * RB + C * 2); voffB[i] = (unsigned)(Rb * RB + C * 2); }
    const size_t kstep = (size_t)(BK * 2);
    const size_t hstep = (size_t)HALF * RB;
    const unsigned ldsw = (unsigned)wid * 1024u;
    const int aoff = lds_byte(wr * 64 + fr, fq * 8), boff = lds_byte(wc * 32 + fr, fq * 8);
#define PG8_SA(b, h) (((b) * 2 + (h)) * HTB)
#define PG8_SB(b, h) ((4 + (b) * 2 + (h)) * HTB)
#define PG8_STAGE(bufoff, gbase, voff) do { _Pragma("unroll") for (int _i = 0; _i < 2; ++_i) \
        __builtin_amdgcn_global_load_lds((const unsigned*)((const char*)(gbase) + (voff)[_i]), (LAS unsigned*)(lds + (bufoff) + ldsw + _i * 8192), 16, 0, 0); } while (0)
#define PG8_LD8(p) __builtin_shufflevector(*(const LAS i32x4*)(p), *(const LAS i32x4*)((p) + 1024), 0, 1, 2, 3, 4, 5, 6, 7)
#define PG8_LDA(dst, b, h) do { _Pragma("unroll") for (int m = 0; m < 4; ++m) dst[m] = PG8_LD8(lds + PG8_SA(b, h) + aoff + m * 2048); } while (0)
#define PG8_LDB(dst, b, h) do { _Pragma("unroll") for (int n = 0; n < 2; ++n) dst[n] = PG8_LD8(lds + PG8_SB(b, h) + boff + n * 2048); } while (0)
#define PG8_LO(x) __builtin_bit_cast(bf16x8, __builtin_shufflevector(x, x, 0, 1, 2, 3))
#define PG8_HI(x) __builtin_bit_cast(bf16x8, __builtin_shufflevector(x, x, 4, 5, 6, 7))
#define PG8_MMA(ai, bj, At, Bt) do { __builtin_amdgcn_s_setprio(1); _Pragma("unroll") for (int m = 0; m < 4; ++m) _Pragma("unroll") for (int n = 0; n < 2; ++n) { \
        if constexpr (FP8) asm volatile("v_mfma_f32_16x16x128_f8f6f4 %0, %1, %2, %0" : "+v"(acc[ai][bj][m][n]) : "v"(Bt[n]), "v"(At[m]));   \
        else { acc[ai][bj][m][n] = __builtin_amdgcn_mfma_f32_16x16x32_bf16(PG8_LO(Bt[n]), PG8_LO(At[m]), acc[ai][bj][m][n], 0, 0, 0); \
               acc[ai][bj][m][n] = __builtin_amdgcn_mfma_f32_16x16x32_bf16(PG8_HI(Bt[n]), PG8_HI(At[m]), acc[ai][bj][m][n], 0, 0, 0); } } \
        __builtin_amdgcn_s_setprio(0); } while (0)
#define PG8_WAIT_V(n) asm volatile("s_waitcnt vmcnt(" #n ")" ::: "memory")
#define PG8_WAIT_L(n) asm volatile("s_waitcnt lgkmcnt(" #n ")" ::: "memory")
#define PG8_BAR __builtin_amdgcn_s_barrier()
#define PG8_SCHED __builtin_amdgcn_sched_barrier(0)
    Unit cur, nxt; int ui = 0;
    if (!S.next(0, cur)) return;
    f32x4 acc[2][2][4][2];
#pragma unroll
    for (int a = 0; a < 2; ++a)
#pragma unroll
        for (int b = 0; b < 2; ++b)
#pragma unroll
            for (int m = 0; m < 4; ++m)
#pragma unroll
                for (int n = 0; n < 2; ++n) acc[a][b][m][n] = (f32x4){0.f, 0.f, 0.f, 0.f};
    i32x8 At[4], B0[2], B1[2];
    const char* cA = S.a_ptr(cur); const char* cB = S.b_ptr(cur);
    if constexpr (SP2) {
        PG8_STAGE(PG8_SB(0, 0), cB, voffB); PG8_STAGE(PG8_SB(0, 1), cB + hstep, voffB); PG8_STAGE(PG8_SA(0, 0), cA, voffA); PG8_STAGE(PG8_SA(0, 1), cA + hstep, voffA);
        if (wr == 1) PG8_BAR;
        PG8_WAIT_V(2); PG8_BAR;
        PG8_STAGE(PG8_SB(1, 0), cB + kstep, voffB); PG8_STAGE(PG8_SA(1, 0), cA + kstep, voffA); PG8_STAGE(PG8_SB(1, 1), cB + hstep + kstep, voffB);
        PG8_WAIT_V(6); PG8_BAR;
    } else {
        PG8_STAGE(PG8_SB(0, 0), cB, voffB); PG8_STAGE(PG8_SA(0, 0), cA, voffA); PG8_STAGE(PG8_SB(0, 1), cB + hstep, voffB); PG8_STAGE(PG8_SA(0, 1), cA + hstep, voffA);
        if (wr == 1) PG8_BAR;
        PG8_WAIT_V(4); PG8_BAR;
        PG8_STAGE(PG8_SB(1, 0), cB + kstep, voffB); PG8_STAGE(PG8_SA(1, 0), cA + kstep, voffA); PG8_STAGE(PG8_SB(1, 1), cB + hstep + kstep, voffB);
        PG8_WAIT_V(6); PG8_BAR;
    }
    for (;;) {
        const bool has_next = S.next(ui + 1, nxt);
        const char* nA = has_next ? S.a_ptr(nxt) : cA; const char* nB = has_next ? S.b_ptr(nxt) : cB;
#pragma nounroll
        for (int t = 0; t < nt; t += 2) {
            const bool last = (t == nt - 2);
            const char* a1 = cA + (size_t)(t + 1) * kstep;
            const char* a2 = last ? nA : cA + (size_t)(t + 2) * kstep; const char* b2 = last ? nB : cB + (size_t)(t + 2) * kstep;
            const char* a3 = a2 + kstep; const char* b3 = b2 + kstep;
            if constexpr (SP2) {
            PG8_LDB(B0, 0, 0); PG8_LDB(B1, 0, 1); PG8_SCHED; PG8_LDA(At, 0, 0); PG8_STAGE(PG8_SA(1, 1), a1 + hstep, voffA);
            PG8_WAIT_V(8); PG8_WAIT_L(0); PG8_BAR; PG8_MMA(0, 0, At, B0); PG8_MMA(0, 1, At, B1); PG8_BAR; PG8_SCHED;
            PG8_LDA(At, 0, 1); PG8_STAGE(PG8_SB(0, 0), b2, voffB); PG8_STAGE(PG8_SB(0, 1), b2 + hstep, voffB); PG8_STAGE(PG8_SA(0, 0), a2, voffA);
            PG8_WAIT_V(8); PG8_WAIT_L(0); PG8_BAR; PG8_MMA(1, 0, At, B0); PG8_MMA(1, 1, At, B1); PG8_BAR; PG8_SCHED;
            PG8_LDB(B0, 1, 0); PG8_LDB(B1, 1, 1); PG8_SCHED; PG8_LDA(At, 1, 0); PG8_STAGE(PG8_SA(0, 1), a2 + hstep, voffA);
            PG8_WAIT_V(8); PG8_WAIT_L(0); PG8_BAR; PG8_MMA(0, 0, At, B0); PG8_MMA(0, 1, At, B1); PG8_BAR; PG8_SCHED;
            PG8_LDA(At, 1, 1); PG8_STAGE(PG8_SB(1, 0), b3, voffB); PG8_STAGE(PG8_SB(1, 1), b3 + hstep, voffB); PG8_STAGE(PG8_SA(1, 0), a3, voffA);
            PG8_WAIT_V(8); PG8_WAIT_L(0); PG8_BAR; PG8_MMA(1, 0, At, B0); PG8_MMA(1, 1, At, B1); PG8_BAR; PG8_SCHED;
            } else {
            PG8_LDB(B0, 0, 0); PG8_SCHED; PG8_LDA(At, 0, 0); PG8_STAGE(PG8_SA(1, 1), a1 + hstep, voffA);
            PG8_WAIT_L(8); PG8_BAR; PG8_WAIT_L(0); PG8_MMA(0, 0, At, B0); PG8_BAR; PG8_SCHED;
            PG8_LDB(B1, 0, 1); PG8_STAGE(PG8_SB(0, 0), b2, voffB);
            PG8_BAR; PG8_WAIT_L(0); PG8_MMA(0, 1, At, B1); PG8_BAR;
            PG8_LDA(At, 0, 1); PG8_STAGE(PG8_SA(0, 0), a2, voffA);
            PG8_BAR; PG8_WAIT_L(0); PG8_MMA(1, 0, At, B0); PG8_BAR; PG8_SCHED;
            PG8_STAGE(PG8_SB(0, 1), b2 + hstep, voffB);
            PG8_WAIT_V(6); PG8_BAR; PG8_MMA(1, 1, At, B1); PG8_BAR;
            PG8_LDB(B0, 1, 0); PG8_SCHED; PG8_LDA(At, 1, 0); PG8_STAGE(PG8_SA(0, 1), a2 + hstep, voffA);
            PG8_WAIT_L(8); PG8_BAR; PG8_WAIT_L(0); PG8_MMA(0, 0, At, B0); PG8_BAR; PG8_SCHED;
            PG8_LDB(B1, 1, 1); PG8_STAGE(PG8_SB(1, 0), b3, voffB);
            PG8_BAR; PG8_WAIT_L(0); PG8_MMA(0, 1, At, B1); PG8_BAR;
            PG8_LDA(At, 1, 1); PG8_STAGE(PG8_SA(1, 0), a3, voffA);
            PG8_BAR; PG8_WAIT_L(0); PG8_MMA(1, 0, At, B0); PG8_BAR; PG8_SCHED;
            PG8_STAGE(PG8_SB(1, 1), b3 + hstep, voffB);
            PG8_WAIT_V(6); PG8_BAR; PG8_MMA(1, 1, At, B1); PG8_BAR;
            }
        }
        if constexpr (ALIGN_EPI) { if (wr == 0) PG8_BAR; }
        if constexpr (FP8) asm volatile("s_nop 15\n\ts_nop 15" ::: "memory");
        E(acc, cur, wr, wc, fr, fq);
        if (!has_next) break;
        if (!S.keep(cur)) {
#pragma unroll
            for (int a = 0; a < 2; ++a)
#pragma unroll
                for (int b = 0; b < 2; ++b)
#pragma unroll
                    for (int m = 0; m < 4; ++m)
#pragma unroll
                        for (int n = 0; n < 2; ++n) acc[a][b][m][n] = (f32x4){0.f, 0.f, 0.f, 0.f};
        }
        cur = nxt; cA = nA; cB = nB; ++ui;
        if constexpr (ALIGN_EPI) { if (wr == 1) PG8_BAR; }
    }
    PG8_WAIT_V(0);
    if constexpr (!ALIGN_EPI) { if (wr == 0) PG8_BAR; }
    PG8_BAR;
#undef PG8_SA
#undef PG8_SB
#undef PG8_STAGE
#undef PG8_LDA
#undef PG8_LDB
#undef PG8_MMA
#undef PG8_LD8
#undef PG8_LO
#undef PG8_HI
#undef PG8_WAIT_V
#undef PG8_WAIT_L
#undef PG8_BAR
#undef PG8_SCHED
}
}
using pg8::Unit;

#ifndef PG8_SP2
#define PG8_SP2 true
#endif
#ifndef PG8_ALIGN
#define PG8_ALIGN true
#endif

enum InIdx { I_X = 0, I_C, I_CTX, I_CCTX, I_WADA, I_BADA, I_GMIX, I_GFFN, I_WIN, I_WDW, I_BDW, I_LNG, I_LNB, I_WCO, I_BCO, I_LQ1, I_LK1, I_LQ2, I_LK2, I_GSUB, I_WAO, I_WOUT, I_WR, I_WEG, I_WEU, I_WED, I_GFIN, N_IN };
struct Args { const float* in[N_IN]; float* out; unsigned char* ws; int ph_lo, ph_hi, li, pad; };

__device__ __forceinline__ void ph_adaln(const Args& a, LAS unsigned char* lds, int bid, int G) {
    const int tid = threadIdx.x;
    LAS float* sil = (LAS float*)lds;
    LAS float* red = sil + 9 * 1024;
    const float* c = a.in[I_C]; const float* cc = a.in[I_CCTX]; const float* w = a.in[I_WADA]; const float* bb = a.in[I_BADA];
    float* mod = (float*)(a.ws + WS_MOD);
    for (int i = tid; i < 9 * 1024; i += 512) { const float v = (i < 8192) ? c[i] : cc[i - 8192]; sil[i] = v / (1.0f + expf(-v)); }
    __syncthreads();
    for (int unit = bid; unit < NMOD / 32; unit += G) {
        const int n0 = unit * 32, col = tid & 31, kp = tid >> 5;
        float acc[9];
#pragma unroll
        for (int r = 0; r < 9; ++r) acc[r] = 0.f;
#pragma unroll 8
        for (int kk = 0; kk < 64; ++kk) { const int k = kp * 64 + kk; const float wv = w[(size_t)k * NMOD + n0 + col];
#pragma unroll
            for (int r = 0; r < 9; ++r) acc[r] += sil[r * 1024 + k] * wv; }
#pragma unroll
        for (int r = 0; r < 9; ++r) red[(kp * 9 + r) * 32 + col] = acc[r];
        __syncthreads();
        if (tid < 288) { const int r = tid >> 5, cl = tid & 31; float s = 0.f;
#pragma unroll
            for (int k2 = 0; k2 < 16; ++k2) s += red[(k2 * 9 + r) * 32 + cl];
            mod[r * NMOD + n0 + cl] = s + bb[n0 + cl]; }
        __syncthreads();
    }
}
__device__ __forceinline__ void ph_rope_table(const Args& a) {
    float* rc = (float*)(a.ws + WS_ROPE); float* rs = rc + 1024;
    for (int i = threadIdx.x; i < 1024; i += 512) { const int pos = i >> 4, f = i & 15;
        const float inv = powf(10000.0f, -(float)f / 16.0f); const float ang = (float)pos * inv;
        rc[i] = cosf(ang); rs[i] = sinf(ang); }
}
template <class DstRow>
__device__ __forceinline__ void transpose_item(const float* W, int K, int N, bf16_t* WT, const DstRow& dr, LAS float* scr, int item, int lane) {
    const int nblk = N / 32, kb = item / nblk, nb = item % nblk, k0 = 64 * kb, n0 = 32 * nb;
#pragma unroll 8
    for (int i = 0; i < 32; ++i) { const int kk = 2 * i + (lane >> 5); scr[kk * 33 + (lane & 31)] = __builtin_nontemporal_load(W + (size_t)(k0 + kk) * N + n0 + (lane & 31)); }
    LDS_WAIT(); asm volatile("" ::: "memory");
    const int c = lane & 7;
#pragma unroll
    for (int j = 0; j < 4; ++j) { const int n = (lane >> 3) + 8 * j; const LAS float* s = scr + (8 * c) * 33 + n;
        u32x4 o; o.x = cvt_pk_bf16(s[0 * 33], s[1 * 33]); o.y = cvt_pk_bf16(s[2 * 33], s[3 * 33]); o.z = cvt_pk_bf16(s[4 * 33], s[5 * 33]); o.w = cvt_pk_bf16(s[6 * 33], s[7 * 33]);
        *(u32x4*)(WT + (size_t)dr(n0 + n) * K + k0 + 8 * c) = o; }
    LDS_WAIT(); asm volatile("" ::: "memory");
}
template <class DstRow>
__device__ __forceinline__ void transpose_item_fp8(const float* W, int K, int N, unsigned char* WT, const DstRow& dr, LAS float* scr, int item, int lane) {
    const int nblk = N / 32, kb = item / nblk, nb = item % nblk, k0 = 64 * kb, n0 = 32 * nb;
#pragma unroll 8
    for (int i = 0; i < 32; ++i) { const int kk = 2 * i + (lane >> 5); scr[kk * 33 + (lane & 31)] = __builtin_nontemporal_load(W + (size_t)(k0 + kk) * N + n0 + (lane & 31)); }
    LDS_WAIT(); asm volatile("" ::: "memory");
    const int c = lane & 7;
#pragma unroll
    for (int j = 0; j < 4; ++j) { const int n = (lane >> 3) + 8 * j; const LAS float* s = scr + (8 * c) * 33 + n;
        u32x2 o; o.x = pack4_fp8(s[0 * 33] * WSCALE, s[1 * 33] * WSCALE, s[2 * 33] * WSCALE, s[3 * 33] * WSCALE); o.y = pack4_fp8(s[4 * 33] * WSCALE, s[5 * 33] * WSCALE, s[6 * 33] * WSCALE, s[7 * 33] * WSCALE);
        *(u32x2*)(WT + (size_t)dr(n0 + n) * K + k0 + 8 * c) = o; }
    LDS_WAIT(); asm volatile("" ::: "memory");
}
__host__ __device__ __forceinline__ int qdst(int d) { const int blk = d >> 5, half = (d >> 4) & 1, i = d & 15; return 8 * (4 * blk + (i >> 2)) + 4 * half + (i & 3); }
struct DrWin { __host__ __device__ int operator()(int j) const {
    if (j < 1024) return 256 * (j >> 7) + (j & 127);
    if (j < 2048) { const int jj = j - 1024; return 256 * (jj >> 7) + 128 + (jj & 127); }
    if (j < 4096) { const int jj = j & 1023, base = j - jj; return base + (jj & ~63) + qdst(jj & 63); }
    return j; } };
struct DrId { __host__ __device__ int operator()(int j) const { return j; } };
struct DrGU { int up; __host__ __device__ int operator()(int f) const { return 256 * (f >> 7) + 128 * up + (f & 127); } };

__device__ __forceinline__ void ph_small_weights(const Args& a, LAS unsigned char* lds, int gw, int NGW, int wave, int lane) {
    LAS float* scr = (LAS float*)(lds + 57344 + wave * 8448);
    constexpr int I_IN = (DM / 64) * (NPROJ / 32), I_SQ = (DM / 64) * (DM / 32);
    for (int it = gw; it < I_IN + 3 * I_SQ; it += NGW) {
        int r = it;
        if (r < I_IN) { transpose_item(a.in[I_WIN], DM, NPROJ, (bf16_t*)(a.ws + WS_WIN), DrWin{}, scr, r, lane); continue; } r -= I_IN;
        if (r < I_SQ) { transpose_item(a.in[I_WCO], DM, DM, (bf16_t*)(a.ws + WS_WCO), DrId{}, scr, r, lane); continue; } r -= I_SQ;
        if (r < I_SQ) { transpose_item(a.in[I_WAO], DM, DM, (bf16_t*)(a.ws + WS_WAO), DrId{}, scr, r, lane); continue; } r -= I_SQ;
        transpose_item(a.in[I_WOUT], DM, DM, (bf16_t*)(a.ws + WS_WO), DrId{}, scr, r, lane);
    }
}
__device__ __forceinline__ void ph_wgu(const Args& a, LAS unsigned char* lds, int gw, int NGW, int wave, int lane) {
    LAS float* scr = (LAS float*)(lds + 57344 + wave * 8448);
    constexpr int I_E = (DM / 64) * (DFF / 32);
    for (int it = gw; it < 2 * NEXP * I_E; it += NGW) {
        const int mat = it / I_E, r = it % I_E, e = mat >> 1, up = mat & 1;
        const float* W = (up ? a.in[I_WEU] : a.in[I_WEG]) + (size_t)e * DM * DFF;
        transpose_item_fp8(W, DM, DFF, (unsigned char*)(a.ws + WS_WGU) + (size_t)e * 2 * DFF * DM, DrGU{up}, scr, r, lane);
    }
}
constexpr int WD_ITEMS = NEXP * (DFF / 64) * (DM / 32);
#ifndef MK_WD_SPLIT
#define MK_WD_SPLIT 85
#endif
constexpr int WD_SPLIT = (WD_ITEMS / 100) * MK_WD_SPLIT;
__device__ __forceinline__ void ph_wd(const Args& a, LAS unsigned char* lds, int gw, int NGW, int wave, int lane, int lo, int hi) {
    LAS float* scr = (LAS float*)(lds + 57344 + wave * 8448);
    constexpr int I_E = (DFF / 64) * (DM / 32);
    for (int it = lo + gw; it < hi; it += NGW) {
        const int e = it / I_E, r = it % I_E;
        transpose_item_fp8(a.in[I_WED] + (size_t)e * DFF * DM, DFF, DM, (unsigned char*)(a.ws + WS_WD) + (size_t)e * DM * DFF, DrId{}, scr, r, lane);
    }
}

__device__ __forceinline__ void ph_norm_rows(const Args& a, int gw, int NGW, int lane) {
    const float* mod = (const float*)(a.ws + WS_MOD); const float* g = a.in[I_GMIX]; bf16_t* H = (bf16_t*)(a.ws + WS_H);
    const int per = (MALL + NGW - 1) / NGW, r0 = gw * per, r1 = (r0 + per < MALL) ? r0 + per : MALL;
    if (r0 >= r1) return;
    auto src_of = [&](int row) { return (const f32x4*)((row < MLAT) ? a.in[I_X] + (size_t)row * DM : a.in[I_CTX] + (size_t)(row - MLAT) * DM) + lane; };
    f32x4 gs[4], sh[4]; int cur_b = -1;
    f32x4 nx[4];
    { const f32x4* xr = src_of(r0);
#pragma unroll
      for (int j = 0; j < 4; ++j) nx[j] = __builtin_nontemporal_load(xr + 64 * j); }
    for (int row = r0; row < r1; ++row) {
        f32x4 v[4];
#pragma unroll
        for (int j = 0; j < 4; ++j) v[j] = nx[j];
        if (row + 1 < r1) { const f32x4* xr = src_of(row + 1);
#pragma unroll
            for (int j = 0; j < 4; ++j) nx[j] = __builtin_nontemporal_load(xr + 64 * j); }
        const int b = (row < MLAT) ? (row >> 12) : 8;
        if (b != cur_b) { cur_b = b; const float* mb = mod + (size_t)b * NMOD;
#pragma unroll
            for (int j = 0; j < 4; ++j) { const int c = 4 * lane + 256 * j; gs[j] = *(const f32x4*)(g + c) * (*(const f32x4*)(mb + 1024 + c) + 1.0f); sh[j] = *(const f32x4*)(mb + c); } }
        float s = 0.f;
#pragma unroll
        for (int j = 0; j < 4; ++j) s += (v[j].x * v[j].x + v[j].y * v[j].y) + (v[j].z * v[j].z + v[j].w * v[j].w);
        const float rstd = 1.0f / sqrtf(wave_sum(s) * (1.0f / DM) + EPS);
        unsigned long long* o8 = (unsigned long long*)(H + (size_t)row * DM) + lane;
#pragma unroll
        for (int j = 0; j < 4; ++j) { const f32x4 y = (v[j] * rstd) * gs[j] + sh[j];
            o8[64 * j] = (unsigned long long)cvt_pk_bf16(y.x, y.y) | ((unsigned long long)cvt_pk_bf16(y.z, y.w) << 32); }
    }
}

struct SchedInProj {
    const char* A; const char* Bt; int G, c;
    static constexpr int NLAT = 128 * 28, NCTXU = 8 * 8;
    __device__ __forceinline__ bool next(int i, Unit& u) const {
        const int L = i * G + c; if (L >= NLAT + NCTXU) return false;
        if (L < NLAT) { pg8::tile_of(L, 128, 28, u.pm, u.pn); } else { const int v = L - NLAT; u.pm = 128 + (v & 7); u.pn = 12 + (v >> 3); }
        u.aux = 0; return true; }
    __device__ __forceinline__ const char* a_ptr(const Unit& u) const { return (u.pn >= 16 && u.pn < 20) ? Bt + (size_t)u.pn * (256 * DM * 2) : A + (size_t)u.pm * (256 * DM * 2); }
    __device__ __forceinline__ const char* b_ptr(const Unit& u) const { return (u.pn >= 16 && u.pn < 20) ? A + (size_t)u.pm * (256 * DM * 2) : Bt + (size_t)u.pn * (256 * DM * 2); }
    __device__ __forceinline__ bool keep(const Unit&) const { return false; }
};
struct EpiInProj {
    static constexpr bool PERM = true;
    bf16_t *U, *Q, *KA, *VA, *GC, *GA; const float* rope;
    __device__ __forceinline__ void operator()(f32x4 (&acc)[2][2][4][2], const Unit& u, int wr, int wc, int fr, int fq) const {
        const int pn = u.pn, pm = u.pm;
        const int cw = wc * 32 + 8 * fq;
        if (pn < 8) {
#pragma unroll
            for (int ai = 0; ai < 2; ++ai)
#pragma unroll
                for (int m = 0; m < 4; ++m) { const int r = pm * 256 + ai * 128 + wr * 64 + m * 16 + fr;
                    const f32x4 a0 = acc[ai][0][m][0], a1 = acc[ai][0][m][1], b0 = acc[ai][1][m][0], b1 = acc[ai][1][m][1];
                    u32x4 w; w.x = cvt_pk_bf16(a0[0] * sigmoidf_(b0[0]), a0[1] * sigmoidf_(b0[1])); w.y = cvt_pk_bf16(a0[2] * sigmoidf_(b0[2]), a0[3] * sigmoidf_(b0[3]));
                    w.z = cvt_pk_bf16(a1[0] * sigmoidf_(b1[0]), a1[1] * sigmoidf_(b1[1])); w.w = cvt_pk_bf16(a1[2] * sigmoidf_(b1[2]), a1[3] * sigmoidf_(b1[3]));
                    *(u32x4*)(U + (size_t)r * DM + pn * 128 + cw) = w; }
            return;
        }
        if (pn < 16) {
            const bool isq = pn < 12, lat = pm < 128;
            bf16_t* base; size_t row0; int rowpos0 = 0;
            if (isq) { base = Q + (size_t)(pn - 8) * 256; row0 = (size_t)pm * 256; }
            else { base = KA + (size_t)(pn - 12) * 256; row0 = lat ? (size_t)(pm >> 4) * KVR + (size_t)(pm & 15) * 256 : (size_t)(pm - 128) * KVR + NT; }
            if (lat) rowpos0 = (pm & 15) * 4;
            const float sc = isq ? QSCALE : 1.0f;
            const float* rc = rope; const float* rs = rope + 1024;
#pragma unroll
            for (int ai = 0; ai < 2; ++ai)
#pragma unroll
                for (int m = 0; m < 4; ++m) { const int rl = ai * 128 + wr * 64 + m * 16 + fr;
                    f32x4 cs = (f32x4){1.f, 1.f, 1.f, 1.f}, sn = (f32x4){0.f, 0.f, 0.f, 0.f};
                    if (lat) { const int pos = (wc & 1) ? (m * 16 + fr) : (rowpos0 + 2 * ai + wr); cs = *(const f32x4*)(rc + pos * 16 + 4 * fq); sn = *(const f32x4*)(rs + pos * 16 + 4 * fq); }
#pragma unroll
                    for (int bj = 0; bj < 2; ++bj) { const f32x4 x1 = acc[ai][bj][m][0], x2 = acc[ai][bj][m][1];
                        const f32x4 y1 = (x1 * cs - x2 * sn) * sc, y2 = (x1 * sn + x2 * cs) * sc;
                        u32x4 w; w.x = cvt_pk_bf16(y1[0], y1[1]); w.y = cvt_pk_bf16(y1[2], y1[3]); w.z = cvt_pk_bf16(y2[0], y2[1]); w.w = cvt_pk_bf16(y2[2], y2[3]);
                        *(u32x4*)(base + (row0 + rl) * DM + bj * 128 + cw) = w; } }
            return;
        }
        if (pn < 20) {
            const bool lat = pm < 128;
            const int bidx = lat ? (pm >> 4) : (pm - 128), key0 = lat ? (pm & 15) * 256 : NT;
            bf16_t* vt = VA + (size_t)(bidx * NHD + 2 * (pn - 16)) * 128 * KVR + key0;
            int fr_ = fr; asm volatile("" : "+v"(fr_));
#pragma unroll
            for (int ai = 0; ai < 2; ++ai)
#pragma unroll
                for (int m = 0; m < 4; ++m) { bf16_t* rowp = vt + (unsigned)((ai * 128 + wr * 64 + m * 16 + fr_) * KVR);
#pragma unroll
                    for (int bj = 0; bj < 2; ++bj) { const f32x4 v0 = acc[ai][bj][m][0], v1 = acc[ai][bj][m][1];
                        unsigned a0 = cvt_pk_bf16(v0[0], v0[1]), a1 = cvt_pk_bf16(v0[2], v0[3]), b0 = cvt_pk_bf16(v1[0], v1[1]), b1 = cvt_pk_bf16(v1[2], v1[3]);
                        { auto r_ = __builtin_amdgcn_permlane16_swap(a0, b0, false, false); a0 = r_[0]; b0 = r_[1]; }
                        { auto r_ = __builtin_amdgcn_permlane16_swap(a1, b1, false, false); a1 = r_[0]; b1 = r_[1]; }
                        *(u32x4*)(rowp + bj * 128 + wc * 32 + 8 * fq) = (u32x4){a0, a1, b0, b1}; }
                    asm volatile("" ::: "memory"); }
            return;
        }
        {
            bf16_t* base; size_t row0;
            if (pn < 24) { base = GC + (size_t)(pn - 20) * 256; row0 = (size_t)pm * 256; }
            else { base = GA + (size_t)(pn - 24) * 256; row0 = (size_t)pm * 256; }
#pragma unroll
            for (int ai = 0; ai < 2; ++ai)
#pragma unroll
                for (int m = 0; m < 4; ++m) { const int rl = ai * 128 + wr * 64 + m * 16 + fr;
#pragma unroll
                    for (int bj = 0; bj < 2; ++bj) { f32x4 v0 = acc[ai][bj][m][0], v1 = acc[ai][bj][m][1];
#pragma unroll
                        for (int j = 0; j < 4; ++j) { v0[j] = sigmoidf_(v0[j]); v1[j] = sigmoidf_(v1[j]); }
                        u32x4 w; w.x = cvt_pk_bf16(v0[0], v0[1]); w.y = cvt_pk_bf16(v0[2], v0[3]); w.z = cvt_pk_bf16(v1[0], v1[1]); w.w = cvt_pk_bf16(v1[2], v1[3]);
                        *(u32x4*)(base + (row0 + rl) * DM + bj * 128 + cw) = w; } }
        }
    }
};

__device__ __forceinline__ void ph_conv_unit(const Args& a, LAS unsigned char* lds, int unit) {
    const int tid = threadIdx.x, lane = tid & 63, wave = __builtin_amdgcn_readfirstlane(tid >> 6);
    const int b = unit >> 5, t0 = (unit & 31) * 128;
    LAS float* ybuf = (LAS float*)lds;
    const int c0 = 2 * tid;
    f32x2 w[31];
    { const float* wp = a.in[I_WDW]; asm volatile("" : "+s"(wp));
      const __attribute__((address_space(1))) f32x2* wp2 = (const __attribute__((address_space(1))) f32x2*)(wp + c0);
#pragma unroll
      for (int j = 0; j < 31; ++j) w[j] = wp2[j * (DM / 2)]; }
    const f32x2 bias = *(const f32x2*)(a.in[I_BDW] + c0);
    const unsigned* Ub = (const unsigned*)(a.ws + WS_U) + (size_t)b * NT * (DM / 2) + tid;
    bf16_t* CA = (bf16_t*)(a.ws + WS_CACT) + (size_t)(b * NT + t0) * DM;
    const float* lng = a.in[I_LNG]; const float* lnb = a.in[I_LNB];
    f32x2 win[32];
#pragma unroll
    for (int s = 0; s < 32; ++s) win[s] = (f32x2){0.f, 0.f};
    unsigned pf[16];
    const unsigned* up = Ub + ((long)t0 - 15) * (DM / 2);
#define CV_LD(i) ({ const int i_ = (i); const int ti_ = t0 - 15 + i_; (i_ < 158 && ti_ >= 0 && ti_ < NT) ? up[(long)i_ * (DM / 2)] : 0u; })
#pragma unroll
    for (int s = 0; s < 16; ++s) pf[s] = CV_LD(s);
    for (int Q = 0; Q < 5; ++Q) {
#pragma unroll
        for (int hb = 0; hb < 2; ++hb)
#pragma unroll
        for (int s16 = 0; s16 < 16; ++s16) {
            const int s = hb * 16 + s16;
            const unsigned pk = pf[s16];
            pf[s16] = CV_LD(32 * Q + s + 16);
            win[s] = (f32x2){bf_lo(pk), bf_hi(pk)};
            const int to = 32 * Q + s - 30;
            if (to >= 0 && to < 128) {
                f32x2 y = bias;
#pragma unroll
                for (int j = 0; j < 31; ++j) y += w[j] * win[(s + 2 + j) & 31];
                *(LAS f32x2*)(ybuf + (to & 15) * DM + c0) = y;
            }
            if (s == 13 || s == 29) {
                if (Q >= 1) {
                    const int tb = 32 * Q + s - 30 - 15;
                    __syncthreads();
#pragma unroll
                    for (int k = 0; k < 2; ++k) { const int tl = 2 * wave + k;
                        f32x4 v[4]; float sm = 0.f;
#pragma unroll
                        for (int j = 0; j < 4; ++j) { v[j] = *(const LAS f32x4*)(ybuf + tl * DM + 4 * lane + 256 * j); sm += (v[j].x + v[j].y) + (v[j].z + v[j].w); }
                        const float mean = wave_sum(sm) * (1.0f / DM); float s2 = 0.f;
#pragma unroll
                        for (int j = 0; j < 4; ++j) { v[j] = v[j] - mean; s2 += (v[j].x * v[j].x + v[j].y * v[j].y) + (v[j].z * v[j].z + v[j].w * v[j].w); }
                        const float rstd = 1.0f / sqrtf(wave_sum(s2) * (1.0f / DM) + EPS);
                        unsigned long long* o8 = (unsigned long long*)(CA + (size_t)(tb + tl) * DM) + lane;
#pragma unroll
                        for (int j = 0; j < 4; ++j) { const int c = 4 * lane + 256 * j;
                            f32x4 y = v[j] * rstd * *(const f32x4*)(lng + c) + *(const f32x4*)(lnb + c);
#pragma unroll
                            for (int q = 0; q < 4; ++q) y[q] = y[q] * sigmoidf_(y[q]);
                            o8[64 * j] = (unsigned long long)cvt_pk_bf16(y.x, y.y) | ((unsigned long long)cvt_pk_bf16(y.z, y.w) << 32); } }
                    __syncthreads();
                }
            }
        }
    }
#undef CV_LD
}

namespace att {
constexpr int NW = 8, QBLK = 32, KVBLK = 64, NTILE = KVR / KVBLK;
constexpr int SHM_V = 128 * KVBLK * 2, SHM_K = KVBLK * 64 * 2;
constexpr int BUFB = SHM_V + SHM_K, NBUF = 4, ATT_LDS = NBUF * BUFB;
constexpr int VT_PITCH = KVR;
#define KSWZ(row, colB) ((row) * 128 + ((colB) ^ ((((row) >> 1) & 7) << 4)))
#define SBAR() __builtin_amdgcn_sched_barrier(0)
__device__ __forceinline__ int crow(int r, int hi) { return (r & 3) + 8 * (r >> 2) + 4 * hi; }
__device__ __forceinline__ void glds16(const void* g, unsigned lds_base) {
    unsigned sv; asm volatile("s_mov_b32 %0, m0\n\ts_mov_b32 m0, %2\n\ts_nop 0\n\tglobal_load_lds_dwordx4 %1, off\n\ts_mov_b32 m0, %0" : "=&s"(sv) : "v"(g), "s"(lds_base) : "memory"); }
__device__ __forceinline__ void attn_map(const bf16_t* __restrict__ Qb, const bf16_t* __restrict__ Kh, const bf16_t* __restrict__ VTh, long dKn, long dVn, bool pre, bool has_next, f32x16 (&o)[4], char* lds) {
    const int tid = threadIdx.x, wid = tid >> 6, lane = tid & 63, r32 = lane & 31, hi = lane >> 5;
    const int wv = __builtin_amdgcn_readfirstlane(tid >> 6);
    const bool isB = wv >= 4;
    float l_reg = 0.f;
#pragma unroll
    for (int d = 0; d < 4; ++d) o[d] = f32x16{};
    bf16x8 qr[4];
    const bf16_t* Qw = Qb + (size_t)(wid * QBLK + r32) * DM + hi * 8;
#pragma unroll
    for (int d0 = 0; d0 < 4; ++d0) qr[d0] = *reinterpret_cast<const bf16x8*>(Qw + d0 * 16);
    const bf16_t* ksrc = Kh + (size_t)(8 * wv + (lane >> 3)) * DM + (((lane & 7) ^ ((4 * wv + (lane >> 4)) & 7)) << 3);
    const bf16_t* vsrc0 = VTh + (size_t)(16 * wv + (lane >> 3)) * VT_PITCH + (((lane & 7) ^ ((lane >> 4) & 7)) << 3);
    const bf16_t* vsrc1 = VTh + (size_t)(16 * wv + 8 + (lane >> 3)) * VT_PITCH + (((lane & 7) ^ ((4 + (lane >> 4)) & 7)) << 3);
    const unsigned lds0 = (unsigned)(uintptr_t)lds;
#define DMAX(ko, vo, b) do { const unsigned bb_ = lds0 + (unsigned)(b) * BUFB; \
    glds16(ksrc + (ko), (unsigned)__builtin_amdgcn_readfirstlane(bb_ + SHM_V + 1024 * wv)); \
    glds16(vsrc0 + (vo), (unsigned)__builtin_amdgcn_readfirstlane(bb_ + 2048 * wv)); \
    glds16(vsrc1 + (vo), (unsigned)__builtin_amdgcn_readfirstlane(bb_ + 2048 * wv + 1024)); } while (0)
#define DMA(t, b) DMAX((long)(t) * (KVBLK * DM), (long)(t) * KVBLK, b)
#define DMAT(T) do { if ((T) < NTILE) DMA((T), (T) & 3); else if (has_next && (T) - NTILE < 2) DMAX(dKn + (long)((T) - NTILE) * (KVBLK * DM), dVn + (long)((T) - NTILE) * KVBLK, ((T) - NTILE) & 3); } while (0)
#define BAR() asm volatile("s_barrier" ::: "memory")
#define BARV() asm volatile("s_waitcnt vmcnt(0)\n\ts_barrier" ::: "memory")
    f32x16 pA0, pA1, pB0, pB1;
    u32x4 pw0, pw1, pw2, pw3;
    typedef LAS const char* lcp;
    const lcp lds3 = (lcp)(LAS char*)(uintptr_t)lds0;
    int kaddr[4], vaddr[4];
#pragma unroll
    for (int d0 = 0; d0 < 4; ++d0) { kaddr[d0] = SHM_V + KSWZ(r32, (d0 * 16 + hi * 8) * 2); vaddr[d0] = KSWZ(r32, (2 * d0 + hi) * 16); }
    bf16x8 kf[8], va[4], vb[4];
    constexpr float REF_MARGIN = 32.0f;
    f32x16 negm = f32x16{};
#define PIN(x) asm volatile("" : "+v"(x))
#define MF(a_, b_, c_) __builtin_amdgcn_mfma_f32_32x32x16_bf16(a_, b_, c_, 0, 0, 0)
#define PB(w) __builtin_bit_cast(bf16x8, w)
#define PKW(P, i) cvt_pk_bf16(P[i], P[i + 1])
#define ADD6(x, A, a0, a1, a2, B, b0, b1, b2) do { x += A[a0]; x += A[a1]; x += A[a2]; x += B[b0]; x += B[b1]; x += B[b2]; } while (0)
#define KRD(kbuf) do { const lcp kb_ = lds3 + (kbuf) * BUFB; \
      _Pragma("unroll") for (int d0 = 0; d0 < 4; ++d0) { kf[2 * d0] = *(const LAS bf16x8*)(kb_ + kaddr[d0]); kf[2 * d0 + 1] = *(const LAS bf16x8*)(kb_ + kaddr[d0] + 4096); } } while (0)
#define VRD4(dst, vb_, blk) do { const lcp vq_ = lds3 + (vb_) * BUFB; _Pragma("unroll") for (int ks_ = 0; ks_ < 4; ++ks_) dst[ks_] = *(const LAS bf16x8*)(vq_ + vaddr[ks_] + (blk) * 4096); } while (0)
#define S1(C0, C1, P0, P1, kbuf, vnext) do { SBAR(); \
    KRD(kbuf); \
    float ps_ = P0[0] + P0[1]; ps_ += P0[2]; ps_ += P0[3]; ps_ += P0[4]; ps_ += P0[5]; ps_ += P0[6]; ps_ += P0[7]; PIN(ps_); SBAR(); \
    C0 = MF(kf[0], qr[0], negm); ADD6(ps_, P0, 8, 9, 10, P0, 11, 12, 13); PIN(ps_); SBAR(); \
    C1 = MF(kf[1], qr[0], negm); ps_ += P0[14]; ps_ += P0[15]; ps_ += P1[0]; ps_ += P1[1]; ps_ += P1[2]; ps_ += P1[3]; PIN(ps_); SBAR(); \
    C0 = MF(kf[2], qr[1], C0); ADD6(ps_, P1, 4, 5, 6, P1, 7, 8, 9); PIN(ps_); SBAR(); \
    C1 = MF(kf[3], qr[1], C1); ADD6(ps_, P1, 10, 11, 12, P1, 13, 14, 15); l_reg += ps_; PIN(l_reg); SBAR(); \
    C0 = MF(kf[4], qr[2], C0); pw0 = (u32x4){PKW(P0, 0), PKW(P0, 2), PKW(P0, 4), PKW(P0, 6)}; PIN(pw0); SBAR(); \
    C1 = MF(kf[5], qr[2], C1); pw1 = (u32x4){PKW(P0, 8), PKW(P0, 10), PKW(P0, 12), PKW(P0, 14)}; PIN(pw1); SBAR(); \
    C0 = MF(kf[6], qr[3], C0); pw2 = (u32x4){PKW(P1, 0), PKW(P1, 2), PKW(P1, 4), PKW(P1, 6)}; PIN(pw2); SBAR(); \
    C1 = MF(kf[7], qr[3], C1); pw3 = (u32x4){PKW(P1, 8), PKW(P1, 10), PKW(P1, 12), PKW(P1, 14)}; PIN(pw3); PIN(C0); PIN(C1); SBAR(); \
    VRD4(va, vnext, 0); VRD4(vb, vnext, 1); SBAR();     \
    } while (0)
#define VRD1(dst, ks, blk) dst[ks] = *(const LAS bf16x8*)(vp_ + vaddr[ks] + (blk) * 4096)
#define EXP2N(X, lo) do { X[lo] = __builtin_amdgcn_exp2f(X[lo]); X[lo + 1] = __builtin_amdgcn_exp2f(X[lo + 1]); } while (0)
#define S2(C0, C1, vbuf) do { SBAR(); \
    const lcp vp_ = lds3 + (vbuf) * BUFB; \
    o[0] = MF(va[0], PB(pw0), o[0]); VRD1(va, 0, 2); EXP2N(C0, 0); PIN(C0); SBAR(); \
    o[0] = MF(va[1], PB(pw1), o[0]); VRD1(va, 1, 2); EXP2N(C0, 2); PIN(C0); SBAR(); \
    o[0] = MF(va[2], PB(pw2), o[0]); VRD1(va, 2, 2); EXP2N(C0, 4); PIN(C0); SBAR(); \
    o[0] = MF(va[3], PB(pw3), o[0]); VRD1(va, 3, 2); EXP2N(C0, 6); PIN(C0); SBAR(); \
    o[1] = MF(vb[0], PB(pw0), o[1]); VRD1(vb, 0, 3); EXP2N(C0, 8); PIN(C0); SBAR(); \
    o[1] = MF(vb[1], PB(pw1), o[1]); VRD1(vb, 1, 3); EXP2N(C0, 10); PIN(C0); SBAR(); \
    o[1] = MF(vb[2], PB(pw2), o[1]); VRD1(vb, 2, 3); EXP2N(C0, 12); PIN(C0); SBAR(); \
    o[1] = MF(vb[3], PB(pw3), o[1]); VRD1(vb, 3, 3); EXP2N(C0, 14); PIN(C0); SBAR(); \
    o[2] = MF(va[0], PB(pw0), o[2]); EXP2N(C1, 0); PIN(C1); SBAR(); \
    o[2] = MF(va[1], PB(pw1), o[2]); EXP2N(C1, 2); PIN(C1); SBAR(); \
    o[2] = MF(va[2], PB(pw2), o[2]); EXP2N(C1, 4); PIN(C1); SBAR(); \
    o[2] = MF(va[3], PB(pw3), o[2]); EXP2N(C1, 6); PIN(C1); SBAR(); \
    o[3] = MF(vb[0], PB(pw0), o[3]); EXP2N(C1, 8); PIN(C1); SBAR(); \
    o[3] = MF(vb[1], PB(pw1), o[3]); EXP2N(C1, 10); PIN(C1); SBAR(); \
    o[3] = MF(vb[2], PB(pw2), o[3]); EXP2N(C1, 12); PIN(C1); SBAR(); \
    o[3] = MF(vb[3], PB(pw3), o[3]); EXP2N(C1, 14); PIN(C1); SBAR(); \
    } while (0)
    pB0 = f32x16{}; pB1 = f32x16{};
    if (!pre) { DMA(0, 0); DMA(1, 1); BARV(); }
    if (isB) { BARV(); DMA(2, 2); }
    S1(pA0, pA1, pB0, pB1, 0, 0);
    if (!isB) { BARV(); DMA(2, 2); }
    { float pm_ = pA0[0];
#pragma unroll
      for (int r = 1; r < 16; ++r) pm_ = __builtin_fmaxf(pm_, pA0[r]);
#pragma unroll
      for (int r = 0; r < 16; ++r) pm_ = __builtin_fmaxf(pm_, pA1[r]);
      { auto rr_ = __builtin_amdgcn_permlane32_swap(__float_as_uint(pm_), __float_as_uint(pm_), false, false); pm_ = __builtin_fmaxf(__uint_as_float(rr_[0]), __uint_as_float(rr_[1])); }
      const float nm_ = -(pm_ + REF_MARGIN);
#pragma unroll
      for (int r = 0; r < 16; ++r) { negm[r] = nm_; pA0[r] = __builtin_amdgcn_exp2f(pA0[r] + nm_); pA1[r] = __builtin_amdgcn_exp2f(pA1[r] + nm_); }
      PIN(negm); }
    for (int j = 1; j < NTILE; j += 2) {
        if (isB) { BARV(); DMAT(j + 2); }
        S1(pB0, pB1, pA0, pA1, j & 3, (j - 1) & 3);
        if (!isB) { BARV(); DMAT(j + 2); }
        S2(pB0, pB1, (j - 1) & 3);
        if (isB) { BARV(); DMAT(j + 3); }
        { const int kt = (j + 1 < NTILE) ? j + 1 : NTILE - 1;
          S1(pA0, pA1, pB0, pB1, kt & 3, j & 3); }
        if (!isB) { BARV(); DMAT(j + 3); }
        S2(pA0, pA1, j & 3);
    }
    { auto rr_ = __builtin_amdgcn_permlane32_swap(__float_as_uint(l_reg), __float_as_uint(l_reg), false, false);
      const float rl = __builtin_amdgcn_rcpf(__uint_as_float(rr_[0]) + __uint_as_float(rr_[1]));
#pragma unroll
      for (int d = 0; d < 4; ++d) o[d] = o[d] * rl; }
    if (!has_next) BAR();
#undef DMA
#undef DMAX
#undef DMAT
#undef BAR
#undef BARV
#undef PIN
#undef MF
#undef PB
#undef PKW
#undef ADD6
#undef S1
#undef S2
#undef KRD
#undef VRD4
#undef VRD1
#undef EXP2N
}
__device__ __forceinline__ void attn_unit(const Args& a, int b, int h, int qb, float lam, char* lds, bool first, bool has_nu, int nb, int nh) {
    const bf16_t* Q = (const bf16_t*)(a.ws + WS_Q); const bf16_t* KA = (const bf16_t*)(a.ws + WS_K); const bf16_t* VT = (const bf16_t*)(a.ws + WS_V);
    const size_t qrow0 = (size_t)b * NT + (size_t)qb * 256, kvrow0 = (size_t)b * KVR;
    for (int m = 0; m < 2; ++m) {
        f32x16 o[4];
        const bf16_t* Kc = KA + kvrow0 * DM + (2 * h + m) * 64; const bf16_t* Vc = VT + (size_t)((b * NHD + h) * 128) * VT_PITCH;
        const bf16_t* Kn = m == 0 ? Kc + 64 : KA + (size_t)nb * KVR * DM + (2 * nh) * 64; const bf16_t* Vn = m == 0 ? Vc : VT + (size_t)((nb * NHD + nh) * 128) * VT_PITCH;
        attn_map(Q + qrow0 * DM + (2 * h + m) * 64, Kc, Vc, (long)(Kn - Kc), (long)(Vn - Vc), !(first && m == 0), m == 0 || has_nu, o, lds);
        int t2 = threadIdx.x; asm volatile("" : "+v"(t2));
        const int wid = t2 >> 6, lane = t2 & 63, r32 = lane & 31, hi = lane >> 5;
        float* o1p = (float*)(a.ws + WS_O1) + (size_t)blockIdx.x * (64 * 512) + t2;
        if (m == 0) {
#pragma unroll
            for (int d = 0; d < 4; ++d)
#pragma unroll
                for (int r = 0; r < 16; ++r) o1p[(d * 16 + r) * 512] = o[d][r];
        } else {
            float ss = 0.f;
#pragma unroll
            for (int d = 0; d < 4; ++d)
#pragma unroll
                for (int r = 0; r < 16; ++r) { const float v = o1p[(d * 16 + r) * 512] - lam * o[d][r]; o[d][r] = v; ss += v * v; }
            { auto rr_ = __builtin_amdgcn_permlane32_swap(__float_as_uint(ss), __float_as_uint(ss), false, false); ss = __uint_as_float(rr_[0]) + __uint_as_float(rr_[1]); }
            const float rstd = 0.8f / sqrtf(ss * (1.0f / 128.0f) + EPS);
            const float* gs = a.in[I_GSUB] + 4 * hi;
            bf16_t* aow = (bf16_t*)(a.ws + WS_ATTO) + (qrow0 + wid * QBLK + r32) * DM + h * 128 + 4 * hi;
#pragma unroll
            for (int d = 0; d < 4; ++d)
#pragma unroll
                for (int rg = 0; rg < 4; ++rg) { const f32x4 g = *(const f32x4*)(gs + 32 * d + 8 * rg);
                    u32x2 w; w.x = cvt_pk_bf16(o[d][4 * rg] * rstd * g[0], o[d][4 * rg + 1] * rstd * g[1]); w.y = cvt_pk_bf16(o[d][4 * rg + 2] * rstd * g[2], o[d][4 * rg + 3] * rstd * g[3]);
                    *(u32x2*)(aow + 32 * d + 8 * rg) = w; }
        }
    }
}
#undef KSWZ
#undef SBAR
}

struct SchedDual {
    const char *A0, *A1, *B0, *B1; int G, c;
    __device__ __forceinline__ bool next(int i, Unit& u) const {
        const int L = (i >> 1) * G + c; if (L >= 512) return false;
        pg8::tile_of(L, 128, 4, u.pm, u.pn); u.aux = i & 1; return true; }
    __device__ __forceinline__ const char* a_ptr(const Unit& u) const { return (u.aux ? A1 : A0) + (size_t)u.pm * (256 * DM * 2); }
    __device__ __forceinline__ const char* b_ptr(const Unit& u) const { return (u.aux ? B1 : B0) + (size_t)u.pn * (256 * DM * 2); }
    __device__ __forceinline__ bool keep(const Unit& u) const { return u.aux == 0; }
};
struct EpiDual {
    static constexpr bool PERM = true;
    const bf16_t *GA, *GC; const float* bc; bf16_t* MIX;
    __device__ __forceinline__ void operator()(f32x4 (&acc)[2][2][4][2], const Unit& u, int wr, int wc, int fr, int fq) const {
        const int col0 = u.pn * 256 + wc * 32 + 8 * fq;
        if (u.aux == 0) {
            u32x4 ga[2][2], gc[2][2];
#define EDL(i, g) do { const int ai_ = (g) >> 2, m_ = (g) & 3; const size_t off_ = (size_t)(u.pm * 256 + ai_ * 128 + wr * 64 + m_ * 16 + fr) * DM + col0; \
    ga[i][0] = *(const u32x4*)(GA + off_); ga[i][1] = *(const u32x4*)(GA + off_ + 128); gc[i][0] = *(const u32x4*)(GC + off_); gc[i][1] = *(const u32x4*)(GC + off_ + 128); } while (0)
            EDL(0, 0);
#pragma unroll
            for (int g = 0; g < 8; ++g) { const int ai = g >> 2, m = g & 3, cur = g & 1;
                if (g + 1 < 8) { if (cur) EDL(0, g + 1); else EDL(1, g + 1); }
#pragma unroll
                for (int bj = 0; bj < 2; ++bj) { const u32x4 a4 = ga[cur][bj], c4 = gc[cur][bj];
                    f32x4 r0, r1;
                    r0[0] = bf_lo(a4.x) * __builtin_amdgcn_rcpf(bf_lo(c4.x)); r0[1] = bf_hi(a4.x) * __builtin_amdgcn_rcpf(bf_hi(c4.x));
                    r0[2] = bf_lo(a4.y) * __builtin_amdgcn_rcpf(bf_lo(c4.y)); r0[3] = bf_hi(a4.y) * __builtin_amdgcn_rcpf(bf_hi(c4.y));
                    r1[0] = bf_lo(a4.z) * __builtin_amdgcn_rcpf(bf_lo(c4.z)); r1[1] = bf_hi(a4.z) * __builtin_amdgcn_rcpf(bf_hi(c4.z));
                    r1[2] = bf_lo(a4.w) * __builtin_amdgcn_rcpf(bf_lo(c4.w)); r1[3] = bf_hi(a4.w) * __builtin_amdgcn_rcpf(bf_hi(c4.w));
                    acc[ai][bj][m][0] *= r0; acc[ai][bj][m][1] *= r1; }
                asm volatile("" ::: "memory"); }
#undef EDL
            return;
        }
        f32x4 bv[2][2];
#pragma unroll
        for (int bj = 0; bj < 2; ++bj)
#pragma unroll
            for (int n = 0; n < 2; ++n) bv[bj][n] = *(const f32x4*)(bc + col0 + bj * 128 + 4 * n);
        u32x4 gc[2][2];
#define EDL(i, g) do { const int ai_ = (g) >> 2, m_ = (g) & 3; const size_t off_ = (size_t)(u.pm * 256 + ai_ * 128 + wr * 64 + m_ * 16 + fr) * DM + col0; \
    gc[i][0] = *(const u32x4*)(GC + off_); gc[i][1] = *(const u32x4*)(GC + off_ + 128); } while (0)
        EDL(0, 0);
#pragma unroll
        for (int g = 0; g < 8; ++g) { const int ai = g >> 2, m = g & 3, cur = g & 1;
            if (g + 1 < 8) { if (cur) EDL(0, g + 1); else EDL(1, g + 1); }
            const size_t off = (size_t)(u.pm * 256 + ai * 128 + wr * 64 + m * 16 + fr) * DM + col0;
#pragma unroll
            for (int bj = 0; bj < 2; ++bj) { const u32x4 c4 = gc[cur][bj];
                const f32x4 v0 = acc[ai][bj][m][0] + bv[bj][0], v1 = acc[ai][bj][m][1] + bv[bj][1];
                u32x4 w; w.x = cvt_pk_bf16(v0[0] * bf_lo(c4.x), v0[1] * bf_hi(c4.x)); w.y = cvt_pk_bf16(v0[2] * bf_lo(c4.y), v0[3] * bf_hi(c4.y));
                w.z = cvt_pk_bf16(v1[0] * bf_lo(c4.z), v1[1] * bf_hi(c4.z)); w.w = cvt_pk_bf16(v1[2] * bf_lo(c4.w), v1[3] * bf_hi(c4.w));
                *(u32x4*)(MIX + off + bj * 128) = w; }
            asm volatile("" ::: "memory"); }
#undef EDL
    }
};

struct SchedPlain {
    const char* A; const char* Bt; int G, c, nM, nN, RB, bgrp;
    __device__ __forceinline__ bool next(int i, Unit& u) const {
        const int L = i * G + c; if (L >= nM * nN) return false;
        pg8::tile_of(L, nM, nN, u.pm, u.pn); u.aux = 0; return true; }
    __device__ __forceinline__ const char* a_ptr(const Unit& u) const { return A + (size_t)u.pm * ((size_t)256 * RB); }
    __device__ __forceinline__ const char* b_ptr(const Unit& u) const { return Bt + (size_t)((u.pm >> 4) * nN * bgrp + u.pn) * ((size_t)256 * RB); }
    __device__ __forceinline__ bool keep(const Unit&) const { return false; }
};
struct EpiResid {
    static constexpr bool PERM = false;
    const float* x; const float* mod; float* out;
    __device__ __forceinline__ void operator()(f32x4 (&acc)[2][2][4][2], const Unit& u, int wr, int wc, int fr, int fq) const {
        const int col0 = u.pn * 256 + wc * 32 + 4 * fq; const float* gm = mod + (size_t)(u.pm >> 4) * NMOD + 2048 + col0;
        f32x4 gv[2][2];
#pragma unroll
        for (int bj = 0; bj < 2; ++bj)
#pragma unroll
            for (int n = 0; n < 2; ++n) gv[bj][n] = *(const f32x4*)(gm + bj * 128 + n * 16);
        f32x4 xv[2][2][2];
#define ERL(i, g) do { const int ai_ = (g) >> 2, m_ = (g) & 3; const size_t off_ = (size_t)(u.pm * 256 + ai_ * 128 + wr * 64 + m_ * 16 + fr) * DM + col0; \
    _Pragma("unroll") for (int bj_ = 0; bj_ < 2; ++bj_) _Pragma("unroll") for (int n_ = 0; n_ < 2; ++n_) xv[i][bj_][n_] = __builtin_nontemporal_load((const f32x4*)(x + off_ + bj_ * 128 + n_ * 16)); } while (0)
        ERL(0, 0);
#pragma unroll
        for (int g = 0; g < 8; ++g) { const int ai = g >> 2, m = g & 3, cur = g & 1;
            if (g + 1 < 8) { if (cur) ERL(0, g + 1); else ERL(1, g + 1); }
            const size_t off = (size_t)(u.pm * 256 + ai * 128 + wr * 64 + m * 16 + fr) * DM + col0;
#pragma unroll
            for (int bj = 0; bj < 2; ++bj)
#pragma unroll
                for (int n = 0; n < 2; ++n) *(f32x4*)(out + off + bj * 128 + n * 16) = xv[cur][bj][n] + gv[bj][n] * acc[ai][bj][m][n];
            asm volatile("" ::: "memory"); }
#undef ERL
    }
};

__device__ __forceinline__ void ph_router(const Args& a, LAS unsigned char* lds, int gw, int NGW, int lane) {
    LAS float* wrt = (LAS float*)lds;
    const float* wr = a.in[I_WR];
    for (int i = threadIdx.x; i < DM * NEXP; i += 512) { const int k = i >> 4, e = i & 15; wrt[e * DM + k] = wr[i]; }
    __syncthreads();
    const float* mod = (const float*)(a.ws + WS_MOD); const float* g = a.in[I_GFFN];
    unsigned char* HF = (unsigned char*)(a.ws + WS_HF); float* AFF = (float*)(a.ws + WS_AFF);
    f32x4 gs[4], shv[4]; int cur_b = -1;
    f32x4 nx[4];
    { const f32x4* xr = (const f32x4*)(a.out + (size_t)gw * DM) + lane;
#pragma unroll
      for (int j = 0; j < 4; ++j) nx[j] = __builtin_nontemporal_load(xr + 64 * j); }
    for (int row = gw; row < MLAT; row += NGW) {
        f32x4 v[4]; float s = 0.f;
#pragma unroll
        for (int j = 0; j < 4; ++j) { v[j] = nx[j]; s += (v[j].x * v[j].x + v[j].y * v[j].y) + (v[j].z * v[j].z + v[j].w * v[j].w); }
        if (row + NGW < MLAT) { const f32x4* xr = (const f32x4*)(a.out + (size_t)(row + NGW) * DM) + lane;
#pragma unroll
            for (int j = 0; j < 4; ++j) nx[j] = __builtin_nontemporal_load(xr + 64 * j); }
        if ((row >> 12) != cur_b) { cur_b = row >> 12; const float* mb = mod + (size_t)cur_b * NMOD + 3072;
#pragma unroll
            for (int j = 0; j < 4; ++j) { const int c = 4 * lane + 256 * j; gs[j] = *(const f32x4*)(g + c) * (*(const f32x4*)(mb + 1024 + c) + 1.0f); shv[j] = *(const f32x4*)(mb + c); } }
        const float rstd = 1.0f / sqrtf(wave_sum(s) * (1.0f / DM) + EPS);
        unsigned* o4 = (unsigned*)(HF + (size_t)row * DM) + lane;
#pragma unroll
        for (int j = 0; j < 4; ++j) { v[j] = (v[j] * rstd) * gs[j] + shv[j];
            o4[64 * j] = pack4_fp8(v[j].x, v[j].y, v[j].z, v[j].w); }
        float p[16];
#pragma unroll
        for (int e = 0; e < 16; ++e) { float t = 0.f;
#pragma unroll
            for (int j = 0; j < 4; ++j) { const f32x4 wv = *(const LAS f32x4*)(wrt + e * DM + 4 * lane + 256 * j); t += (v[j].x * wv.x + v[j].y * wv.y) + (v[j].z * wv.z + v[j].w * wv.w); }
            p[e] = t; if ((e & 3) == 3) __builtin_amdgcn_sched_barrier(0); }
        float r8[8], r4[4], r2[2], r1;
        { const bool up = (lane & 32) != 0;
#pragma unroll
          for (int i = 0; i < 8; ++i) { const float send = up ? p[i] : p[i + 8], keepv = up ? p[i + 8] : p[i]; r8[i] = keepv + __shfl_xor(send, 32); } }
        { const bool up = (lane & 16) != 0;
#pragma unroll
          for (int i = 0; i < 4; ++i) { const float send = up ? r8[i] : r8[i + 4], keepv = up ? r8[i + 4] : r8[i]; r4[i] = keepv + __shfl_xor(send, 16); } }
        { const bool up = (lane & 8) != 0;
#pragma unroll
          for (int i = 0; i < 2; ++i) { const float send = up ? r4[i] : r4[i + 2], keepv = up ? r4[i + 2] : r4[i]; r2[i] = keepv + __shfl_xor(send, 8); } }
        { const bool up = (lane & 4) != 0; const float send = up ? r2[0] : r2[1], keepv = up ? r2[1] : r2[0]; r1 = keepv + __shfl_xor(send, 4); }
        r1 += __shfl_xor(r1, 2); r1 += __shfl_xor(r1, 1);
        float mx = r1;
#pragma unroll
        for (int o = 4; o < 64; o <<= 1) mx = fmaxf(mx, __shfl_xor(mx, o));
        const float ex = expf(r1 - mx); float sm = ex;
#pragma unroll
        for (int o = 4; o < 64; o <<= 1) sm += __shfl_xor(sm, o);
        if ((lane & 3) == 0) AFF[(size_t)row * NEXP + (lane >> 2)] = ex / sm;
    }
}

__device__ __forceinline__ void ph_topk_unit(const Args& a, LAS unsigned char* lds, int g  ) {
    const int tid = threadIdx.x, lane = tid & 63, wave = __builtin_amdgcn_readfirstlane(tid >> 6);
    const int b = g >> 4, e = g & 15;
    LAS unsigned* hist = (LAS unsigned*)lds;
    LAS unsigned* ctl = hist + 256;
    LAS unsigned* wsum = hist + 264;
    LAS int* S = (LAS int*)(hist + 512);
    const float* AFF = (const float*)(a.ws + WS_AFF) + (size_t)b * NT * NEXP + e;
    unsigned key[8];
#pragma unroll
    for (int q = 0; q < 8; ++q) key[q] = __float_as_uint(AFF[(size_t)(8 * tid + q) * NEXP]);
    unsigned prefix = 0, need = CAP;
#pragma unroll
    for (int pass = 0; pass < 4; ++pass) {
        const int shift = 24 - 8 * pass;
        const unsigned himask = pass == 0 ? 0u : (0xFFFFFFFFu << (shift + 8));
        if (tid < 256) hist[tid] = 0;
        __syncthreads();
#pragma unroll
        for (int q = 0; q < 8; ++q) if ((key[q] & himask) == prefix) __hip_atomic_fetch_add(hist + ((key[q] >> shift) & 255), 1u, __ATOMIC_RELAXED, __HIP_MEMORY_SCOPE_WORKGROUP);
        __syncthreads();
        if (wave == 0) {
            const u32x4 h = *(const LAS u32x4*)(hist + 4 * lane);
            const unsigned c = h.x + h.y + h.z + h.w;
            unsigned v = c;
#pragma unroll
            for (int off = 1; off < 64; off <<= 1) { const unsigned o = __shfl_down(v, off); if (lane + off < 64) v += o; }
            const unsigned above = v - c;
            if (above < need && need <= v) {
                unsigned acc = above; int d;
                if (acc + h.w >= need) d = 3; else { acc += h.w; if (acc + h.z >= need) d = 2; else { acc += h.z; if (acc + h.y >= need) d = 1; else { acc += h.y; d = 0; } } }
                ctl[0] = prefix | ((unsigned)(4 * lane + d) << shift); ctl[1] = need - acc;
            }
        }
        __syncthreads();
        prefix = ctl[0]; need = ctl[1];
    }
    unsigned cg = 0, ce = 0;
#pragma unroll
    for (int q = 0; q < 8; ++q) { cg += key[q] > prefix; ce += key[q] == prefix; }
    const unsigned pk = cg | (ce << 16);
    unsigned inc = pk;
#pragma unroll
    for (int off = 1; off < 64; off <<= 1) { const unsigned o = __shfl_up(inc, off); if (lane >= off) inc += o; }
    if (lane == 63) wsum[wave] = inc;
    __syncthreads();
    unsigned base = 0;
    for (int w = 0; w < wave; ++w) base += wsum[w];
    const unsigned excl = base + inc - pk;
    unsigned gbef = excl & 0xFFFFu, ebef = excl >> 16;
    int* SEL = (int*)(a.ws + WS_SEL) + (size_t)b * NT * NEXP + e;
#pragma unroll
    for (int q = 0; q < 8; ++q) { const int tok = 8 * tid + q; int sel = -1;
        if (key[q] > prefix) { sel = (int)(gbef + (ebef < need ? ebef : need)); ++gbef; }
        else if (key[q] == prefix) { if (ebef < need) sel = (int)(gbef + ebef); ++ebef; }
        SEL[(size_t)tok * NEXP] = sel; if (sel >= 0) S[sel] = tok; }
    __syncthreads();
    const unsigned char* HF = (const unsigned char*)(a.ws + WS_HF) + (size_t)b * NT * DM;
    unsigned char* XS = (unsigned char*)(a.ws + WS_XS) + (size_t)(e * NB + b) * CAP * DM;
    for (int k = 0; k < 64; k += 8) {
        u32x4 v[8];
#pragma unroll
        for (int q = 0; q < 8; ++q) { const int s = wave * 64 + k + q; const unsigned tok = (unsigned)S[s];
            v[q] = ((const u32x4*)(HF + (size_t)tok * DM))[lane]; }
#pragma unroll
        for (int q = 0; q < 8; ++q) { const int s = wave * 64 + k + q; ((u32x4*)(XS + (size_t)s * DM))[lane] = v[q]; }
    }
    __syncthreads();
}

struct EpiSwiGLU {
    static constexpr bool PERM = true;
    unsigned char* HID;
    __device__ __forceinline__ void operator()(f32x4 (&acc)[2][2][4][2], const Unit& u, int wr, int wc, int fr, int fq) const {
        const int col0 = u.pn * 128 + wc * 32 + 8 * fq;
#pragma unroll
        for (int ai = 0; ai < 2; ++ai)
#pragma unroll
            for (int m = 0; m < 4; ++m) { const size_t r = (size_t)u.pm * 256 + ai * 128 + wr * 64 + m * 16 + fr;
                const f32x4 g0 = acc[ai][0][m][0] * WSCALE_INV, g1 = acc[ai][0][m][1] * WSCALE_INV, u0 = acc[ai][1][m][0] * WSCALE_INV, u1 = acc[ai][1][m][1] * WSCALE_INV;
                u32x2 w; w.x = pack4_fp8(g0[0] * sigmoidf_(g0[0]) * u0[0], g0[1] * sigmoidf_(g0[1]) * u0[1], g0[2] * sigmoidf_(g0[2]) * u0[2], g0[3] * sigmoidf_(g0[3]) * u0[3]);
                w.y = pack4_fp8(g1[0] * sigmoidf_(g1[0]) * u1[0], g1[1] * sigmoidf_(g1[1]) * u1[1], g1[2] * sigmoidf_(g1[2]) * u1[2], g1[3] * sigmoidf_(g1[3]) * u1[3]);
                *(u32x2*)(HID + r * DFF + col0) = w; }
    }
};
struct EpiPlainBf16 {
    static constexpr bool PERM = true;
    bf16_t* O; int ldc; float scale;
    __device__ __forceinline__ void operator()(f32x4 (&acc)[2][2][4][2], const Unit& u, int wr, int wc, int fr, int fq) const {
        const int col0 = u.pn * 256 + wc * 32 + 8 * fq;
#pragma unroll
        for (int ai = 0; ai < 2; ++ai)
#pragma unroll
            for (int m = 0; m < 4; ++m) { bf16_t* rowp = O + ((size_t)u.pm * 256 + ai * 128 + wr * 64 + m * 16 + fr) * ldc + col0;
#pragma unroll
                for (int bj = 0; bj < 2; ++bj) { const f32x4 v0 = acc[ai][bj][m][0] * scale, v1 = acc[ai][bj][m][1] * scale;
                    u32x4 w; w.x = cvt_pk_bf16(v0[0], v0[1]); w.y = cvt_pk_bf16(v0[2], v0[3]); w.z = cvt_pk_bf16(v1[0], v1[1]); w.w = cvt_pk_bf16(v1[2], v1[3]);
                    *(u32x4*)(rowp + bj * 128) = w; } }
    }
};

__device__ __forceinline__ void ph_final(const Args& a, int gw, int NGW, int lane) {
    const float* mod = (const float*)(a.ws + WS_MOD); const float* gfin = a.in[I_GFIN];
    const float* AFF = (const float*)(a.ws + WS_AFF); const int* SEL = (const int*)(a.ws + WS_SEL); const bf16_t* YS = (const bf16_t*)(a.ws + WS_YS);
    const int per = MLAT / NGW, r0 = gw * per, b = r0 >> 12;
    f32x4 gfv[2][2], gnv[2][2];
    { const float* gf = mod + (size_t)b * NMOD + 5120;
#pragma unroll
      for (int jj = 0; jj < 2; ++jj)
#pragma unroll
          for (int q = 0; q < 2; ++q) { const int c = 8 * lane + 512 * jj + 4 * q; gfv[jj][q] = *(const f32x4*)(gf + c); gnv[jj][q] = *(const f32x4*)(gfin + c); } }
    for (int row = r0; row < r0 + per; ++row) {
        float* xr = a.out + (size_t)row * DM;
        const int selv = (lane < 16) ? SEL[(size_t)row * NEXP + lane] : -1; const float affv = (lane < 16) ? AFF[(size_t)row * NEXP + lane] : 0.f;
        f32x4 acc[2][2];
#pragma unroll
        for (int jj = 0; jj < 2; ++jj) { acc[jj][0] = (f32x4){0.f, 0.f, 0.f, 0.f}; acc[jj][1] = (f32x4){0.f, 0.f, 0.f, 0.f}; }
#pragma unroll
        for (int e = 0; e < NEXP; ++e) { const int s = __builtin_amdgcn_readlane(selv, e); const float gt = __uint_as_float(__builtin_amdgcn_readlane(__float_as_uint(affv), e));
            if (s >= 0) { const bf16_t* yr = YS + ((size_t)(e * NB + b) * CAP + s) * DM;
#pragma unroll
                for (int jj = 0; jj < 2; ++jj) { const u32x4 y = *(const u32x4*)(yr + 8 * lane + 512 * jj);
                    acc[jj][0] += gt * (f32x4){bf_lo(y.x), bf_hi(y.x), bf_lo(y.y), bf_hi(y.y)}; acc[jj][1] += gt * (f32x4){bf_lo(y.z), bf_hi(y.z), bf_lo(y.w), bf_hi(y.w)}; } } }
        f32x4 v[2][2]; float ss = 0.f;
#pragma unroll
        for (int jj = 0; jj < 2; ++jj)
#pragma unroll
            for (int q = 0; q < 2; ++q) { const int c = 8 * lane + 512 * jj + 4 * q;
                v[jj][q] = __builtin_nontemporal_load((const f32x4*)(xr + c)) + gfv[jj][q] * acc[jj][q];
                ss += (v[jj][q].x * v[jj][q].x + v[jj][q].y * v[jj][q].y) + (v[jj][q].z * v[jj][q].z + v[jj][q].w * v[jj][q].w); }
        const float rstd = 1.0f / sqrtf(wave_sum(ss) * (1.0f / DM) + EPS);
#pragma unroll
        for (int jj = 0; jj < 2; ++jj)
#pragma unroll
            for (int q = 0; q < 2; ++q) { const int c = 8 * lane + 512 * jj + 4 * q; __builtin_nontemporal_store(v[jj][q] * rstd * gnv[jj][q], (f32x4*)(xr + c)); }
    }
}

constexpr int N_PHASES = 12;
#ifndef MK_ATTN_REPS
#define MK_ATTN_REPS 1
#endif
struct Ctx { LAS unsigned char* lds; char* lds_gen; int G, bid, vcu, gw, NGW, wave, lane; };
template <int P> __device__ __forceinline__ void run_phase(const Args& args, const Ctx& c) {
    LAS unsigned char* lds = c.lds; const int G = c.G, bid = c.bid, vcu = c.vcu, gw = c.gw, NGW = c.NGW, wave = c.wave, lane = c.lane;
    if constexpr (P == 0) {
        ph_adaln(args, lds, bid, G);
        if (bid == G - 1) ph_rope_table(args);
        ph_small_weights(args, lds, gw, NGW, wave, lane);
    }
    if constexpr (P == 1) ph_norm_rows(args, gw, NGW, lane);
    if constexpr (P == 2) {
        SchedInProj S{(const char*)(args.ws + WS_H), (const char*)(args.ws + WS_WIN), G, bid};
        EpiInProj E{(bf16_t*)(args.ws + WS_U), (bf16_t*)(args.ws + WS_Q), (bf16_t*)(args.ws + WS_K), (bf16_t*)(args.ws + WS_V), (bf16_t*)(args.ws + WS_GC), (bf16_t*)(args.ws + WS_GA), (const float*)(args.ws + WS_ROPE)};
        pg8::gemm_phase<EpiInProj, SchedInProj, PG8_ALIGN, PG8_SP2>(lds, DM * 2, S, E);
    }
    if constexpr (P == 3) {
#ifndef MK_NO_CONV
        for (int u = vcu; u < 256; u += G) ph_conv_unit(args, lds, u);
        __syncthreads();
#endif
#ifndef MK_NO_ATTN
        float lam;
        { const float s1 = wave_sum(args.in[I_LQ1][lane] * args.in[I_LK1][lane]), s2 = wave_sum(args.in[I_LQ2][lane] * args.in[I_LK2][lane]); lam = __uint_as_float(__builtin_amdgcn_readfirstlane(__float_as_uint(expf(s1) - expf(s2) + 0.2f))); }
#if defined(MK_PROBE_CLOCK)
        const unsigned long long pc0_ = __builtin_amdgcn_s_memtime(), pr0_ = __builtin_amdgcn_s_memrealtime();
#endif
        for (int i = 0; i < 4 * MK_ATTN_REPS; ++i) { const int u = (i & 3) * 256 + vcu; if (u >= 1024) break;
            const int un = ((i + 1) & 3) * 256 + vcu; const bool has_nu = (i + 1 < 4 * MK_ATTN_REPS) && un < 1024;
            att::attn_unit(args, u >> 7, (u >> 4) & 7, u & 15, lam, c.lds_gen, i == 0, has_nu, un >> 7, (un >> 4) & 7); }
#if defined(MK_PROBE_CLOCK)
        { const unsigned long long pc1_ = __builtin_amdgcn_s_memtime(), pr1_ = __builtin_amdgcn_s_memrealtime();
          if (threadIdx.x == 0) { volatile LAS unsigned* mw = (volatile LAS unsigned*)(c.lds + LDSCTL_OFF); mw[16] = (unsigned)(pc1_ - pc0_); mw[17] = (unsigned)(pr1_ - pr0_);
              unsigned* pw_ = (unsigned*)(args.ws + WS_CTL) + 15000;
              atomicMax(pw_, (unsigned)(pr1_ - pr0_)); atomicAdd(pw_ + 1, (unsigned)(pr1_ - pr0_)); atomicMax(pw_ + 2, 0xFFFFFFFFu - (unsigned)(pr1_ - pr0_)); } }
#endif
#endif
    }
    if constexpr (P == 4) {
        SchedDual S{(const char*)(args.ws + WS_ATTO), (const char*)(args.ws + WS_CACT), (const char*)(args.ws + WS_WAO), (const char*)(args.ws + WS_WCO), G, bid};
        EpiDual E{(const bf16_t*)(args.ws + WS_GA), (const bf16_t*)(args.ws + WS_GC), args.in[I_BCO], (bf16_t*)(args.ws + WS_MIX)};
        pg8::gemm_phase<EpiDual, SchedDual, PG8_ALIGN, PG8_SP2>(lds, DM * 2, S, E);
    }
    if constexpr (P == 5) {
        SchedPlain S{(const char*)(args.ws + WS_MIX), (const char*)(args.ws + WS_WO), G, bid, 128, 4, DM * 2, 0};
        EpiResid E{args.in[I_X], (const float*)(args.ws + WS_MOD), args.out};
        pg8::gemm_phase<EpiResid, SchedPlain, PG8_ALIGN, PG8_SP2>(lds, DM * 2, S, E);
    }
    if constexpr (P == 6) {
        ph_router(args, lds, gw, NGW, lane);
        __syncthreads();
        ph_wgu(args, lds, gw, NGW, wave, lane);
        ph_wd(args, lds, gw, NGW, wave, lane, 0, G < 2 ? WD_ITEMS : WD_SPLIT);
    }
    if constexpr (P == 7) {
        if (G < 2) { for (int g = 0; g < NB * NEXP; ++g) ph_topk_unit(args, lds, g); }
        else if ((vcu & 1) == 0) { for (int g = vcu >> 1; g < NB * NEXP; g += (G + 1) / 2) ph_topk_unit(args, lds, g); }
        else ph_wd(args, lds, (vcu >> 1) * 8 + wave, (G / 2) * 8, wave, lane, WD_SPLIT, WD_ITEMS);
    }
    if constexpr (P == 8) {
        SchedPlain S{(const char*)(args.ws + WS_XS), (const char*)(args.ws + WS_WGU), G, bid, 256, 22, DM, 1};
        EpiSwiGLU E{(unsigned char*)(args.ws + WS_HID)};
        pg8::gemm_phase<EpiSwiGLU, SchedPlain, PG8_ALIGN, PG8_SP2, true>(lds, DM, S, E);
    }
    if constexpr (P == 10) {
        SchedPlain S{(const char*)(args.ws + WS_HID), (const char*)(args.ws + WS_WD), G, bid, 256, 4, DFF, 1};
        EpiPlainBf16 E{(bf16_t*)(args.ws + WS_YS), DM, WSCALE_INV};
        pg8::gemm_phase<EpiPlainBf16, SchedPlain, PG8_ALIGN, PG8_SP2, true>(lds, DFF, S, E);
    }
    if constexpr (P == 11) ph_final(args, gw, NGW, lane);
}
#ifndef MK_PHASE_MASK
#define MK_PHASE_MASK 0xFFF
#endif
#ifndef MK_REPEAT_MASK
#define MK_REPEAT_MASK 0
#endif
__global__ void __launch_bounds__(512, 2) mk_fwd(Args args) {
    extern __shared__ __attribute__((aligned(16))) unsigned char lds_raw[];
    LAS unsigned char* lds = (LAS unsigned char*)lds_raw;
    const int tid = threadIdx.x;
    Ctx c; c.lds = lds; c.lds_gen = (char*)lds_raw; c.lane = tid & 63; c.wave = __builtin_amdgcn_readfirstlane(tid >> 6);
    c.G = gridDim.x; c.bid = blockIdx.x;
    c.vcu = (c.G % 8 == 0) ? (c.bid % 8) * (c.G / 8) + c.bid / 8 : c.bid;
    c.gw = c.vcu * 8 + c.wave; c.NGW = c.G * 8;
    volatile LAS unsigned* misc = (volatile LAS unsigned*)(lds + LDSCTL_OFF);
    if (tid < 64) misc[tid] = 0u;
    __syncthreads();
#if defined(MK_PROBE_TS)
    const unsigned long long kstart_ = __builtin_amdgcn_s_memrealtime();
#endif
    const int lo = args.ph_lo, hi = args.ph_hi;
    XcdBarrier bar; bar.bar = (unsigned*)(args.ws + WS_CTL) + 1024 + args.li * XCD_BAR_WORDS; bar.x = 0; bar.st = nullptr;
    if (hi - lo > 1) bar = xcd_barrier_post((unsigned*)(args.ws + WS_CTL) + 1024 + args.li * XCD_BAR_WORDS, misc + 8);
#define IN(k) (((MK_PHASE_MASK >> (k)) & 1) && lo <= (k) && (k) < hi)
#if defined(MK_PROBE_PHASE)
#define PH_T0() const unsigned long long pt0_ = __builtin_amdgcn_s_memrealtime()
#define PH_T1(k) do { const unsigned long long pt1_ = __builtin_amdgcn_s_memrealtime(); if (threadIdx.x == 0) atomicMax((unsigned*)(args.ws + WS_CTL) + 15100 + (k), (unsigned)(pt1_ - pt0_)); } while (0)
#else
#define PH_T0() do { } while (0)
#define PH_T1(k) do { } while (0)
#endif
#if defined(MK_PROBE_BAR)
#define PB_T0() const unsigned long long bt0_ = __builtin_amdgcn_s_memrealtime()
#define PB_T1(k) do { const unsigned long long bt1_ = __builtin_amdgcn_s_memrealtime(); if (threadIdx.x == 0) atomicMax((unsigned*)(args.ws + WS_CTL) + 15200 + (k), 0xFFFFFFFFu - (unsigned)(bt1_ - bt0_)); } while (0)
#else
#define PB_T0() do { } while (0)
#define PB_T1(k) do { } while (0)
#endif
#if defined(MK_PROBE_TS)
#define PH_TS(k) do { if ((k) == MK_PROBE_TS && blockIdx.x == 0 && threadIdx.x == 0) misc[20] = (unsigned)(__builtin_amdgcn_s_memrealtime() - kstart_); } while (0)
#else
#define PH_TS(k) do { } while (0)
#endif
#define PHASE(k) do { PH_TS(k); if (IN(k)) { PH_T0(); run_phase<k>(args, c); if constexpr ((MK_REPEAT_MASK >> (k)) & 1) { __syncthreads(); run_phase<k>(args, c); } PH_T1(k); PH_TS((k) + 100); } \
                      if ((k) != 9 && (k) + 1 < N_PHASES && IN(k) && IN((k) + 1)) { PB_T0(); xcd_barrier(bar); PB_T1(k); } } while (0)
    PHASE(0); PHASE(1); PHASE(2); PHASE(3); PHASE(4); PHASE(5); PHASE(6); PHASE(7); PHASE(8); PHASE(9); PHASE(10); PHASE(11);
#if defined(MK_PROBE_TS)
    PH_TS(12);
    if (blockIdx.x == 0 && threadIdx.x == 0) {
        const unsigned long long wait_ticks = misc[20];
        const unsigned long long w0 = __builtin_amdgcn_s_memrealtime();
        while (__builtin_amdgcn_s_memrealtime() - w0 < wait_ticks) __builtin_amdgcn_s_sleep(8);
    }
#endif
#if defined(MK_PROBE_BAR)
    if (blockIdx.x == 0 && threadIdx.x == 0) {
        unsigned long long wait_ticks = 0;
        for (int k = 0; k < 10; ++k) { const unsigned v = __hip_atomic_load((unsigned*)(args.ws + WS_CTL) + 15200 + k, __ATOMIC_RELAXED, __HIP_MEMORY_SCOPE_AGENT); if (v) wait_ticks += 0xFFFFFFFFu - v; }
        wait_ticks *= 10;
        const unsigned long long w0 = __builtin_amdgcn_s_memrealtime();
        while (__builtin_amdgcn_s_memrealtime() - w0 < wait_ticks) __builtin_amdgcn_s_sleep(8);
    }
#endif
#if defined(MK_PROBE_PHASE)
    if (blockIdx.x == 0 && threadIdx.x == 0) {
        const unsigned long long wait_ticks = __hip_atomic_load((unsigned*)(args.ws + WS_CTL) + 15100 + MK_PROBE_PHASE, __ATOMIC_RELAXED, __HIP_MEMORY_SCOPE_AGENT);
        const unsigned long long w0 = __builtin_amdgcn_s_memrealtime();
        while (__builtin_amdgcn_s_memrealtime() - w0 < wait_ticks) __builtin_amdgcn_s_sleep(8);
    }
#endif
#if defined(MK_PROBE_CLOCK)
    if (blockIdx.x == 0 && threadIdx.x == 0) {
        const unsigned dc = misc[16], dr = misc[17];
        unsigned* pw_ = (unsigned*)(args.ws + WS_CTL) + 15000;
        const unsigned long long wait_ticks = (MK_PROBE_CLOCK == 1) ? (unsigned long long)(((double)dc / (double)dr) * 0.1 * 500.0 * 100.0) : (MK_PROBE_CLOCK == 2) ? (unsigned long long)dr
            : (MK_PROBE_CLOCK == 3) ? (unsigned long long)__hip_atomic_load(pw_, __ATOMIC_RELAXED, __HIP_MEMORY_SCOPE_AGENT)
            : (MK_PROBE_CLOCK == 4) ? (unsigned long long)(__hip_atomic_load(pw_ + 1, __ATOMIC_RELAXED, __HIP_MEMORY_SCOPE_AGENT) / gridDim.x)
            : (unsigned long long)(0xFFFFFFFFu - __hip_atomic_load(pw_ + 2, __ATOMIC_RELAXED, __HIP_MEMORY_SCOPE_AGENT));
        const unsigned long long w0 = __builtin_amdgcn_s_memrealtime();
        while (__builtin_amdgcn_s_memrealtime() - w0 < wait_ticks) __builtin_amdgcn_s_sleep(8);
    }
#endif
#undef IN
#undef PHASE
}

extern "C" void kernel_launch(void* const* d_in, const int* in_sizes, int n_in, void* d_out, int out_size, void* d_ws, size_t ws_size, hipStream_t stream) {
    static int grid = 0;
    if (grid == 0) {
        if (n_in != N_IN || out_size != MLAT * DM || ws_size < WS_END) { fprintf(stderr, "kernel_launch: unexpected shapes: n_in %d out %d ws %zu (need %zu)\n", n_in, out_size, ws_size, (size_t)WS_END); grid = -1; return; }
        int dev = 0, cus = 0, per_cu = 0;
        if (hipGetDevice(&dev) != hipSuccess || hipDeviceGetAttribute(&cus, hipDeviceAttributeMultiprocessorCount, dev) != hipSuccess) { grid = -1; return; }
        if (hipFuncSetAttribute((const void*)mk_fwd, hipFuncAttributeMaxDynamicSharedMemorySize, LDS_BYTES) != hipSuccess) { fprintf(stderr, "kernel_launch: hipFuncSetAttribute failed\n"); grid = -1; return; }
        if (hipOccupancyMaxActiveBlocksPerMultiprocessor(&per_cu, (const void*)mk_fwd, 512, LDS_BYTES) != hipSuccess || per_cu < 1) fprintf(stderr, "kernel_launch: occupancy query reports %d\n", per_cu);
        (void)hipGetLastError();
        grid = cus;
    }
    if (grid < 0) return;
    if (hipMemsetAsync((char*)d_ws + WS_CTL, 0, CTL_ZERO_BYTES, stream) != hipSuccess) return;
    Args a{};
    for (int i = 0; i < N_IN; ++i) a.in[i] = (const float*)d_in[i];
    a.out = (float*)d_out; a.ws = (unsigned char*)d_ws;
    constexpr int NL = MK_N_LAUNCHES;
    for (int li = 0; li < NL; ++li) {
        a.ph_lo = (NL == N_PHASES) ? li : (li * N_PHASES) / NL; a.ph_hi = (NL == N_PHASES) ? li + 1 : ((li + 1) * N_PHASES) / NL; a.li = (NL == N_PHASES) ? 0 : li; a.pad = 0;
        hipLaunchKernelGGL(mk_fwd, dim3(grid), dim3(512), LDS_BYTES, stream, a);
    }
}
```

```cpp
#include <hip/hip_runtime.h>
#include <cstdio>
#include <cstdint>

#ifndef MK_N_LAUNCHES
#define MK_N_LAUNCHES 1
#endif

#define LAS __attribute__((address_space(3)))
typedef unsigned short bf16_t;
typedef short bf16x8 __attribute__((ext_vector_type(8)));
typedef short s16x4 __attribute__((ext_vector_type(4)));
typedef float f32x2 __attribute__((ext_vector_type(2)));
typedef float f32x4 __attribute__((ext_vector_type(4)));
typedef float f32x16 __attribute__((ext_vector_type(16)));
typedef unsigned u32x2 __attribute__((ext_vector_type(2)));
typedef unsigned u32x4 __attribute__((ext_vector_type(4)));
typedef int i32x4 __attribute__((ext_vector_type(4)));
typedef int i32x8 __attribute__((ext_vector_type(8)));

constexpr int NB = 8, NT = 4096, DM = 1024, NCX = 256, NHD = 8, NEXP = 16, CAP = 512, DFF = 2816;
constexpr int MLAT = NB * NT, MCTX = NB * NCX, MALL = MLAT + MCTX, KVR = NT + NCX;
constexpr int NPROJ = 7168, NMOD = 6 * DM;
constexpr float EPS = 1e-6f;
constexpr float QSCALE = 0.125f * 1.4426950408889634f;

constexpr size_t MiB = 1u << 20;
constexpr size_t WS_CTL = 0, CTL_ZERO_BYTES = 65536;
constexpr size_t WS_MOD = 65536;
constexpr size_t WS_ROPE = 294912;
constexpr size_t WS_AFF = 1 * MiB;
constexpr size_t WS_SEL = 3 * MiB;
constexpr size_t WS_WIN = 8 * MiB, WS_WCO = 22 * MiB, WS_WAO = 24 * MiB, WS_WO = 26 * MiB;
constexpr size_t WS_H = 28 * MiB;
constexpr size_t WS_ATTO = 28 * MiB;
constexpr size_t WS_U = 96 * MiB;
constexpr size_t WS_MIX = 96 * MiB;
constexpr size_t WS_Q = 160 * MiB;
constexpr size_t WS_K = 224 * MiB;
constexpr size_t WS_V = 292 * MiB;
constexpr size_t WS_GC = 360 * MiB, WS_GA = 424 * MiB;
constexpr size_t WS_CACT = 488 * MiB;
constexpr size_t WS_O1 = 552 * MiB;
constexpr size_t WS_WGU = 8 * MiB;
constexpr size_t WS_XS = 96 * MiB;
constexpr size_t WS_HF = 160 * MiB;
constexpr size_t WS_HID = 192 * MiB;
constexpr size_t WS_WD = 368 * MiB;
constexpr size_t WS_YS = 416 * MiB;
constexpr float WSCALE = 64.0f, WSCALE_INV = 1.0f / 64.0f;
constexpr size_t WS_END = 680 * MiB;

constexpr int RING_BYTES = 131072, LDSCTL_OFF = RING_BYTES, LDS_BYTES = 147456;

#define LDS_WAIT() asm volatile("s_waitcnt lgkmcnt(0)" ::: "memory")
#define VM_WAIT() asm volatile("s_waitcnt vmcnt(0)" ::: "memory")
__device__ __forceinline__ unsigned cvt_pk_bf16(float lo, float hi) { unsigned r; asm volatile("v_cvt_pk_bf16_f32 %0, %1, %2" : "=v"(r) : "v"(lo), "v"(hi)); return r; }
__device__ __forceinline__ unsigned pack4_fp8(float a, float b, float c, float d) { int w = 0; w = __builtin_amdgcn_cvt_pk_fp8_f32(a, b, w, false); w = __builtin_amdgcn_cvt_pk_fp8_f32(c, d, w, true); return (unsigned)w; }
__device__ __forceinline__ float bf_lo(unsigned u) { return __uint_as_float(u << 16); }
__device__ __forceinline__ float bf_hi(unsigned u) { return __uint_as_float(u & 0xffff0000u); }
__device__ __forceinline__ float wave_sum(float v) {
#pragma unroll
    for (int o = 1; o < 64; o <<= 1) v += __shfl_xor(v, o);
    return v;
}
__device__ __forceinline__ float sigmoidf_(float x) { return __builtin_amdgcn_rcpf(1.0f + __expf(-x)); }

#define XB_TMO      128
#define XB_XCNT(j)  (256  + 64 * (j))
#define XB_XSUB(j)  (1280 + 64 * (j))
#define XB_XGEN(j)  (2304 + 64 * (j))
#define XB_TOP      3328
#define XB_TOPGEN   3392
#define XCD_BAR_WORDS 3456
#define XB_SPIN_CAP (1u << 18)
__device__ __forceinline__ unsigned xb_ld(unsigned* p)              { return __hip_atomic_load(p, __ATOMIC_RELAXED, __HIP_MEMORY_SCOPE_AGENT); }
__device__ __forceinline__ unsigned xb_add(unsigned* p, unsigned v) { return __hip_atomic_fetch_add(p, v, __ATOMIC_RELAXED, __HIP_MEMORY_SCOPE_AGENT); }
__device__ __forceinline__ unsigned xb_xcc_id() { return (unsigned)__builtin_amdgcn_s_getreg((3 << 11) | 20) & 0xFu; }
#define XB_SPIN(cond, bar) do { unsigned _sp = 0; while (cond) { __builtin_amdgcn_s_sleep(1); \
    if ((++_sp & 255u) == 0u) { if (xb_ld(&(bar)[XB_TMO])) break; if (_sp > XB_SPIN_CAP) { atomicAdd(&(bar)[XB_TMO], 1u); break; } } } } while (0)
struct XcdBarrier { unsigned* bar; unsigned x; volatile LAS unsigned* st; };
__device__ __forceinline__ XcdBarrier xcd_barrier_post(unsigned* bar, volatile LAS unsigned* st) {
    XcdBarrier b; b.bar = bar; b.x = xb_xcc_id(); b.st = st;
    if (threadIdx.x == 0) (void)xb_add(&bar[XB_XCNT(b.x)], 1u);
    return b;
}
__device__ __forceinline__ void xcd_barrier_complete(unsigned* bar, unsigned x, unsigned& nloc, unsigned& nx) {
    const unsigned G = gridDim.x * gridDim.y * gridDim.z;
    unsigned sum, cnt, mine, sp = 0u;
    for (;;) {
        sum = 0u; cnt = 0u; mine = 0u;
#pragma unroll
        for (unsigned j = 0; j < 16; ++j) { const unsigned c = xb_ld(&bar[XB_XCNT(j)]); sum += c; cnt += (c > 0u) ? 1u : 0u; mine = (j == x) ? c : mine; }
        if (sum == G) break;
        __builtin_amdgcn_s_sleep(1);
        if ((++sp & 255u) == 0u) { if (xb_ld(&bar[XB_TMO])) break; if (sp > XB_SPIN_CAP) { atomicAdd(&bar[XB_TMO], 1u); break; } }
    }
    nloc = mine > 0u ? mine : 1u; nx = cnt > 0u ? cnt : 1u;
}
__device__ __forceinline__ void xcd_barrier(const XcdBarrier& b) {
    asm volatile("s_waitcnt vmcnt(0)" ::: "memory");
    __syncthreads();
    if (threadIdx.x == 0) {
        unsigned* bar = b.bar;
        __builtin_amdgcn_s_waitcnt(0);
        unsigned nloc = b.st[0], nx = b.st[1];
        if (nloc == 0u) { xcd_barrier_complete(bar, b.x, nloc, nx); b.st[0] = nloc; b.st[1] = nx; }
        const unsigned old = xb_add(&bar[XB_XSUB(b.x)], 1u);
        const unsigned gen = old / nloc;
        if (old + 1u == (gen + 1u) * nloc) {
            __builtin_amdgcn_fence(__ATOMIC_RELEASE, "agent");
            asm volatile("s_waitcnt vmcnt(0)" ::: "memory");
            const unsigned og = xb_add(&bar[XB_TOP], 1u);
            const unsigned tg = og / nx;
            if (og + 1u == (tg + 1u) * nx) xb_add(&bar[XB_TOPGEN], 1u);
            else XB_SPIN(xb_ld(&bar[XB_TOPGEN]) == tg, bar);
            __builtin_amdgcn_fence(__ATOMIC_ACQUIRE, "agent");
            xb_add(&bar[XB_XGEN(b.x)], 1u);
            asm volatile("s_waitcnt vmcnt(0)" ::: "memory");
        } else {
            XB_SPIN(xb_ld(&bar[XB_XGEN(b.x)]) == gen, bar);
            __builtin_amdgcn_fence(__ATOMIC_ACQUIRE, "agent");
            asm volatile("s_waitcnt vmcnt(0)" ::: "memory");
        }
    }
    __syncthreads();
}

namespace pg8 {
constexpr int BM = 256, BK = 64, HALF = 128, HTB = HALF * BK * 2, STAGE_BYTES = 8 * HTB, NXCD = 8, WGM = 8;
__host__ __device__ __forceinline__ int lds_byte(int r, int c) { const int st = (r >> 4) * 2 + (c >> 5), rr = r & 15, cc = c & 31, ob = rr * 64 + cc * 2; return st * 1024 + (ob ^ (((ob >> 9) & 1) << 5)); }
__host__ __device__ __forceinline__ void stage_rc(int b, int& R, int& C) { const int st = b / 1024, sb = b % 1024, swz = sb ^ (((sb >> 9) & 1) << 5); R = (st >> 1) * 16 + swz / 64; C = (st & 1) * 32 + (swz % 64) / 2; }
__host__ __device__ __forceinline__ int perm32(int rho) { const int n = rho >> 4, i = rho & 15; return 8 * (i >> 2) + 4 * n + (i & 3); }

struct Unit { int pm, pn, aux; };

__device__ __forceinline__ void tile_of(int L, int nM, int nN, int& pm, int& pn) {
    const int nwg = nM * nN; int wgid = L;
    { const int q = nwg / NXCD, r = nwg % NXCD, xcd = wgid % NXCD, off = wgid / NXCD; wgid = (xcd < r ? xcd * (q + 1) : r * (q + 1) + (xcd - r) * q) + off; }
    const int nig = WGM * nN, gid = wgid / nig, fm = gid * WGM, gsz = (nM - fm) < WGM ? (nM - fm) : WGM;
    pm = fm + ((wgid % nig) % gsz); pn = (wgid % nig) / gsz;
}

template <class Epi, class Sched, bool ALIGN_EPI, bool SP2, bool FP8 = false>
__device__ __forceinline__ void gemm_phase(LAS unsigned char* lds, const int RB, const Sched& S, const Epi& E) {
    const int tid = threadIdx.x, wid = __builtin_amdgcn_readfirstlane(tid >> 6), lane = tid & 63, wr = wid >> 2, wc = wid & 3, fr = lane & 15, fq = lane >> 4;
    const int nt = RB / 128;
    unsigned voffA[2], voffB[2];
#pragma unroll
    for (int i = 0; i < 2; ++i) { int R, C; stage_rc(tid * 16 + i * 8192, R, C); const int Rb = Epi::PERM ? ((R & ~31) + perm32(R & 31)) : R;
        voffA[i] = (unsigned)(R * RB + C * 2); voffB[i] = (unsigned)(Rb * RB + C * 2); }
    const size_t kstep = (size_t)(BK * 2);
    const size_t hstep = (size_t)HALF * RB;
    const unsigned ldsw = (unsigned)wid * 1024u;
    const int aoff = lds_byte(wr * 64 + fr, fq * 8), boff = lds_byte(wc * 32 + fr, fq * 8);
#define PG8_SA(b, h) (((b) * 2 + (h)) * HTB)
#define PG8_SB(b, h) ((4 + (b) * 2 + (h)) * HTB)
#define PG8_STAGE(bufoff, gbase, voff) do { _Pragma("unroll") for (int _i = 0; _i < 2; ++_i) \
        __builtin_amdgcn_global_load_lds((const unsigned*)((const char*)(gbase) + (voff)[_i]), (LAS unsigned*)(lds + (bufoff) + ldsw + _i * 8192), 16, 0, 0); } while (0)
#define PG8_LD8(p) __builtin_shufflevector(*(const LAS i32x4*)(p), *(const LAS i32x4*)((p) + 1024), 0, 1, 2, 3, 4, 5, 6, 7)
#define PG8_LDA(dst, b, h) do { _Pragma("unroll") for (int m = 0; m < 4; ++m) dst[m] = PG8_LD8(lds + PG8_SA(b, h) + aoff + m * 2048); } while (0)
#define PG8_LDB(dst, b, h) do { _Pragma("unroll") for (int n = 0; n < 2; ++n) dst[n] = PG8_LD8(lds + PG8_SB(b, h) + boff + n * 2048); } while (0)
#define PG8_LO(x) __builtin_bit_cast(bf16x8, __builtin_shufflevector(x, x, 0, 1, 2, 3))
#define PG8_HI(x) __builtin_bit_cast(bf16x8, __builtin_shufflevector(x, x, 4, 5, 6, 7))
#define PG8_MMA(ai, bj, At, Bt) do { __builtin_amdgcn_s_setprio(1); _Pragma("unroll") for (int m = 0; m < 4; ++m) _Pragma("unroll") for (int n = 0; n < 2; ++n) { \
        if constexpr (FP8) asm volatile("v_mfma_f32_16x16x128_f8f6f4 %0, %1, %2, %0" : "+v"(acc[ai][bj][m][n]) : "v"(Bt[n]), "v"(At[m]));   \
        else { acc[ai][bj][m][n] = __builtin_amdgcn_mfma_f32_16x16x32_bf16(PG8_LO(Bt[n]), PG8_LO(At[m]), acc[ai][bj][m][n], 0, 0, 0); \
               acc[ai][bj][m][n] = __builtin_amdgcn_mfma_f32_16x16x32_bf16(PG8_HI(Bt[n]), PG8_HI(At[m]), acc[ai][bj][m][n], 0, 0, 0); } } \
        __builtin_amdgcn_s_setprio(0); } while (0)
#define PG8_WAIT_V(n) asm volatile("s_waitcnt vmcnt(" #n ")" ::: "memory")
#define PG8_WAIT_L(n) asm volatile("s_waitcnt lgkmcnt(" #n ")" ::: "memory")
#define PG8_BAR __builtin_amdgcn_s_barrier()
#define PG8_SCHED __builtin_amdgcn_sched_barrier(0)
    Unit cur, nxt; int ui = 0;
    if (!S.next(0, cur)) return;
    f32x4 acc[2][2][4][2];
#pragma unroll
    for (int a = 0; a < 2; ++a)
#pragma unroll
        for (int b = 0; b < 2; ++b)
#pragma unroll
            for (int m = 0; m < 4; ++m)
#pragma unroll
                for (int n = 0; n < 2; ++n) acc[a][b][m][n] = (f32x4){0.f, 0.f, 0.f, 0.f};
    i32x8 At[4], B0[2], B1[2];
    const char* cA = S.a_ptr(cur); const char* cB = S.b_ptr(cur);
    if constexpr (SP2) {
        PG8_STAGE(PG8_SB(0, 0), cB, voffB); PG8_STAGE(PG8_SB(0, 1), cB + hstep, voffB); PG8_STAGE(PG8_SA(0, 0), cA, voffA); PG8_STAGE(PG8_SA(0, 1), cA + hstep, voffA);
        if (wr == 1) PG8_BAR;
        PG8_WAIT_V(2); PG8_BAR;
        PG8_STAGE(PG8_SB(1, 0), cB + kstep, voffB); PG8_STAGE(PG8_SA(1, 0), cA + kstep, voffA); PG8_STAGE(PG8_SB(1, 1), cB + hstep + kstep, voffB);
        PG8_WAIT_V(6); PG8_BAR;
    } else {
        PG8_STAGE(PG8_SB(0, 0), cB, voffB); PG8_STAGE(PG8_SA(0, 0), cA, voffA); PG8_STAGE(PG8_SB(0, 1), cB + hstep, voffB); PG8_STAGE(PG8_SA(0, 1), cA + hstep, voffA);
        if (wr == 1) PG8_BAR;
        PG8_WAIT_V(4); PG8_BAR;
        PG8_STAGE(PG8_SB(1, 0), cB + kstep, voffB); PG8_STAGE(PG8_SA(1, 0), cA + kstep, voffA); PG8_STAGE(PG8_SB(1, 1), cB + hstep + kstep, voffB);
        PG8_WAIT_V(6); PG8_BAR;
    }
    for (;;) {
        const bool has_next = S.next(ui + 1, nxt);
        const char* nA = has_next ? S.a_ptr(nxt) : cA; const char* nB = has_next ? S.b_ptr(nxt) : cB;
#pragma nounroll
        for (int t = 0; t < nt; t += 2) {
            const bool last = (t == nt - 2);
            const char* a1 = cA + (size_t)(t + 1) * kstep;
            const char* a2 = last ? nA : cA + (size_t)(t + 2) * kstep; const char* b2 = last ? nB : cB + (size_t)(t + 2) * kstep;
            const char* a3 = a2 + kstep; const char* b3 = b2 + kstep;
            if constexpr (SP2) {
            PG8_LDB(B0, 0, 0); PG8_LDB(B1, 0, 1); PG8_SCHED; PG8_LDA(At, 0, 0); PG8_STAGE(PG8_SA(1, 1), a1 + hstep, voffA);
            PG8_WAIT_V(8); PG8_WAIT_L(0); PG8_BAR; PG8_MMA(0, 0, At, B0); PG8_MMA(0, 1, At, B1); PG8_BAR; PG8_SCHED;
            PG8_LDA(At, 0, 1); PG8_STAGE(PG8_SB(0, 0), b2, voffB); PG8_STAGE(PG8_SB(0, 1), b2 + hstep, voffB); PG8_STAGE(PG8_SA(0, 0), a2, voffA);
            PG8_WAIT_V(8); PG8_WAIT_L(0); PG8_BAR; PG8_MMA(1, 0, At, B0); PG8_MMA(1, 1, At, B1); PG8_BAR; PG8_SCHED;
            PG8_LDB(B0, 1, 0); PG8_LDB(B1, 1, 1); PG8_SCHED; PG8_LDA(At, 1, 0); PG8_STAGE(PG8_SA(0, 1), a2 + hstep, voffA);
            PG8_WAIT_V(8); PG8_WAIT_L(0); PG8_BAR; PG8_MMA(0, 0, At, B0); PG8_MMA(0, 1, At, B1); PG8_BAR; PG8_SCHED;
            PG8_LDA(At, 1, 1); PG8_STAGE(PG8_SB(1, 0), b3, voffB); PG8_STAGE(PG8_SB(1, 1), b3 + hstep, voffB); PG8_STAGE(PG8_SA(1, 0), a3, voffA);
            PG8_WAIT_V(8); PG8_WAIT_L(0); PG8_BAR; PG8_MMA(1, 0, At, B0); PG8_MMA(1, 1, At, B1); PG8_BAR; PG8_SCHED;
            } else {
            PG8_LDB(B0, 0, 0); PG8_SCHED; PG8_LDA(At, 0, 0); PG8_STAGE(PG8_SA(1, 1), a1 + hstep, voffA);
            PG8_WAIT_L(8); PG8_BAR; PG8_WAIT_L(0); PG8_MMA(0, 0, At, B0); PG8_BAR; PG8_SCHED;
            PG8_LDB(B1, 0, 1); PG8_STAGE(PG8_SB(0, 0), b2, voffB);
            PG8_BAR; PG8_WAIT_L(0); PG8_MMA(0, 1, At, B1); PG8_BAR;
            PG8_LDA(At, 0, 1); PG8_STAGE(PG8_SA(0, 0), a2, voffA);
            PG8_BAR; PG8_WAIT_L(0); PG8_MMA(1, 0, At, B0); PG8_BAR; PG8_SCHED;
            PG8_STAGE(PG8_SB(0, 1), b2 + hstep, voffB);
            PG8_WAIT_V(6); PG8_BAR; PG8_MMA(1, 1, At, B1); PG8_BAR;
            PG8_LDB(B0, 1, 0); PG8_SCHED; PG8_LDA(At, 1, 0); PG8_STAGE(PG8_SA(0, 1), a2 + hstep, voffA);
            PG8_WAIT_L(8); PG8_BAR; PG8_WAIT_L(0); PG8_MMA(0, 0, At, B0); PG8_BAR; PG8_SCHED;
            PG8_LDB(B1, 1, 1); PG8_STAGE(PG8_SB(1, 0), b3, voffB);
            PG8_BAR; PG8_WAIT_L(0); PG8_MMA(0, 1, At, B1); PG8_BAR;
            PG8_LDA(At, 1, 1); PG8_STAGE(PG8_SA(1, 0), a3, voffA);
            PG8_BAR; PG8_WAIT_L(0); PG8_MMA(1, 0, At, B0); PG8_BAR; PG8_SCHED;
            PG8_STAGE(PG8_SB(1, 1), b3 + hstep, voffB);
            PG8_WAIT_V(6); PG8_BAR; PG8_MMA(1, 1, At, B1); PG8_BAR;
            }
        }
        if constexpr (ALIGN_EPI) { if (wr == 0) PG8_BAR; }
        if constexpr (FP8) asm volatile("s_nop 15\n\ts_nop 15" ::: "memory");
        E(acc, cur, wr, wc, fr, fq);
        if (!has_next) break;
        if (!S.keep(cur)) {
#pragma unroll
            for (int a = 0; a < 2; ++a)
#pragma unroll
                for (int b = 0; b < 2; ++b)
#pragma unroll
                    for (int m = 0; m < 4; ++m)
#pragma unroll
                        for (int n = 0; n < 2; ++n) acc[a][b][m][n] = (f32x4){0.f, 0.f, 0.f, 0.f};
        }
        cur = nxt; cA = nA; cB = nB; ++ui;
        if constexpr (ALIGN_EPI) { if (wr == 1) PG8_BAR; }
    }
    PG8_WAIT_V(0);
    if constexpr (!ALIGN_EPI) { if (wr == 0) PG8_BAR; }
    PG8_BAR;
#undef PG8_SA
#undef PG8_SB
#undef PG8_STAGE
#undef PG8_LDA
#undef PG8_LDB
#undef PG8_MMA
#undef PG8_LD8
#undef PG8_LO
#undef PG8_HI
#undef PG8_WAIT_V
#undef PG8_WAIT_L
#undef PG8_BAR
#undef PG8_SCHED
}
}
using pg8::Unit;

#ifndef PG8_SP2
#define PG8_SP2 true
#endif
#ifndef PG8_ALIGN
#define PG8_ALIGN true
#endif

enum InIdx { I_X = 0, I_C, I_CTX, I_CCTX, I_WADA, I_BADA, I_GMIX, I_GFFN, I_WIN, I_WDW, I_BDW, I_LNG, I_LNB, I_WCO, I_BCO, I_LQ1, I_LK1, I_LQ2, I_LK2, I_GSUB, I_WAO, I_WOUT, I_WR, I_WEG, I_WEU, I_WED, I_GFIN, N_IN };
struct Args { const float* in[N_IN]; float* out; unsigned char* ws; int ph_lo, ph_hi, li, pad; };

__device__ __forceinline__ void ph_adaln(const Args& a, LAS unsigned char* lds, int bid, int G) {
    const int tid = threadIdx.x;
    LAS float* sil = (LAS float*)lds;
    LAS float* red = sil + 9 * 1024;
    const float* c = a.in[I_C]; const float* cc = a.in[I_CCTX]; const float* w = a.in[I_WADA]; const float* bb = a.in[I_BADA];
    float* mod = (float*)(a.ws + WS_MOD);
    for (int i = tid; i < 9 * 1024; i += 512) { const float v = (i < 8192) ? c[i] : cc[i - 8192]; sil[i] = v / (1.0f + expf(-v)); }
    __syncthreads();
    for (int unit = bid; unit < NMOD / 32; unit += G) {
        const int n0 = unit * 32, col = tid & 31, kp = tid >> 5;
        float acc[9];
#pragma unroll
        for (int r = 0; r < 9; ++r) acc[r] = 0.f;
#pragma unroll 8
        for (int kk = 0; kk < 64; ++kk) { const int k = kp * 64 + kk; const float wv = w[(size_t)k * NMOD + n0 + col];
#pragma unroll
            for (int r = 0; r < 9; ++r) acc[r] += sil[r * 1024 + k] * wv; }
#pragma unroll
        for (int r = 0; r < 9; ++r) red[(kp * 9 + r) * 32 + col] = acc[r];
        __syncthreads();
        if (tid < 288) { const int r = tid >> 5, cl = tid & 31; float s = 0.f;
#pragma unroll
            for (int k2 = 0; k2 < 16; ++k2) s += red[(k2 * 9 + r) * 32 + cl];
            mod[r * NMOD + n0 + cl] = s + bb[n0 + cl]; }
        __syncthreads();
    }
}
__device__ __forceinline__ void ph_rope_table(const Args& a) {
    float* rc = (float*)(a.ws + WS_ROPE); float* rs = rc + 1024;
    for (int i = threadIdx.x; i < 1024; i += 512) { const int pos = i >> 4, f = i & 15;
        const float inv = powf(10000.0f, -(float)f / 16.0f); const float ang = (float)pos * inv;
        rc[i] = cosf(ang); rs[i] = sinf(ang); }
}
template <class DstRow>
__device__ __forceinline__ void transpose_item(const float* W, int K, int N, bf16_t* WT, const DstRow& dr, LAS float* scr, int item, int lane) {
    const int nblk = N / 32, kb = item / nblk, nb = item % nblk, k0 = 64 * kb, n0 = 32 * nb;
#pragma unroll 8
    for (int i = 0; i < 32; ++i) { const int kk = 2 * i + (lane >> 5); scr[kk * 33 + (lane & 31)] = __builtin_nontemporal_load(W + (size_t)(k0 + kk) * N + n0 + (lane & 31)); }
    LDS_WAIT(); asm volatile("" ::: "memory");
    const int c = lane & 7;
#pragma unroll
    for (int j = 0; j < 4; ++j) { const int n = (lane >> 3) + 8 * j; const LAS float* s = scr + (8 * c) * 33 + n;
        u32x4 o; o.x = cvt_pk_bf16(s[0 * 33], s[1 * 33]); o.y = cvt_pk_bf16(s[2 * 33], s[3 * 33]); o.z = cvt_pk_bf16(s[4 * 33], s[5 * 33]); o.w = cvt_pk_bf16(s[6 * 33], s[7 * 33]);
        *(u32x4*)(WT + (size_t)dr(n0 + n) * K + k0 + 8 * c) = o; }
    LDS_WAIT(); asm volatile("" ::: "memory");
}
template <class DstRow>
__device__ __forceinline__ void transpose_item_fp8(const float* W, int K, int N, unsigned char* WT, const DstRow& dr, LAS float* scr, int item, int lane) {
    const int nblk = N / 32, kb = item / nblk, nb = item % nblk, k0 = 64 * kb, n0 = 32 * nb;
#pragma unroll 8
    for (int i = 0; i < 32; ++i) { const int kk = 2 * i + (lane >> 5); scr[kk * 33 + (lane & 31)] = __builtin_nontemporal_load(W + (size_t)(k0 + kk) * N + n0 + (lane & 31)); }
    LDS_WAIT(); asm volatile("" ::: "memory");
    const int c = lane & 7;
#pragma unroll
    for (int j = 0; j < 4; ++j) { const int n = (lane >> 3) + 8 * j; const LAS float* s = scr + (8 * c) * 33 + n;
        u32x2 o; o.x = pack4_fp8(s[0 * 33] * WSCALE, s[1 * 33] * WSCALE, s[2 * 33] * WSCALE, s[3 * 33] * WSCALE); o.y = pack4_fp8(s[4 * 33] * WSCALE, s[5 * 33] * WSCALE, s[6 * 33] * WSCALE, s[7 * 33] * WSCALE);
        *(u32x2*)(WT + (size_t)dr(n0 + n) * K + k0 + 8 * c) = o; }
    LDS_WAIT(); asm volatile("" ::: "memory");
}
__host__ __device__ __forceinline__ int qdst(int d) { const int blk = d >> 5, half = (d >> 4) & 1, i = d & 15; return 8 * (4 * blk + (i >> 2)) + 4 * half + (i & 3); }
struct DrWin { __host__ __device__ int operator()(int j) const {
    if (j < 1024) return 256 * (j >> 7) + (j & 127);
    if (j < 2048) { const int jj = j - 1024; return 256 * (jj >> 7) + 128 + (jj & 127); }
    if (j < 4096) { const int jj = j & 1023, base = j - jj; return base + (jj & ~63) + qdst(jj & 63); }
    return j; } };
struct DrId { __host__ __device__ int operator()(int j) const { return j; } };
struct DrGU { int up; __host__ __device__ int operator()(int f) const { return 256 * (f >> 7) + 128 * up + (f & 127); } };

__device__ __forceinline__ void ph_small_weights(const Args& a, LAS unsigned char* lds, int gw, int NGW, int wave, int lane) {
    LAS float* scr = (LAS float*)(lds + 57344 + wave * 8448);
    constexpr int I_IN = (DM / 64) * (NPROJ / 32), I_SQ = (DM / 64) * (DM / 32);
    for (int it = gw; it < I_IN + 3 * I_SQ; it += NGW) {
        int r = it;
        if (r < I_IN) { transpose_item(a.in[I_WIN], DM, NPROJ, (bf16_t*)(a.ws + WS_WIN), DrWin{}, scr, r, lane); continue; } r -= I_IN;
        if (r < I_SQ) { transpose_item(a.in[I_WCO], DM, DM, (bf16_t*)(a.ws + WS_WCO), DrId{}, scr, r, lane); continue; } r -= I_SQ;
        if (r < I_SQ) { transpose_item(a.in[I_WAO], DM, DM, (bf16_t*)(a.ws + WS_WAO), DrId{}, scr, r, lane); continue; } r -= I_SQ;
        transpose_item(a.in[I_WOUT], DM, DM, (bf16_t*)(a.ws + WS_WO), DrId{}, scr, r, lane);
    }
}
__device__ __forceinline__ void ph_wgu(const Args& a, LAS unsigned char* lds, int gw, int NGW, int wave, int lane) {
    LAS float* scr = (LAS float*)(lds + 57344 + wave * 8448);
    constexpr int I_E = (DM / 64) * (DFF / 32);
    for (int it = gw; it < 2 * NEXP * I_E; it += NGW) {
        const int mat = it / I_E, r = it % I_E, e = mat >> 1, up = mat & 1;
        const float* W = (up ? a.in[I_WEU] : a.in[I_WEG]) + (size_t)e * DM * DFF;
        transpose_item_fp8(W, DM, DFF, (unsigned char*)(a.ws + WS_WGU) + (size_t)e * 2 * DFF * DM, DrGU{up}, scr, r, lane);
    }
}
constexpr int WD_ITEMS = NEXP * (DFF / 64) * (DM / 32);
#ifndef MK_WD_SPLIT
#define MK_WD_SPLIT 85
#endif
constexpr int WD_SPLIT = (WD_ITEMS / 100) * MK_WD_SPLIT;
__device__ __forceinline__ void ph_wd(const Args& a, LAS unsigned char* lds, int gw, int NGW, int wave, int lane, int lo, int hi) {
    LAS float* scr = (LAS float*)(lds + 57344 + wave * 8448);
    constexpr int I_E = (DFF / 64) * (DM / 32);
    for (int it = lo + gw; it < hi; it += NGW) {
        const int e = it / I_E, r = it % I_E;
        transpose_item_fp8(a.in[I_WED] + (size_t)e * DFF * DM, DFF, DM, (unsigned char*)(a.ws + WS_WD) + (size_t)e * DM * DFF, DrId{}, scr, r, lane);
    }
}

__device__ __forceinline__ void ph_norm_rows(const Args& a, int gw, int NGW, int lane) {
    const float* mod = (const float*)(a.ws + WS_MOD); const float* g = a.in[I_GMIX]; bf16_t* H = (bf16_t*)(a.ws + WS_H);
    const int per = (MALL + NGW - 1) / NGW, r0 = gw * per, r1 = (r0 + per < MALL) ? r0 + per : MALL;
    if (r0 >= r1) return;
    auto src_of = [&](int row) { return (const f32x4*)((row < MLAT) ? a.in[I_X] + (size_t)row * DM : a.in[I_CTX] + (size_t)(row - MLAT) * DM) + lane; };
    f32x4 gs[4], sh[4]; int cur_b = -1;
    f32x4 nx[4];
    { const f32x4* xr = src_of(r0);
#pragma unroll
      for (int j = 0; j < 4; ++j) nx[j] = __builtin_nontemporal_load(xr + 64 * j); }
    for (int row = r0; row < r1; ++row) {
        f32x4 v[4];
#pragma unroll
        for (int j = 0; j < 4; ++j) v[j] = nx[j];
        if (row + 1 < r1) { const f32x4* xr = src_of(row + 1);
#pragma unroll
            for (int j = 0; j < 4; ++j) nx[j] = __builtin_nontemporal_load(xr + 64 * j); }
        const int b = (row < MLAT) ? (row >> 12) : 8;
        if (b != cur_b) { cur_b = b; const float* mb = mod + (size_t)b * NMOD;
#pragma unroll
            for (int j = 0; j < 4; ++j) { const int c = 4 * lane + 256 * j; gs[j] = *(const f32x4*)(g + c) * (*(const f32x4*)(mb + 1024 + c) + 1.0f); sh[j] = *(const f32x4*)(mb + c); } }
        float s = 0.f;
#pragma unroll
        for (int j = 0; j < 4; ++j) s += (v[j].x * v[j].x + v[j].y * v[j].y) + (v[j].z * v[j].z + v[j].w * v[j].w);
        const float rstd = 1.0f / sqrtf(wave_sum(s) * (1.0f / DM) + EPS);
        unsigned long long* o8 = (unsigned long long*)(H + (size_t)row * DM) + lane;
#pragma unroll
        for (int j = 0; j < 4; ++j) { const f32x4 y = (v[j] * rstd) * gs[j] + sh[j];
            o8[64 * j] = (unsigned long long)cvt_pk_bf16(y.x, y.y) | ((unsigned long long)cvt_pk_bf16(y.z, y.w) << 32); }
    }
}

struct SchedInProj {
    const char* A; const char* Bt; int G, c;
    static constexpr int NLAT = 128 * 28, NCTXU = 8 * 8;
    __device__ __forceinline__ bool next(int i, Unit& u) const {
        const int L = i * G + c; if (L >= NLAT + NCTXU) return false;
        if (L < NLAT) { pg8::tile_of(L, 128, 28, u.pm, u.pn); } else { const int v = L - NLAT; u.pm = 128 + (v & 7); u.pn = 12 + (v >> 3); }
        u.aux = 0; return true; }
    __device__ __forceinline__ const char* a_ptr(const Unit& u) const { return (u.pn >= 16 && u.pn < 20) ? Bt + (size_t)u.pn * (256 * DM * 2) : A + (size_t)u.pm * (256 * DM * 2); }
    __device__ __forceinline__ const char* b_ptr(const Unit& u) const { return (u.pn >= 16 && u.pn < 20) ? A + (size_t)u.pm * (256 * DM * 2) : Bt + (size_t)u.pn * (256 * DM * 2); }
    __device__ __forceinline__ bool keep(const Unit&) const { return false; }
};
struct EpiInProj {
    static constexpr bool PERM = true;
    bf16_t *U, *Q, *KA, *VA, *GC, *GA; const float* rope;
    __device__ __forceinline__ void operator()(f32x4 (&acc)[2][2][4][2], const Unit& u, int wr, int wc, int fr, int fq) const {
        const int pn = u.pn, pm = u.pm;
        const int cw = wc * 32 + 8 * fq;
        if (pn < 8) {
#pragma unroll
            for (int ai = 0; ai < 2; ++ai)
#pragma unroll
                for (int m = 0; m < 4; ++m) { const int r = pm * 256 + ai * 128 + wr * 64 + m * 16 + fr;
                    const f32x4 a0 = acc[ai][0][m][0], a1 = acc[ai][0][m][1], b0 = acc[ai][1][m][0], b1 = acc[ai][1][m][1];
                    u32x4 w; w.x = cvt_pk_bf16(a0[0] * sigmoidf_(b0[0]), a0[1] * sigmoidf_(b0[1])); w.y = cvt_pk_bf16(a0[2] * sigmoidf_(b0[2]), a0[3] * sigmoidf_(b0[3]));
                    w.z = cvt_pk_bf16(a1[0] * sigmoidf_(b1[0]), a1[1] * sigmoidf_(b1[1])); w.w = cvt_pk_bf16(a1[2] * sigmoidf_(b1[2]), a1[3] * sigmoidf_(b1[3]));
                    *(u32x4*)(U + (size_t)r * DM + pn * 128 + cw) = w; }
            return;
        }
        if (pn < 16) {
            const bool isq = pn < 12, lat = pm < 128;
            bf16_t* base; size_t row0; int rowpos0 = 0;
            if (isq) { base = Q + (size_t)(pn - 8) * 256; row0 = (size_t)pm * 256; }
            else { base = KA + (size_t)(pn - 12) * 256; row0 = lat ? (size_t)(pm >> 4) * KVR + (size_t)(pm & 15) * 256 : (size_t)(pm - 128) * KVR + NT; }
            if (lat) rowpos0 = (pm & 15) * 4;
            const float sc = isq ? QSCALE : 1.0f;
            const float* rc = rope; const float* rs = rope + 1024;
#pragma unroll
            for (int ai = 0; ai < 2; ++ai)
#pragma unroll
                for (int m = 0; m < 4; ++m) { const int rl = ai * 128 + wr * 64 + m * 16 + fr;
                    f32x4 cs = (f32x4){1.f, 1.f, 1.f, 1.f}, sn = (f32x4){0.f, 0.f, 0.f, 0.f};
                    if (lat) { const int pos = (wc & 1) ? (m * 16 + fr) : (rowpos0 + 2 * ai + wr); cs = *(const f32x4*)(rc + pos * 16 + 4 * fq); sn = *(const f32x4*)(rs + pos * 16 + 4 * fq); }
#pragma unroll
                    for (int bj = 0; bj < 2; ++bj) { const f32x4 x1 = acc[ai][bj][m][0], x2 = acc[ai][bj][m][1];
                        const f32x4 y1 = (x1 * cs - x2 * sn) * sc, y2 = (x1 * sn + x2 * cs) * sc;
                        u32x4 w; w.x = cvt_pk_bf16(y1[0], y1[1]); w.y = cvt_pk_bf16(y1[2], y1[3]); w.z = cvt_pk_bf16(y2[0], y2[1]); w.w = cvt_pk_bf16(y2[2], y2[3]);
                        *(u32x4*)(base + (row0 + rl) * DM + bj * 128 + cw) = w; } }
            return;
        }
        if (pn < 20) {
            const bool lat = pm < 128;
            const int bidx = lat ? (pm >> 4) : (pm - 128), key0 = lat ? (pm & 15) * 256 : NT;
            bf16_t* vt = VA + (size_t)(bidx * NHD + 2 * (pn - 16)) * 128 * KVR + key0;
            int fr_ = fr; asm volatile("" : "+v"(fr_));
#pragma unroll
            for (int ai = 0; ai < 2; ++ai)
#pragma unroll
                for (int m = 0; m < 4; ++m) { bf16_t* rowp = vt + (unsigned)((ai * 128 + wr * 64 + m * 16 + fr_) * KVR);
#pragma unroll
                    for (int bj = 0; bj < 2; ++bj) { const f32x4 v0 = acc[ai][bj][m][0], v1 = acc[ai][bj][m][1];
                        unsigned a0 = cvt_pk_bf16(v0[0], v0[1]), a1 = cvt_pk_bf16(v0[2], v0[3]), b0 = cvt_pk_bf16(v1[0], v1[1]), b1 = cvt_pk_bf16(v1[2], v1[3]);
                        { auto r_ = __builtin_amdgcn_permlane16_swap(a0, b0, false, false); a0 = r_[0]; b0 = r_[1]; }
                        { auto r_ = __builtin_amdgcn_permlane16_swap(a1, b1, false, false); a1 = r_[0]; b1 = r_[1]; }
                        *(u32x4*)(rowp + bj * 128 + wc * 32 + 8 * fq) = (u32x4){a0, a1, b0, b1}; }
                    asm volatile("" ::: "memory"); }
            return;
        }
        {
            bf16_t* base; size_t row0;
            if (pn < 24) { base = GC + (size_t)(pn - 20) * 256; row0 = (size_t)pm * 256; }
            else { base = GA + (size_t)(pn - 24) * 256; row0 = (size_t)pm * 256; }
#pragma unroll
            for (int ai = 0; ai < 2; ++ai)
#pragma unroll
                for (int m = 0; m < 4; ++m) { const int rl = ai * 128 + wr * 64 + m * 16 + fr;
#pragma unroll
                    for (int bj = 0; bj < 2; ++bj) { f32x4 v0 = acc[ai][bj][m][0], v1 = acc[ai][bj][m][1];
#pragma unroll
                        for (int j = 0; j < 4; ++j) { v0[j] = sigmoidf_(v0[j]); v1[j] = sigmoidf_(v1[j]); }
                        u32x4 w; w.x = cvt_pk_bf16(v0[0], v0[1]); w.y = cvt_pk_bf16(v0[2], v0[3]); w.z = cvt_pk_bf16(v1[0], v1[1]); w.w = cvt_pk_bf16(v1[2], v1[3]);
                        *(u32x4*)(base + (row0 + rl) * DM + bj * 128 + cw) = w; } }
        }
    }
};

__device__ __forceinline__ void ph_conv_unit(const Args& a, LAS unsigned char* lds, int unit) {
    const int tid = threadIdx.x, lane = tid & 63, wave = __builtin_amdgcn_readfirstlane(tid >> 6);
    const int b = unit >> 5, t0 = (unit & 31) * 128;
    LAS float* ybuf = (LAS float*)lds;
    const int c0 = 2 * tid;
    f32x2 w[31];
    { const float* wp = a.in[I_WDW]; asm volatile("" : "+s"(wp));
      const __attribute__((address_space(1))) f32x2* wp2 = (const __attribute__((address_space(1))) f32x2*)(wp + c0);
#pragma unroll
      for (int j = 0; j < 31; ++j) w[j] = wp2[j * (DM / 2)]; }
    const f32x2 bias = *(const f32x2*)(a.in[I_BDW] + c0);
    const unsigned* Ub = (const unsigned*)(a.ws + WS_U) + (size_t)b * NT * (DM / 2) + tid;
    bf16_t* CA = (bf16_t*)(a.ws + WS_CACT) + (size_t)(b * NT + t0) * DM;
    const float* lng = a.in[I_LNG]; const float* lnb = a.in[I_LNB];
    f32x2 win[32];
#pragma unroll
    for (int s = 0; s < 32; ++s) win[s] = (f32x2){0.f, 0.f};
    unsigned pf[16];
    const unsigned* up = Ub + ((long)t0 - 15) * (DM / 2);
#define CV_LD(i) ({ const int i_ = (i); const int ti_ = t0 - 15 + i_; (i_ < 158 && ti_ >= 0 && ti_ < NT) ? up[(long)i_ * (DM / 2)] : 0u; })
#pragma unroll
    for (int s = 0; s < 16; ++s) pf[s] = CV_LD(s);
    for (int Q = 0; Q < 5; ++Q) {
#pragma unroll
        for (int hb = 0; hb < 2; ++hb)
#pragma unroll
        for (int s16 = 0; s16 < 16; ++s16) {
            const int s = hb * 16 + s16;
            const unsigned pk = pf[s16];
            pf[s16] = CV_LD(32 * Q + s + 16);
            win[s] = (f32x2){bf_lo(pk), bf_hi(pk)};
            const int to = 32 * Q + s - 30;
            if (to >= 0 && to < 128) {
                f32x2 y = bias;
#pragma unroll
                for (int j = 0; j < 31; ++j) y += w[j] * win[(s + 2 + j) & 31];
                *(LAS f32x2*)(ybuf + (to & 15) * DM + c0) = y;
            }
            if (s == 13 || s == 29) {
                if (Q >= 1) {
                    const int tb = 32 * Q + s - 30 - 15;
                    __syncthreads();
#pragma unroll
                    for (int k = 0; k < 2; ++k) { const int tl = 2 * wave + k;
                        f32x4 v[4]; float sm = 0.f;
#pragma unroll
                        for (int j = 0; j < 4; ++j) { v[j] = *(const LAS f32x4*)(ybuf + tl * DM + 4 * lane + 256 * j); sm += (v[j].x + v[j].y) + (v[j].z + v[j].w); }
                        const float mean = wave_sum(sm) * (1.0f / DM); float s2 = 0.f;
#pragma unroll
                        for (int j = 0; j < 4; ++j) { v[j] = v[j] - mean; s2 += (v[j].x * v[j].x + v[j].y * v[j].y) + (v[j].z * v[j].z + v[j].w * v[j].w); }
                        const float rstd = 1.0f / sqrtf(wave_sum(s2) * (1.0f / DM) + EPS);
                        unsigned long long* o8 = (unsigned long long*)(CA + (size_t)(tb + tl) * DM) + lane;
#pragma unroll
                        for (int j = 0; j < 4; ++j) { const int c = 4 * lane + 256 * j;
                            f32x4 y = v[j] * rstd * *(const f32x4*)(lng + c) + *(const f32x4*)(lnb + c);
#pragma unroll
                            for (int q = 0; q < 4; ++q) y[q] = y[q] * sigmoidf_(y[q]);
                            o8[64 * j] = (unsigned long long)cvt_pk_bf16(y.x, y.y) | ((unsigned long long)cvt_pk_bf16(y.z, y.w) << 32); } }
                    __syncthreads();
                }
            }
        }
    }
#undef CV_LD
}

namespace att {
constexpr int NW = 8, QBLK = 32, KVBLK = 64, NTILE = KVR / KVBLK;
constexpr int SHM_V = 128 * KVBLK * 2, SHM_K = KVBLK * 64 * 2;
constexpr int BUFB = SHM_V + SHM_K, NBUF = 4, ATT_LDS = NBUF * BUFB;
constexpr int VT_PITCH = KVR;
#define KSWZ(row, colB) ((row) * 128 + ((colB) ^ ((((row) >> 1) & 7) << 4)))
#define SBAR() __builtin_amdgcn_sched_barrier(0)
__device__ __forceinline__ int crow(int r, int hi) { return (r & 3) + 8 * (r >> 2) + 4 * hi; }
__device__ __forceinline__ void glds16(const void* g, unsigned lds_base) {
    unsigned sv; asm volatile("s_mov_b32 %0, m0\n\ts_mov_b32 m0, %2\n\ts_nop 0\n\tglobal_load_lds_dwordx4 %1, off\n\ts_mov_b32 m0, %0" : "=&s"(sv) : "v"(g), "s"(lds_base) : "memory"); }
__device__ __forceinline__ void attn_map(const bf16_t* __restrict__ Qb, const bf16_t* __restrict__ Kh, const bf16_t* __restrict__ VTh, long dKn, long dVn, bool pre, bool has_next, f32x16 (&o)[4], char* lds) {
    const int tid = threadIdx.x, wid = tid >> 6, lane = tid & 63, r32 = lane & 31, hi = lane >> 5;
    const int wv = __builtin_amdgcn_readfirstlane(tid >> 6);
    const bool isB = wv >= 4;
    float l_reg = 0.f;
#pragma unroll
    for (int d = 0; d < 4; ++d) o[d] = f32x16{};
    bf16x8 qr[4];
    const bf16_t* Qw = Qb + (size_t)(wid * QBLK + r32) * DM + hi * 8;
#pragma unroll
    for (int d0 = 0; d0 < 4; ++d0) qr[d0] = *reinterpret_cast<const bf16x8*>(Qw + d0 * 16);
    const bf16_t* ksrc = Kh + (size_t)(8 * wv + (lane >> 3)) * DM + (((lane & 7) ^ ((4 * wv + (lane >> 4)) & 7)) << 3);
    const bf16_t* vsrc0 = VTh + (size_t)(16 * wv + (lane >> 3)) * VT_PITCH + (((lane & 7) ^ ((lane >> 4) & 7)) << 3);
    const bf16_t* vsrc1 = VTh + (size_t)(16 * wv + 8 + (lane >> 3)) * VT_PITCH + (((lane & 7) ^ ((4 + (lane >> 4)) & 7)) << 3);
    const unsigned lds0 = (unsigned)(uintptr_t)lds;
#define DMAX(ko, vo, b) do { const unsigned bb_ = lds0 + (unsigned)(b) * BUFB; \
    glds16(ksrc + (ko), (unsigned)__builtin_amdgcn_readfirstlane(bb_ + SHM_V + 1024 * wv)); \
    glds16(vsrc0 + (vo), (unsigned)__builtin_amdgcn_readfirstlane(bb_ + 2048 * wv)); \
    glds16(vsrc1 + (vo), (unsigned)__builtin_amdgcn_readfirstlane(bb_ + 2048 * wv + 1024)); } while (0)
#define DMA(t, b) DMAX((long)(t) * (KVBLK * DM), (long)(t) * KVBLK, b)
#define DMAT(T) do { if ((T) < NTILE) DMA((T), (T) & 3); else if (has_next && (T) - NTILE < 2) DMAX(dKn + (long)((T) - NTILE) * (KVBLK * DM), dVn + (long)((T) - NTILE) * KVBLK, ((T) - NTILE) & 3); } while (0)
#define BAR() asm volatile("s_barrier" ::: "memory")
#define BARV() asm volatile("s_waitcnt vmcnt(0)\n\ts_barrier" ::: "memory")
    f32x16 pA0, pA1, pB0, pB1;
    u32x4 pw0, pw1, pw2, pw3;
    typedef LAS const char* lcp;
    const lcp lds3 = (lcp)(LAS char*)(uintptr_t)lds0;
    int kaddr[4], vaddr[4];
#pragma unroll
    for (int d0 = 0; d0 < 4; ++d0) { kaddr[d0] = SHM_V + KSWZ(r32, (d0 * 16 + hi * 8) * 2); vaddr[d0] = KSWZ(r32, (2 * d0 + hi) * 16); }
    bf16x8 kf[8], va[4], vb[4];
    constexpr float REF_MARGIN = 32.0f;
    f32x16 negm = f32x16{};
#define PIN(x) asm volatile("" : "+v"(x))
#define MF(a_, b_, c_) __builtin_amdgcn_mfma_f32_32x32x16_bf16(a_, b_, c_, 0, 0, 0)
#define PB(w) __builtin_bit_cast(bf16x8, w)
#define PKW(P, i) cvt_pk_bf16(P[i], P[i + 1])
#define ADD6(x, A, a0, a1, a2, B, b0, b1, b2) do { x += A[a0]; x += A[a1]; x += A[a2]; x += B[b0]; x += B[b1]; x += B[b2]; } while (0)
#define KRD(kbuf) do { const lcp kb_ = lds3 + (kbuf) * BUFB; \
      _Pragma("unroll") for (int d0 = 0; d0 < 4; ++d0) { kf[2 * d0] = *(const LAS bf16x8*)(kb_ + kaddr[d0]); kf[2 * d0 + 1] = *(const LAS bf16x8*)(kb_ + kaddr[d0] + 4096); } } while (0)
#define VRD4(dst, vb_, blk) do { const lcp vq_ = lds3 + (vb_) * BUFB; _Pragma("unroll") for (int ks_ = 0; ks_ < 4; ++ks_) dst[ks_] = *(const LAS bf16x8*)(vq_ + vaddr[ks_] + (blk) * 4096); } while (0)
#define S1(C0, C1, P0, P1, kbuf, vnext) do { SBAR(); \
    KRD(kbuf); \
    float ps_ = P0[0] + P0[1]; ps_ += P0[2]; ps_ += P0[3]; ps_ += P0[4]; ps_ += P0[5]; ps_ += P0[6]; ps_ += P0[7]; PIN(ps_); SBAR(); \
    C0 = MF(kf[0], qr[0], negm); ADD6(ps_, P0, 8, 9, 10, P0, 11, 12, 13); PIN(ps_); SBAR(); \
    C1 = MF(kf[1], qr[0], negm); ps_ += P0[14]; ps_ += P0[15]; ps_ += P1[0]; ps_ += P1[1]; ps_ += P1[2]; ps_ += P1[3]; PIN(ps_); SBAR(); \
    C0 = MF(kf[2], qr[1], C0); ADD6(ps_, P1, 4, 5, 6, P1, 7, 8, 9); PIN(ps_); SBAR(); \
    C1 = MF(kf[3], qr[1], C1); ADD6(ps_, P1, 10, 11, 12, P1, 13, 14, 15); l_reg += ps_; PIN(l_reg); SBAR(); \
    C0 = MF(kf[4], qr[2], C0); pw0 = (u32x4){PKW(P0, 0), PKW(P0, 2), PKW(P0, 4), PKW(P0, 6)}; PIN(pw0); SBAR(); \
    C1 = MF(kf[5], qr[2], C1); pw1 = (u32x4){PKW(P0, 8), PKW(P0, 10), PKW(P0, 12), PKW(P0, 14)}; PIN(pw1); SBAR(); \
    C0 = MF(kf[6], qr[3], C0); pw2 = (u32x4){PKW(P1, 0), PKW(P1, 2), PKW(P1, 4), PKW(P1, 6)}; PIN(pw2); SBAR(); \
    C1 = MF(kf[7], qr[3], C1); pw3 = (u32x4){PKW(P1, 8), PKW(P1, 10), PKW(P1, 12), PKW(P1, 14)}; PIN(pw3); PIN(C0); PIN(C1); SBAR(); \
    VRD4(va, vnext, 0); VRD4(vb, vnext, 1); SBAR();     \
    } while (0)
#define VRD1(dst, ks, blk) dst[ks] = *(const LAS bf16x8*)(vp_ + vaddr[ks] + (blk) * 4096)
#define EXP2N(X, lo) do { X[lo] = __builtin_amdgcn_exp2f(X[lo]); X[lo + 1] = __builtin_amdgcn_exp2f(X[lo + 1]); } while (0)
#define S2(C0, C1, vbuf) do { SBAR(); \
    const lcp vp_ = lds3 + (vbuf) * BUFB; \
    o[0] = MF(va[0], PB(pw0), o[0]); VRD1(va, 0, 2); EXP2N(C0, 0); PIN(C0); SBAR(); \
    o[0] = MF(va[1], PB(pw1), o[0]); VRD1(va, 1, 2); EXP2N(C0, 2); PIN(C0); SBAR(); \
    o[0] = MF(va[2], PB(pw2), o[0]); VRD1(va, 2, 2); EXP2N(C0, 4); PIN(C0); SBAR(); \
    o[0] = MF(va[3], PB(pw3), o[0]); VRD1(va, 3, 2); EXP2N(C0, 6); PIN(C0); SBAR(); \
    o[1] = MF(vb[0], PB(pw0), o[1]); VRD1(vb, 0, 3); EXP2N(C0, 8); PIN(C0); SBAR(); \
    o[1] = MF(vb[1], PB(pw1), o[1]); VRD1(vb, 1, 3); EXP2N(C0, 10); PIN(C0); SBAR(); \
    o[1] = MF(vb[2], PB(pw2), o[1]); VRD1(vb, 2, 3); EXP2N(C0, 12); PIN(C0); SBAR(); \
    o[1] = MF(vb[3], PB(pw3), o[1]); VRD1(vb, 3, 3); EXP2N(C0, 14); PIN(C0); SBAR(); \
    o[2] = MF(va[0], PB(pw0), o[2]); EXP2N(C1, 0); PIN(C1); SBAR(); \
    o[2] = MF(va[1], PB(pw1), o[2]); EXP2N(C1, 2); PIN(C1); SBAR(); \
    o[2] = MF(va[2], PB(pw2), o[2]); EXP2N(C1, 4); PIN(C1); SBAR(); \
    o[2] = MF(va[3], PB(pw3), o[2]); EXP2N(C1, 6); PIN(C1); SBAR(); \
    o[3] = MF(vb[0], PB(pw0), o[3]); EXP2N(C1, 8); PIN(C1); SBAR(); \
    o[3] = MF(vb[1], PB(pw1), o[3]); EXP2N(C1, 10); PIN(C1); SBAR(); \
    o[3] = MF(vb[2], PB(pw2), o[3]); EXP2N(C1, 12); PIN(C1); SBAR(); \
    o[3] = MF(vb[3], PB(pw3), o[3]); EXP2N(C1, 14); PIN(C1); SBAR(); \
    } while (0)
    pB0 = f32x16{}; pB1 = f32x16{};
    if (!pre) { DMA(0, 0); DMA(1, 1); BARV(); }
    if (isB) { BARV(); DMA(2, 2); }
    S1(pA0, pA1, pB0, pB1, 0, 0);
    if (!isB) { BARV(); DMA(2, 2); }
    { float pm_ = pA0[0];
#pragma unroll
      for (int r = 1; r < 16; ++r) pm_ = __builtin_fmaxf(pm_, pA0[r]);
#pragma unroll
      for (int r = 0; r < 16; ++r) pm_ = __builtin_fmaxf(pm_, pA1[r]);
      { auto rr_ = __builtin_amdgcn_permlane32_swap(__float_as_uint(pm_), __float_as_uint(pm_), false, false); pm_ = __builtin_fmaxf(__uint_as_float(rr_[0]), __uint_as_float(rr_[1])); }
      const float nm_ = -(pm_ + REF_MARGIN);
#pragma unroll
      for (int r = 0; r < 16; ++r) { negm[r] = nm_; pA0[r] = __builtin_amdgcn_exp2f(pA0[r] + nm_); pA1[r] = __builtin_amdgcn_exp2f(pA1[r] + nm_); }
      PIN(negm); }
    for (int j = 1; j < NTILE; j += 2) {
        if (isB) { BARV(); DMAT(j + 2); }
        S1(pB0, pB1, pA0, pA1, j & 3, (j - 1) & 3);
        if (!isB) { BARV(); DMAT(j + 2); }
        S2(pB0, pB1, (j - 1) & 3);
        if (isB) { BARV(); DMAT(j + 3); }
        { const int kt = (j + 1 < NTILE) ? j + 1 : NTILE - 1;
          S1(pA0, pA1, pB0, pB1, kt & 3, j & 3); }
        if (!isB) { BARV(); DMAT(j + 3); }
        S2(pA0, pA1, j & 3);
    }
    { auto rr_ = __builtin_amdgcn_permlane32_swap(__float_as_uint(l_reg), __float_as_uint(l_reg), false, false);
      const float rl = __builtin_amdgcn_rcpf(__uint_as_float(rr_[0]) + __uint_as_float(rr_[1]));
#pragma unroll
      for (int d = 0; d < 4; ++d) o[d] = o[d] * rl; }
    if (!has_next) BAR();
#undef DMA
#undef DMAX
#undef DMAT
#undef BAR
#undef BARV
#undef PIN
#undef MF
#undef PB
#undef PKW
#undef ADD6
#undef S1
#undef S2
#undef KRD
#undef VRD4
#undef VRD1
#undef EXP2N
}
__device__ __forceinline__ void attn_unit(const Args& a, int b, int h, int qb, float lam, char* lds, bool first, bool has_nu, int nb, int nh) {
    const bf16_t* Q = (const bf16_t*)(a.ws + WS_Q); const bf16_t* KA = (const bf16_t*)(a.ws + WS_K); const bf16_t* VT = (const bf16_t*)(a.ws + WS_V);
    const size_t qrow0 = (size_t)b * NT + (size_t)qb * 256, kvrow0 = (size_t)b * KVR;
    for (int m = 0; m < 2; ++m) {
        f32x16 o[4];
        const bf16_t* Kc = KA + kvrow0 * DM + (2 * h + m) * 64; const bf16_t* Vc = VT + (size_t)((b * NHD + h) * 128) * VT_PITCH;
        const bf16_t* Kn = m == 0 ? Kc + 64 : KA + (size_t)nb * KVR * DM + (2 * nh) * 64; const bf16_t* Vn = m == 0 ? Vc : VT + (size_t)((nb * NHD + nh) * 128) * VT_PITCH;
        attn_map(Q + qrow0 * DM + (2 * h + m) * 64, Kc, Vc, (long)(Kn - Kc), (long)(Vn - Vc), !(first && m == 0), m == 0 || has_nu, o, lds);
        int t2 = threadIdx.x; asm volatile("" : "+v"(t2));
        const int wid = t2 >> 6, lane = t2 & 63, r32 = lane & 31, hi = lane >> 5;
        float* o1p = (float*)(a.ws + WS_O1) + (size_t)blockIdx.x * (64 * 512) + t2;
        if (m == 0) {
#pragma unroll
            for (int d = 0; d < 4; ++d)
#pragma unroll
                for (int r = 0; r < 16; ++r) o1p[(d * 16 + r) * 512] = o[d][r];
        } else {
            float ss = 0.f;
#pragma unroll
            for (int d = 0; d < 4; ++d)
#pragma unroll
                for (int r = 0; r < 16; ++r) { const float v = o1p[(d * 16 + r) * 512] - lam * o[d][r]; o[d][r] = v; ss += v * v; }
            { auto rr_ = __builtin_amdgcn_permlane32_swap(__float_as_uint(ss), __float_as_uint(ss), false, false); ss = __uint_as_float(rr_[0]) + __uint_as_float(rr_[1]); }
            const float rstd = 0.8f / sqrtf(ss * (1.0f / 128.0f) + EPS);
            const float* gs = a.in[I_GSUB] + 4 * hi;
            bf16_t* aow = (bf16_t*)(a.ws + WS_ATTO) + (qrow0 + wid * QBLK + r32) * DM + h * 128 + 4 * hi;
#pragma unroll
            for (int d = 0; d < 4; ++d)
#pragma unroll
                for (int rg = 0; rg < 4; ++rg) { const f32x4 g = *(const f32x4*)(gs + 32 * d + 8 * rg);
                    u32x2 w; w.x = cvt_pk_bf16(o[d][4 * rg] * rstd * g[0], o[d][4 * rg + 1] * rstd * g[1]); w.y = cvt_pk_bf16(o[d][4 * rg + 2] * rstd * g[2], o[d][4 * rg + 3] * rstd * g[3]);
                    *(u32x2*)(aow + 32 * d + 8 * rg) = w; }
        }
    }
}
#undef KSWZ
#undef SBAR
}

struct SchedDual {
    const char *A0, *A1, *B0, *B1; int G, c;
    __device__ __forceinline__ bool next(int i, Unit& u) const {
        const int L = (i >> 1) * G + c; if (L >= 512) return false;
        pg8::tile_of(L, 128, 4, u.pm, u.pn); u.aux = i & 1; return true; }
    __device__ __forceinline__ const char* a_ptr(const Unit& u) const { return (u.aux ? A1 : A0) + (size_t)u.pm * (256 * DM * 2); }
    __device__ __forceinline__ const char* b_ptr(const Unit& u) const { return (u.aux ? B1 : B0) + (size_t)u.pn * (256 * DM * 2); }
    __device__ __forceinline__ bool keep(const Unit& u) const { return u.aux == 0; }
};
struct EpiDual {
    static constexpr bool PERM = true;
    const bf16_t *GA, *GC; const float* bc; bf16_t* MIX;
    __device__ __forceinline__ void operator()(f32x4 (&acc)[2][2][4][2], const Unit& u, int wr, int wc, int fr, int fq) const {
        const int col0 = u.pn * 256 + wc * 32 + 8 * fq;
        if (u.aux == 0) {
            u32x4 ga[2][2], gc[2][2];
#define EDL(i, g) do { const int ai_ = (g) >> 2, m_ = (g) & 3; const size_t off_ = (size_t)(u.pm * 256 + ai_ * 128 + wr * 64 + m_ * 16 + fr) * DM + col0; \
    ga[i][0] = *(const u32x4*)(GA + off_); ga[i][1] = *(const u32x4*)(GA + off_ + 128); gc[i][0] = *(const u32x4*)(GC + off_); gc[i][1] = *(const u32x4*)(GC + off_ + 128); } while (0)
            EDL(0, 0);
#pragma unroll
            for (int g = 0; g < 8; ++g) { const int ai = g >> 2, m = g & 3, cur = g & 1;
                if (g + 1 < 8) { if (cur) EDL(0, g + 1); else EDL(1, g + 1); }
#pragma unroll
                for (int bj = 0; bj < 2; ++bj) { const u32x4 a4 = ga[cur][bj], c4 = gc[cur][bj];
                    f32x4 r0, r1;
                    r0[0] = bf_lo(a4.x) * __builtin_amdgcn_rcpf(bf_lo(c4.x)); r0[1] = bf_hi(a4.x) * __builtin_amdgcn_rcpf(bf_hi(c4.x));
                    r0[2] = bf_lo(a4.y) * __builtin_amdgcn_rcpf(bf_lo(c4.y)); r0[3] = bf_hi(a4.y) * __builtin_amdgcn_rcpf(bf_hi(c4.y));
                    r1[0] = bf_lo(a4.z) * __builtin_amdgcn_rcpf(bf_lo(c4.z)); r1[1] = bf_hi(a4.z) * __builtin_amdgcn_rcpf(bf_hi(c4.z));
                    r1[2] = bf_lo(a4.w) * __builtin_amdgcn_rcpf(bf_lo(c4.w)); r1[3] = bf_hi(a4.w) * __builtin_amdgcn_rcpf(bf_hi(c4.w));
                    acc[ai][bj][m][0] *= r0; acc[ai][bj][m][1] *= r1; }
                asm volatile("" ::: "memory"); }
#undef EDL
            return;
        }
        f32x4 bv[2][2];
#pragma unroll
        for (int bj = 0; bj < 2; ++bj)
#pragma unroll
            for (int n = 0; n < 2; ++n) bv[bj][n] = *(const f32x4*)(bc + col0 + bj * 128 + 4 * n);
        u32x4 gc[2][2];
#define EDL(i, g) do { const int ai_ = (g) >> 2, m_ = (g) & 3; const size_t off_ = (size_t)(u.pm * 256 + ai_ * 128 + wr * 64 + m_ * 16 + fr) * DM + col0; \
    gc[i][0] = *(const u32x4*)(GC + off_); gc[i][1] = *(const u32x4*)(GC + off_ + 128); } while (0)
        EDL(0, 0);
#pragma unroll
        for (int g = 0; g < 8; ++g) { const int ai = g >> 2, m = g & 3, cur = g & 1;
            if (g + 1 < 8) { if (cur) EDL(0, g + 1); else EDL(1, g + 1); }
            const size_t off = (size_t)(u.pm * 256 + ai * 128 + wr * 64 + m * 16 + fr) * DM + col0;
#pragma unroll
            for (int bj = 0; bj < 2; ++bj) { const u32x4 c4 = gc[cur][bj];
                const f32x4 v0 = acc[ai][bj][m][0] + bv[bj][0], v1 = acc[ai][bj][m][1] + bv[bj][1];
                u32x4 w; w.x = cvt_pk_bf16(v0[0] * bf_lo(c4.x), v0[1] * bf_hi(c4.x)); w.y = cvt_pk_bf16(v0[2] * bf_lo(c4.y), v0[3] * bf_hi(c4.y));
                w.z = cvt_pk_bf16(v1[0] * bf_lo(c4.z), v1[1] * bf_hi(c4.z)); w.w = cvt_pk_bf16(v1[2] * bf_lo(c4.w), v1[3] * bf_hi(c4.w));
                *(u32x4*)(MIX + off + bj * 128) = w; }
            asm volatile("" ::: "memory"); }
#undef EDL
    }
};

struct SchedPlain {
    const char* A; const char* Bt; int G, c, nM, nN, RB, bgrp;
    __device__ __forceinline__ bool next(int i, Unit& u) const {
        const int L = i * G + c; if (L >= nM * nN) return false;
        pg8::tile_of(L, nM, nN, u.pm, u.pn); u.aux = 0; return true; }
    __device__ __forceinline__ const char* a_ptr(const Unit& u) const { return A + (size_t)u.pm * ((size_t)256 * RB); }
    __device__ __forceinline__ const char* b_ptr(const Unit& u) const { return Bt + (size_t)((u.pm >> 4) * nN * bgrp + u.pn) * ((size_t)256 * RB); }
    __device__ __forceinline__ bool keep(const Unit&) const { return false; }
};
struct EpiResid {
    static constexpr bool PERM = false;
    const float* x; const float* mod; float* out;
    __device__ __forceinline__ void operator()(f32x4 (&acc)[2][2][4][2], const Unit& u, int wr, int wc, int fr, int fq) const {
        const int col0 = u.pn * 256 + wc * 32 + 4 * fq; const float* gm = mod + (size_t)(u.pm >> 4) * NMOD + 2048 + col0;
        f32x4 gv[2][2];
#pragma unroll
        for (int bj = 0; bj < 2; ++bj)
#pragma unroll
            for (int n = 0; n < 2; ++n) gv[bj][n] = *(const f32x4*)(gm + bj * 128 + n * 16);
        f32x4 xv[2][2][2];
#define ERL(i, g) do { const int ai_ = (g) >> 2, m_ = (g) & 3; const size_t off_ = (size_t)(u.pm * 256 + ai_ * 128 + wr * 64 + m_ * 16 + fr) * DM + col0; \
    _Pragma("unroll") for (int bj_ = 0; bj_ < 2; ++bj_) _Pragma("unroll") for (int n_ = 0; n_ < 2; ++n_) xv[i][bj_][n_] = __builtin_nontemporal_load((const f32x4*)(x + off_ + bj_ * 128 + n_ * 16)); } while (0)
        ERL(0, 0);
#pragma unroll
        for (int g = 0; g < 8; ++g) { const int ai = g >> 2, m = g & 3, cur = g & 1;
            if (g + 1 < 8) { if (cur) ERL(0, g + 1); else ERL(1, g + 1); }
            const size_t off = (size_t)(u.pm * 256 + ai * 128 + wr * 64 + m * 16 + fr) * DM + col0;
#pragma unroll
            for (int bj = 0; bj < 2; ++bj)
#pragma unroll
                for (int n = 0; n < 2; ++n) *(f32x4*)(out + off + bj * 128 + n * 16) = xv[cur][bj][n] + gv[bj][n] * acc[ai][bj][m][n];
            asm volatile("" ::: "memory"); }
#undef ERL
    }
};

__device__ __forceinline__ void ph_router(const Args& a, LAS unsigned char* lds, int gw, int NGW, int lane) {
    LAS float* wrt = (LAS float*)lds;
    const float* wr = a.in[I_WR];
    for (int k = threadIdx.x; k < DM; k += 512) {
        f32x4 w4[4];
#pragma unroll
        for (int q = 0; q < 4; ++q) w4[q] = *(const f32x4*)(wr + (size_t)k * NEXP + 4 * q);
#pragma unroll
        for (int q = 0; q < 4; ++q) { wrt[(4 * q + 0) * DM + k] = w4[q].x; wrt[(4 * q + 1) * DM + k] = w4[q].y; wrt[(4 * q + 2) * DM + k] = w4[q].z; wrt[(4 * q + 3) * DM + k] = w4[q].w; } }
    __syncthreads();
    const float* mod = (const float*)(a.ws + WS_MOD); const float* g = a.in[I_GFFN];
    unsigned char* HF = (unsigned char*)(a.ws + WS_HF); float* AFF = (float*)(a.ws + WS_AFF);
    f32x4 gs[4], shv[4]; int cur_b = -1;
    f32x4 nx[2][4];
    { const f32x4* xr = (const f32x4*)(a.out + (size_t)(2 * gw) * DM) + lane;
#pragma unroll
      for (int r = 0; r < 2; ++r)
#pragma unroll
        for (int j = 0; j < 4; ++j) nx[r][j] = __builtin_nontemporal_load(xr + r * (DM / 4) + 64 * j); }
    for (int pr = gw; pr < MLAT / 2; pr += NGW) {
        const int row = 2 * pr;
        f32x4 v[2][4]; float s[2] = {0.f, 0.f};
#pragma unroll
        for (int r = 0; r < 2; ++r)
#pragma unroll
            for (int j = 0; j < 4; ++j) { v[r][j] = nx[r][j]; s[r] += (v[r][j].x * v[r][j].x + v[r][j].y * v[r][j].y) + (v[r][j].z * v[r][j].z + v[r][j].w * v[r][j].w); }
        if (pr + NGW < MLAT / 2) { const f32x4* xr = (const f32x4*)(a.out + (size_t)(row + 2 * NGW) * DM) + lane;
#pragma unroll
            for (int r = 0; r < 2; ++r)
#pragma unroll
                for (int j = 0; j < 4; ++j) nx[r][j] = __builtin_nontemporal_load(xr + r * (DM / 4) + 64 * j); }
        if ((row >> 12) != cur_b) { cur_b = row >> 12; const float* mb = mod + (size_t)cur_b * NMOD + 3072;
#pragma unroll
            for (int j = 0; j < 4; ++j) { const int c = 4 * lane + 256 * j; gs[j] = *(const f32x4*)(g + c) * (*(const f32x4*)(mb + 1024 + c) + 1.0f); shv[j] = *(const f32x4*)(mb + c); } }
        const float rstd0 = 1.0f / sqrtf(wave_sum(s[0]) * (1.0f / DM) + EPS), rstd1 = 1.0f / sqrtf(wave_sum(s[1]) * (1.0f / DM) + EPS);
#pragma unroll
        for (int r = 0; r < 2; ++r) { unsigned* o4 = (unsigned*)(HF + (size_t)(row + r) * DM) + lane; const float rstd = r ? rstd1 : rstd0;
#pragma unroll
            for (int j = 0; j < 4; ++j) { v[r][j] = (v[r][j] * rstd) * gs[j] + shv[j];
                o4[64 * j] = pack4_fp8(v[r][j].x, v[r][j].y, v[r][j].z, v[r][j].w); } }
        float p[2][16];
#pragma unroll
        for (int e = 0; e < 16; ++e) { float t0 = 0.f, t1 = 0.f;
#pragma unroll
            for (int j = 0; j < 4; ++j) { const f32x4 wv = *(const LAS f32x4*)(wrt + e * DM + 4 * lane + 256 * j);
                t0 += (v[0][j].x * wv.x + v[0][j].y * wv.y) + (v[0][j].z * wv.z + v[0][j].w * wv.w); t1 += (v[1][j].x * wv.x + v[1][j].y * wv.y) + (v[1][j].z * wv.z + v[1][j].w * wv.w); }
            p[0][e] = t0; p[1][e] = t1; if ((e & 3) == 3) __builtin_amdgcn_sched_barrier(0); }
        float r16[16], r8[8], r4[4], r2[2], r1;
        { const bool up = (lane & 32) != 0;
#pragma unroll
          for (int i = 0; i < 16; ++i) { const float send = up ? p[0][i] : p[1][i], keepv = up ? p[1][i] : p[0][i]; r16[i] = keepv + __shfl_xor(send, 32); } }
        { const bool up = (lane & 16) != 0;
#pragma unroll
          for (int i = 0; i < 8; ++i) { const float send = up ? r16[i] : r16[i + 8], keepv = up ? r16[i + 8] : r16[i]; r8[i] = keepv + __shfl_xor(send, 16); } }
        { const bool up = (lane & 8) != 0;
#pragma unroll
          for (int i = 0; i < 4; ++i) { const float send = up ? r8[i] : r8[i + 4], keepv = up ? r8[i + 4] : r8[i]; r4[i] = keepv + __shfl_xor(send, 8); } }
        { const bool up = (lane & 4) != 0;
#pragma unroll
          for (int i = 0; i < 2; ++i) { const float send = up ? r4[i] : r4[i + 2], keepv = up ? r4[i + 2] : r4[i]; r2[i] = keepv + __shfl_xor(send, 4); } }
        { const bool up = (lane & 2) != 0; const float send = up ? r2[0] : r2[1], keepv = up ? r2[1] : r2[0]; r1 = keepv + __shfl_xor(send, 2); }
        r1 += __shfl_xor(r1, 1);
        float mx = r1;
#pragma unroll
        for (int o = 2; o < 32; o <<= 1) mx = fmaxf(mx, __shfl_xor(mx, o));
        const float ex = expf(r1 - mx); float sm = ex;
#pragma unroll
        for (int o = 2; o < 32; o <<= 1) sm += __shfl_xor(sm, o);
        if ((lane & 1) == 0) AFF[(size_t)(row + (lane >> 5)) * NEXP + ((lane >> 1) & 15)] = ex / sm;
    }
}

__device__ __forceinline__ void ph_topk_unit(const Args& a, LAS unsigned char* lds, int g  ) {
    const int tid = threadIdx.x, lane = tid & 63, wave = __builtin_amdgcn_readfirstlane(tid >> 6);
    const int b = g >> 4, e = g & 15;
    LAS unsigned* hist = (LAS unsigned*)lds;
    LAS unsigned* ctl = hist + 256;
    LAS unsigned* wsum = hist + 264;
    LAS int* S = (LAS int*)(hist + 512);
    const float* AFF = (const float*)(a.ws + WS_AFF) + (size_t)b * NT * NEXP + e;
    unsigned key[8];
#pragma unroll
    for (int q = 0; q < 8; ++q) key[q] = __float_as_uint(AFF[(size_t)(8 * tid + q) * NEXP]);
    unsigned prefix = 0, need = CAP;
#pragma unroll
    for (int pass = 0; pass < 4; ++pass) {
        const int shift = 24 - 8 * pass;
        const unsigned himask = pass == 0 ? 0u : (0xFFFFFFFFu << (shift + 8));
        if (tid < 256) hist[tid] = 0;
        __syncthreads();
#pragma unroll
        for (int q = 0; q < 8; ++q) if ((key[q] & himask) == prefix) __hip_atomic_fetch_add(hist + ((key[q] >> shift) & 255), 1u, __ATOMIC_RELAXED, __HIP_MEMORY_SCOPE_WORKGROUP);
        __syncthreads();
        if (wave == 0) {
            const u32x4 h = *(const LAS u32x4*)(hist + 4 * lane);
            const unsigned c = h.x + h.y + h.z + h.w;
            unsigned v = c;
#pragma unroll
            for (int off = 1; off < 64; off <<= 1) { const unsigned o = __shfl_down(v, off); if (lane + off < 64) v += o; }
            const unsigned above = v - c;
            if (above < need && need <= v) {
                unsigned acc = above; int d;
                if (acc + h.w >= need) d = 3; else { acc += h.w; if (acc + h.z >= need) d = 2; else { acc += h.z; if (acc + h.y >= need) d = 1; else { acc += h.y; d = 0; } } }
                ctl[0] = prefix | ((unsigned)(4 * lane + d) << shift); ctl[1] = need - acc;
            }
        }
        __syncthreads();
        prefix = ctl[0]; need = ctl[1];
    }
    unsigned cg = 0, ce = 0;
#pragma unroll
    for (int q = 0; q < 8; ++q) { cg += key[q] > prefix; ce += key[q] == prefix; }
    const unsigned pk = cg | (ce << 16);
    unsigned inc = pk;
#pragma unroll
    for (int off = 1; off < 64; off <<= 1) { const unsigned o = __shfl_up(inc, off); if (lane >= off) inc += o; }
    if (lane == 63) wsum[wave] = inc;
    __syncthreads();
    unsigned base = 0;
    for (int w = 0; w < wave; ++w) base += wsum[w];
    const unsigned excl = base + inc - pk;
    unsigned gbef = excl & 0xFFFFu, ebef = excl >> 16;
    int* SEL = (int*)(a.ws + WS_SEL) + (size_t)b * NT * NEXP + e;
#pragma unroll
    for (int q = 0; q < 8; ++q) { const int tok = 8 * tid + q; int sel = -1;
        if (key[q] > prefix) { sel = (int)(gbef + (ebef < need ? ebef : need)); ++gbef; }
        else if (key[q] == prefix) { if (ebef < need) sel = (int)(gbef + ebef); ++ebef; }
        SEL[(size_t)tok * NEXP] = sel; if (sel >= 0) S[sel] = tok; }
    __syncthreads();
    const unsigned char* HF = (const unsigned char*)(a.ws + WS_HF) + (size_t)b * NT * DM;
    unsigned char* XS = (unsigned char*)(a.ws + WS_XS) + (size_t)(e * NB + b) * CAP * DM;
    for (int k = 0; k < 64; k += 8) {
        u32x4 v[8];
#pragma unroll
        for (int q = 0; q < 8; ++q) { const int s = wave * 64 + k + q; const unsigned tok = (unsigned)S[s];
            v[q] = ((const u32x4*)(HF + (size_t)tok * DM))[lane]; }
#pragma unroll
        for (int q = 0; q < 8; ++q) { const int s = wave * 64 + k + q; ((u32x4*)(XS + (size_t)s * DM))[lane] = v[q]; }
    }
    __syncthreads();
}

struct EpiSwiGLU {
    static constexpr bool PERM = true;
    unsigned char* HID;
    __device__ __forceinline__ void operator()(f32x4 (&acc)[2][2][4][2], const Unit& u, int wr, int wc, int fr, int fq) const {
        const int col0 = u.pn * 128 + wc * 32 + 8 * fq;
#pragma unroll
        for (int ai = 0; ai < 2; ++ai)
#pragma unroll
            for (int m = 0; m < 4; ++m) { const size_t r = (size_t)u.pm * 256 + ai * 128 + wr * 64 + m * 16 + fr;
                const f32x4 g0 = acc[ai][0][m][0] * WSCALE_INV, g1 = acc[ai][0][m][1] * WSCALE_INV, u0 = acc[ai][1][m][0] * WSCALE_INV, u1 = acc[ai][1][m][1] * WSCALE_INV;
                u32x2 w; w.x = pack4_fp8(g0[0] * sigmoidf_(g0[0]) * u0[0], g0[1] * sigmoidf_(g0[1]) * u0[1], g0[2] * sigmoidf_(g0[2]) * u0[2], g0[3] * sigmoidf_(g0[3]) * u0[3]);
                w.y = pack4_fp8(g1[0] * sigmoidf_(g1[0]) * u1[0], g1[1] * sigmoidf_(g1[1]) * u1[1], g1[2] * sigmoidf_(g1[2]) * u1[2], g1[3] * sigmoidf_(g1[3]) * u1[3]);
                *(u32x2*)(HID + r * DFF + col0) = w; }
    }
};
struct EpiPlainBf16 {
    static constexpr bool PERM = true;
    bf16_t* O; int ldc; float scale;
    __device__ __forceinline__ void operator()(f32x4 (&acc)[2][2][4][2], const Unit& u, int wr, int wc, int fr, int fq) const {
        const int col0 = u.pn * 256 + wc * 32 + 8 * fq;
#pragma unroll
        for (int ai = 0; ai < 2; ++ai)
#pragma unroll
            for (int m = 0; m < 4; ++m) { bf16_t* rowp = O + ((size_t)u.pm * 256 + ai * 128 + wr * 64 + m * 16 + fr) * ldc + col0;
#pragma unroll
                for (int bj = 0; bj < 2; ++bj) { const f32x4 v0 = acc[ai][bj][m][0] * scale, v1 = acc[ai][bj][m][1] * scale;
                    u32x4 w; w.x = cvt_pk_bf16(v0[0], v0[1]); w.y = cvt_pk_bf16(v0[2], v0[3]); w.z = cvt_pk_bf16(v1[0], v1[1]); w.w = cvt_pk_bf16(v1[2], v1[3]);
                    *(u32x4*)(rowp + bj * 128) = w; } }
    }
};

__device__ __forceinline__ void ph_final(const Args& a, int gw, int NGW, int lane) {
    const float* mod = (const float*)(a.ws + WS_MOD); const float* gfin = a.in[I_GFIN];
    const float* AFF = (const float*)(a.ws + WS_AFF); const int* SEL = (const int*)(a.ws + WS_SEL); const bf16_t* YS = (const bf16_t*)(a.ws + WS_YS);
    const int per = MLAT / NGW, r0 = gw * per, b = r0 >> 12;
    f32x4 gfv[2][2], gnv[2][2];
    { const float* gf = mod + (size_t)b * NMOD + 5120;
#pragma unroll
      for (int jj = 0; jj < 2; ++jj)
#pragma unroll
          for (int q = 0; q < 2; ++q) { const int c = 8 * lane + 512 * jj + 4 * q; gfv[jj][q] = *(const f32x4*)(gf + c); gnv[jj][q] = *(const f32x4*)(gfin + c); } }
    for (int row = r0; row < r0 + per; ++row) {
        float* xr = a.out + (size_t)row * DM;
        const int selv = (lane < 16) ? SEL[(size_t)row * NEXP + lane] : -1; const float affv = (lane < 16) ? AFF[(size_t)row * NEXP + lane] : 0.f;
        f32x4 acc[2][2];
#pragma unroll
        for (int jj = 0; jj < 2; ++jj) { acc[jj][0] = (f32x4){0.f, 0.f, 0.f, 0.f}; acc[jj][1] = (f32x4){0.f, 0.f, 0.f, 0.f}; }
#pragma unroll
        for (int e = 0; e < NEXP; ++e) { const int s = __builtin_amdgcn_readlane(selv, e); const float gt = __uint_as_float(__builtin_amdgcn_readlane(__float_as_uint(affv), e));
            if (s >= 0) { const bf16_t* yr = YS + ((size_t)(e * NB + b) * CAP + s) * DM;
#pragma unroll
                for (int jj = 0; jj < 2; ++jj) { const u32x4 y = *(const u32x4*)(yr + 8 * lane + 512 * jj);
                    acc[jj][0] += gt * (f32x4){bf_lo(y.x), bf_hi(y.x), bf_lo(y.y), bf_hi(y.y)}; acc[jj][1] += gt * (f32x4){bf_lo(y.z), bf_hi(y.z), bf_lo(y.w), bf_hi(y.w)}; } } }
        f32x4 v[2][2]; float ss = 0.f;
#pragma unroll
        for (int jj = 0; jj < 2; ++jj)
#pragma unroll
            for (int q = 0; q < 2; ++q) { const int c = 8 * lane + 512 * jj + 4 * q;
                v[jj][q] = __builtin_nontemporal_load((const f32x4*)(xr + c)) + gfv[jj][q] * acc[jj][q];
                ss += (v[jj][q].x * v[jj][q].x + v[jj][q].y * v[jj][q].y) + (v[jj][q].z * v[jj][q].z + v[jj][q].w * v[jj][q].w); }
        const float rstd = 1.0f / sqrtf(wave_sum(ss) * (1.0f / DM) + EPS);
#pragma unroll
        for (int jj = 0; jj < 2; ++jj)
#pragma unroll
            for (int q = 0; q < 2; ++q) { const int c = 8 * lane + 512 * jj + 4 * q; __builtin_nontemporal_store(v[jj][q] * rstd * gnv[jj][q], (f32x4*)(xr + c)); }
    }
}

constexpr int N_PHASES = 12;
#ifndef MK_ATTN_REPS
#define MK_ATTN_REPS 1
#endif
struct Ctx { LAS unsigned char* lds; char* lds_gen; int G, bid, vcu, gw, NGW, wave, lane; };
template <int P> __device__ __forceinline__ void run_phase(const Args& args, const Ctx& c) {
    LAS unsigned char* lds = c.lds; const int G = c.G, bid = c.bid, vcu = c.vcu, gw = c.gw, NGW = c.NGW, wave = c.wave, lane = c.lane;
    if constexpr (P == 0) {
        ph_adaln(args, lds, bid, G);
        if (bid == G - 1) ph_rope_table(args);
        ph_small_weights(args, lds, gw, NGW, wave, lane);
    }
    if constexpr (P == 1) ph_norm_rows(args, gw, NGW, lane);
    if constexpr (P == 2) {
        SchedInProj S{(const char*)(args.ws + WS_H), (const char*)(args.ws + WS_WIN), G, bid};
        EpiInProj E{(bf16_t*)(args.ws + WS_U), (bf16_t*)(args.ws + WS_Q), (bf16_t*)(args.ws + WS_K), (bf16_t*)(args.ws + WS_V), (bf16_t*)(args.ws + WS_GC), (bf16_t*)(args.ws + WS_GA), (const float*)(args.ws + WS_ROPE)};
        pg8::gemm_phase<EpiInProj, SchedInProj, PG8_ALIGN, PG8_SP2>(lds, DM * 2, S, E);
    }
    if constexpr (P == 3) {
#ifndef MK_NO_CONV
        for (int u = vcu; u < 256; u += G) ph_conv_unit(args, lds, u);
        __syncthreads();
#endif
#ifndef MK_NO_ATTN
        float lam;
        { const float s1 = wave_sum(args.in[I_LQ1][lane] * args.in[I_LK1][lane]), s2 = wave_sum(args.in[I_LQ2][lane] * args.in[I_LK2][lane]); lam = __uint_as_float(__builtin_amdgcn_readfirstlane(__float_as_uint(expf(s1) - expf(s2) + 0.2f))); }
#if defined(MK_PROBE_CLOCK)
        const unsigned long long pc0_ = __builtin_amdgcn_s_memtime(), pr0_ = __builtin_amdgcn_s_memrealtime();
#endif
        for (int i = 0; i < 4 * MK_ATTN_REPS; ++i) { const int u = (i & 3) * 256 + vcu; if (u >= 1024) break;
            const int un = ((i + 1) & 3) * 256 + vcu; const bool has_nu = (i + 1 < 4 * MK_ATTN_REPS) && un < 1024;
            att::attn_unit(args, u >> 7, (u >> 4) & 7, u & 15, lam, c.lds_gen, i == 0, has_nu, un >> 7, (un >> 4) & 7); }
#if defined(MK_PROBE_CLOCK)
        { const unsigned long long pc1_ = __builtin_amdgcn_s_memtime(), pr1_ = __builtin_amdgcn_s_memrealtime();
          if (threadIdx.x == 0) { volatile LAS unsigned* mw = (volatile LAS unsigned*)(c.lds + LDSCTL_OFF); mw[16] = (unsigned)(pc1_ - pc0_); mw[17] = (unsigned)(pr1_ - pr0_);
              unsigned* pw_ = (unsigned*)(args.ws + WS_CTL) + 15000;
              atomicMax(pw_, (unsigned)(pr1_ - pr0_)); atomicAdd(pw_ + 1, (unsigned)(pr1_ - pr0_)); atomicMax(pw_ + 2, 0xFFFFFFFFu - (unsigned)(pr1_ - pr0_)); } }
#endif
#endif
    }
    if constexpr (P == 4) {
        SchedDual S{(const char*)(args.ws + WS_ATTO), (const char*)(args.ws + WS_CACT), (const char*)(args.ws + WS_WAO), (const char*)(args.ws + WS_WCO), G, bid};
        EpiDual E{(const bf16_t*)(args.ws + WS_GA), (const bf16_t*)(args.ws + WS_GC), args.in[I_BCO], (bf16_t*)(args.ws + WS_MIX)};
        pg8::gemm_phase<EpiDual, SchedDual, PG8_ALIGN, PG8_SP2>(lds, DM * 2, S, E);
    }
    if constexpr (P == 5) {
        SchedPlain S{(const char*)(args.ws + WS_MIX), (const char*)(args.ws + WS_WO), G, bid, 128, 4, DM * 2, 0};
        EpiResid E{args.in[I_X], (const float*)(args.ws + WS_MOD), args.out};
        pg8::gemm_phase<EpiResid, SchedPlain, PG8_ALIGN, PG8_SP2>(lds, DM * 2, S, E);
    }
    if constexpr (P == 6) {
        ph_router(args, lds, gw, NGW, lane);
        __syncthreads();
        ph_wgu(args, lds, gw, NGW, wave, lane);
        ph_wd(args, lds, gw, NGW, wave, lane, 0, G < 2 ? WD_ITEMS : WD_SPLIT);
    }
    if constexpr (P == 7) {
        if (G < 2) { for (int g = 0; g < NB * NEXP; ++g) ph_topk_unit(args, lds, g); }
        else if ((vcu & 1) == 0) { for (int g = vcu >> 1; g < NB * NEXP; g += (G + 1) / 2) ph_topk_unit(args, lds, g); }
        else ph_wd(args, lds, (vcu >> 1) * 8 + wave, (G / 2) * 8, wave, lane, WD_SPLIT, WD_ITEMS);
    }
    if constexpr (P == 8) {
        SchedPlain S{(const char*)(args.ws + WS_XS), (const char*)(args.ws + WS_WGU), G, bid, 256, 22, DM, 1};
        EpiSwiGLU E{(unsigned char*)(args.ws + WS_HID)};
        pg8::gemm_phase<EpiSwiGLU, SchedPlain, PG8_ALIGN, PG8_SP2, true>(lds, DM, S, E);
    }
    if constexpr (P == 10) {
        SchedPlain S{(const char*)(args.ws + WS_HID), (const char*)(args.ws + WS_WD), G, bid, 256, 4, DFF, 1};
        EpiPlainBf16 E{(bf16_t*)(args.ws + WS_YS), DM, WSCALE_INV};
        pg8::gemm_phase<EpiPlainBf16, SchedPlain, PG8_ALIGN, PG8_SP2, true>(lds, DFF, S, E);
    }
    if constexpr (P == 11) ph_final(args, gw, NGW, lane);
}
#ifndef MK_PHASE_MASK
#define MK_PHASE_MASK 0xFFF
#endif
#ifndef MK_REPEAT_MASK
#define MK_REPEAT_MASK 0
#endif
__global__ void __launch_bounds__(512, 2) mk_fwd(Args args) {
    extern __shared__ __attribute__((aligned(16))) unsigned char lds_raw[];
    LAS unsigned char* lds = (LAS unsigned char*)lds_raw;
    const int tid = threadIdx.x;
    Ctx c; c.lds = lds; c.lds_gen = (char*)lds_raw; c.lane = tid & 63; c.wave = __builtin_amdgcn_readfirstlane(tid >> 6);
    c.G = gridDim.x; c.bid = blockIdx.x;
    c.vcu = (c.G % 8 == 0) ? (c.bid % 8) * (c.G / 8) + c.bid / 8 : c.bid;
    c.gw = c.vcu * 8 + c.wave; c.NGW = c.G * 8;
    volatile LAS unsigned* misc = (volatile LAS unsigned*)(lds + LDSCTL_OFF);
    if (tid < 64) misc[tid] = 0u;
    __syncthreads();
#if defined(MK_PROBE_TS)
    const unsigned long long kstart_ = __builtin_amdgcn_s_memrealtime();
#endif
    const int lo = args.ph_lo, hi = args.ph_hi;
    XcdBarrier bar; bar.bar = (unsigned*)(args.ws + WS_CTL) + 1024 + args.li * XCD_BAR_WORDS; bar.x = 0; bar.st = nullptr;
    if (hi - lo > 1) bar = xcd_barrier_post((unsigned*)(args.ws + WS_CTL) + 1024 + args.li * XCD_BAR_WORDS, misc + 8);
#define IN(k) (((MK_PHASE_MASK >> (k)) & 1) && lo <= (k) && (k) < hi)
#if defined(MK_PROBE_PHASE)
#define PH_T0() const unsigned long long pt0_ = __builtin_amdgcn_s_memrealtime()
#define PH_T1(k) do { const unsigned long long pt1_ = __builtin_amdgcn_s_memrealtime(); if (threadIdx.x == 0) atomicMax((unsigned*)(args.ws + WS_CTL) + 15100 + (k), (unsigned)(pt1_ - pt0_)); } while (0)
#else
#define PH_T0() do { } while (0)
#define PH_T1(k) do { } while (0)
#endif
#if defined(MK_PROBE_BAR)
#define PB_T0() const unsigned long long bt0_ = __builtin_amdgcn_s_memrealtime()
#define PB_T1(k) do { const unsigned long long bt1_ = __builtin_amdgcn_s_memrealtime(); if (threadIdx.x == 0) atomicMax((unsigned*)(args.ws + WS_CTL) + 15200 + (k), 0xFFFFFFFFu - (unsigned)(bt1_ - bt0_)); } while (0)
#else
#define PB_T0() do { } while (0)
#define PB_T1(k) do { } while (0)
#endif
#if defined(MK_PROBE_TS)
#define PH_TS(k) do { if ((k) == MK_PROBE_TS && blockIdx.x == 0 && threadIdx.x == 0) misc[20] = (unsigned)(__builtin_amdgcn_s_memrealtime() - kstart_); } while (0)
#else
#define PH_TS(k) do { } while (0)
#endif
#define PHASE(k) do { PH_TS(k); if (IN(k)) { PH_T0(); run_phase<k>(args, c); if constexpr ((MK_REPEAT_MASK >> (k)) & 1) { __syncthreads(); run_phase<k>(args, c); } PH_T1(k); PH_TS((k) + 100); } \
                      if ((k) != 9 && (k) + 1 < N_PHASES && IN(k) && IN((k) + 1)) { PB_T0(); xcd_barrier(bar); PB_T1(k); } } while (0)
    PHASE(0); PHASE(1); PHASE(2); PHASE(3); PHASE(4); PHASE(5); PHASE(6); PHASE(7); PHASE(8); PHASE(9); PHASE(10); PHASE(11);
#if defined(MK_PROBE_TS)
    PH_TS(12);
    if (blockIdx.x == 0 && threadIdx.x == 0) {
        const unsigned long long wait_ticks = misc[20];
        const unsigned long long w0 = __builtin_amdgcn_s_memrealtime();
        while (__builtin_amdgcn_s_memrealtime() - w0 < wait_ticks) __builtin_amdgcn_s_sleep(8);
    }
#endif
#if defined(MK_PROBE_BAR)
    if (blockIdx.x == 0 && threadIdx.x == 0) {
        unsigned long long wait_ticks = 0;
        for (int k = 0; k < 10; ++k) { const unsigned v = __hip_atomic_load((unsigned*)(args.ws + WS_CTL) + 15200 + k, __ATOMIC_RELAXED, __HIP_MEMORY_SCOPE_AGENT); if (v) wait_ticks += 0xFFFFFFFFu - v; }
        wait_ticks *= 10;
        const unsigned long long w0 = __builtin_amdgcn_s_memrealtime();
        while (__builtin_amdgcn_s_memrealtime() - w0 < wait_ticks) __builtin_amdgcn_s_sleep(8);
    }
#endif
#if defined(MK_PROBE_PHASE)
    if (blockIdx.x == 0 && threadIdx.x == 0) {
        const unsigned long long wait_ticks = __hip_atomic_load((unsigned*)(args.ws + WS_CTL) + 15100 + MK_PROBE_PHASE, __ATOMIC_RELAXED, __HIP_MEMORY_SCOPE_AGENT);
        const unsigned long long w0 = __builtin_amdgcn_s_memrealtime();
        while (__builtin_amdgcn_s_memrealtime() - w0 < wait_ticks) __builtin_amdgcn_s_sleep(8);
    }
#endif
#if defined(MK_PROBE_CLOCK)
    if (blockIdx.x == 0 && threadIdx.x == 0) {
        const unsigned dc = misc[16], dr = misc[17];
        unsigned* pw_ = (unsigned*)(args.ws + WS_CTL) + 15000;
        const unsigned long long wait_ticks = (MK_PROBE_CLOCK == 1) ? (unsigned long long)(((double)dc / (double)dr) * 0.1 * 500.0 * 100.0) : (MK_PROBE_CLOCK == 2) ? (unsigned long long)dr
            : (MK_PROBE_CLOCK == 3) ? (unsigned long long)__hip_atomic_load(pw_, __ATOMIC_RELAXED, __HIP_MEMORY_SCOPE_AGENT)
            : (MK_PROBE_CLOCK == 4) ? (unsigned long long)(__hip_atomic_load(pw_ + 1, __ATOMIC_RELAXED, __HIP_MEMORY_SCOPE_AGENT) / gridDim.x)
            : (unsigned long long)(0xFFFFFFFFu - __hip_atomic_load(pw_ + 2, __ATOMIC_RELAXED, __HIP_MEMORY_SCOPE_AGENT));
        const unsigned long long w0 = __builtin_amdgcn_s_memrealtime();
        while (__builtin_amdgcn_s_memrealtime() - w0 < wait_ticks) __builtin_amdgcn_s_sleep(8);
    }
#endif
#undef IN
#undef PHASE
}

extern "C" void kernel_launch(void* const* d_in, const int* in_sizes, int n_in, void* d_out, int out_size, void* d_ws, size_t ws_size, hipStream_t stream) {
    static int grid = 0;
    if (grid == 0) {
        if (n_in != N_IN || out_size != MLAT * DM || ws_size < WS_END) { fprintf(stderr, "kernel_launch: unexpected shapes: n_in %d out %d ws %zu (need %zu)\n", n_in, out_size, ws_size, (size_t)WS_END); grid = -1; return; }
        int dev = 0, cus = 0, per_cu = 0;
        if (hipGetDevice(&dev) != hipSuccess || hipDeviceGetAttribute(&cus, hipDeviceAttributeMultiprocessorCount, dev) != hipSuccess) { grid = -1; return; }
        if (hipFuncSetAttribute((const void*)mk_fwd, hipFuncAttributeMaxDynamicSharedMemorySize, LDS_BYTES) != hipSuccess) { fprintf(stderr, "kernel_launch: hipFuncSetAttribute failed\n"); grid = -1; return; }
        if (hipOccupancyMaxActiveBlocksPerMultiprocessor(&per_cu, (const void*)mk_fwd, 512, LDS_BYTES) != hipSuccess || per_cu < 1) fprintf(stderr, "kernel_launch: occupancy query reports %d\n", per_cu);
        (void)hipGetLastError();
        grid = cus;
    }
    if (grid < 0) return;
    if (hipMemsetAsync((char*)d_ws + WS_CTL, 0, CTL_ZERO_BYTES, stream) != hipSuccess) return;
    Args a{};
    for (int i = 0; i < N_IN; ++i) a.in[i] = (const float*)d_in[i];
    a.out = (float*)d_out; a.ws = (unsigned char*)d_ws;
    constexpr int NL = MK_N_LAUNCHES;
    for (int li = 0; li < NL; ++li) {
        a.ph_lo = (NL == N_PHASES) ? li : (li * N_PHASES) / NL; a.ph_hi = (NL == N_PHASES) ? li + 1 : ((li + 1) * N_PHASES) / NL; a.li = (NL == N_PHASES) ? 0 : li; a.pad = 0;
        hipLaunchKernelGGL(mk_fwd, dim3(grid), dim3(512), LDS_BYTES, stream, a);
    }
}
```

```cpp
#include <hip/hip_runtime.h>
#include <cstdio>
#include <cstdint>

#ifndef MK_N_LAUNCHES
#define MK_N_LAUNCHES 1
#endif

#define LAS __attribute__((address_space(3)))
typedef unsigned short bf16_t;
typedef short bf16x8 __attribute__((ext_vector_type(8)));
typedef short s16x4 __attribute__((ext_vector_type(4)));
typedef float f32x2 __attribute__((ext_vector_type(2)));
typedef float f32x4 __attribute__((ext_vector_type(4)));
typedef float f32x16 __attribute__((ext_vector_type(16)));
typedef unsigned u32x2 __attribute__((ext_vector_type(2)));
typedef unsigned u32x4 __attribute__((ext_vector_type(4)));
typedef int i32x4 __attribute__((ext_vector_type(4)));
typedef int i32x8 __attribute__((ext_vector_type(8)));

constexpr int NB = 8, NT = 4096, DM = 1024, NCX = 256, NHD = 8, NEXP = 16, CAP = 512, DFF = 2816;
constexpr int MLAT = NB * NT, MCTX = NB * NCX, MALL = MLAT + MCTX, KVR = NT + NCX;
constexpr int NPROJ = 7168, NMOD = 6 * DM;
constexpr float EPS = 1e-6f;
constexpr float QSCALE = 0.125f * 1.4426950408889634f;

constexpr size_t MiB = 1u << 20;
constexpr size_t WS_CTL = 0, CTL_ZERO_BYTES = 65536;
constexpr size_t WS_MOD = 65536;
constexpr size_t WS_ROPE = 294912;
constexpr size_t WS_AFF = 1 * MiB;
constexpr size_t WS_SEL = 3 * MiB;
constexpr size_t WS_WIN = 8 * MiB, WS_WCO = 22 * MiB, WS_WAO = 24 * MiB, WS_WO = 26 * MiB;
constexpr size_t WS_H = 28 * MiB;
constexpr size_t WS_ATTO = 28 * MiB;
constexpr size_t WS_U = 96 * MiB;
constexpr size_t WS_MIX = 96 * MiB;
constexpr size_t WS_Q = 160 * MiB;
constexpr size_t WS_K = 224 * MiB;
constexpr size_t WS_V = 292 * MiB;
constexpr size_t WS_GC = 360 * MiB, WS_GA = 424 * MiB;
constexpr size_t WS_CACT = 488 * MiB;
constexpr size_t WS_X1 = 552 * MiB;
constexpr size_t WS_O1 = 552 * MiB;
constexpr size_t WS_WGU = 8 * MiB;
constexpr size_t WS_XS = 96 * MiB;
constexpr size_t WS_HF = 160 * MiB;
constexpr size_t WS_HID = 192 * MiB;
constexpr size_t WS_WD = 368 * MiB;
constexpr size_t WS_YS = 416 * MiB;
constexpr float WSCALE = 64.0f, WSCALE_INV = 1.0f / 64.0f;
constexpr size_t WS_END = 680 * MiB;

constexpr int RING_BYTES = 131072, LDSCTL_OFF = RING_BYTES, LDS_BYTES = 147456;

#define LDS_WAIT() asm volatile("s_waitcnt lgkmcnt(0)" ::: "memory")
#define VM_WAIT() asm volatile("s_waitcnt vmcnt(0)" ::: "memory")
__device__ __forceinline__ unsigned cvt_pk_bf16(float lo, float hi) { unsigned r; asm volatile("v_cvt_pk_bf16_f32 %0, %1, %2" : "=v"(r) : "v"(lo), "v"(hi)); return r; }
__device__ __forceinline__ unsigned pack4_fp8(float a, float b, float c, float d) { int w = 0; w = __builtin_amdgcn_cvt_pk_fp8_f32(a, b, w, false); w = __builtin_amdgcn_cvt_pk_fp8_f32(c, d, w, true); return (unsigned)w; }
__device__ __forceinline__ float bf_lo(unsigned u) { return __uint_as_float(u << 16); }
__device__ __forceinline__ float bf_hi(unsigned u) { return __uint_as_float(u & 0xffff0000u); }
__device__ __forceinline__ float wave_sum(float v) {
#pragma unroll
    for (int o = 1; o < 64; o <<= 1) v += __shfl_xor(v, o);
    return v;
}
__device__ __forceinline__ float sigmoidf_(float x) { return __builtin_amdgcn_rcpf(1.0f + __expf(-x)); }

#define XB_TMO      128
#define XB_XCNT(j)  (256  + 64 * (j))
#define XB_XSUB(j)  (1280 + 64 * (j))
#define XB_XGEN(j)  (2304 + 64 * (j))
#define XB_TOP      3328
#define XB_TOPGEN   3392
#define XCD_BAR_WORDS 3456
#define XB_SPIN_CAP (1u << 18)
__device__ __forceinline__ unsigned xb_ld(unsigned* p)              { return __hip_atomic_load(p, __ATOMIC_RELAXED, __HIP_MEMORY_SCOPE_AGENT); }
__device__ __forceinline__ unsigned xb_add(unsigned* p, unsigned v) { return __hip_atomic_fetch_add(p, v, __ATOMIC_RELAXED, __HIP_MEMORY_SCOPE_AGENT); }
__device__ __forceinline__ unsigned xb_xcc_id() { return (unsigned)__builtin_amdgcn_s_getreg((3 << 11) | 20) & 0xFu; }
#define XB_SPIN(cond, bar) do { unsigned _sp = 0; while (cond) { __builtin_amdgcn_s_sleep(1); \
    if ((++_sp & 255u) == 0u) { if (xb_ld(&(bar)[XB_TMO])) break; if (_sp > XB_SPIN_CAP) { atomicAdd(&(bar)[XB_TMO], 1u); break; } } } } while (0)
struct XcdBarrier { unsigned* bar; unsigned x; volatile LAS unsigned* st; };
__device__ __forceinline__ XcdBarrier xcd_barrier_post(unsigned* bar, volatile LAS unsigned* st) {
    XcdBarrier b; b.bar = bar; b.x = xb_xcc_id(); b.st = st;
    if (threadIdx.x == 0) (void)xb_add(&bar[XB_XCNT(b.x)], 1u);
    return b;
}
__device__ __forceinline__ void xcd_barrier_complete(unsigned* bar, unsigned x, unsigned& nloc, unsigned& nx) {
    const unsigned G = gridDim.x * gridDim.y * gridDim.z;
    unsigned sum, cnt, mine, sp = 0u;
    for (;;) {
        sum = 0u; cnt = 0u; mine = 0u;
#pragma unroll
        for (unsigned j = 0; j < 16; ++j) { const unsigned c = xb_ld(&bar[XB_XCNT(j)]); sum += c; cnt += (c > 0u) ? 1u : 0u; mine = (j == x) ? c : mine; }
        if (sum == G) break;
        __builtin_amdgcn_s_sleep(1);
        if ((++sp & 255u) == 0u) { if (xb_ld(&bar[XB_TMO])) break; if (sp > XB_SPIN_CAP) { atomicAdd(&bar[XB_TMO], 1u); break; } }
    }
    nloc = mine > 0u ? mine : 1u; nx = cnt > 0u ? cnt : 1u;
}
__device__ __forceinline__ void xcd_barrier(const XcdBarrier& b) {
    asm volatile("s_waitcnt vmcnt(0)" ::: "memory");
    __syncthreads();
    if (threadIdx.x == 0) {
        unsigned* bar = b.bar;
        __builtin_amdgcn_s_waitcnt(0);
        unsigned nloc = b.st[0], nx = b.st[1];
        if (nloc == 0u) { xcd_barrier_complete(bar, b.x, nloc, nx); b.st[0] = nloc; b.st[1] = nx; }
        const unsigned old = xb_add(&bar[XB_XSUB(b.x)], 1u);
        const unsigned gen = old / nloc;
        if (old + 1u == (gen + 1u) * nloc) {
            __builtin_amdgcn_fence(__ATOMIC_RELEASE, "agent");
            asm volatile("s_waitcnt vmcnt(0)" ::: "memory");
            const unsigned og = xb_add(&bar[XB_TOP], 1u);
            const unsigned tg = og / nx;
            if (og + 1u == (tg + 1u) * nx) xb_add(&bar[XB_TOPGEN], 1u);
            else XB_SPIN(xb_ld(&bar[XB_TOPGEN]) == tg, bar);
            __builtin_amdgcn_fence(__ATOMIC_ACQUIRE, "agent");
            xb_add(&bar[XB_XGEN(b.x)], 1u);
            asm volatile("s_waitcnt vmcnt(0)" ::: "memory");
        } else {
            XB_SPIN(xb_ld(&bar[XB_XGEN(b.x)]) == gen, bar);
            __builtin_amdgcn_fence(__ATOMIC_ACQUIRE, "agent");
            asm volatile("s_waitcnt vmcnt(0)" ::: "memory");
        }
    }
    __syncthreads();
}

namespace pg8 {
constexpr int BM = 256, BK = 64, HALF = 128, HTB = HALF * BK * 2, STAGE_BYTES = 8 * HTB, NXCD = 8, WGM = 8;
__host__ __device__ __forceinline__ int lds_byte(int r, int c) { const int st = (r >> 4) * 2 + (c >> 5), rr = r & 15, cc = c & 31, ob = rr * 64 + cc * 2; return st * 1024 + (ob ^ (((ob >> 9) & 1) << 5)); }
__host__ __device__ __forceinline__ void stage_rc(int b, int& R, int& C) { const int st = b / 1024, sb = b % 1024, swz = sb ^ (((sb >> 9) & 1) << 5); R = (st >> 1) * 16 + swz / 64; C = (st & 1) * 32 + (swz % 64) / 2; }
__host__ __device__ __forceinline__ int perm32(int rho) { const int n = rho >> 4, i = rho & 15; return 8 * (i >> 2) + 4 * n + (i & 3); }

struct Unit { int pm, pn, aux; };

__device__ __forceinline__ void tile_of(int L, int nM, int nN, int& pm, int& pn) {
    const int nwg = nM * nN; int wgid = L;
    { const int q = nwg / NXCD, r = nwg % NXCD, xcd = wgid % NXCD, off = wgid / NXCD; wgid = (xcd < r ? xcd * (q + 1) : r * (q + 1) + (xcd - r) * q) + off; }
    const int nig = WGM * nN, gid = wgid / nig, fm = gid * WGM, gsz = (nM - fm) < WGM ? (nM - fm) : WGM;
    pm = fm + ((wgid % nig) % gsz); pn = (wgid % nig) / gsz;
}

template <class Epi, class Sched, bool ALIGN_EPI, bool SP2, bool FP8 = false>
__device__ __forceinline__ void gemm_phase(LAS unsigned char* lds, const int RB, const Sched& S, const Epi& E) {
    const int tid = threadIdx.x, wid = __builtin_amdgcn_readfirstlane(tid >> 6), lane = tid & 63, wr = wid >> 2, wc = wid & 3, fr = lane & 15, fq = lane >> 4;
    const int nt = RB / 128;
    unsigned voffA[2], voffB[2];
#pragma unroll
    for (int i = 0; i < 2; ++i) { int R, C; stage_rc(tid * 16 + i * 8192, R, C); const int Rb = Epi::PERM ? ((R & ~31) + perm32(R & 31)) : R;
        voffA[i] = (unsigned)(R * RB + C * 2); voffB[i] = (unsigned)(Rb * RB + C * 2); }
    const size_t kstep = (size_t)(BK * 2);
    const size_t hstep = (size_t)HALF * RB;
    const unsigned ldsw = (unsigned)wid * 1024u;
    const int aoff = lds_byte(wr * 64 + fr, fq * 8), boff = lds_byte(wc * 32 + fr, fq * 8);
#define PG8_SA(b, h) (((b) * 2 + (h)) * HTB)
#define PG8_SB(b, h) ((4 + (b) * 2 + (h)) * HTB)
#define PG8_STAGE(bufoff, gbase, voff) do { _Pragma("unroll") for (int _i = 0; _i < 2; ++_i) \
        __builtin_amdgcn_global_load_lds((const unsigned*)((const char*)(gbase) + (voff)[_i]), (LAS unsigned*)(lds + (bufoff) + ldsw + _i * 8192), 16, 0, 0); } while (0)
#define PG8_LD8(p) __builtin_shufflevector(*(const LAS i32x4*)(p), *(const LAS i32x4*)((p) + 1024), 0, 1, 2, 3, 4, 5, 6, 7)
#define PG8_LDA(dst, b, h) do { _Pragma("unroll") for (int m = 0; m < 4; ++m) dst[m] = PG8_LD8(lds + PG8_SA(b, h) + aoff + m * 2048); } while (0)
#define PG8_LDB(dst, b, h) do { _Pragma("unroll") for (int n = 0; n < 2; ++n) dst[n] = PG8_LD8(lds + PG8_SB(b, h) + boff + n * 2048); } while (0)
#define PG8_LO(x) __builtin_bit_cast(bf16x8, __builtin_shufflevector(x, x, 0, 1, 2, 3))
#define PG8_HI(x) __builtin_bit_cast(bf16x8, __builtin_shufflevector(x, x, 4, 5, 6, 7))
#define PG8_MMA(ai, bj, At, Bt) do { __builtin_amdgcn_s_setprio(1); _Pragma("unroll") for (int m = 0; m < 4; ++m) _Pragma("unroll") for (int n = 0; n < 2; ++n) { \
        if constexpr (FP8) asm volatile("v_mfma_f32_16x16x128_f8f6f4 %0, %1, %2, %0" : "+v"(acc[ai][bj][m][n]) : "v"(Bt[n]), "v"(At[m]));   \
        else { acc[ai][bj][m][n] = __builtin_amdgcn_mfma_f32_16x16x32_bf16(PG8_LO(Bt[n]), PG8_LO(At[m]), acc[ai][bj][m][n], 0, 0, 0); \
               acc[ai][bj][m][n] = __builtin_amdgcn_mfma_f32_16x16x32_bf16(PG8_HI(Bt[n]), PG8_HI(At[m]), acc[ai][bj][m][n], 0, 0, 0); } } \
        __builtin_amdgcn_s_setprio(0); } while (0)
#define PG8_WAIT_V(n) asm volatile("s_waitcnt vmcnt(" #n ")" ::: "memory")
#define PG8_WAIT_L(n) asm volatile("s_waitcnt lgkmcnt(" #n ")" ::: "memory")
#define PG8_BAR __builtin_amdgcn_s_barrier()
#define PG8_SCHED __builtin_amdgcn_sched_barrier(0)
    Unit cur, nxt; int ui = 0;
    if (!S.next(0, cur)) return;
    f32x4 acc[2][2][4][2];
#pragma unroll
    for (int a = 0; a < 2; ++a)
#pragma unroll
        for (int b = 0; b < 2; ++b)
#pragma unroll
            for (int m = 0; m < 4; ++m)
#pragma unroll
                for (int n = 0; n < 2; ++n) acc[a][b][m][n] = (f32x4){0.f, 0.f, 0.f, 0.f};
    i32x8 At[4], B0[2], B1[2];
    const char* cA = S.a_ptr(cur); const char* cB = S.b_ptr(cur);
    if constexpr (SP2) {
        PG8_STAGE(PG8_SB(0, 0), cB, voffB); PG8_STAGE(PG8_SB(0, 1), cB + hstep, voffB); PG8_STAGE(PG8_SA(0, 0), cA, voffA); PG8_STAGE(PG8_SA(0, 1), cA + hstep, voffA);
        if (wr == 1) PG8_BAR;
        PG8_WAIT_V(2); PG8_BAR;
        PG8_STAGE(PG8_SB(1, 0), cB + kstep, voffB); PG8_STAGE(PG8_SA(1, 0), cA + kstep, voffA); PG8_STAGE(PG8_SB(1, 1), cB + hstep + kstep, voffB);
        PG8_WAIT_V(6); PG8_BAR;
    } else {
        PG8_STAGE(PG8_SB(0, 0), cB, voffB); PG8_STAGE(PG8_SA(0, 0), cA, voffA); PG8_STAGE(PG8_SB(0, 1), cB + hstep, voffB); PG8_STAGE(PG8_SA(0, 1), cA + hstep, voffA);
        if (wr == 1) PG8_BAR;
        PG8_WAIT_V(4); PG8_BAR;
        PG8_STAGE(PG8_SB(1, 0), cB + kstep, voffB); PG8_STAGE(PG8_SA(1, 0), cA + kstep, voffA); PG8_STAGE(PG8_SB(1, 1), cB + hstep + kstep, voffB);
        PG8_WAIT_V(6); PG8_BAR;
    }
    for (;;) {
        const bool has_next = S.next(ui + 1, nxt);
        const char* nA = has_next ? S.a_ptr(nxt) : cA; const char* nB = has_next ? S.b_ptr(nxt) : cB;
#pragma nounroll
        for (int t = 0; t < nt; t += 2) {
            const bool last = (t == nt - 2);
            const char* a1 = cA + (size_t)(t + 1) * kstep;
            const char* a2 = last ? nA : cA + (size_t)(t + 2) * kstep; const char* b2 = last ? nB : cB + (size_t)(t + 2) * kstep;
            const char* a3 = a2 + kstep; const char* b3 = b2 + kstep;
            if constexpr (SP2) {
            PG8_LDB(B0, 0, 0); PG8_LDB(B1, 0, 1); PG8_SCHED; PG8_LDA(At, 0, 0); PG8_STAGE(PG8_SA(1, 1), a1 + hstep, voffA);
            PG8_WAIT_V(8); PG8_WAIT_L(0); PG8_BAR; PG8_MMA(0, 0, At, B0); PG8_MMA(0, 1, At, B1); PG8_BAR; PG8_SCHED;
            PG8_LDA(At, 0, 1); PG8_STAGE(PG8_SB(0, 0), b2, voffB); PG8_STAGE(PG8_SB(0, 1), b2 + hstep, voffB); PG8_STAGE(PG8_SA(0, 0), a2, voffA);
            PG8_WAIT_V(8); PG8_WAIT_L(0); PG8_BAR; PG8_MMA(1, 0, At, B0); PG8_MMA(1, 1, At, B1); PG8_BAR; PG8_SCHED;
            PG8_LDB(B0, 1, 0); PG8_LDB(B1, 1, 1); PG8_SCHED; PG8_LDA(At, 1, 0); PG8_STAGE(PG8_SA(0, 1), a2 + hstep, voffA);
            PG8_WAIT_V(8); PG8_WAIT_L(0); PG8_BAR; PG8_MMA(0, 0, At, B0); PG8_MMA(0, 1, At, B1); PG8_BAR; PG8_SCHED;
            PG8_LDA(At, 1, 1); PG8_STAGE(PG8_SB(1, 0), b3, voffB); PG8_STAGE(PG8_SB(1, 1), b3 + hstep, voffB); PG8_STAGE(PG8_SA(1, 0), a3, voffA);
            PG8_WAIT_V(8); PG8_WAIT_L(0); PG8_BAR; PG8_MMA(1, 0, At, B0); PG8_MMA(1, 1, At, B1); PG8_BAR; PG8_SCHED;
            } else {
            PG8_LDB(B0, 0, 0); PG8_SCHED; PG8_LDA(At, 0, 0); PG8_STAGE(PG8_SA(1, 1), a1 + hstep, voffA);
            PG8_WAIT_L(8); PG8_BAR; PG8_WAIT_L(0); PG8_MMA(0, 0, At, B0); PG8_BAR; PG8_SCHED;
            PG8_LDB(B1, 0, 1); PG8_STAGE(PG8_SB(0, 0), b2, voffB);
            PG8_BAR; PG8_WAIT_L(0); PG8_MMA(0, 1, At, B1); PG8_BAR;
            PG8_LDA(At, 0, 1); PG8_STAGE(PG8_SA(0, 0), a2, voffA);
            PG8_BAR; PG8_WAIT_L(0); PG8_MMA(1, 0, At, B0); PG8_BAR; PG8_SCHED;
            PG8_STAGE(PG8_SB(0, 1), b2 + hstep, voffB);
            PG8_WAIT_V(6); PG8_BAR; PG8_MMA(1, 1, At, B1); PG8_BAR;
            PG8_LDB(B0, 1, 0); PG8_SCHED; PG8_LDA(At, 1, 0); PG8_STAGE(PG8_SA(0, 1), a2 + hstep, voffA);
            PG8_WAIT_L(8); PG8_BAR; PG8_WAIT_L(0); PG8_MMA(0, 0, At, B0); PG8_BAR; PG8_SCHED;
            PG8_LDB(B1, 1, 1); PG8_STAGE(PG8_SB(1, 0), b3, voffB);
            PG8_BAR; PG8_WAIT_L(0); PG8_MMA(0, 1, At, B1); PG8_BAR;
            PG8_LDA(At, 1, 1); PG8_STAGE(PG8_SA(1, 0), a3, voffA);
            PG8_BAR; PG8_WAIT_L(0); PG8_MMA(1, 0, At, B0); PG8_BAR; PG8_SCHED;
            PG8_STAGE(PG8_SB(1, 1), b3 + hstep, voffB);
            PG8_WAIT_V(6); PG8_BAR; PG8_MMA(1, 1, At, B1); PG8_BAR;
            }
        }
        if constexpr (ALIGN_EPI) { if (wr == 0) PG8_BAR; }
        if constexpr (FP8) asm volatile("s_nop 15\n\ts_nop 15" ::: "memory");
        E(acc, cur, wr, wc, fr, fq);
        if (!has_next) break;
        if (!S.keep(cur)) {
#pragma unroll
            for (int a = 0; a < 2; ++a)
#pragma unroll
                for (int b = 0; b < 2; ++b)
#pragma unroll
                    for (int m = 0; m < 4; ++m)
#pragma unroll
                        for (int n = 0; n < 2; ++n) acc[a][b][m][n] = (f32x4){0.f, 0.f, 0.f, 0.f};
        }
        cur = nxt; cA = nA; cB = nB; ++ui;
        if constexpr (ALIGN_EPI) { if (wr == 1) PG8_BAR; }
    }
    PG8_WAIT_V(0);
    if constexpr (!ALIGN_EPI) { if (wr == 0) PG8_BAR; }
    PG8_BAR;
#undef PG8_SA
#undef PG8_SB
#undef PG8_STAGE
#undef PG8_LDA
#undef PG8_LDB
#undef PG8_MMA
#undef PG8_LD8
#undef PG8_LO
#undef PG8_HI
#undef PG8_WAIT_V
#undef PG8_WAIT_L
#undef PG8_BAR
#undef PG8_SCHED
}
}
using pg8::Unit;

#ifndef PG8_SP2
#define PG8_SP2 true
#endif
#ifndef PG8_ALIGN
#define PG8_ALIGN true
#endif

enum InIdx { I_X = 0, I_C, I_CTX, I_CCTX, I_WADA, I_BADA, I_GMIX, I_GFFN, I_WIN, I_WDW, I_BDW, I_LNG, I_LNB, I_WCO, I_BCO, I_LQ1, I_LK1, I_LQ2, I_LK2, I_GSUB, I_WAO, I_WOUT, I_WR, I_WEG, I_WEU, I_WED, I_GFIN, N_IN };
struct Args { const float* in[N_IN]; float* out; unsigned char* ws; int ph_lo, ph_hi, li, pad; };

__device__ __forceinline__ void ph_adaln(const Args& a, LAS unsigned char* lds, int bid, int G) {
    const int tid = threadIdx.x;
    LAS float* sil = (LAS float*)lds;
    LAS float* red = sil + 9 * 1024;
    const float* c = a.in[I_C]; const float* cc = a.in[I_CCTX]; const float* w = a.in[I_WADA]; const float* bb = a.in[I_BADA];
    float* mod = (float*)(a.ws + WS_MOD);
    for (int i = tid; i < 9 * 1024; i += 512) { const float v = (i < 8192) ? c[i] : cc[i - 8192]; sil[i] = v / (1.0f + expf(-v)); }
    __syncthreads();
    for (int unit = bid; unit < NMOD / 32; unit += G) {
        const int n0 = unit * 32, col = tid & 31, kp = tid >> 5;
        float acc[9];
#pragma unroll
        for (int r = 0; r < 9; ++r) acc[r] = 0.f;
#pragma unroll 8
        for (int kk = 0; kk < 64; ++kk) { const int k = kp * 64 + kk; const float wv = w[(size_t)k * NMOD + n0 + col];
#pragma unroll
            for (int r = 0; r < 9; ++r) acc[r] += sil[r * 1024 + k] * wv; }
#pragma unroll
        for (int r = 0; r < 9; ++r) red[(kp * 9 + r) * 32 + col] = acc[r];
        __syncthreads();
        if (tid < 288) { const int r = tid >> 5, cl = tid & 31; float s = 0.f;
#pragma unroll
            for (int k2 = 0; k2 < 16; ++k2) s += red[(k2 * 9 + r) * 32 + cl];
            mod[r * NMOD + n0 + cl] = s + bb[n0 + cl]; }
        __syncthreads();
    }
}
__device__ __forceinline__ void ph_rope_table(const Args& a) {
    float* rc = (float*)(a.ws + WS_ROPE); float* rs = rc + 1024;
    for (int i = threadIdx.x; i < 1024; i += 512) { const int pos = i >> 4, f = i & 15;
        const float inv = powf(10000.0f, -(float)f / 16.0f); const float ang = (float)pos * inv;
        rc[i] = cosf(ang); rs[i] = sinf(ang); }
}
template <class DstRow>
__device__ __forceinline__ void transpose_item(const float* W, int K, int N, bf16_t* WT, const DstRow& dr, LAS float* scr, int item, int lane) {
    const int nblk = N / 32, kb = item / nblk, nb = item % nblk, k0 = 64 * kb, n0 = 32 * nb;
#pragma unroll 8
    for (int i = 0; i < 32; ++i) { const int kk = 2 * i + (lane >> 5); scr[kk * 33 + (lane & 31)] = __builtin_nontemporal_load(W + (size_t)(k0 + kk) * N + n0 + (lane & 31)); }
    LDS_WAIT(); asm volatile("" ::: "memory");
    const int c = lane & 7;
#pragma unroll
    for (int j = 0; j < 4; ++j) { const int n = (lane >> 3) + 8 * j; const LAS float* s = scr + (8 * c) * 33 + n;
        u32x4 o; o.x = cvt_pk_bf16(s[0 * 33], s[1 * 33]); o.y = cvt_pk_bf16(s[2 * 33], s[3 * 33]); o.z = cvt_pk_bf16(s[4 * 33], s[5 * 33]); o.w = cvt_pk_bf16(s[6 * 33], s[7 * 33]);
        *(u32x4*)(WT + (size_t)dr(n0 + n) * K + k0 + 8 * c) = o; }
    LDS_WAIT(); asm volatile("" ::: "memory");
}
template <class DstRow>
__device__ __forceinline__ void transpose_item_fp8(const float* W, int K, int N, unsigned char* WT, const DstRow& dr, LAS float* scr, int item, int lane) {
    const int nblk = N / 32, kb = item / nblk, nb = item % nblk, k0 = 64 * kb, n0 = 32 * nb;
#pragma unroll 8
    for (int i = 0; i < 32; ++i) { const int kk = 2 * i + (lane >> 5); scr[kk * 33 + (lane & 31)] = __builtin_nontemporal_load(W + (size_t)(k0 + kk) * N + n0 + (lane & 31)); }
    LDS_WAIT(); asm volatile("" ::: "memory");
    const int c = lane & 7;
#pragma unroll
    for (int j = 0; j < 4; ++j) { const int n = (lane >> 3) + 8 * j; const LAS float* s = scr + (8 * c) * 33 + n;
        u32x2 o; o.x = pack4_fp8(s[0 * 33] * WSCALE, s[1 * 33] * WSCALE, s[2 * 33] * WSCALE, s[3 * 33] * WSCALE); o.y = pack4_fp8(s[4 * 33] * WSCALE, s[5 * 33] * WSCALE, s[6 * 33] * WSCALE, s[7 * 33] * WSCALE);
        *(u32x2*)(WT + (size_t)dr(n0 + n) * K + k0 + 8 * c) = o; }
    LDS_WAIT(); asm volatile("" ::: "memory");
}
__host__ __device__ __forceinline__ int qdst(int d) { const int blk = d >> 5, half = (d >> 4) & 1, i = d & 15; return 8 * (4 * blk + (i >> 2)) + 4 * half + (i & 3); }
struct DrWin { __host__ __device__ int operator()(int j) const {
    if (j < 1024) return 256 * (j >> 7) + (j & 127);
    if (j < 2048) { const int jj = j - 1024; return 256 * (jj >> 7) + 128 + (jj & 127); }
    if (j < 4096) { const int jj = j & 1023, base = j - jj; return base + (jj & ~63) + qdst(jj & 63); }
    return j; } };
struct DrId { __host__ __device__ int operator()(int j) const { return j; } };
struct DrGU { int up; __host__ __device__ int operator()(int f) const { return 256 * (f >> 7) + 128 * up + (f & 127); } };

__device__ __forceinline__ void ph_small_weights(const Args& a, LAS unsigned char* lds, int gw, int NGW, int wave, int lane) {
    LAS float* scr = (LAS float*)(lds + 57344 + wave * 8448);
    constexpr int I_IN = (DM / 64) * (NPROJ / 32), I_SQ = (DM / 64) * (DM / 32);
    for (int it = gw; it < I_IN + 3 * I_SQ; it += NGW) {
        int r = it;
        if (r < I_IN) { transpose_item(a.in[I_WIN], DM, NPROJ, (bf16_t*)(a.ws + WS_WIN), DrWin{}, scr, r, lane); continue; } r -= I_IN;
        if (r < I_SQ) { transpose_item(a.in[I_WCO], DM, DM, (bf16_t*)(a.ws + WS_WCO), DrId{}, scr, r, lane); continue; } r -= I_SQ;
        if (r < I_SQ) { transpose_item(a.in[I_WAO], DM, DM, (bf16_t*)(a.ws + WS_WAO), DrId{}, scr, r, lane); continue; } r -= I_SQ;
        transpose_item(a.in[I_WOUT], DM, DM, (bf16_t*)(a.ws + WS_WO), DrId{}, scr, r, lane);
    }
}
__device__ __forceinline__ void ph_wgu(const Args& a, LAS unsigned char* lds, int gw, int NGW, int wave, int lane) {
    LAS float* scr = (LAS float*)(lds + 57344 + wave * 8448);
    constexpr int I_E = (DM / 64) * (DFF / 32);
    for (int it = gw; it < 2 * NEXP * I_E; it += NGW) {
        const int mat = it / I_E, r = it % I_E, e = mat >> 1, up = mat & 1;
        const float* W = (up ? a.in[I_WEU] : a.in[I_WEG]) + (size_t)e * DM * DFF;
        transpose_item_fp8(W, DM, DFF, (unsigned char*)(a.ws + WS_WGU) + (size_t)e * 2 * DFF * DM, DrGU{up}, scr, r, lane);
    }
}
constexpr int WD_ITEMS = NEXP * (DFF / 64) * (DM / 32);
#ifndef MK_WD_SPLIT
#define MK_WD_SPLIT 85
#endif
constexpr int WD_SPLIT = (WD_ITEMS / 100) * MK_WD_SPLIT;
__device__ __forceinline__ void ph_wd(const Args& a, LAS unsigned char* lds, int gw, int NGW, int wave, int lane, int lo, int hi) {
    LAS float* scr = (LAS float*)(lds + 57344 + wave * 8448);
    constexpr int I_E = (DFF / 64) * (DM / 32);
    for (int it = lo + gw; it < hi; it += NGW) {
        const int e = it / I_E, r = it % I_E;
        transpose_item_fp8(a.in[I_WED] + (size_t)e * DFF * DM, DFF, DM, (unsigned char*)(a.ws + WS_WD) + (size_t)e * DM * DFF, DrId{}, scr, r, lane);
    }
}

__device__ __forceinline__ void ph_norm_rows(const Args& a, int gw, int NGW, int lane) {
    const float* mod = (const float*)(a.ws + WS_MOD); const float* g = a.in[I_GMIX]; bf16_t* H = (bf16_t*)(a.ws + WS_H);
    const int per = (MALL + NGW - 1) / NGW, r0 = gw * per, r1 = (r0 + per < MALL) ? r0 + per : MALL;
    if (r0 >= r1) return;
    auto src_of = [&](int row) { return (const f32x4*)((row < MLAT) ? a.in[I_X] + (size_t)row * DM : a.in[I_CTX] + (size_t)(row - MLAT) * DM) + lane; };
    f32x4 gs[4], sh[4]; int cur_b = -1;
    f32x4 nx[4];
    { const f32x4* xr = src_of(r0);
#pragma unroll
      for (int j = 0; j < 4; ++j) nx[j] = __builtin_nontemporal_load(xr + 64 * j); }
    for (int row = r0; row < r1; ++row) {
        f32x4 v[4];
#pragma unroll
        for (int j = 0; j < 4; ++j) v[j] = nx[j];
        if (row + 1 < r1) { const f32x4* xr = src_of(row + 1);
#pragma unroll
            for (int j = 0; j < 4; ++j) nx[j] = __builtin_nontemporal_load(xr + 64 * j); }
        const int b = (row < MLAT) ? (row >> 12) : 8;
        if (b != cur_b) { cur_b = b; const float* mb = mod + (size_t)b * NMOD;
#pragma unroll
            for (int j = 0; j < 4; ++j) { const int c = 4 * lane + 256 * j; gs[j] = *(const f32x4*)(g + c) * (*(const f32x4*)(mb + 1024 + c) + 1.0f); sh[j] = *(const f32x4*)(mb + c); } }
        float s = 0.f;
#pragma unroll
        for (int j = 0; j < 4; ++j) s += (v[j].x * v[j].x + v[j].y * v[j].y) + (v[j].z * v[j].z + v[j].w * v[j].w);
        const float rstd = 1.0f / sqrtf(wave_sum(s) * (1.0f / DM) + EPS);
        unsigned long long* o8 = (unsigned long long*)(H + (size_t)row * DM) + lane;
#pragma unroll
        for (int j = 0; j < 4; ++j) { const f32x4 y = (v[j] * rstd) * gs[j] + sh[j];
            o8[64 * j] = (unsigned long long)cvt_pk_bf16(y.x, y.y) | ((unsigned long long)cvt_pk_bf16(y.z, y.w) << 32); }
    }
}

struct SchedInProj {
    const char* A; const char* Bt; int G, c;
    static constexpr int NLAT = 128 * 28, NCTXU = 8 * 8;
    __device__ __forceinline__ bool next(int i, Unit& u) const {
        const int L = i * G + c; if (L >= NLAT + NCTXU) return false;
        if (L < NLAT) { pg8::tile_of(L, 128, 28, u.pm, u.pn); } else { const int v = L - NLAT; u.pm = 128 + (v & 7); u.pn = 12 + (v >> 3); }
        u.aux = 0; return true; }
    __device__ __forceinline__ const char* a_ptr(const Unit& u) const { return (u.pn >= 16 && u.pn < 20) ? Bt + (size_t)u.pn * (256 * DM * 2) : A + (size_t)u.pm * (256 * DM * 2); }
    __device__ __forceinline__ const char* b_ptr(const Unit& u) const { return (u.pn >= 16 && u.pn < 20) ? A + (size_t)u.pm * (256 * DM * 2) : Bt + (size_t)u.pn * (256 * DM * 2); }
    __device__ __forceinline__ bool keep(const Unit&) const { return false; }
};
struct EpiInProj {
    static constexpr bool PERM = true;
    bf16_t *U, *Q, *KA, *VA, *GC, *GA; const float* rope;
    __device__ __forceinline__ void operator()(f32x4 (&acc)[2][2][4][2], const Unit& u, int wr, int wc, int fr, int fq) const {
        const int pn = u.pn, pm = u.pm;
        const int cw = wc * 32 + 8 * fq;
        if (pn < 8) {
#pragma unroll
            for (int ai = 0; ai < 2; ++ai)
#pragma unroll
                for (int m = 0; m < 4; ++m) { const int r = pm * 256 + ai * 128 + wr * 64 + m * 16 + fr;
                    const f32x4 a0 = acc[ai][0][m][0], a1 = acc[ai][0][m][1], b0 = acc[ai][1][m][0], b1 = acc[ai][1][m][1];
                    u32x4 w; w.x = cvt_pk_bf16(a0[0] * sigmoidf_(b0[0]), a0[1] * sigmoidf_(b0[1])); w.y = cvt_pk_bf16(a0[2] * sigmoidf_(b0[2]), a0[3] * sigmoidf_(b0[3]));
                    w.z = cvt_pk_bf16(a1[0] * sigmoidf_(b1[0]), a1[1] * sigmoidf_(b1[1])); w.w = cvt_pk_bf16(a1[2] * sigmoidf_(b1[2]), a1[3] * sigmoidf_(b1[3]));
                    *(u32x4*)(U + (size_t)r * DM + pn * 128 + cw) = w; }
            return;
        }
        if (pn < 16) {
            const bool isq = pn < 12, lat = pm < 128;
            bf16_t* base; size_t row0; int rowpos0 = 0;
            if (isq) { base = Q + (size_t)(pn - 8) * 256; row0 = (size_t)pm * 256; }
            else { base = KA + (size_t)(pn - 12) * 256; row0 = lat ? (size_t)(pm >> 4) * KVR + (size_t)(pm & 15) * 256 : (size_t)(pm - 128) * KVR + NT; }
            if (lat) rowpos0 = (pm & 15) * 4;
            const float sc = isq ? QSCALE : 1.0f;
            const float* rc = rope; const float* rs = rope + 1024;
#pragma unroll
            for (int ai = 0; ai < 2; ++ai)
#pragma unroll
                for (int m = 0; m < 4; ++m) { const int rl = ai * 128 + wr * 64 + m * 16 + fr;
                    f32x4 cs = (f32x4){1.f, 1.f, 1.f, 1.f}, sn = (f32x4){0.f, 0.f, 0.f, 0.f};
                    if (lat) { const int pos = (wc & 1) ? (m * 16 + fr) : (rowpos0 + 2 * ai + wr); cs = *(const f32x4*)(rc + pos * 16 + 4 * fq); sn = *(const f32x4*)(rs + pos * 16 + 4 * fq); }
#pragma unroll
                    for (int bj = 0; bj < 2; ++bj) { const f32x4 x1 = acc[ai][bj][m][0], x2 = acc[ai][bj][m][1];
                        const f32x4 y1 = (x1 * cs - x2 * sn) * sc, y2 = (x1 * sn + x2 * cs) * sc;
                        u32x4 w; w.x = cvt_pk_bf16(y1[0], y1[1]); w.y = cvt_pk_bf16(y1[2], y1[3]); w.z = cvt_pk_bf16(y2[0], y2[1]); w.w = cvt_pk_bf16(y2[2], y2[3]);
                        *(u32x4*)(base + (row0 + rl) * DM + bj * 128 + cw) = w; } }
            return;
        }
        if (pn < 20) {
            const bool lat = pm < 128;
            const int bidx = lat ? (pm >> 4) : (pm - 128), key0 = lat ? (pm & 15) * 256 : NT;
            bf16_t* vt = VA + (size_t)(bidx * NHD + 2 * (pn - 16)) * 128 * KVR + key0;
            int fr_ = fr; asm volatile("" : "+v"(fr_));
#pragma unroll
            for (int ai = 0; ai < 2; ++ai)
#pragma unroll
                for (int m = 0; m < 4; ++m) { bf16_t* rowp = vt + (unsigned)((ai * 128 + wr * 64 + m * 16 + fr_) * KVR);
#pragma unroll
                    for (int bj = 0; bj < 2; ++bj) { const f32x4 v0 = acc[ai][bj][m][0], v1 = acc[ai][bj][m][1];
                        unsigned a0 = cvt_pk_bf16(v0[0], v0[1]), a1 = cvt_pk_bf16(v0[2], v0[3]), b0 = cvt_pk_bf16(v1[0], v1[1]), b1 = cvt_pk_bf16(v1[2], v1[3]);
                        { auto r_ = __builtin_amdgcn_permlane16_swap(a0, b0, false, false); a0 = r_[0]; b0 = r_[1]; }
                        { auto r_ = __builtin_amdgcn_permlane16_swap(a1, b1, false, false); a1 = r_[0]; b1 = r_[1]; }
                        *(u32x4*)(rowp + bj * 128 + wc * 32 + 8 * fq) = (u32x4){a0, a1, b0, b1}; }
                    asm volatile("" ::: "memory"); }
            return;
        }
        {
            bf16_t* base; size_t row0;
            if (pn < 24) { base = GC + (size_t)(pn - 20) * 256; row0 = (size_t)pm * 256; }
            else { base = GA + (size_t)(pn - 24) * 256; row0 = (size_t)pm * 256; }
#pragma unroll
            for (int ai = 0; ai < 2; ++ai)
#pragma unroll
                for (int m = 0; m < 4; ++m) { const int rl = ai * 128 + wr * 64 + m * 16 + fr;
#pragma unroll
                    for (int bj = 0; bj < 2; ++bj) { f32x4 v0 = acc[ai][bj][m][0], v1 = acc[ai][bj][m][1];
#pragma unroll
                        for (int j = 0; j < 4; ++j) { v0[j] = sigmoidf_(v0[j]); v1[j] = sigmoidf_(v1[j]); }
                        u32x4 w; w.x = cvt_pk_bf16(v0[0], v0[1]); w.y = cvt_pk_bf16(v0[2], v0[3]); w.z = cvt_pk_bf16(v1[0], v1[1]); w.w = cvt_pk_bf16(v1[2], v1[3]);
                        *(u32x4*)(base + (row0 + rl) * DM + bj * 128 + cw) = w; } }
        }
    }
};

__device__ __forceinline__ void ph_conv_unit(const Args& a, LAS unsigned char* lds, int unit) {
    const int tid = threadIdx.x, lane = tid & 63, wave = __builtin_amdgcn_readfirstlane(tid >> 6);
    const int b = unit >> 5, t0 = (unit & 31) * 128;
    LAS float* ybuf = (LAS float*)lds;
    const int c0 = 2 * tid;
    f32x2 w[31];
    { const float* wp = a.in[I_WDW]; asm volatile("" : "+s"(wp));
      const __attribute__((address_space(1))) f32x2* wp2 = (const __attribute__((address_space(1))) f32x2*)(wp + c0);
#pragma unroll
      for (int j = 0; j < 31; ++j) w[j] = wp2[j * (DM / 2)]; }
    const f32x2 bias = *(const f32x2*)(a.in[I_BDW] + c0);
    const unsigned* Ub = (const unsigned*)(a.ws + WS_U) + (size_t)b * NT * (DM / 2) + tid;
    bf16_t* CA = (bf16_t*)(a.ws + WS_CACT) + (size_t)(b * NT + t0) * DM;
    const float* lng = a.in[I_LNG]; const float* lnb = a.in[I_LNB];
    f32x2 win[32];
#pragma unroll
    for (int s = 0; s < 32; ++s) win[s] = (f32x2){0.f, 0.f};
    unsigned pf[16];
    const unsigned* up = Ub + ((long)t0 - 15) * (DM / 2);
#define CV_LD(i) ({ const int i_ = (i); const int ti_ = t0 - 15 + i_; (i_ < 158 && ti_ >= 0 && ti_ < NT) ? up[(long)i_ * (DM / 2)] : 0u; })
#pragma unroll
    for (int s = 0; s < 16; ++s) pf[s] = CV_LD(s);
    for (int Q = 0; Q < 5; ++Q) {
#pragma unroll
        for (int hb = 0; hb < 2; ++hb)
#pragma unroll
        for (int s16 = 0; s16 < 16; ++s16) {
            const int s = hb * 16 + s16;
            const unsigned pk = pf[s16];
            pf[s16] = CV_LD(32 * Q + s + 16);
            win[s] = (f32x2){bf_lo(pk), bf_hi(pk)};
            const int to = 32 * Q + s - 30;
            if (to >= 0 && to < 128) {
                f32x2 y = bias;
#pragma unroll
                for (int j = 0; j < 31; ++j) y += w[j] * win[(s + 2 + j) & 31];
                *(LAS f32x2*)(ybuf + (to & 15) * DM + c0) = y;
            }
            if (s == 13 || s == 29) {
                if (Q >= 1) {
                    const int tb = 32 * Q + s - 30 - 15;
                    __syncthreads();
#pragma unroll
                    for (int k = 0; k < 2; ++k) { const int tl = 2 * wave + k;
                        f32x4 v[4]; float sm = 0.f;
#pragma unroll
                        for (int j = 0; j < 4; ++j) { v[j] = *(const LAS f32x4*)(ybuf + tl * DM + 4 * lane + 256 * j); sm += (v[j].x + v[j].y) + (v[j].z + v[j].w); }
                        const float mean = wave_sum(sm) * (1.0f / DM); float s2 = 0.f;
#pragma unroll
                        for (int j = 0; j < 4; ++j) { v[j] = v[j] - mean; s2 += (v[j].x * v[j].x + v[j].y * v[j].y) + (v[j].z * v[j].z + v[j].w * v[j].w); }
                        const float rstd = 1.0f / sqrtf(wave_sum(s2) * (1.0f / DM) + EPS);
                        unsigned long long* o8 = (unsigned long long*)(CA + (size_t)(tb + tl) * DM) + lane;
#pragma unroll
                        for (int j = 0; j < 4; ++j) { const int c = 4 * lane + 256 * j;
                            f32x4 y = v[j] * rstd * *(const f32x4*)(lng + c) + *(const f32x4*)(lnb + c);
#pragma unroll
                            for (int q = 0; q < 4; ++q) y[q] = y[q] * sigmoidf_(y[q]);
                            o8[64 * j] = (unsigned long long)cvt_pk_bf16(y.x, y.y) | ((unsigned long long)cvt_pk_bf16(y.z, y.w) << 32); } }
                    __syncthreads();
                }
            }
        }
    }
#undef CV_LD
}

namespace att {
constexpr int NW = 8, QBLK = 32, KVBLK = 64, NTILE = KVR / KVBLK;
constexpr int SHM_V = 128 * KVBLK * 2, SHM_K = KVBLK * 64 * 2;
constexpr int BUFB = SHM_V + SHM_K, NBUF = 4, ATT_LDS = NBUF * BUFB;
constexpr int VT_PITCH = KVR;
#define KSWZ(row, colB) ((row) * 128 + ((colB) ^ ((((row) >> 1) & 7) << 4)))
#define SBAR() __builtin_amdgcn_sched_barrier(0)
__device__ __forceinline__ int crow(int r, int hi) { return (r & 3) + 8 * (r >> 2) + 4 * hi; }
__device__ __forceinline__ void glds16(const void* g, unsigned lds_base) {
    unsigned sv; asm volatile("s_mov_b32 %0, m0\n\ts_mov_b32 m0, %2\n\ts_nop 0\n\tglobal_load_lds_dwordx4 %1, off\n\ts_mov_b32 m0, %0" : "=&s"(sv) : "v"(g), "s"(lds_base) : "memory"); }
__device__ __forceinline__ void attn_map(const bf16_t* __restrict__ Qb, const bf16_t* __restrict__ Kh, const bf16_t* __restrict__ VTh, long dKn, long dVn, bool pre, bool has_next, f32x16 (&o)[4], char* lds) {
    const int tid = threadIdx.x, wid = tid >> 6, lane = tid & 63, r32 = lane & 31, hi = lane >> 5;
    const int wv = __builtin_amdgcn_readfirstlane(tid >> 6);
    const bool isB = wv >= 4;
    float l_reg = 0.f;
#pragma unroll
    for (int d = 0; d < 4; ++d) o[d] = f32x16{};
    bf16x8 qr[4];
    const bf16_t* Qw = Qb + (size_t)(wid * QBLK + r32) * DM + hi * 8;
#pragma unroll
    for (int d0 = 0; d0 < 4; ++d0) qr[d0] = *reinterpret_cast<const bf16x8*>(Qw + d0 * 16);
    const bf16_t* ksrc = Kh + (size_t)(8 * wv + (lane >> 3)) * DM + (((lane & 7) ^ ((4 * wv + (lane >> 4)) & 7)) << 3);
    const bf16_t* vsrc0 = VTh + (size_t)(16 * wv + (lane >> 3)) * VT_PITCH + (((lane & 7) ^ ((lane >> 4) & 7)) << 3);
    const bf16_t* vsrc1 = VTh + (size_t)(16 * wv + 8 + (lane >> 3)) * VT_PITCH + (((lane & 7) ^ ((4 + (lane >> 4)) & 7)) << 3);
    const unsigned lds0 = (unsigned)(uintptr_t)lds;
#define DMAX(ko, vo, b) do { const unsigned bb_ = lds0 + (unsigned)(b) * BUFB; \
    glds16(ksrc + (ko), (unsigned)__builtin_amdgcn_readfirstlane(bb_ + SHM_V + 1024 * wv)); \
    glds16(vsrc0 + (vo), (unsigned)__builtin_amdgcn_readfirstlane(bb_ + 2048 * wv)); \
    glds16(vsrc1 + (vo), (unsigned)__builtin_amdgcn_readfirstlane(bb_ + 2048 * wv + 1024)); } while (0)
#define DMA(t, b) DMAX((long)(t) * (KVBLK * DM), (long)(t) * KVBLK, b)
#define DMAT(T) do { if ((T) < NTILE) DMA((T), (T) & 3); else if (has_next && (T) - NTILE < 2) DMAX(dKn + (long)((T) - NTILE) * (KVBLK * DM), dVn + (long)((T) - NTILE) * KVBLK, ((T) - NTILE) & 3); } while (0)
#define BAR() asm volatile("s_barrier" ::: "memory")
#define BARV() asm volatile("s_waitcnt vmcnt(0)\n\ts_barrier" ::: "memory")
    f32x16 pA0, pA1, pB0, pB1;
    u32x4 pw0, pw1, pw2, pw3;
    typedef LAS const char* lcp;
    const lcp lds3 = (lcp)(LAS char*)(uintptr_t)lds0;
    int kaddr[4], vaddr[4];
#pragma unroll
    for (int d0 = 0; d0 < 4; ++d0) { kaddr[d0] = SHM_V + KSWZ(r32, (d0 * 16 + hi * 8) * 2); vaddr[d0] = KSWZ(r32, (2 * d0 + hi) * 16); }
    bf16x8 kf[8], va[4], vb[4];
    constexpr float REF_MARGIN = 32.0f;
    f32x16 negm = f32x16{};
#define PIN(x) asm volatile("" : "+v"(x))
#define MF(a_, b_, c_) __builtin_amdgcn_mfma_f32_32x32x16_bf16(a_, b_, c_, 0, 0, 0)
#define PB(w) __builtin_bit_cast(bf16x8, w)
#define PKW(P, i) cvt_pk_bf16(P[i], P[i + 1])
#define ADD6(x, A, a0, a1, a2, B, b0, b1, b2) do { x += A[a0]; x += A[a1]; x += A[a2]; x += B[b0]; x += B[b1]; x += B[b2]; } while (0)
#define KRD(kbuf) do { const lcp kb_ = lds3 + (kbuf) * BUFB; \
      _Pragma("unroll") for (int d0 = 0; d0 < 4; ++d0) { kf[2 * d0] = *(const LAS bf16x8*)(kb_ + kaddr[d0]); kf[2 * d0 + 1] = *(const LAS bf16x8*)(kb_ + kaddr[d0] + 4096); } } while (0)
#define VRD4(dst, vb_, blk) do { const lcp vq_ = lds3 + (vb_) * BUFB; _Pragma("unroll") for (int ks_ = 0; ks_ < 4; ++ks_) dst[ks_] = *(const LAS bf16x8*)(vq_ + vaddr[ks_] + (blk) * 4096); } while (0)
#define S1(C0, C1, P0, P1, kbuf, vnext) do { SBAR(); \
    KRD(kbuf); \
    float ps_ = P0[0] + P0[1]; ps_ += P0[2]; ps_ += P0[3]; ps_ += P0[4]; ps_ += P0[5]; ps_ += P0[6]; ps_ += P0[7]; PIN(ps_); SBAR(); \
    C0 = MF(kf[0], qr[0], negm); ADD6(ps_, P0, 8, 9, 10, P0, 11, 12, 13); PIN(ps_); SBAR(); \
    C1 = MF(kf[1], qr[0], negm); ps_ += P0[14]; ps_ += P0[15]; ps_ += P1[0]; ps_ += P1[1]; ps_ += P1[2]; ps_ += P1[3]; PIN(ps_); SBAR(); \
    C0 = MF(kf[2], qr[1], C0); ADD6(ps_, P1, 4, 5, 6, P1, 7, 8, 9); PIN(ps_); SBAR(); \
    C1 = MF(kf[3], qr[1], C1); ADD6(ps_, P1, 10, 11, 12, P1, 13, 14, 15); l_reg += ps_; PIN(l_reg); SBAR(); \
    C0 = MF(kf[4], qr[2], C0); pw0 = (u32x4){PKW(P0, 0), PKW(P0, 2), PKW(P0, 4), PKW(P0, 6)}; PIN(pw0); SBAR(); \
    C1 = MF(kf[5], qr[2], C1); pw1 = (u32x4){PKW(P0, 8), PKW(P0, 10), PKW(P0, 12), PKW(P0, 14)}; PIN(pw1); SBAR(); \
    C0 = MF(kf[6], qr[3], C0); pw2 = (u32x4){PKW(P1, 0), PKW(P1, 2), PKW(P1, 4), PKW(P1, 6)}; PIN(pw2); SBAR(); \
    C1 = MF(kf[7], qr[3], C1); pw3 = (u32x4){PKW(P1, 8), PKW(P1, 10), PKW(P1, 12), PKW(P1, 14)}; PIN(pw3); PIN(C0); PIN(C1); SBAR(); \
    VRD4(va, vnext, 0); VRD4(vb, vnext, 1); SBAR();     \
    } while (0)
#define VRD1(dst, ks, blk) dst[ks] = *(const LAS bf16x8*)(vp_ + vaddr[ks] + (blk) * 4096)
#define EXP2N(X, lo) do { X[lo] = __builtin_amdgcn_exp2f(X[lo]); X[lo + 1] = __builtin_amdgcn_exp2f(X[lo + 1]); } while (0)
#define S2(C0, C1, vbuf) do { SBAR(); \
    const lcp vp_ = lds3 + (vbuf) * BUFB; \
    o[0] = MF(va[0], PB(pw0), o[0]); VRD1(va, 0, 2); EXP2N(C0, 0); PIN(C0); SBAR(); \
    o[0] = MF(va[1], PB(pw1), o[0]); VRD1(va, 1, 2); EXP2N(C0, 2); PIN(C0); SBAR(); \
    o[0] = MF(va[2], PB(pw2), o[0]); VRD1(va, 2, 2); EXP2N(C0, 4); PIN(C0); SBAR(); \
    o[0] = MF(va[3], PB(pw3), o[0]); VRD1(va, 3, 2); EXP2N(C0, 6); PIN(C0); SBAR(); \
    o[1] = MF(vb[0], PB(pw0), o[1]); VRD1(vb, 0, 3); EXP2N(C0, 8); PIN(C0); SBAR(); \
    o[1] = MF(vb[1], PB(pw1), o[1]); VRD1(vb, 1, 3); EXP2N(C0, 10); PIN(C0); SBAR(); \
    o[1] = MF(vb[2], PB(pw2), o[1]); VRD1(vb, 2, 3); EXP2N(C0, 12); PIN(C0); SBAR(); \
    o[1] = MF(vb[3], PB(pw3), o[1]); VRD1(vb, 3, 3); EXP2N(C0, 14); PIN(C0); SBAR(); \
    o[2] = MF(va[0], PB(pw0), o[2]); EXP2N(C1, 0); PIN(C1); SBAR(); \
    o[2] = MF(va[1], PB(pw1), o[2]); EXP2N(C1, 2); PIN(C1); SBAR(); \
    o[2] = MF(va[2], PB(pw2), o[2]); EXP2N(C1, 4); PIN(C1); SBAR(); \
    o[2] = MF(va[3], PB(pw3), o[2]); EXP2N(C1, 6); PIN(C1); SBAR(); \
    o[3] = MF(vb[0], PB(pw0), o[3]); EXP2N(C1, 8); PIN(C1); SBAR(); \
    o[3] = MF(vb[1], PB(pw1), o[3]); EXP2N(C1, 10); PIN(C1); SBAR(); \
    o[3] = MF(vb[2], PB(pw2), o[3]); EXP2N(C1, 12); PIN(C1); SBAR(); \
    o[3] = MF(vb[3], PB(pw3), o[3]); EXP2N(C1, 14); PIN(C1); SBAR(); \
    } while (0)
    pB0 = f32x16{}; pB1 = f32x16{};
    if (!pre) { DMA(0, 0); DMA(1, 1); BARV(); }
    if (isB) { BARV(); DMA(2, 2); }
    S1(pA0, pA1, pB0, pB1, 0, 0);
    if (!isB) { BARV(); DMA(2, 2); }
    { float pm_ = pA0[0];
#pragma unroll
      for (int r = 1; r < 16; ++r) pm_ = __builtin_fmaxf(pm_, pA0[r]);
#pragma unroll
      for (int r = 0; r < 16; ++r) pm_ = __builtin_fmaxf(pm_, pA1[r]);
      { auto rr_ = __builtin_amdgcn_permlane32_swap(__float_as_uint(pm_), __float_as_uint(pm_), false, false); pm_ = __builtin_fmaxf(__uint_as_float(rr_[0]), __uint_as_float(rr_[1])); }
      const float nm_ = -(pm_ + REF_MARGIN);
#pragma unroll
      for (int r = 0; r < 16; ++r) { negm[r] = nm_; pA0[r] = __builtin_amdgcn_exp2f(pA0[r] + nm_); pA1[r] = __builtin_amdgcn_exp2f(pA1[r] + nm_); }
      PIN(negm); }
    for (int j = 1; j < NTILE; j += 2) {
        if (isB) { BARV(); DMAT(j + 2); }
        S1(pB0, pB1, pA0, pA1, j & 3, (j - 1) & 3);
        if (!isB) { BARV(); DMAT(j + 2); }
        S2(pB0, pB1, (j - 1) & 3);
        if (isB) { BARV(); DMAT(j + 3); }
        { const int kt = (j + 1 < NTILE) ? j + 1 : NTILE - 1;
          S1(pA0, pA1, pB0, pB1, kt & 3, j & 3); }
        if (!isB) { BARV(); DMAT(j + 3); }
        S2(pA0, pA1, j & 3);
    }
    { auto rr_ = __builtin_amdgcn_permlane32_swap(__float_as_uint(l_reg), __float_as_uint(l_reg), false, false);
      const float rl = __builtin_amdgcn_rcpf(__uint_as_float(rr_[0]) + __uint_as_float(rr_[1]));
#pragma unroll
      for (int d = 0; d < 4; ++d) o[d] = o[d] * rl; }
    if (!has_next) BAR();
#undef DMA
#undef DMAX
#undef DMAT
#undef BAR
#undef BARV
#undef PIN
#undef MF
#undef PB
#undef PKW
#undef ADD6
#undef S1
#undef S2
#undef KRD
#undef VRD4
#undef VRD1
#undef EXP2N
}
__device__ __forceinline__ void attn_unit(const Args& a, int b, int h, int qb, float lam, char* lds, bool first, bool has_nu, int nb, int nh) {
    const bf16_t* Q = (const bf16_t*)(a.ws + WS_Q); const bf16_t* KA = (const bf16_t*)(a.ws + WS_K); const bf16_t* VT = (const bf16_t*)(a.ws + WS_V);
    const size_t qrow0 = (size_t)b * NT + (size_t)qb * 256, kvrow0 = (size_t)b * KVR;
    for (int m = 0; m < 2; ++m) {
        f32x16 o[4];
        const bf16_t* Kc = KA + kvrow0 * DM + (2 * h + m) * 64; const bf16_t* Vc = VT + (size_t)((b * NHD + h) * 128) * VT_PITCH;
        const bf16_t* Kn = m == 0 ? Kc + 64 : KA + (size_t)nb * KVR * DM + (2 * nh) * 64; const bf16_t* Vn = m == 0 ? Vc : VT + (size_t)((nb * NHD + nh) * 128) * VT_PITCH;
        attn_map(Q + qrow0 * DM + (2 * h + m) * 64, Kc, Vc, (long)(Kn - Kc), (long)(Vn - Vc), !(first && m == 0), m == 0 || has_nu, o, lds);
        int t2 = threadIdx.x; asm volatile("" : "+v"(t2));
        const int wid = t2 >> 6, lane = t2 & 63, r32 = lane & 31, hi = lane >> 5;
        float* o1p = (float*)(a.ws + WS_O1) + (size_t)blockIdx.x * (64 * 512) + t2;
        if (m == 0) {
#pragma unroll
            for (int d = 0; d < 4; ++d)
#pragma unroll
                for (int r = 0; r < 16; ++r) o1p[(d * 16 + r) * 512] = o[d][r];
        } else {
            float ss = 0.f;
#pragma unroll
            for (int d = 0; d < 4; ++d)
#pragma unroll
                for (int r = 0; r < 16; ++r) { const float v = o1p[(d * 16 + r) * 512] - lam * o[d][r]; o[d][r] = v; ss += v * v; }
            { auto rr_ = __builtin_amdgcn_permlane32_swap(__float_as_uint(ss), __float_as_uint(ss), false, false); ss = __uint_as_float(rr_[0]) + __uint_as_float(rr_[1]); }
            const float rstd = 0.8f / sqrtf(ss * (1.0f / 128.0f) + EPS);
            const float* gs = a.in[I_GSUB] + 4 * hi;
            bf16_t* aow = (bf16_t*)(a.ws + WS_ATTO) + (qrow0 + wid * QBLK + r32) * DM + h * 128 + 4 * hi;
#pragma unroll
            for (int d = 0; d < 4; ++d)
#pragma unroll
                for (int rg = 0; rg < 4; ++rg) { const f32x4 g = *(const f32x4*)(gs + 32 * d + 8 * rg);
                    u32x2 w; w.x = cvt_pk_bf16(o[d][4 * rg] * rstd * g[0], o[d][4 * rg + 1] * rstd * g[1]); w.y = cvt_pk_bf16(o[d][4 * rg + 2] * rstd * g[2], o[d][4 * rg + 3] * rstd * g[3]);
                    *(u32x2*)(aow + 32 * d + 8 * rg) = w; }
        }
    }
}
#undef KSWZ
#undef SBAR
}

struct SchedDual {
    const char *A0, *A1, *B0, *B1; int G, c;
    __device__ __forceinline__ bool next(int i, Unit& u) const {
        const int L = (i >> 1) * G + c; if (L >= 512) return false;
        pg8::tile_of(L, 128, 4, u.pm, u.pn); u.aux = i & 1; return true; }
    __device__ __forceinline__ const char* a_ptr(const Unit& u) const { return (u.aux ? A1 : A0) + (size_t)u.pm * (256 * DM * 2); }
    __device__ __forceinline__ const char* b_ptr(const Unit& u) const { return (u.aux ? B1 : B0) + (size_t)u.pn * (256 * DM * 2); }
    __device__ __forceinline__ bool keep(const Unit& u) const { return u.aux == 0; }
};
struct EpiDual {
    static constexpr bool PERM = true;
    const bf16_t *GA, *GC; const float* bc; bf16_t* MIX;
    __device__ __forceinline__ void operator()(f32x4 (&acc)[2][2][4][2], const Unit& u, int wr, int wc, int fr, int fq) const {
        const int col0 = u.pn * 256 + wc * 32 + 8 * fq;
        if (u.aux == 0) {
            u32x4 ga[2][2], gc[2][2];
#define EDL(i, g) do { const int ai_ = (g) >> 2, m_ = (g) & 3; const size_t off_ = (size_t)(u.pm * 256 + ai_ * 128 + wr * 64 + m_ * 16 + fr) * DM + col0; \
    ga[i][0] = *(const u32x4*)(GA + off_); ga[i][1] = *(const u32x4*)(GA + off_ + 128); gc[i][0] = *(const u32x4*)(GC + off_); gc[i][1] = *(const u32x4*)(GC + off_ + 128); } while (0)
            EDL(0, 0);
#pragma unroll
            for (int g = 0; g < 8; ++g) { const int ai = g >> 2, m = g & 3, cur = g & 1;
                if (g + 1 < 8) { if (cur) EDL(0, g + 1); else EDL(1, g + 1); }
#pragma unroll
                for (int bj = 0; bj < 2; ++bj) { const u32x4 a4 = ga[cur][bj], c4 = gc[cur][bj];
                    f32x4 r0, r1;
                    r0[0] = bf_lo(a4.x) * __builtin_amdgcn_rcpf(bf_lo(c4.x)); r0[1] = bf_hi(a4.x) * __builtin_amdgcn_rcpf(bf_hi(c4.x));
                    r0[2] = bf_lo(a4.y) * __builtin_amdgcn_rcpf(bf_lo(c4.y)); r0[3] = bf_hi(a4.y) * __builtin_amdgcn_rcpf(bf_hi(c4.y));
                    r1[0] = bf_lo(a4.z) * __builtin_amdgcn_rcpf(bf_lo(c4.z)); r1[1] = bf_hi(a4.z) * __builtin_amdgcn_rcpf(bf_hi(c4.z));
                    r1[2] = bf_lo(a4.w) * __builtin_amdgcn_rcpf(bf_lo(c4.w)); r1[3] = bf_hi(a4.w) * __builtin_amdgcn_rcpf(bf_hi(c4.w));
                    acc[ai][bj][m][0] *= r0; acc[ai][bj][m][1] *= r1; }
                asm volatile("" ::: "memory"); }
#undef EDL
            return;
        }
        f32x4 bv[2][2];
#pragma unroll
        for (int bj = 0; bj < 2; ++bj)
#pragma unroll
            for (int n = 0; n < 2; ++n) bv[bj][n] = *(const f32x4*)(bc + col0 + bj * 128 + 4 * n);
        u32x4 gc[2][2];
#define EDL(i, g) do { const int ai_ = (g) >> 2, m_ = (g) & 3; const size_t off_ = (size_t)(u.pm * 256 + ai_ * 128 + wr * 64 + m_ * 16 + fr) * DM + col0; \
    gc[i][0] = *(const u32x4*)(GC + off_); gc[i][1] = *(const u32x4*)(GC + off_ + 128); } while (0)
        EDL(0, 0);
#pragma unroll
        for (int g = 0; g < 8; ++g) { const int ai = g >> 2, m = g & 3, cur = g & 1;
            if (g + 1 < 8) { if (cur) EDL(0, g + 1); else EDL(1, g + 1); }
            const size_t off = (size_t)(u.pm * 256 + ai * 128 + wr * 64 + m * 16 + fr) * DM + col0;
#pragma unroll
            for (int bj = 0; bj < 2; ++bj) { const u32x4 c4 = gc[cur][bj];
                const f32x4 v0 = acc[ai][bj][m][0] + bv[bj][0], v1 = acc[ai][bj][m][1] + bv[bj][1];
                u32x4 w; w.x = cvt_pk_bf16(v0[0] * bf_lo(c4.x), v0[1] * bf_hi(c4.x)); w.y = cvt_pk_bf16(v0[2] * bf_lo(c4.y), v0[3] * bf_hi(c4.y));
                w.z = cvt_pk_bf16(v1[0] * bf_lo(c4.z), v1[1] * bf_hi(c4.z)); w.w = cvt_pk_bf16(v1[2] * bf_lo(c4.w), v1[3] * bf_hi(c4.w));
                *(u32x4*)(MIX + off + bj * 128) = w; }
            asm volatile("" ::: "memory"); }
#undef EDL
    }
};

struct SchedPlain {
    const char* A; const char* Bt; int G, c, nM, nN, RB, bgrp;
    __device__ __forceinline__ bool next(int i, Unit& u) const {
        const int L = i * G + c; if (L >= nM * nN) return false;
        pg8::tile_of(L, nM, nN, u.pm, u.pn); u.aux = 0; return true; }
    __device__ __forceinline__ const char* a_ptr(const Unit& u) const { return A + (size_t)u.pm * ((size_t)256 * RB); }
    __device__ __forceinline__ const char* b_ptr(const Unit& u) const { return Bt + (size_t)((u.pm >> 4) * nN * bgrp + u.pn) * ((size_t)256 * RB); }
    __device__ __forceinline__ bool keep(const Unit&) const { return false; }
};
struct EpiResid {
    static constexpr bool PERM = true;
    const float* x; const float* mod; bf16_t* out;
    __device__ __forceinline__ void operator()(f32x4 (&acc)[2][2][4][2], const Unit& u, int wr, int wc, int fr, int fq) const {
        const int col0 = u.pn * 256 + wc * 32 + 8 * fq; const float* gm = mod + (size_t)(u.pm >> 4) * NMOD + 2048 + col0;
        f32x4 gv[2][2];
#pragma unroll
        for (int bj = 0; bj < 2; ++bj)
#pragma unroll
            for (int n = 0; n < 2; ++n) gv[bj][n] = *(const f32x4*)(gm + bj * 128 + n * 4);
        f32x4 xv[2][2][2];
#define ERL(i, g) do { const int ai_ = (g) >> 2, m_ = (g) & 3; const size_t off_ = (size_t)(u.pm * 256 + ai_ * 128 + wr * 64 + m_ * 16 + fr) * DM + col0; \
    _Pragma("unroll") for (int bj_ = 0; bj_ < 2; ++bj_) _Pragma("unroll") for (int n_ = 0; n_ < 2; ++n_) xv[i][bj_][n_] = __builtin_nontemporal_load((const f32x4*)(x + off_ + bj_ * 128 + n_ * 4)); } while (0)
        ERL(0, 0);
#pragma unroll
        for (int g = 0; g < 8; ++g) { const int ai = g >> 2, m = g & 3, cur = g & 1;
            if (g + 1 < 8) { if (cur) ERL(0, g + 1); else ERL(1, g + 1); }
            const size_t off = (size_t)(u.pm * 256 + ai * 128 + wr * 64 + m * 16 + fr) * DM + col0;
#pragma unroll
            for (int bj = 0; bj < 2; ++bj) { const f32x4 v0 = xv[cur][bj][0] + gv[bj][0] * acc[ai][bj][m][0], v1 = xv[cur][bj][1] + gv[bj][1] * acc[ai][bj][m][1];
                u32x4 w; w.x = cvt_pk_bf16(v0[0], v0[1]); w.y = cvt_pk_bf16(v0[2], v0[3]); w.z = cvt_pk_bf16(v1[0], v1[1]); w.w = cvt_pk_bf16(v1[2], v1[3]);
                *(u32x4*)(out + off + bj * 128) = w; }
            asm volatile("" ::: "memory"); }
#undef ERL
    }
};

__device__ __forceinline__ void ph_router(const Args& a, LAS unsigned char* lds, int gw, int NGW, int lane) {
    LAS float* wrt = (LAS float*)lds;
    const float* wr = a.in[I_WR];
    for (int k = threadIdx.x; k < DM; k += 512) {
        f32x4 w4[4];
#pragma unroll
        for (int q = 0; q < 4; ++q) w4[q] = *(const f32x4*)(wr + (size_t)k * NEXP + 4 * q);
#pragma unroll
        for (int q = 0; q < 4; ++q) { wrt[(4 * q + 0) * DM + k] = w4[q].x; wrt[(4 * q + 1) * DM + k] = w4[q].y; wrt[(4 * q + 2) * DM + k] = w4[q].z; wrt[(4 * q + 3) * DM + k] = w4[q].w; } }
    __syncthreads();
    const float* mod = (const float*)(a.ws + WS_MOD); const float* g = a.in[I_GFFN];
    unsigned char* HF = (unsigned char*)(a.ws + WS_HF); float* AFF = (float*)(a.ws + WS_AFF);
    f32x4 gs[4], shv[4]; int cur_b = -1;
    u32x2 nx[2][4];
    const bf16_t* X1 = (const bf16_t*)(a.ws + WS_X1);
    { const u32x2* xr = (const u32x2*)(X1 + (size_t)(2 * gw) * DM) + lane;
#pragma unroll
      for (int r = 0; r < 2; ++r)
#pragma unroll
        for (int j = 0; j < 4; ++j) nx[r][j] = __builtin_nontemporal_load(xr + r * (DM / 4) + 64 * j); }
    for (int pr = gw; pr < MLAT / 2; pr += NGW) {
        const int row = 2 * pr;
        f32x4 v[2][4]; float s[2] = {0.f, 0.f};
#pragma unroll
        for (int r = 0; r < 2; ++r)
#pragma unroll
            for (int j = 0; j < 4; ++j) { v[r][j] = (f32x4){bf_lo(nx[r][j].x), bf_hi(nx[r][j].x), bf_lo(nx[r][j].y), bf_hi(nx[r][j].y)}; s[r] += (v[r][j].x * v[r][j].x + v[r][j].y * v[r][j].y) + (v[r][j].z * v[r][j].z + v[r][j].w * v[r][j].w); }
        if (pr + NGW < MLAT / 2) { const u32x2* xr = (const u32x2*)(X1 + (size_t)(row + 2 * NGW) * DM) + lane;
#pragma unroll
            for (int r = 0; r < 2; ++r)
#pragma unroll
                for (int j = 0; j < 4; ++j) nx[r][j] = __builtin_nontemporal_load(xr + r * (DM / 4) + 64 * j); }
        if ((row >> 12) != cur_b) { cur_b = row >> 12; const float* mb = mod + (size_t)cur_b * NMOD + 3072;
#pragma unroll
            for (int j = 0; j < 4; ++j) { const int c = 4 * lane + 256 * j; gs[j] = *(const f32x4*)(g + c) * (*(const f32x4*)(mb + 1024 + c) + 1.0f); shv[j] = *(const f32x4*)(mb + c); } }
        const float rstd0 = 1.0f / sqrtf(wave_sum(s[0]) * (1.0f / DM) + EPS), rstd1 = 1.0f / sqrtf(wave_sum(s[1]) * (1.0f / DM) + EPS);
#pragma unroll
        for (int r = 0; r < 2; ++r) { unsigned* o4 = (unsigned*)(HF + (size_t)(row + r) * DM) + lane; const float rstd = r ? rstd1 : rstd0;
#pragma unroll
            for (int j = 0; j < 4; ++j) { v[r][j] = (v[r][j] * rstd) * gs[j] + shv[j];
                o4[64 * j] = pack4_fp8(v[r][j].x, v[r][j].y, v[r][j].z, v[r][j].w); } }
        float p[2][16];
#pragma unroll
        for (int e = 0; e < 16; ++e) { float t0 = 0.f, t1 = 0.f;
#pragma unroll
            for (int j = 0; j < 4; ++j) { const f32x4 wv = *(const LAS f32x4*)(wrt + e * DM + 4 * lane + 256 * j);
                t0 += (v[0][j].x * wv.x + v[0][j].y * wv.y) + (v[0][j].z * wv.z + v[0][j].w * wv.w); t1 += (v[1][j].x * wv.x + v[1][j].y * wv.y) + (v[1][j].z * wv.z + v[1][j].w * wv.w); }
            p[0][e] = t0; p[1][e] = t1; if ((e & 3) == 3) __builtin_amdgcn_sched_barrier(0); }
        float r16[16], r8[8], r4[4], r2[2], r1;
        { const bool up = (lane & 32) != 0;
#pragma unroll
          for (int i = 0; i < 16; ++i) { const float send = up ? p[0][i] : p[1][i], keepv = up ? p[1][i] : p[0][i]; r16[i] = keepv + __shfl_xor(send, 32); } }
        { const bool up = (lane & 16) != 0;
#pragma unroll
          for (int i = 0; i < 8; ++i) { const float send = up ? r16[i] : r16[i + 8], keepv = up ? r16[i + 8] : r16[i]; r8[i] = keepv + __shfl_xor(send, 16); } }
        { const bool up = (lane & 8) != 0;
#pragma unroll
          for (int i = 0; i < 4; ++i) { const float send = up ? r8[i] : r8[i + 4], keepv = up ? r8[i + 4] : r8[i]; r4[i] = keepv + __shfl_xor(send, 8); } }
        { const bool up = (lane & 4) != 0;
#pragma unroll
          for (int i = 0; i < 2; ++i) { const float send = up ? r4[i] : r4[i + 2], keepv = up ? r4[i + 2] : r4[i]; r2[i] = keepv + __shfl_xor(send, 4); } }
        { const bool up = (lane & 2) != 0; const float send = up ? r2[0] : r2[1], keepv = up ? r2[1] : r2[0]; r1 = keepv + __shfl_xor(send, 2); }
        r1 += __shfl_xor(r1, 1);
        float mx = r1;
#pragma unroll
        for (int o = 2; o < 32; o <<= 1) mx = fmaxf(mx, __shfl_xor(mx, o));
        const float ex = expf(r1 - mx); float sm = ex;
#pragma unroll
        for (int o = 2; o < 32; o <<= 1) sm += __shfl_xor(sm, o);
        if ((lane & 1) == 0) AFF[(size_t)(row + (lane >> 5)) * NEXP + ((lane >> 1) & 15)] = ex / sm;
    }
}

__device__ __forceinline__ void ph_topk_unit(const Args& a, LAS unsigned char* lds, int g  ) {
    const int tid = threadIdx.x, lane = tid & 63, wave = __builtin_amdgcn_readfirstlane(tid >> 6);
    const int b = g >> 4, e = g & 15;
    LAS unsigned* hist = (LAS unsigned*)lds;
    LAS unsigned* ctl = hist + 256;
    LAS unsigned* wsum = hist + 264;
    LAS int* S = (LAS int*)(hist + 512);
    const float* AFF = (const float*)(a.ws + WS_AFF) + (size_t)b * NT * NEXP + e;
    unsigned key[8];
#pragma unroll
    for (int q = 0; q < 8; ++q) key[q] = __float_as_uint(AFF[(size_t)(8 * tid + q) * NEXP]);
    unsigned prefix = 0, need = CAP;
#pragma unroll
    for (int pass = 0; pass < 4; ++pass) {
        const int shift = 24 - 8 * pass;
        const unsigned himask = pass == 0 ? 0u : (0xFFFFFFFFu << (shift + 8));
        if (tid < 256) hist[tid] = 0;
        __syncthreads();
#pragma unroll
        for (int q = 0; q < 8; ++q) if ((key[q] & himask) == prefix) __hip_atomic_fetch_add(hist + ((key[q] >> shift) & 255), 1u, __ATOMIC_RELAXED, __HIP_MEMORY_SCOPE_WORKGROUP);
        __syncthreads();
        if (wave == 0) {
            const u32x4 h = *(const LAS u32x4*)(hist + 4 * lane);
            const unsigned c = h.x + h.y + h.z + h.w;
            unsigned v = c;
#pragma unroll
            for (int off = 1; off < 64; off <<= 1) { const unsigned o = __shfl_down(v, off); if (lane + off < 64) v += o; }
            const unsigned above = v - c;
            if (above < need && need <= v) {
                unsigned acc = above; int d;
                if (acc + h.w >= need) d = 3; else { acc += h.w; if (acc + h.z >= need) d = 2; else { acc += h.z; if (acc + h.y >= need) d = 1; else { acc += h.y; d = 0; } } }
                ctl[0] = prefix | ((unsigned)(4 * lane + d) << shift); ctl[1] = need - acc;
            }
        }
        __syncthreads();
        prefix = ctl[0]; need = ctl[1];
    }
    unsigned cg = 0, ce = 0;
#pragma unroll
    for (int q = 0; q < 8; ++q) { cg += key[q] > prefix; ce += key[q] == prefix; }
    const unsigned pk = cg | (ce << 16);
    unsigned inc = pk;
#pragma unroll
    for (int off = 1; off < 64; off <<= 1) { const unsigned o = __shfl_up(inc, off); if (lane >= off) inc += o; }
    if (lane == 63) wsum[wave] = inc;
    __syncthreads();
    unsigned base = 0;
    for (int w = 0; w < wave; ++w) base += wsum[w];
    const unsigned excl = base + inc - pk;
    unsigned gbef = excl & 0xFFFFu, ebef = excl >> 16;
    int* SEL = (int*)(a.ws + WS_SEL) + (size_t)b * NT * NEXP + e;
#pragma unroll
    for (int q = 0; q < 8; ++q) { const int tok = 8 * tid + q; int sel = -1;
        if (key[q] > prefix) { sel = (int)(gbef + (ebef < need ? ebef : need)); ++gbef; }
        else if (key[q] == prefix) { if (ebef < need) sel = (int)(gbef + ebef); ++ebef; }
        SEL[(size_t)tok * NEXP] = sel; if (sel >= 0) S[sel] = tok; }
    __syncthreads();
    const unsigned char* HF = (const unsigned char*)(a.ws + WS_HF) + (size_t)b * NT * DM;
    unsigned char* XS = (unsigned char*)(a.ws + WS_XS) + (size_t)(e * NB + b) * CAP * DM;
    for (int k = 0; k < 64; k += 8) {
        u32x4 v[8];
#pragma unroll
        for (int q = 0; q < 8; ++q) { const int s = wave * 64 + k + q; const unsigned tok = (unsigned)S[s];
            v[q] = ((const u32x4*)(HF + (size_t)tok * DM))[lane]; }
#pragma unroll
        for (int q = 0; q < 8; ++q) { const int s = wave * 64 + k + q; ((u32x4*)(XS + (size_t)s * DM))[lane] = v[q]; }
    }
    __syncthreads();
}

struct EpiSwiGLU {
    static constexpr bool PERM = true;
    unsigned char* HID;
    __device__ __forceinline__ void operator()(f32x4 (&acc)[2][2][4][2], const Unit& u, int wr, int wc, int fr, int fq) const {
        const int col0 = u.pn * 128 + wc * 32 + 8 * fq;
#pragma unroll
        for (int ai = 0; ai < 2; ++ai)
#pragma unroll
            for (int m = 0; m < 4; ++m) { const size_t r = (size_t)u.pm * 256 + ai * 128 + wr * 64 + m * 16 + fr;
                const f32x4 g0 = acc[ai][0][m][0] * WSCALE_INV, g1 = acc[ai][0][m][1] * WSCALE_INV, u0 = acc[ai][1][m][0] * WSCALE_INV, u1 = acc[ai][1][m][1] * WSCALE_INV;
                u32x2 w; w.x = pack4_fp8(g0[0] * sigmoidf_(g0[0]) * u0[0], g0[1] * sigmoidf_(g0[1]) * u0[1], g0[2] * sigmoidf_(g0[2]) * u0[2], g0[3] * sigmoidf_(g0[3]) * u0[3]);
                w.y = pack4_fp8(g1[0] * sigmoidf_(g1[0]) * u1[0], g1[1] * sigmoidf_(g1[1]) * u1[1], g1[2] * sigmoidf_(g1[2]) * u1[2], g1[3] * sigmoidf_(g1[3]) * u1[3]);
                *(u32x2*)(HID + r * DFF + col0) = w; }
    }
};
struct EpiPlainBf16 {
    static constexpr bool PERM = true;
    bf16_t* O; int ldc; float scale;
    __device__ __forceinline__ void operator()(f32x4 (&acc)[2][2][4][2], const Unit& u, int wr, int wc, int fr, int fq) const {
        const int col0 = u.pn * 256 + wc * 32 + 8 * fq;
#pragma unroll
        for (int ai = 0; ai < 2; ++ai)
#pragma unroll
            for (int m = 0; m < 4; ++m) { bf16_t* rowp = O + ((size_t)u.pm * 256 + ai * 128 + wr * 64 + m * 16 + fr) * ldc + col0;
#pragma unroll
                for (int bj = 0; bj < 2; ++bj) { const f32x4 v0 = acc[ai][bj][m][0] * scale, v1 = acc[ai][bj][m][1] * scale;
                    u32x4 w; w.x = cvt_pk_bf16(v0[0], v0[1]); w.y = cvt_pk_bf16(v0[2], v0[3]); w.z = cvt_pk_bf16(v1[0], v1[1]); w.w = cvt_pk_bf16(v1[2], v1[3]);
                    *(u32x4*)(rowp + bj * 128) = w; } }
    }
};

__device__ __forceinline__ void ph_final(const Args& a, int gw, int NGW, int lane) {
    const float* mod = (const float*)(a.ws + WS_MOD); const float* gfin = a.in[I_GFIN];
    const float* AFF = (const float*)(a.ws + WS_AFF); const int* SEL = (const int*)(a.ws + WS_SEL); const bf16_t* YS = (const bf16_t*)(a.ws + WS_YS);
    const int per = MLAT / NGW, r0 = gw * per, b = r0 >> 12;
    f32x4 gfv[2][2], gnv[2][2];
    { const float* gf = mod + (size_t)b * NMOD + 5120;
#pragma unroll
      for (int jj = 0; jj < 2; ++jj)
#pragma unroll
          for (int q = 0; q < 2; ++q) { const int c = 8 * lane + 512 * jj + 4 * q; gfv[jj][q] = *(const f32x4*)(gf + c); gnv[jj][q] = *(const f32x4*)(gfin + c); } }
    for (int row = r0; row < r0 + per; ++row) {
        float* xr = a.out + (size_t)row * DM; const bf16_t* x1r = (const bf16_t*)(a.ws + WS_X1) + (size_t)row * DM;
        const int selv = (lane < 16) ? SEL[(size_t)row * NEXP + lane] : -1; const float affv = (lane < 16) ? AFF[(size_t)row * NEXP + lane] : 0.f;
        f32x4 acc[2][2];
#pragma unroll
        for (int jj = 0; jj < 2; ++jj) { acc[jj][0] = (f32x4){0.f, 0.f, 0.f, 0.f}; acc[jj][1] = (f32x4){0.f, 0.f, 0.f, 0.f}; }
#pragma unroll
        for (int e = 0; e < NEXP; ++e) { const int s = __builtin_amdgcn_readlane(selv, e); const float gt = __uint_as_float(__builtin_amdgcn_readlane(__float_as_uint(affv), e));
            if (s >= 0) { const bf16_t* yr = YS + ((size_t)(e * NB + b) * CAP + s) * DM;
#pragma unroll
                for (int jj = 0; jj < 2; ++jj) { const u32x4 y = *(const u32x4*)(yr + 8 * lane + 512 * jj);
                    acc[jj][0] += gt * (f32x4){bf_lo(y.x), bf_hi(y.x), bf_lo(y.y), bf_hi(y.y)}; acc[jj][1] += gt * (f32x4){bf_lo(y.z), bf_hi(y.z), bf_lo(y.w), bf_hi(y.w)}; } } }
        f32x4 v[2][2]; float ss = 0.f;
#pragma unroll
        for (int jj = 0; jj < 2; ++jj) { const u32x4 xb = __builtin_nontemporal_load((const u32x4*)(x1r + 8 * lane + 512 * jj));
#pragma unroll
            for (int q = 0; q < 2; ++q) {
                v[jj][q] = (q ? (f32x4){bf_lo(xb.z), bf_hi(xb.z), bf_lo(xb.w), bf_hi(xb.w)} : (f32x4){bf_lo(xb.x), bf_hi(xb.x), bf_lo(xb.y), bf_hi(xb.y)}) + gfv[jj][q] * acc[jj][q];
                ss += (v[jj][q].x * v[jj][q].x + v[jj][q].y * v[jj][q].y) + (v[jj][q].z * v[jj][q].z + v[jj][q].w * v[jj][q].w); } }
        const float rstd = 1.0f / sqrtf(wave_sum(ss) * (1.0f / DM) + EPS);
#pragma unroll
        for (int jj = 0; jj < 2; ++jj)
#pragma unroll
            for (int q = 0; q < 2; ++q) { const int c = 8 * lane + 512 * jj + 4 * q; __builtin_nontemporal_store(v[jj][q] * rstd * gnv[jj][q], (f32x4*)(xr + c)); }
    }
}

constexpr int N_PHASES = 12;
#ifndef MK_ATTN_REPS
#define MK_ATTN_REPS 1
#endif
struct Ctx { LAS unsigned char* lds; char* lds_gen; int G, bid, vcu, gw, NGW, wave, lane; };
template <int P> __device__ __forceinline__ void run_phase(const Args& args, const Ctx& c) {
    LAS unsigned char* lds = c.lds; const int G = c.G, bid = c.bid, vcu = c.vcu, gw = c.gw, NGW = c.NGW, wave = c.wave, lane = c.lane;
    if constexpr (P == 0) {
        ph_adaln(args, lds, bid, G);
        if (bid == G - 1) ph_rope_table(args);
        ph_small_weights(args, lds, gw, NGW, wave, lane);
    }
    if constexpr (P == 1) ph_norm_rows(args, gw, NGW, lane);
    if constexpr (P == 2) {
        SchedInProj S{(const char*)(args.ws + WS_H), (const char*)(args.ws + WS_WIN), G, bid};
        EpiInProj E{(bf16_t*)(args.ws + WS_U), (bf16_t*)(args.ws + WS_Q), (bf16_t*)(args.ws + WS_K), (bf16_t*)(args.ws + WS_V), (bf16_t*)(args.ws + WS_GC), (bf16_t*)(args.ws + WS_GA), (const float*)(args.ws + WS_ROPE)};
        pg8::gemm_phase<EpiInProj, SchedInProj, PG8_ALIGN, PG8_SP2>(lds, DM * 2, S, E);
    }
    if constexpr (P == 3) {
#ifndef MK_NO_CONV
        for (int u = vcu; u < 256; u += G) ph_conv_unit(args, lds, u);
        __syncthreads();
#endif
#ifndef MK_NO_ATTN
        float lam;
        { const float s1 = wave_sum(args.in[I_LQ1][lane] * args.in[I_LK1][lane]), s2 = wave_sum(args.in[I_LQ2][lane] * args.in[I_LK2][lane]); lam = __uint_as_float(__builtin_amdgcn_readfirstlane(__float_as_uint(expf(s1) - expf(s2) + 0.2f))); }
#if defined(MK_PROBE_CLOCK)
        const unsigned long long pc0_ = __builtin_amdgcn_s_memtime(), pr0_ = __builtin_amdgcn_s_memrealtime();
#endif
        for (int i = 0; i < 4 * MK_ATTN_REPS; ++i) { const int u = (i & 3) * 256 + vcu; if (u >= 1024) break;
            const int un = ((i + 1) & 3) * 256 + vcu; const bool has_nu = (i + 1 < 4 * MK_ATTN_REPS) && un < 1024;
            att::attn_unit(args, u >> 7, (u >> 4) & 7, u & 15, lam, c.lds_gen, i == 0, has_nu, un >> 7, (un >> 4) & 7); }
#if defined(MK_PROBE_CLOCK)
        { const unsigned long long pc1_ = __builtin_amdgcn_s_memtime(), pr1_ = __builtin_amdgcn_s_memrealtime();
          if (threadIdx.x == 0) { volatile LAS unsigned* mw = (volatile LAS unsigned*)(c.lds + LDSCTL_OFF); mw[16] = (unsigned)(pc1_ - pc0_); mw[17] = (unsigned)(pr1_ - pr0_);
              unsigned* pw_ = (unsigned*)(args.ws + WS_CTL) + 15000;
              atomicMax(pw_, (unsigned)(pr1_ - pr0_)); atomicAdd(pw_ + 1, (unsigned)(pr1_ - pr0_)); atomicMax(pw_ + 2, 0xFFFFFFFFu - (unsigned)(pr1_ - pr0_)); } }
#endif
#endif
    }
    if constexpr (P == 4) {
        SchedDual S{(const char*)(args.ws + WS_ATTO), (const char*)(args.ws + WS_CACT), (const char*)(args.ws + WS_WAO), (const char*)(args.ws + WS_WCO), G, bid};
        EpiDual E{(const bf16_t*)(args.ws + WS_GA), (const bf16_t*)(args.ws + WS_GC), args.in[I_BCO], (bf16_t*)(args.ws + WS_MIX)};
        pg8::gemm_phase<EpiDual, SchedDual, PG8_ALIGN, PG8_SP2>(lds, DM * 2, S, E);
    }
    if constexpr (P == 5) {
        SchedPlain S{(const char*)(args.ws + WS_MIX), (const char*)(args.ws + WS_WO), G, bid, 128, 4, DM * 2, 0};
        EpiResid E{args.in[I_X], (const float*)(args.ws + WS_MOD), (bf16_t*)(args.ws + WS_X1)};
        pg8::gemm_phase<EpiResid, SchedPlain, PG8_ALIGN, PG8_SP2>(lds, DM * 2, S, E);
    }
    if constexpr (P == 6) {
        ph_router(args, lds, gw, NGW, lane);
        __syncthreads();
        ph_wgu(args, lds, gw, NGW, wave, lane);
        ph_wd(args, lds, gw, NGW, wave, lane, 0, G < 2 ? WD_ITEMS : WD_SPLIT);
    }
    if constexpr (P == 7) {
        if (G < 2) { for (int g = 0; g < NB * NEXP; ++g) ph_topk_unit(args, lds, g); }
        else if ((vcu & 1) == 0) { for (int g = vcu >> 1; g < NB * NEXP; g += (G + 1) / 2) ph_topk_unit(args, lds, g); }
        else ph_wd(args, lds, (vcu >> 1) * 8 + wave, (G / 2) * 8, wave, lane, WD_SPLIT, WD_ITEMS);
    }
    if constexpr (P == 8) {
        SchedPlain S{(const char*)(args.ws + WS_XS), (const char*)(args.ws + WS_WGU), G, bid, 256, 22, DM, 1};
        EpiSwiGLU E{(unsigned char*)(args.ws + WS_HID)};
        pg8::gemm_phase<EpiSwiGLU, SchedPlain, PG8_ALIGN, PG8_SP2, true>(lds, DM, S, E);
    }
    if constexpr (P == 10) {
        SchedPlain S{(const char*)(args.ws + WS_HID), (const char*)(args.ws + WS_WD), G, bid, 256, 4, DFF, 1};
        EpiPlainBf16 E{(bf16_t*)(args.ws + WS_YS), DM, WSCALE_INV};
        pg8::gemm_phase<EpiPlainBf16, SchedPlain, PG8_ALIGN, PG8_SP2, true>(lds, DFF, S, E);
    }
    if constexpr (P == 11) ph_final(args, gw, NGW, lane);
}
#ifndef MK_PHASE_MASK
#define MK_PHASE_MASK 0xFFF
#endif
#ifndef MK_REPEAT_MASK
#define MK_REPEAT_MASK 0
#endif
__global__ void __launch_bounds__(512, 2) mk_fwd(Args args) {
    extern __shared__ __attribute__((aligned(16))) unsigned char lds_raw[];
    LAS unsigned char* lds = (LAS unsigned char*)lds_raw;
    const int tid = threadIdx.x;
    Ctx c; c.lds = lds; c.lds_gen = (char*)lds_raw; c.lane = tid & 63; c.wave = __builtin_amdgcn_readfirstlane(tid >> 6);
    c.G = gridDim.x; c.bid = blockIdx.x;
    c.vcu = (c.G % 8 == 0) ? (c.bid % 8) * (c.G / 8) + c.bid / 8 : c.bid;
    c.gw = c.vcu * 8 + c.wave; c.NGW = c.G * 8;
    volatile LAS unsigned* misc = (volatile LAS unsigned*)(lds + LDSCTL_OFF);
    if (tid < 64) misc[tid] = 0u;
    __syncthreads();
#if defined(MK_PROBE_TS)
    const unsigned long long kstart_ = __builtin_amdgcn_s_memrealtime();
#endif
    const int lo = args.ph_lo, hi = args.ph_hi;
    XcdBarrier bar; bar.bar = (unsigned*)(args.ws + WS_CTL) + 1024 + args.li * XCD_BAR_WORDS; bar.x = 0; bar.st = nullptr;
    if (hi - lo > 1) bar = xcd_barrier_post((unsigned*)(args.ws + WS_CTL) + 1024 + args.li * XCD_BAR_WORDS, misc + 8);
#define IN(k) (((MK_PHASE_MASK >> (k)) & 1) && lo <= (k) && (k) < hi)
#if defined(MK_PROBE_PHASE)
#define PH_T0() const unsigned long long pt0_ = __builtin_amdgcn_s_memrealtime()
#define PH_T1(k) do { const unsigned long long pt1_ = __builtin_amdgcn_s_memrealtime(); if (threadIdx.x == 0) atomicMax((unsigned*)(args.ws + WS_CTL) + 15100 + (k), (unsigned)(pt1_ - pt0_)); } while (0)
#else
#define PH_T0() do { } while (0)
#define PH_T1(k) do { } while (0)
#endif
#if defined(MK_PROBE_BAR)
#define PB_T0() const unsigned long long bt0_ = __builtin_amdgcn_s_memrealtime()
#define PB_T1(k) do { const unsigned long long bt1_ = __builtin_amdgcn_s_memrealtime(); if (threadIdx.x == 0) atomicMax((unsigned*)(args.ws + WS_CTL) + 15200 + (k), 0xFFFFFFFFu - (unsigned)(bt1_ - bt0_)); } while (0)
#else
#define PB_T0() do { } while (0)
#define PB_T1(k) do { } while (0)
#endif
#if defined(MK_PROBE_TS)
#define PH_TS(k) do { if ((k) == MK_PROBE_TS && blockIdx.x == 0 && threadIdx.x == 0) misc[20] = (unsigned)(__builtin_amdgcn_s_memrealtime() - kstart_); } while (0)
#else
#define PH_TS(k) do { } while (0)
#endif
#define PHASE(k) do { PH_TS(k); if (IN(k)) { PH_T0(); run_phase<k>(args, c); if constexpr ((MK_REPEAT_MASK >> (k)) & 1) { __syncthreads(); run_phase<k>(args, c); } PH_T1(k); PH_TS((k) + 100); } \
                      if ((k) != 9 && (k) + 1 < N_PHASES && IN(k) && IN((k) + 1)) { PB_T0(); xcd_barrier(bar); PB_T1(k); } } while (0)
    PHASE(0); PHASE(1); PHASE(2); PHASE(3); PHASE(4); PHASE(5); PHASE(6); PHASE(7); PHASE(8); PHASE(9); PHASE(10); PHASE(11);
#if defined(MK_PROBE_TS)
    PH_TS(12);
    if (blockIdx.x == 0 && threadIdx.x == 0) {
        const unsigned long long wait_ticks = misc[20];
        const unsigned long long w0 = __builtin_amdgcn_s_memrealtime();
        while (__builtin_amdgcn_s_memrealtime() - w0 < wait_ticks) __builtin_amdgcn_s_sleep(8);
    }
#endif
#if defined(MK_PROBE_BAR)
    if (blockIdx.x == 0 && threadIdx.x == 0) {
        unsigned long long wait_ticks = 0;
        for (int k = 0; k < 10; ++k) { const unsigned v = __hip_atomic_load((unsigned*)(args.ws + WS_CTL) + 15200 + k, __ATOMIC_RELAXED, __HIP_MEMORY_SCOPE_AGENT); if (v) wait_ticks += 0xFFFFFFFFu - v; }
        wait_ticks *= 10;
        const unsigned long long w0 = __builtin_amdgcn_s_memrealtime();
        while (__builtin_amdgcn_s_memrealtime() - w0 < wait_ticks) __builtin_amdgcn_s_sleep(8);
    }
#endif
#if defined(MK_PROBE_PHASE)
    if (blockIdx.x == 0 && threadIdx.x == 0) {
        const unsigned long long wait_ticks = __hip_atomic_load((unsigned*)(args.ws + WS_CTL) + 15100 + MK_PROBE_PHASE, __ATOMIC_RELAXED, __HIP_MEMORY_SCOPE_AGENT);
        const unsigned long long w0 = __builtin_amdgcn_s_memrealtime();
        while (__builtin_amdgcn_s_memrealtime() - w0 < wait_ticks) __builtin_amdgcn_s_sleep(8);
    }
#endif
#if defined(MK_PROBE_CLOCK)
    if (blockIdx.x == 0 && threadIdx.x == 0) {
        const unsigned dc = misc[16], dr = misc[17];
        unsigned* pw_ = (unsigned*)(args.ws + WS_CTL) + 15000;
        const unsigned long long wait_ticks = (MK_PROBE_CLOCK == 1) ? (unsigned long long)(((double)dc / (double)dr) * 0.1 * 500.0 * 100.0) : (MK_PROBE_CLOCK == 2) ? (unsigned long long)dr
            : (MK_PROBE_CLOCK == 3) ? (unsigned long long)__hip_atomic_load(pw_, __ATOMIC_RELAXED, __HIP_MEMORY_SCOPE_AGENT)
            : (MK_PROBE_CLOCK == 4) ? (unsigned long long)(__hip_atomic_load(pw_ + 1, __ATOMIC_RELAXED, __HIP_MEMORY_SCOPE_AGENT) / gridDim.x)
            : (unsigned long long)(0xFFFFFFFFu - __hip_atomic_load(pw_ + 2, __ATOMIC_RELAXED, __HIP_MEMORY_SCOPE_AGENT));
        const unsigned long long w0 = __builtin_amdgcn_s_memrealtime();
        while (__builtin_amdgcn_s_memrealtime() - w0 < wait_ticks) __builtin_amdgcn_s_sleep(8);
    }
#endif
#undef IN
#undef PHASE
}

extern "C" void kernel_launch(void* const* d_in, const int* in_sizes, int n_in, void* d_out, int out_size, void* d_ws, size_t ws_size, hipStream_t stream) {
    static int grid = 0;
    if (grid == 0) {
        if (n_in != N_IN || out_size != MLAT * DM || ws_size < WS_END) { fprintf(stderr, "kernel_launch: unexpected shapes: n_in %d out %d ws %zu (need %zu)\n", n_in, out_size, ws_size, (size_t)WS_END); grid = -1; return; }
        int dev = 0, cus = 0, per_cu = 0;
        if (hipGetDevice(&dev) != hipSuccess || hipDeviceGetAttribute(&cus, hipDeviceAttributeMultiprocessorCount, dev) != hipSuccess) { grid = -1; return; }
        if (hipFuncSetAttribute((const void*)mk_fwd, hipFuncAttributeMaxDynamicSharedMemorySize, LDS_BYTES) != hipSuccess) { fprintf(stderr, "kernel_launch: hipFuncSetAttribute failed\n"); grid = -1; return; }
        if (hipOccupancyMaxActiveBlocksPerMultiprocessor(&per_cu, (const void*)mk_fwd, 512, LDS_BYTES) != hipSuccess || per_cu < 1) fprintf(stderr, "kernel_launch: occupancy query reports %d\n", per_cu);
        (void)hipGetLastError();
        grid = cus;
    }
    if (grid < 0) return;
    if (hipMemsetAsync((char*)d_ws + WS_CTL, 0, CTL_ZERO_BYTES, stream) != hipSuccess) return;
    Args a{};
    for (int i = 0; i < N_IN; ++i) a.in[i] = (const float*)d_in[i];
    a.out = (float*)d_out; a.ws = (unsigned char*)d_ws;
    constexpr int NL = MK_N_LAUNCHES;
    for (int li = 0; li < NL; ++li) {
        a.ph_lo = (NL == N_PHASES) ? li : (li * N_PHASES) / NL; a.ph_hi = (NL == N_PHASES) ? li + 1 : ((li + 1) * N_PHASES) / NL; a.li = (NL == N_PHASES) ? 0 : li; a.pad = 0;
        hipLaunchKernelGGL(mk_fwd, dim3(grid), dim3(512), LDS_BYTES, stream, a);
    }
}
```
